# Optimizing an MI355X kernel written in HIP

```python
import math
import jax, jax.numpy as jnp
from jax import lax
import numpy as np

D_MODEL = 2048
BATCH = 1
SEQ = 8192
DEPTH = 1

D_MIX = D_MODEL
GLA_HEADS = 4
GLA_DV = D_MIX // 2
GLA_DK = GLA_DV // 2
GLA_HEAD_K = GLA_DK // GLA_HEADS
GLA_HEAD_V = GLA_DV // GLA_HEADS
GLA_GATE_RANK = 16
GLA_GATE_TAU = 16.0
GLA_CHUNK = 64
S5_WIDTH = D_MIX - GLA_DV
S5_GROUP = 16
S5_GROUPS = S5_WIDTH // S5_GROUP
S5_STATE = 64
S5_DT_MIN = 1e-3
S5_DT_MAX = 1e-1
PROJ_SPLITS = (GLA_DK, 2 * GLA_DK, 2 * GLA_DK + GLA_DV, 2 * GLA_DK + 2 * GLA_DV,
               2 * GLA_DK + 2 * GLA_DV + GLA_GATE_RANK)
PROJ_WIDTH = 2 * GLA_DK + 2 * GLA_DV + GLA_GATE_RANK + S5_WIDTH
N_EXPERTS = 32
TOP_K = 4
D_FF_EXPERT = D_MODEL
SWIGLU_ALPHA = 1.702
SWIGLU_LIMIT = 7.0
MOE_BLOCK = 128
RMS_EPS = 1e-6

kernel_name = "hymba_style_gla_s5_moe_block"


def rms_norm(x, g, eps=RMS_EPS):
    xf = x.astype(jnp.float32)
    y = xf * lax.rsqrt(jnp.mean(xf * xf, axis=-1, keepdims=True) + eps)
    return (y * g.astype(jnp.float32)).astype(x.dtype)


def gla_chunked(q, k, v, g):
    bsz, t, h, dk = q.shape
    dv = v.shape[-1]
    n = t // GLA_CHUNK

    def to_chunks(a):
        return a.astype(jnp.float32).reshape(bsz, n, GLA_CHUNK, h, a.shape[-1]).transpose(1, 0, 3, 2, 4)

    causal = jnp.tril(jnp.ones((GLA_CHUNK, GLA_CHUNK), dtype=bool))[:, :, None]

    def step(state, inp):
        qc, kc, vc, gc = inp
        b = jnp.cumsum(gc, axis=2)
        o_inter = jnp.einsum('bhti,bhij->bhtj', qc * jnp.exp(b), state)
        diff = b[:, :, :, None, :] - b[:, :, None, :, :]
        decay = jnp.exp(jnp.where(causal, diff, -jnp.inf))
        scores = jnp.einsum('bhti,bhsi,bhtsi->bhts', qc, kc, decay)
        o = o_inter + jnp.einsum('bhts,bhsj->bhtj', scores, vc)
        b_last = b[:, :, -1:, :]
        state = (jnp.exp(b_last[:, :, 0, :])[..., None] * state
                 + jnp.einsum('bhsi,bhsj->bhij', kc * jnp.exp(b_last - b), vc))
        return state, o

    state0 = jnp.zeros((bsz, h, dk, dv), jnp.float32)
    _, o = lax.scan(step, state0, (to_chunks(q), to_chunks(k), to_chunks(v), to_chunks(g)))
    return o.transpose(1, 0, 3, 2, 4).reshape(bsz, t, h, dv)


def _ssm_combine(e1, e2):
    a1, b1 = e1
    a2, b2 = e2
    return a1 * a2, a2 * b1 + b2


def s5_scan(u, a_re, a_im, b_re, b_im, c_re, c_im, d_skip, log_step):
    bsz, t, _ = u.shape
    f32 = jnp.float32
    lam = lax.complex(a_re.astype(f32), a_im.astype(f32))
    delta = jnp.exp(log_step.astype(f32))[:, None]
    a_bar = jnp.exp(lam * delta)
    b_bar = ((a_bar - 1.0) / lam)[:, :, None] * lax.complex(b_re.astype(f32), b_im.astype(f32))
    c = lax.complex(c_re.astype(f32), c_im.astype(f32))
    ug = u.astype(f32).reshape(bsz, t, S5_GROUPS, S5_GROUP)
    bu = jnp.einsum('gpn,btgn->btgp', b_bar, ug.astype(jnp.complex64))
    a_seq = jnp.broadcast_to(a_bar, bu.shape)
    _, states = lax.associative_scan(_ssm_combine, (a_seq, bu), axis=1)
    y = jnp.real(jnp.einsum('gnp,btgp->btgn', c, states)) + d_skip.astype(f32) * ug
    return y.reshape(bsz, t, S5_WIDTH)


def hybrid_mixer(hn, w_in, gla_gate_w2, gla_gate_b, gla_norm_g, s5_a_re, s5_a_im, s5_b_re, s5_b_im,
                 s5_c_re, s5_c_im, s5_d, s5_log_step, s5_glu_w, s5_glu_b, s5_norm_g, w_out):
    bsz, t, _ = hn.shape
    f32 = jnp.float32
    proj = hn @ w_in
    q, k, v, r, g_lr, u = jnp.split(proj, PROJ_SPLITS, axis=-1)
    q = q.reshape(bsz, t, GLA_HEADS, GLA_HEAD_K) * (GLA_HEAD_K ** -0.5)
    k = k.reshape(bsz, t, GLA_HEADS, GLA_HEAD_K)
    v = v.reshape(bsz, t, GLA_HEADS, GLA_HEAD_V)
    log_gate = jax.nn.log_sigmoid((g_lr @ gla_gate_w2 + gla_gate_b).astype(f32)) / GLA_GATE_TAU
    log_gate = log_gate.reshape(bsz, t, GLA_HEADS, GLA_HEAD_K)
    o = gla_chunked(q, k, v, log_gate)
    o = rms_norm(o, gla_norm_g) * jax.nn.silu(r.astype(f32).reshape(bsz, t, GLA_HEADS, GLA_HEAD_V))
    gla_out = o.reshape(bsz, t, GLA_DV).astype(hn.dtype)
    y = s5_scan(u, s5_a_re, s5_a_im, s5_b_re, s5_b_im, s5_c_re, s5_c_im, s5_d, s5_log_step)
    z = jax.nn.gelu(y)
    z = z * jax.nn.sigmoid(z @ s5_glu_w.astype(f32) + s5_glu_b.astype(f32))
    s5_out = rms_norm(z, s5_norm_g).astype(hn.dtype)
    return jnp.concatenate([gla_out, s5_out], axis=-1) @ w_out


def moe_ffn(hn, router_w, router_b, w1, b1, w2, b2):
    bsz, t, d = hn.shape
    n_tok = bsz * t
    xt = hn.reshape(n_tok, d)
    logits = (xt @ router_w + router_b).astype(jnp.float32)
    top_val, top_idx = lax.top_k(logits, TOP_K)
    gates = jax.nn.softmax(top_val, axis=-1)
    n_assign = n_tok * TOP_K
    flat_e = top_idx.reshape(-1).astype(jnp.int32)
    flat_tok = jnp.arange(n_assign, dtype=jnp.int32) // TOP_K
    order = jnp.argsort(flat_e)
    sorted_e = flat_e[order]
    counts = jnp.bincount(flat_e, length=N_EXPERTS)
    starts = jnp.cumsum(counts) - counts
    padded = (counts + MOE_BLOCK - 1) // MOE_BLOCK * MOE_BLOCK
    pad_ends = jnp.cumsum(padded)
    pad_starts = pad_ends - padded
    dest = pad_starts[sorted_e] + (jnp.arange(n_assign, dtype=jnp.int32) - starts[sorted_e])
    num_blocks = (n_assign + N_EXPERTS * (MOE_BLOCK - 1) + MOE_BLOCK - 1) // MOE_BLOCK
    n_rows = num_blocks * MOE_BLOCK
    row_tok = jnp.full((n_rows,), n_tok, jnp.int32).at[dest].set(flat_tok[order])
    row_gate = jnp.zeros((n_rows,), jnp.float32).at[dest].set(gates.reshape(-1)[order])
    block_e = jnp.minimum(
        jnp.searchsorted(pad_ends, jnp.arange(num_blocks, dtype=jnp.int32) * MOE_BLOCK, side='right'),
        N_EXPERTS - 1)
    x_pad = jnp.concatenate([xt, jnp.zeros((1, d), xt.dtype)], axis=0)
    xs = x_pad[row_tok].reshape(num_blocks, MOE_BLOCK, d)

    def expert_block(args):
        xb, e = args
        hcat = xb @ w1[e] + b1[e]
        glu, lin = jnp.split(hcat, 2, axis=-1)
        glu = jnp.minimum(glu, SWIGLU_LIMIT)
        lin = jnp.clip(lin, -SWIGLU_LIMIT, SWIGLU_LIMIT)
        act = glu * jax.nn.sigmoid(SWIGLU_ALPHA * glu) * (lin + 1.0)
        return act @ w2[e] + b2[e]

    ys = lax.map(expert_block, (xs, block_e)).reshape(n_rows, d)
    out = jax.ops.segment_sum(ys * row_gate[:, None].astype(ys.dtype), row_tok, num_segments=n_tok + 1)[:n_tok]
    return out.reshape(bsz, t, d)


def setup_inputs(seed: int = 0) -> dict:
    key = jax.random.key(seed)
    ks = jax.random.split(key, 26)
    L = DEPTH

    def nrm(k, shape, scale):
        return scale * jax.random.normal(k, shape, jnp.float32)

    n_idx = jnp.arange(S5_STATE, dtype=jnp.float32)
    return {
        "x": nrm(ks[0], (BATCH, SEQ, D_MODEL), 1.0),
        "norm1_g": 1.0 + nrm(ks[1], (L, D_MODEL), 0.02),
        "w_in": nrm(ks[2], (L, D_MODEL, PROJ_WIDTH), D_MODEL ** -0.5),
        "gla_gate_w2": nrm(ks[3], (L, GLA_GATE_RANK, GLA_DK), GLA_GATE_RANK ** -0.5),
        "gla_gate_b": nrm(ks[4], (L, GLA_DK), 0.1),
        "gla_norm_g": 1.0 + nrm(ks[5], (L, GLA_HEAD_V), 0.02),
        "s5_a_re": -0.5 + nrm(ks[6], (L, S5_GROUPS, S5_STATE), 0.01),
        "s5_a_im": math.pi * n_idx + nrm(ks[7], (L, S5_GROUPS, S5_STATE), 0.01),
        "s5_b_re": nrm(ks[8], (L, S5_GROUPS, S5_STATE, S5_GROUP), (2 * S5_GROUP) ** -0.5),
        "s5_b_im": nrm(ks[9], (L, S5_GROUPS, S5_STATE, S5_GROUP), (2 * S5_GROUP) ** -0.5),
        "s5_c_re": nrm(ks[10], (L, S5_GROUPS, S5_GROUP, S5_STATE), S5_STATE ** -0.5),
        "s5_c_im": nrm(ks[11], (L, S5_GROUPS, S5_GROUP, S5_STATE), S5_STATE ** -0.5),
        "s5_d": nrm(ks[12], (L, S5_GROUPS, S5_GROUP), 0.5),
        "s5_log_step": jax.random.uniform(ks[13], (L, S5_GROUPS), jnp.float32,
                                          math.log(S5_DT_MIN), math.log(S5_DT_MAX)),
        "s5_glu_w": nrm(ks[14], (L, S5_WIDTH, S5_WIDTH), S5_WIDTH ** -0.5),
        "s5_glu_b": nrm(ks[15], (L, S5_WIDTH), 0.02),
        "s5_norm_g": 1.0 + nrm(ks[16], (L, S5_WIDTH), 0.02),
        "w_out": nrm(ks[17], (L, D_MIX, D_MODEL), D_MIX ** -0.5),
        "norm2_g": 1.0 + nrm(ks[18], (L, D_MODEL), 0.02),
        "router_w": nrm(ks[19], (L, D_MODEL, N_EXPERTS), D_MODEL ** -0.5),
        "router_b": nrm(ks[20], (L, N_EXPERTS), 0.01),
        "expert_w1": nrm(ks[21], (L, N_EXPERTS, D_MODEL, 2 * D_FF_EXPERT), D_MODEL ** -0.5),
        "expert_b1": nrm(ks[22], (L, N_EXPERTS, 2 * D_FF_EXPERT), 0.02),
        "expert_w2": nrm(ks[23], (L, N_EXPERTS, D_FF_EXPERT, D_MODEL), D_FF_EXPERT ** -0.5),
        "expert_b2": nrm(ks[24], (L, N_EXPERTS, D_MODEL), 0.02),
        "final_norm_g": 1.0 + nrm(ks[25], (D_MODEL,), 0.02),
    }


def reference(x, norm1_g, w_in, gla_gate_w2, gla_gate_b, gla_norm_g, s5_a_re, s5_a_im, s5_b_re, s5_b_im,
              s5_c_re, s5_c_im, s5_d, s5_log_step, s5_glu_w, s5_glu_b, s5_norm_g, w_out, norm2_g,
              router_w, router_b, expert_w1, expert_b1, expert_w2, expert_b2, final_norm_g):
    h = x
    for l in range(DEPTH):
        hn = rms_norm(h, norm1_g[l])
        h = h + hybrid_mixer(hn, w_in[l], gla_gate_w2[l], gla_gate_b[l], gla_norm_g[l],
                             s5_a_re[l], s5_a_im[l], s5_b_re[l], s5_b_im[l], s5_c_re[l], s5_c_im[l],
                             s5_d[l], s5_log_step[l], s5_glu_w[l], s5_glu_b[l], s5_norm_g[l], w_out[l])
        hn = rms_norm(h, norm2_g[l])
        h = h + moe_ffn(hn, router_w[l], router_b[l], expert_w1[l], expert_b1[l], expert_w2[l], expert_b2[l])
    return rms_norm(h, final_norm_g)
```

```cpp
#include <hip/hip_runtime.h>
#include <hip/hip_bf16.h>
#include <stdint.h>
#include <stdio.h>

#ifndef N_LAUNCH_SPLIT
#define N_LAUNCH_SPLIT 0
#endif

#define DEVI __device__ __forceinline__
typedef __attribute__((ext_vector_type(8))) short bf16x8;
typedef __attribute__((ext_vector_type(4))) float f32x4;
typedef __attribute__((ext_vector_type(4))) int i32x4;
typedef __attribute__((ext_vector_type(2))) float f2v;
typedef __attribute__((ext_vector_type(2))) __bf16 b2v;
typedef unsigned short u16;

constexpr int T = 8192, D = 2048, PW = 4112;
constexpr int NH = 4, HK = 128, HV = 256, CH = 64, NCH = 128, RANK = 16;
constexpr int SW = 1024, SG = 16, NG = 64, SP = 64;
constexpr int NE = 32, FF = 2048, CAP = 8192;
constexpr int PJ = 4096;
constexpr float EPS = 1e-6f;

constexpr size_t WS_BAR   = 0;
constexpr size_t WS_CNT   = 32768;
constexpr size_t WS_SSQ   = 65536;
constexpr size_t WS_GLR   = WS_SSQ + 65536;
constexpr size_t WS_DEC   = WS_GLR + (size_t)T * 16 * 4;
constexpr size_t WS_S5AL  = WS_DEC + (size_t)NCH * NH * HK * 4;
constexpr size_t WS_TSLOT = WS_S5AL + 65536;
constexpr size_t WS_LTOK  = WS_TSLOT + (size_t)T * 4 * 4;
constexpr size_t WS_LGATE = WS_LTOK + (size_t)NE * CAP * 4;
constexpr size_t WS_S5K   = WS_LGATE + (size_t)NE * CAP * 4;
constexpr size_t WS_S5WE  = WS_S5K + (size_t)NG * 64 * 256 * 2;
constexpr size_t WS_S5V   = WS_S5WE + (size_t)NG * 128 * 1024 * 2;
constexpr size_t WS_S5E   = WS_S5V + (size_t)NG * 1024 * 128 * 2;
constexpr size_t WS_S5H   = WS_S5E + (size_t)NG * 128 * 128 * 4;
constexpr size_t WS_HN    = WS_S5H + (size_t)NG * 128 * 128 * 2;
constexpr size_t WS_PROJ  = WS_HN + (size_t)T * D * 2;
constexpr size_t WS_KV    = WS_PROJ + (size_t)T * PJ * 2;
constexpr size_t WS_ST    = WS_KV + (size_t)NCH * NH * HV * HK * 4;
constexpr size_t WS_Z     = WS_ST + (size_t)NCH * NH * HV * HK * 2;
constexpr size_t WS_MIX   = WS_Z + (size_t)T * SW * 2;
constexpr size_t WS_H1    = WS_MIX + (size_t)T * D * 2;
constexpr size_t WS_HN2   = WS_H1 + (size_t)T * D * 4;
constexpr size_t WS_ACT   = WS_HN2 + (size_t)T * D * 2;
constexpr size_t WS_Y     = WS_ACT + (size_t)(T * 4 + 256) * FF * 2;
constexpr size_t WS_W1T   = WS_Y + (size_t)(T * 4 + 256) * D * 2;
constexpr size_t WS_W2T   = WS_W1T + (size_t)NE * 4096 * D;
constexpr size_t WS_WINT  = WS_W2T + (size_t)NE * D * FF;
constexpr size_t WS_GLUT  = WS_WINT + (size_t)PJ * D * 2;
constexpr size_t WS_WOUTT = WS_GLUT + (size_t)SW * SW * 2;
constexpr size_t WS_END   = WS_WOUTT + (size_t)D * D * 2;

constexpr int LDS_BYTES = 163840;
constexpr int LDS_CONV = 131072;
constexpr int LDS_BASE = 1024;

DEVI unsigned pack2(float a, float b) { f2v v = {a, b}; b2v r = __builtin_convertvector(v, b2v); return __builtin_bit_cast(unsigned, r); }
DEVI u16 f2bf(float a) { __bf16 r = (__bf16)a; return __builtin_bit_cast(u16, r); }
DEVI float bf2f(u16 h) { return __uint_as_float(((unsigned)h) << 16); }
DEVI float bflo(unsigned w) { return __uint_as_float(w << 16); }
DEVI float bfhi(unsigned w) { return __uint_as_float(w & 0xffff0000u); }
DEVI float wave_sum(float v) {
#pragma unroll
    for (int o = 32; o >= 1; o >>= 1) v += __shfl_xor(v, o);
    return v;
}
DEVI float sum16(float v) {
#pragma unroll
    for (int o = 8; o >= 1; o >>= 1) v += __shfl_xor(v, o);
    return v;
}
DEVI float sigmoidf_(float x) { return __builtin_amdgcn_rcpf(1.0f + __expf(-x)); }
DEVI float logsigmoid_(float x) { return fminf(x, 0.0f) - __logf(1.0f + __expf(-fabsf(x))); }
DEVI float gelu_tanh(float x) {
    const float a = 0.7978845608028654f * (x + 0.044715f * x * x * x);
    return x * __builtin_amdgcn_rcpf(1.0f + __expf(-2.0f * a));
}

#define WAIT_V0() asm volatile("s_waitcnt vmcnt(0)" ::: "memory")
#define WAIT_L0() asm volatile("s_waitcnt lgkmcnt(0)" ::: "memory")

#define XB_TMO      128
#define XB_XCNT(j)  (256  + 64 * (j))
#define XB_XSUB(j)  (1280 + 64 * (j))
#define XB_XGEN(j)  (2304 + 64 * (j))
#define XB_TOP      3328
#define XB_TOPGEN   3392
#define XCD_BAR_WORDS 3456
#define XB_SPIN_CAP (1u << 20)
#define LAS __attribute__((address_space(3)))

DEVI unsigned xb_ld(unsigned* p)              { return __hip_atomic_load(p, __ATOMIC_RELAXED, __HIP_MEMORY_SCOPE_AGENT); }
DEVI unsigned xb_add(unsigned* p, unsigned v) { return __hip_atomic_fetch_add(p, v, __ATOMIC_RELAXED, __HIP_MEMORY_SCOPE_AGENT); }
DEVI unsigned xb_xcc_id() { return (unsigned)__builtin_amdgcn_s_getreg((3 << 11) | 20) & 0xFu; }
#define XB_SPIN(cond, bar) do { unsigned _sp = 0; while (cond) { __builtin_amdgcn_s_sleep(1); \
    if ((++_sp & 255u) == 0u) { if (xb_ld(&(bar)[XB_TMO])) break; if (_sp > XB_SPIN_CAP) { atomicAdd(&(bar)[XB_TMO], 1u); break; } } } } while (0)

struct XcdBarrier { unsigned* bar; unsigned x; volatile LAS unsigned* st; };

DEVI XcdBarrier xcd_barrier_post(unsigned* bar, volatile LAS unsigned* st) {
    XcdBarrier b; b.bar = bar; b.x = xb_xcc_id(); b.st = st;
    if (threadIdx.x == 0) (void)xb_add(&bar[XB_XCNT(b.x)], 1u);
    return b;
}
DEVI void xcd_barrier_complete(unsigned* bar, unsigned x, unsigned& nloc, unsigned& nx) {
    const unsigned G = gridDim.x * gridDim.y * gridDim.z;
    unsigned sum, cnt, mine, sp = 0u;
    for (;;) {
        sum = 0u; cnt = 0u; mine = 0u;
#pragma unroll
        for (unsigned j = 0; j < 16; ++j) { const unsigned c = xb_ld(&bar[XB_XCNT(j)]); sum += c; cnt += (c > 0u) ? 1u : 0u; mine = (j == x) ? c : mine; }
        if (sum == G) break;
        __builtin_amdgcn_s_sleep(1);
        if ((++sp & 255u) == 0u) { if (xb_ld(&bar[XB_TMO])) break; if (sp > XB_SPIN_CAP) { atomicAdd(&bar[XB_TMO], 1u); break; } }
    }
    nloc = mine > 0u ? mine : 1u; nx = cnt > 0u ? cnt : 1u;
}
DEVI void xcd_barrier(const XcdBarrier& b) {
    asm volatile("s_waitcnt vmcnt(0)" ::: "memory");
    __syncthreads();
    if (threadIdx.x == 0) {
        unsigned* bar = b.bar;
        __builtin_amdgcn_s_waitcnt(0);
        unsigned nloc = b.st[0], nx = b.st[1];
        if (nloc == 0u) { xcd_barrier_complete(bar, b.x, nloc, nx); b.st[0] = nloc; b.st[1] = nx; }
        const unsigned old = xb_add(&bar[XB_XSUB(b.x)], 1u);
        const unsigned gen = old / nloc;
        if (old + 1u == (gen + 1u) * nloc) {
            __builtin_amdgcn_fence(__ATOMIC_RELEASE, "agent");
            asm volatile("s_waitcnt vmcnt(0)" ::: "memory");
            const unsigned og = xb_add(&bar[XB_TOP], 1u);
            const unsigned tg = og / nx;
            if (og + 1u == (tg + 1u) * nx) xb_add(&bar[XB_TOPGEN], 1u);
            else XB_SPIN(xb_ld(&bar[XB_TOPGEN]) == tg, bar);
            __builtin_amdgcn_fence(__ATOMIC_ACQUIRE, "agent");
            xb_add(&bar[XB_XGEN(b.x)], 1u);
            asm volatile("s_waitcnt vmcnt(0)" ::: "memory");
        } else {
            XB_SPIN(xb_ld(&bar[XB_XGEN(b.x)]) == gen, bar);
            __builtin_amdgcn_fence(__ATOMIC_ACQUIRE, "agent");
            asm volatile("s_waitcnt vmcnt(0)" ::: "memory");
        }
    }
    __syncthreads();
}

struct Args {
    const float* in[26];
    float* out;
    unsigned char* ws;
    int ph_lo, ph_hi;
};

template <int KS> DEVI int lds_byte(int r, int c) {
    int st = (r >> 4) * KS + (c >> 5), ob = (r & 15) * 64 + (c & 31) * 2;
    return st * 1024 + (ob ^ (((ob >> 9) & 1) << 5));
}
typedef __attribute__((ext_vector_type(16))) float f32x16;
typedef __attribute__((ext_vector_type(8))) int i32x8;
DEVI void f8_stage_rb(int wid, int lane, int i, int& R, int& CB) {
    R = wid * 16 + i * 128 + (lane >> 2);
    CB = (((lane & 3) ^ (R >> 2)) & 3) * 16;
}
DEVI int acc_row32(int wr, int m, int r, int lane) { return wr * 128 + m * 32 + (r & 3) + 8 * (r >> 2) + 4 * (lane >> 5); }
DEVI unsigned cvt4_fp8(float a, float b, float c, float d) {
    int r = 0;
    r = __builtin_amdgcn_cvt_pk_fp8_f32(a, b, r, false);
    r = __builtin_amdgcn_cvt_pk_fp8_f32(c, d, r, true);
    return (unsigned)r;
}
#define WAIT_VN(n) asm volatile("s_waitcnt vmcnt(" #n ")" ::: "memory")
DEVI void f8_stage(char* lds, const unsigned char* __restrict__ A, const unsigned (&aoff)[2], const unsigned char* __restrict__ B, const unsigned (&boffv)[2], int wid, int t) {
    char* sb = lds + (t & 3) * 32768 + wid * 1024;
#pragma unroll
    for (int i = 0; i < 2; ++i) {
        __builtin_amdgcn_global_load_lds((const unsigned*)(A + aoff[i] + t * 64), (LAS unsigned*)(sb + i * 8192), 16, 0, 0);
        __builtin_amdgcn_global_load_lds((const unsigned*)(B + boffv[i] + t * 64), (LAS unsigned*)(sb + 16384 + i * 8192), 16, 0, 0);
    }
}
DEVI void f8_prefetch(char* lds, const unsigned char* __restrict__ A, const unsigned (&aoff)[2], const unsigned char* __restrict__ B, const unsigned (&boffv)[2], int wid) {
    f8_stage(lds, A, aoff, B, boffv, wid, 0); f8_stage(lds, A, aoff, B, boffv, wid, 1); f8_stage(lds, A, aoff, B, boffv, wid, 2);
}
DEVI void q8_stage(char* lds, const unsigned char* __restrict__ A, const unsigned (&aoff)[2], const unsigned char* __restrict__ B, const unsigned (&boffv)[2], int wid, int t) {
    char* sb = lds + (t & 3) * 32768 + wid * 1024;
#pragma unroll
    for (int i = 0; i < 2; ++i) {
        __builtin_amdgcn_global_load_lds((const unsigned*)(A + aoff[i] + t * 64), (LAS unsigned*)(sb + i * 8192), 16, 0, 0);
        __builtin_amdgcn_global_load_lds((const unsigned*)(B + boffv[i] + t * 8192), (LAS unsigned*)(sb + 16384 + i * 8192), 16, 0, 0);
    }
}
DEVI void q8_prefetch(char* lds, const unsigned char* __restrict__ A, const unsigned (&aoff)[2], const unsigned char* __restrict__ B, const unsigned (&boffv)[2], int wid) {
    q8_stage(lds, A, aoff, B, boffv, wid, 0); q8_stage(lds, A, aoff, B, boffv, wid, 1); q8_stage(lds, A, aoff, B, boffv, wid, 2);
}
template <int NT, int SCALE_A, int SCALE_B, bool MOE1>
DEVI void f8_mainloop(char* lds, const unsigned char* __restrict__ A, const unsigned (&aoff)[2], const unsigned char* __restrict__ B, const unsigned (&boffv)[2],
                      int wid, int lane, f32x16 (&acc)[2][4]) {
    const int wr = wid >> 2, wc = wid & 3, l31 = lane & 31, hh = lane >> 5;
    const int xs = (l31 >> 2) & 3;
    const int p0 = ((2 * hh) ^ xs) << 4, p1 = ((2 * hh + 1) ^ xs) << 4;
    const int a_lo = (wr * 128 + l31) * 64 + p0, a_hi = (wr * 128 + l31) * 64 + p1;
    int b_rd[2];
#pragma unroll
    for (int nf = 0; nf < 2; ++nf) {
        const int ntile = MOE1 ? nf : (wc >> 1), nbase = MOE1 ? wc * 32 : (wc & 1) * 64 + nf * 32;
        b_rd[nf] = 16384 + ntile * 8192 + (8 * hh) * 512 + (nbase + l31) * 4;
    }
    auto ldfrag = [&](const char* sa, int lo, int hi) -> i32x8 {
        const i32x4 x = *(const i32x4*)(sa + lo), y = *(const i32x4*)(sa + hi);
        i32x8 r; r[0] = x[0]; r[1] = x[1]; r[2] = x[2]; r[3] = x[3]; r[4] = y[0]; r[5] = y[1]; r[6] = y[2]; r[7] = y[3];
        return r;
    };
    auto compute = [&](int t) {
        const char* sa = lds + (t & 3) * 32768;
        i32x8 fa[4], fb[2];
#pragma unroll
        for (int m = 0; m < 4; ++m) fa[m] = ldfrag(sa + m * 2048, a_lo, a_hi);
#pragma unroll
        for (int n = 0; n < 2; ++n)
#pragma unroll
            for (int j = 0; j < 8; ++j) fb[n][j] = *(const int*)(sa + b_rd[n] + j * 512);
#pragma unroll
        for (int m = 0; m < 4; ++m)
#pragma unroll
            for (int n = 0; n < 2; ++n)
                acc[n][m] = __builtin_amdgcn_mfma_scale_f32_32x32x64_f8f6f4(fb[n], fa[m], acc[n][m], 0, 0, 0, SCALE_B, 0, SCALE_A);
    };
    WAIT_V0(); __builtin_amdgcn_s_barrier();
#pragma unroll 1
    for (int t = 0; t < NT; ++t) {
        if (t + 3 < NT) q8_stage(lds, A, aoff, B, boffv, wid, t + 3);
        compute(t);
        if (t + 3 < NT) { WAIT_VN(8); } else if (t + 2 < NT) { WAIT_VN(4); } else { WAIT_V0(); }
        WAIT_L0(); __builtin_amdgcn_s_barrier();
    }
}
DEVI void touch4(const f32x4& v) { asm volatile("" :: "v"(v)); }
DEVI void touchf(float v) { asm volatile("" :: "v"(v)); }
DEVI void zero_acc32(f32x16 (&acc)[2][4]) {
#pragma unroll
    for (int n = 0; n < 2; ++n)
#pragma unroll
        for (int m = 0; m < 4; ++m)
#pragma unroll
            for (int r = 0; r < 16; ++r) acc[n][m][r] = 0.f;
}

DEVI void bf_stage_rb(int wid, int lane, int i, int& R, int& CB) {
    R = wid * 16 + i * 128 + (lane >> 2);
    CB = (((lane & 3) ^ (R >> 1)) & 3) * 16;
}
template <int NT>
DEVI void bf_mainloop(char* lds, const unsigned char* __restrict__ A, const unsigned (&aoff)[2], const unsigned char* __restrict__ B, const unsigned (&boffv)[2],
                      int wid, int lane, f32x4 (&acc)[4][8]) {
    const int wr = wid >> 2, wc = wid & 3, l15 = lane & 15, q = lane >> 4;
    const int cp = (q ^ ((l15 >> 1) & 3)) << 4;
    const int t_rd = (wr * 128 + l15) * 64 + cp;
    const int w_rd = 16384 + (wc * 64 + l15) * 64 + cp;
    auto compute = [&](int t) {
        const char* sa = lds + (t & 3) * 32768;
        bf16x8 tf[8], wf[4];
#pragma unroll
        for (int nt = 0; nt < 4; ++nt) wf[nt] = *(const bf16x8*)(sa + w_rd + nt * 1024);
#pragma unroll
        for (int mt = 0; mt < 8; ++mt) tf[mt] = *(const bf16x8*)(sa + t_rd + mt * 1024);
#pragma unroll
        for (int mt = 0; mt < 8; ++mt)
#pragma unroll
            for (int nt = 0; nt < 4; ++nt)
                acc[nt][mt] = __builtin_amdgcn_mfma_f32_16x16x32_bf16(wf[nt], tf[mt], acc[nt][mt], 0, 0, 0);
    };
    WAIT_V0(); __builtin_amdgcn_s_barrier();
#pragma unroll 1
    for (int t = 0; t < NT; ++t) {
        if (t + 3 < NT) f8_stage(lds, A, aoff, B, boffv, wid, t + 3);
        compute(t);
        if (t + 3 < NT) { WAIT_VN(8); } else if (t + 2 < NT) { WAIT_VN(4); } else { WAIT_V0(); }
        WAIT_L0(); __builtin_amdgcn_s_barrier();
    }
}
DEVI void zero_acc16(f32x4 (&acc)[4][8]) {
#pragma unroll
    for (int nt = 0; nt < 4; ++nt)
#pragma unroll
        for (int mt = 0; mt < 8; ++mt) acc[nt][mt] = f32x4{0.f, 0.f, 0.f, 0.f};
}
DEVI void bf_offsets(unsigned (&off)[2], int wid, int lane, int row0, int ld) {
#pragma unroll
    for (int i = 0; i < 2; ++i) { int R, CB; bf_stage_rb(wid, lane, i, R, CB); off[i] = ((unsigned)(row0 + R) * ld) * 2u + CB; }
}

DEVI void dense_convert(const Args& a, char* lds, int tid, int wid, int lane) {
    constexpr int RS = 132;
    unsigned* L = (unsigned*)lds;
    const int kq = tid >> 5, nq = tid & 31;
    auto tile = [&](int tl, const float*& src, int& ld, int& ldo, u16*& dst) {
        if (tl < 512) { const int kt = tl & 15, nt = tl >> 4; const int c0 = (nt < 24) ? nt * 128 : 3088 + (nt - 24) * 128;
            src = a.in[2] + (size_t)(kt * 128) * PW + c0; ld = PW; ldo = D; dst = (u16*)(a.ws + WS_WINT) + (size_t)(nt * 128) * D + kt * 128; }
        else if (tl < 576) { const int t2 = tl - 512, kt = t2 & 7, nt = t2 >> 3;
            src = a.in[14] + (size_t)(kt * 128) * SW + nt * 128; ld = SW; ldo = SW; dst = (u16*)(a.ws + WS_GLUT) + (size_t)(nt * 128) * SW + kt * 128; }
        else { const int t2 = tl - 576, kt = t2 & 15, nt = t2 >> 4;
            src = a.in[17] + (size_t)(kt * 128) * D + nt * 128; ld = D; ldo = D; dst = (u16*)(a.ws + WS_WOUTT) + (size_t)(nt * 128) * D + kt * 128; }
    };
    f32x4 v[2][4];
    auto issue = [&](int tl) {
        const float* src; int ld, ldo; u16* dst; tile(tl, src, ld, ldo, dst);
#pragma unroll
        for (int h = 0; h < 2; ++h)
#pragma unroll
            for (int r = 0; r < 4; ++r) v[h][r] = *(const f32x4*)(src + (size_t)(4 * (kq + 16 * h) + r) * ld + 4 * nq);
    };
    if ((int)blockIdx.x < 832) issue(blockIdx.x);
#pragma unroll 1
    for (int tl = blockIdx.x; tl < 832; tl += gridDim.x) {
        const float* src; int ld, ldo; u16* dst; tile(tl, src, ld, ldo, dst);
        __syncthreads();
#pragma unroll
        for (int h = 0; h < 2; ++h) {
            i32x4 d0, d1;
#pragma unroll
            for (int c = 0; c < 4; ++c) { d0[c] = (int)pack2(v[h][0][c], v[h][1][c]); d1[c] = (int)pack2(v[h][2][c], v[h][3][c]); }
            *(i32x4*)(L + (2 * (kq + 16 * h)) * RS + 4 * nq) = d0;
            *(i32x4*)(L + (2 * (kq + 16 * h) + 1) * RS + 4 * nq) = d1;
        }
        if (tl + (int)gridDim.x < 832) issue(tl + gridDim.x);
        __syncthreads();
        {
            const int part = wid & 3, n = (wid >> 2) * 64 + lane;
            unsigned o[16];
#pragma unroll
            for (int j = 0; j < 16; ++j) o[j] = L[(16 * part + j) * RS + n];
            uint4* dp = (uint4*)(dst + (size_t)n * ldo + 32 * part);
            dp[0] = make_uint4(o[0], o[1], o[2], o[3]); dp[1] = make_uint4(o[4], o[5], o[6], o[7]);
            dp[2] = make_uint4(o[8], o[9], o[10], o[11]); dp[3] = make_uint4(o[12], o[13], o[14], o[15]);
        }
    }
}

DEVI void convert_range(const Args& a, char* lds, int t_lo, int t_hi, int tid, int wid, int lane) {
    const float* w1 = a.in[21]; const float* w2 = a.in[23];
    unsigned char* W1Q = a.ws + WS_W1T; unsigned char* W2Q = a.ws + WS_W2T;
    { int lq = lane; asm volatile("" : "+v"(lq)); lane = lq; tid = wid * 64 + lq; }
    const int kq0 = tid >> 5, n4 = tid & 31;
    auto tile_src = [&](int tl, const float*& src, int& ld, unsigned char*& dst) {
        if (tl < 16384) { const int kt = tl & 15, nt = (tl >> 4) & 31, e = tl >> 9;
            src = w1 + (size_t)e * D * 4096 + (size_t)(kt * 128) * 4096 + nt * 128; ld = 4096;
            dst = W1Q + ((size_t)(e * 32 + nt) * 512 + kt * 32) * 512; }
        else { const int t2 = tl - 16384, kt = t2 & 15, nt = (t2 >> 4) & 15, e = t2 >> 8;
            src = w2 + (size_t)e * FF * D + (size_t)(kt * 128) * D + nt * 128; ld = D;
            dst = W2Q + ((size_t)(e * 16 + nt) * 512 + kt * 32) * 512; }
    };
    f32x4 va[2][4], vb[2][4];
    auto issue = [&](int tl, f32x4 (&v)[2][4]) {
        const float* src; int ld; unsigned char* dst; tile_src(tl, src, ld, dst);
#pragma unroll
        for (int h = 0; h < 2; ++h)
#pragma unroll
            for (int r = 0; r < 4; ++r) v[h][r] = __builtin_nontemporal_load((const f32x4*)(src + (size_t)(4 * (kq0 + 16 * h) + r) * ld + 4 * n4));
    };
    auto finish = [&](int tl, f32x4 (&v)[2][4], int tnext) {
        const float* src; int ld; unsigned char* dst; tile_src(tl, src, ld, dst);
        uint4 o[2];
#pragma unroll
        for (int h = 0; h < 2; ++h) {
            o[h].x = cvt4_fp8(v[h][0][0] * 256.f, v[h][1][0] * 256.f, v[h][2][0] * 256.f, v[h][3][0] * 256.f);
            o[h].y = cvt4_fp8(v[h][0][1] * 256.f, v[h][1][1] * 256.f, v[h][2][1] * 256.f, v[h][3][1] * 256.f);
            o[h].z = cvt4_fp8(v[h][0][2] * 256.f, v[h][1][2] * 256.f, v[h][2][2] * 256.f, v[h][3][2] * 256.f);
            o[h].w = cvt4_fp8(v[h][0][3] * 256.f, v[h][1][3] * 256.f, v[h][2][3] * 256.f, v[h][3][3] * 256.f);
        }
        if (tnext < t_hi) issue(tnext, v);
#pragma unroll
        for (int h = 0; h < 2; ++h) *(uint4*)(dst + ((size_t)(kq0 + 16 * h) * 128 + 4 * n4) * 4) = o[h];
    };
    if (t_lo < t_hi) issue(t_lo, va);
    if (t_lo + 1 < t_hi) issue(t_lo + 1, vb);
#pragma unroll 1
    for (int tl = t_lo; tl < t_hi; tl += 2) {
        finish(tl, va, tl + 2);
        if (tl + 1 < t_hi) finish(tl + 1, vb, tl + 3);
    }
}

DEVI void convert_pool(const Args& a, char* lds, int which, int p_lo, int p_hi, int tid, int wid, int lane) {
    int* cur = (int*)(a.ws + WS_CNT) + 64 + which;
    volatile int* bc = (volatile int*)(lds - LDS_BASE + 32);
#pragma unroll 1
    while (true) {
        __syncthreads();
        if (tid == 0) *bc = atomicAdd(cur, 4);
        __syncthreads();
        const int t = p_lo + *bc;
        if (t >= p_hi) break;
        convert_range(a, lds, t, min(t + 4, p_hi), tid, wid, lane);
    }
}

DEVI void phase0(const Args& a, char* lds, int tid, int wid, int lane) {
    const float* x = a.in[0]; const float* g1 = a.in[1]; const float* w_in = a.in[2];
    u16* HN = (u16*)(a.ws + WS_HN); float* GLR = (float*)(a.ws + WS_GLR);
    float* Wt = (float*)lds;
    for (int u = blockIdx.x; u < 256; u += gridDim.x) {
        __syncthreads();
        for (int k = 0; k < 4; ++k) {
            const int d = (tid + 512 * k + 8 * (int)blockIdx.x) & 2047;
            const f32x4* src = (const f32x4*)(w_in + (size_t)d * PW + 3072);
#pragma unroll
            for (int q = 0; q < 4; ++q) { f32x4 v = src[q];
#pragma unroll
                for (int c = 0; c < 4; ++c) Wt[(q * 4 + c) * 2048 + d] = v[c]; }
        }
        if (tid < 32) ((float*)(a.ws + WS_SSQ))[u * 32 + tid] = 0.f;
        if (u == 0 && tid < 32) { ((int*)(a.ws + WS_CNT))[tid] = 0; ((int*)(a.ws + WS_CNT))[64 + tid] = 0; }
        __syncthreads();
        for (int pr = 0; pr < 2; ++pr) {
            const int tokA = u * 32 + wid * 4 + pr * 2, tokB = tokA + 1;
            f32x4 xa[8], xb[8];
            float ssa = 0.f, ssb = 0.f;
#pragma unroll
            for (int i = 0; i < 8; ++i) {
                xa[i] = *(const f32x4*)(x + (size_t)tokA * D + 256 * i + 4 * lane);
                xb[i] = *(const f32x4*)(x + (size_t)tokB * D + 256 * i + 4 * lane);
#pragma unroll
                for (int c = 0; c < 4; ++c) { ssa += xa[i][c] * xa[i][c]; ssb += xb[i][c] * xb[i][c]; }
            }
            ssa = wave_sum(ssa); ssb = wave_sum(ssb);
            const float ra = rsqrtf(ssa * (1.0f / D) + EPS), rb = rsqrtf(ssb * (1.0f / D) + EPS);
#pragma unroll
            for (int i = 0; i < 8; ++i) {
                const f32x4 g = *(const f32x4*)(g1 + 256 * i + 4 * lane);
#pragma unroll
                for (int c = 0; c < 4; ++c) { xa[i][c] *= ra * g[c]; xb[i][c] *= rb * g[c]; }
                uint2 pa, pb;
                pa.x = pack2(xa[i][0], xa[i][1]); pa.y = pack2(xa[i][2], xa[i][3]);
                pb.x = pack2(xb[i][0], xb[i][1]); pb.y = pack2(xb[i][2], xb[i][3]);
                *(uint2*)(HN + (size_t)tokA * D + 256 * i + 4 * lane) = pa;
                *(uint2*)(HN + (size_t)tokB * D + 256 * i + 4 * lane) = pb;
            }
            float oa = 0.f, ob = 0.f;
#pragma unroll 1
            for (int r = 0; r < 16; ++r) {
                float pa = 0.f, pb = 0.f;
#pragma unroll
                for (int i = 0; i < 8; ++i) {
                    const f32x4 w = *(const f32x4*)(Wt + r * 2048 + 256 * i + 4 * lane);
#pragma unroll
                    for (int c = 0; c < 4; ++c) { pa += xa[i][c] * w[c]; pb += xb[i][c] * w[c]; }
                }
                pa = wave_sum(pa); pb = wave_sum(pb);
                if (lane == r) { oa = pa; ob = pb; }
            }
            if (lane < 16) { GLR[(size_t)tokA * 16 + lane] = oa; GLR[(size_t)tokB * 16 + lane] = ob; }
        }
    }
    const float* a_re = a.in[6]; const float* a_im = a.in[7]; const float* b_re = a.in[8]; const float* b_im = a.in[9];
    const float* c_re = a.in[10]; const float* c_im = a.in[11]; const float* lstep = a.in[13];
    u16* KT = (u16*)(a.ws + WS_S5K); u16* WE = (u16*)(a.ws + WS_S5WE); u16* VV = (u16*)(a.ws + WS_S5V); float* AL = (float*)(a.ws + WS_S5AL);
    float* Bre = (float*)lds;
    float* Bim = Bre + 1024;
    float* Cre = Bim + 1024;
    float* Cim = Cre + 1024;
    float* Pre = Cim + 1024;
    float* Pim = Pre + 65 * 64;
    for (int u = blockIdx.x; u < 256; u += gridDim.x) {
        const int g = u >> 2, q = u & 3;
        __syncthreads();
        const float delta = __expf(lstep[g]);
        if (tid < 64) {
            const int p = tid;
            const float ar = a_re[g * 64 + p], ai = a_im[g * 64 + p];
            const float ea = expf(ar * delta);
            float sn, cs; sincosf(ai * delta, &sn, &cs);
            const float xr = ea * cs - 1.0f, xi = ea * sn;
            const float den = 1.0f / (ar * ar + ai * ai);
            const float cr = (xr * ar + xi * ai) * den, ci = (xi * ar - xr * ai) * den;
#pragma unroll
            for (int m = 0; m < 16; ++m) {
                const float br = b_re[(g * 64 + p) * 16 + m], bi = b_im[(g * 64 + p) * 16 + m];
                Bre[p * 16 + m] = cr * br - ci * bi;
                Bim[p * 16 + m] = cr * bi + ci * br;
            }
        }
        for (int i = tid; i < 1024; i += 512) { Cre[i] = c_re[g * 1024 + i]; Cim[i] = c_im[g * 1024 + i]; }
        for (int i = tid; i < 65 * 64; i += 512) {
            const int tau = i >> 6, p = i & 63;
            const float ar = a_re[g * 64 + p], ai = a_im[g * 64 + p];
            const float e = expf((float)tau * ar * delta);
            float sn, cs; sincosf((float)tau * (ai * delta), &sn, &cs);
            Pre[i] = e * cs; Pim[i] = e * sn;
        }
        __syncthreads();
        if (q == 0 && tid < 64) { AL[(g * 64 + tid) * 2] = Pre[64 * 64 + tid]; AL[(g * 64 + tid) * 2 + 1] = Pim[64 * 64 + tid]; }
        if (tid < 256) {
            const int tau = q * 16 + (tid >> 4), n = tid & 15;
            float acc[16];
#pragma unroll
            for (int m = 0; m < 16; ++m) acc[m] = 0.f;
#pragma unroll 2
            for (int p = 0; p < 64; ++p) {
                const float cr = Cre[n * 64 + p], ci = Cim[n * 64 + p], pr = Pre[tau * 64 + p], pi = Pim[tau * 64 + p];
                const float xr = cr * pr - ci * pi, xi = cr * pi + ci * pr;
#pragma unroll
                for (int m4 = 0; m4 < 4; ++m4) {
                    const f32x4 br = *(const f32x4*)(Bre + p * 16 + m4 * 4), bi = *(const f32x4*)(Bim + p * 16 + m4 * 4);
#pragma unroll
                    for (int c = 0; c < 4; ++c) acc[m4 * 4 + c] += xr * br[c] - xi * bi[c];
                }
            }
            uint4 o0, o1;
            o0.x = pack2(acc[0], acc[1]); o0.y = pack2(acc[2], acc[3]); o0.z = pack2(acc[4], acc[5]); o0.w = pack2(acc[6], acc[7]);
            o1.x = pack2(acc[8], acc[9]); o1.y = pack2(acc[10], acc[11]); o1.z = pack2(acc[12], acc[13]); o1.w = pack2(acc[14], acc[15]);
            uint4* dst = (uint4*)(KT + ((size_t)(g * 64 + tau) * 16 + n) * 16);
            dst[0] = o0; dst[1] = o1;
        }
        {
            const int p = tid >> 3;
#pragma unroll
            for (int ss = 0; ss < 2; ++ss) {
                const int s = q * 16 + (tid & 7) * 2 + ss;
                const float pr = Pre[(63 - s) * 64 + p], pi = Pim[(63 - s) * 64 + p];
                float vr[16], vi[16];
#pragma unroll
                for (int m = 0; m < 16; ++m) { const float br = Bre[p * 16 + m], bi = Bim[p * 16 + m]; vr[m] = pr * br - pi * bi; vi[m] = pr * bi + pi * br; }
                uint4 r0, r1, i0, i1;
                r0.x = pack2(vr[0], vr[1]); r0.y = pack2(vr[2], vr[3]); r0.z = pack2(vr[4], vr[5]); r0.w = pack2(vr[6], vr[7]);
                r1.x = pack2(vr[8], vr[9]); r1.y = pack2(vr[10], vr[11]); r1.z = pack2(vr[12], vr[13]); r1.w = pack2(vr[14], vr[15]);
                i0.x = pack2(vi[0], vi[1]); i0.y = pack2(vi[2], vi[3]); i0.z = pack2(vi[4], vi[5]); i0.w = pack2(vi[6], vi[7]);
                i1.x = pack2(vi[8], vi[9]); i1.y = pack2(vi[10], vi[11]); i1.z = pack2(vi[12], vi[13]); i1.w = pack2(vi[14], vi[15]);
                uint4* dr = (uint4*)(WE + ((size_t)(g * 128 + 2 * p) * 1024 + s * 16));
                uint4* di = (uint4*)(WE + ((size_t)(g * 128 + 2 * p + 1) * 1024 + s * 16));
                dr[0] = r0; dr[1] = r1; di[0] = i0; di[1] = i1;
            }
        }
        {
            const int tau = q * 16 + (tid >> 5), n = (tid >> 1) & 15, ph = tid & 1;
            unsigned* dst = (unsigned*)(VV + ((size_t)(g * 1024 + tau * 16 + n) * 128 + ph * 64));
#pragma unroll 4
            for (int pp = 0; pp < 32; ++pp) {
                const int p = ph * 32 + pp;
                const float cr = Cre[n * 64 + p], ci = Cim[n * 64 + p], pr = Pre[(tau + 1) * 64 + p], pi = Pim[(tau + 1) * 64 + p];
                dst[pp] = pack2(cr * pr - ci * pi, -(cr * pi + ci * pr));
            }
        }
    }
    __syncthreads();
    dense_convert(a, lds, tid, wid, lane);
}

DEVI void phase1(const Args& a, char* lds, int tid, int wid, int lane) {
    const unsigned char* HN = a.ws + WS_HN; const unsigned char* WT = a.ws + WS_WINT; u16* PROJ = (u16*)(a.ws + WS_PROJ);
    const int wr = wid >> 2, wc = wid & 3;
    auto unit = [&](int uu, int& mt, int& nt) { const int u = (uu & 7) * 64 + (uu >> 3); mt = u & 31; nt = u >> 5; };
    int uu = blockIdx.x;
    const int cpos = blockIdx.x % 3, c_lo = blockIdx.x * 24, c_hi = c_lo + 24;
    if (cpos == 0) convert_range(a, lds, c_lo, c_hi, tid, wid, lane);
    int mt, nt; unit(uu, mt, nt);
    unsigned aoff[2], boffv[2];
    bf_offsets(aoff, wid, lane, mt * 256, D); bf_offsets(boffv, wid, lane, nt * 256, D);
    f8_prefetch(lds, HN, aoff, WT, boffv, wid);
    int it = 0;
    while (true) {
        const int un = uu + gridDim.x;
        const bool has_next = un < 512;
        f32x4 acc[4][8]; zero_acc16(acc);
        bf_mainloop<64>(lds, HN, aoff, WT, boffv, wid, lane, acc);
        int lz = lane; asm volatile("" : "+v"(lz));
        const int l15 = lz & 15, q = lz >> 4;
        const int mtc = mt, ntc = nt;
        if (has_next) { unit(un, mt, nt); bf_offsets(aoff, wid, lz, mt * 256, D); bf_offsets(boffv, wid, lz, nt * 256, D); f8_prefetch(lds, HN, aoff, WT, boffv, wid); }
        const float sc = (ntc < 2) ? 0.08838834764831845f : 1.0f;
#pragma unroll
        for (int m8 = 0; m8 < 8; ++m8) {
            u16* dst = PROJ + (size_t)(mtc * 256 + wr * 128 + m8 * 16 + l15) * PJ + ntc * 256 + wc * 64 + 4 * q;
#pragma unroll
            for (int n4 = 0; n4 < 4; ++n4) {
                uint2 pk;
                pk.x = pack2(acc[n4][m8][0] * sc, acc[n4][m8][1] * sc);
                pk.y = pack2(acc[n4][m8][2] * sc, acc[n4][m8][3] * sc);
                *(uint2*)(dst + n4 * 16) = pk;
            }
        }
        if (cpos == 1 && it == 0) convert_range(a, lds, c_lo, c_hi, tid, wid, lane);
        ++it;
        if (!has_next) break;
        uu = un;
    }
    if (cpos == 2) convert_range(a, lds, c_lo, c_hi, tid, wid, lane);
    convert_pool(a, lds, 0, 6144, 8192, tid, wid, lane);
}

DEVI void gla_gate(const Args& a, int n, int h, int tid, float* glr, float* tot, float (&b)[16], float& blast) {
    const float* GLR = (const float*)(a.ws + WS_GLR);
    const float* W2 = a.in[3]; const float* gb = a.in[4];
    for (int i = tid; i < 1024; i += 512) glr[i] = GLR[(size_t)n * 64 * 16 + i];
    const int ch = tid & 127, tq = tid >> 7;
    float w[16];
#pragma unroll
    for (int r = 0; r < 16; ++r) w[r] = W2[r * 512 + h * 128 + ch];
    const float bias = gb[h * 128 + ch];
    __syncthreads();
    float run = 0.f;
#pragma unroll
    for (int tt = 0; tt < 16; ++tt) {
        const int t = tq * 16 + tt;
        float s = bias;
#pragma unroll
        for (int r4 = 0; r4 < 4; ++r4) {
            const f32x4 gv = *(const f32x4*)(glr + t * 16 + r4 * 4);
            s += gv[0] * w[r4 * 4] + gv[1] * w[r4 * 4 + 1] + gv[2] * w[r4 * 4 + 2] + gv[3] * w[r4 * 4 + 3];
        }
        run += logsigmoid_(s) * (1.0f / 16.0f);
        b[tt] = run;
    }
    tot[tq * 128 + ch] = run;
    __syncthreads();
    float pre = 0.f;
#pragma unroll
    for (int k = 0; k < 4; ++k) { const float v = tot[k * 128 + ch]; if (k < tq) pre += v; }
    blast = tot[ch] + tot[128 + ch] + tot[256 + ch] + tot[384 + ch];
#pragma unroll
    for (int tt = 0; tt < 16; ++tt) b[tt] += pre;
}
DEVI void gla_stage_vT(const u16* PROJ, int t0, int vcol0, char* img, int tid) {
    if (tid < 256) {
        const int tb = tid >> 5, jb = tid & 31;
        unsigned R[8][4];
#pragma unroll
        for (int tt = 0; tt < 8; ++tt) {
            const uint4 v = *(const uint4*)(PROJ + (size_t)(t0 + tb * 8 + tt) * PJ + vcol0 + jb * 8);
            R[tt][0] = v.x; R[tt][1] = v.y; R[tt][2] = v.z; R[tt][3] = v.w;
        }
#pragma unroll
        for (int jj = 0; jj < 8; ++jj) {
            unsigned o[4];
#pragma unroll
            for (int d = 0; d < 4; ++d) {
                const unsigned lo = R[2 * d][jj >> 1], hi = R[2 * d + 1][jj >> 1];
                o[d] = (jj & 1) ? ((lo >> 16) | (hi & 0xffff0000u)) : ((lo & 0xffffu) | (hi << 16));
            }
            *(uint4*)(img + lds_byte<2>(jb * 8 + jj, tb * 8)) = make_uint4(o[0], o[1], o[2], o[3]);
        }
    }
}

constexpr int USTR = 2048 + 16;
DEVI void s5_fill_U(const u16* PROJ, int g, int cb, char* U, int tid) {
    for (int k = 0; k < 4; ++k) {
        const int idx = tid + 512 * k, c = idx >> 6, s = idx & 63;
        const uint4* src = (const uint4*)(PROJ + (size_t)((cb * 32 + c) * 64 + s) * PJ + 3072 + g * 16);
        uint4* dst = (uint4*)(U + c * USTR + s * 32);
        dst[0] = src[0]; dst[1] = src[1];
    }
}
DEVI void phase2(const Args& a, char* lds, int tid, int wid, int lane) {
    const u16* PROJ = (const u16*)(a.ws + WS_PROJ);
#pragma unroll 1
    for (int u = blockIdx.x; u < 768; u += gridDim.x) {
        { int lq = lane; asm volatile("" : "+v"(lq)); lane = lq; tid = wid * 64 + lq; }
        const int fr = lane & 15, fq = lane >> 4;
        __syncthreads();
        if (u < 256) {
            const int g = u >> 2, cb = u & 3;
            s5_fill_U(PROJ, g, cb, lds, tid);
            __syncthreads();
            const u16* WE = (const u16*)(a.ws + WS_S5WE) + (size_t)(g * 128 + wid * 16 + fr) * 1024 + fq * 8;
            f32x4 acc0 = {0.f, 0.f, 0.f, 0.f}, acc1 = {0.f, 0.f, 0.f, 0.f};
#pragma unroll 8
            for (int ks = 0; ks < 32; ++ks) {
                const bf16x8 bf = *(const bf16x8*)(WE + ks * 32);
                const bf16x8 a0 = *(const bf16x8*)(lds + fr * USTR + (ks * 32 + fq * 8) * 2);
                const bf16x8 a1 = *(const bf16x8*)(lds + (16 + fr) * USTR + (ks * 32 + fq * 8) * 2);
                acc0 = __builtin_amdgcn_mfma_f32_16x16x32_bf16(a0, bf, acc0, 0, 0, 0);
                acc1 = __builtin_amdgcn_mfma_f32_16x16x32_bf16(a1, bf, acc1, 0, 0, 0);
            }
            float* E = (float*)(a.ws + WS_S5E);
#pragma unroll
            for (int j = 0; j < 4; ++j) {
                E[(size_t)(g * 128 + cb * 32 + fq * 4 + j) * 128 + wid * 16 + fr] = acc0[j];
                E[(size_t)(g * 128 + cb * 32 + 16 + fq * 4 + j) * 128 + wid * 16 + fr] = acc1[j];
            }
        } else {
            const int uu = u - 256, n = uu >> 2, h = uu & 3, t0 = n * 64;
            char* vT = lds;
            char* kT = lds + 32768;
            float* glr = (float*)(lds + 49152);
            float* tot = glr + 1024;
            float b[16], blast;
            gla_gate(a, n, h, tid, glr, tot, b, blast);
            const int ch = tid & 127, tq = tid >> 7;
            {
                unsigned pk[8];
#pragma unroll
                for (int tt = 0; tt < 16; tt += 2) {
                    const float k0 = bf2f(PROJ[(size_t)(t0 + tq * 16 + tt) * PJ + 512 + h * 128 + ch]);
                    const float k1 = bf2f(PROJ[(size_t)(t0 + tq * 16 + tt + 1) * PJ + 512 + h * 128 + ch]);
                    pk[tt >> 1] = pack2(k0 * __expf(blast - b[tt]), k1 * __expf(blast - b[tt + 1]));
                }
                *(uint4*)(kT + lds_byte<2>(ch, tq * 16)) = make_uint4(pk[0], pk[1], pk[2], pk[3]);
                *(uint4*)(kT + lds_byte<2>(ch, tq * 16 + 8)) = make_uint4(pk[4], pk[5], pk[6], pk[7]);
                if (tq == 3) ((float*)(a.ws + WS_DEC))[(size_t)(n * 4 + h) * 128 + ch] = __expf(blast);
            }
            gla_stage_vT(PROJ, t0, 1024 + h * 256, vT, tid);
            __syncthreads();
            const int wr = wid >> 1, wc = wid & 1;
            f32x4 acc[4][4];
#pragma unroll
            for (int m = 0; m < 4; ++m)
#pragma unroll
                for (int nn = 0; nn < 4; ++nn) acc[m][nn] = f32x4{0.f, 0.f, 0.f, 0.f};
#pragma unroll
            for (int ks = 0; ks < 2; ++ks) {
                bf16x8 Af[4], Bf[4];
#pragma unroll
                for (int m = 0; m < 4; ++m) Af[m] = *(const bf16x8*)(vT + lds_byte<2>(wr * 64 + m * 16 + fr, ks * 32 + fq * 8));
#pragma unroll
                for (int nn = 0; nn < 4; ++nn) Bf[nn] = *(const bf16x8*)(kT + lds_byte<2>(wc * 64 + nn * 16 + fr, ks * 32 + fq * 8));
#pragma unroll
                for (int m = 0; m < 4; ++m)
#pragma unroll
                    for (int nn = 0; nn < 4; ++nn) acc[m][nn] = __builtin_amdgcn_mfma_f32_16x16x32_bf16(Af[m], Bf[nn], acc[m][nn], 0, 0, 0);
            }
            float* KV = (float*)(a.ws + WS_KV) + (size_t)(n * 4 + h) * (HV * HK);
#pragma unroll
            for (int m = 0; m < 4; ++m)
#pragma unroll
                for (int nn = 0; nn < 4; ++nn)
#pragma unroll
                    for (int j = 0; j < 4; ++j)
                        KV[(size_t)(wr * 64 + m * 16 + fq * 4 + j) * 128 + wc * 64 + nn * 16 + fr] = acc[m][nn][j];
        }
    }
}

DEVI void phase3(const Args& a, int tid) {
    const float* KV = (const float*)(a.ws + WS_KV); u16* ST = (u16*)(a.ws + WS_ST); const float* DEC = (const float*)(a.ws + WS_DEC);
    for (int e = blockIdx.x * 512 + tid; e < NH * HV * HK; e += gridDim.x * 512) {
        const int h = e >> 15, rem = e & 32767, i = e & 127;
        float S = 0.f;
#pragma unroll 1
        for (int n0 = 0; n0 < NCH; n0 += 16) {
            float kv[16], dc[16];
#pragma unroll
            for (int k = 0; k < 16; ++k) { kv[k] = KV[(size_t)((n0 + k) * 4 + h) * 32768 + rem]; dc[k] = DEC[(size_t)((n0 + k) * 4 + h) * 128 + i]; }
#pragma unroll
            for (int k = 0; k < 16; ++k) { ST[(size_t)((n0 + k) * 4 + h) * 32768 + rem] = f2bf(S); S = dc[k] * S + kv[k]; }
        }
    }
    const float* E = (const float*)(a.ws + WS_S5E); const float* AL = (const float*)(a.ws + WS_S5AL); unsigned* HP = (unsigned*)(a.ws + WS_S5H);
    for (int e = blockIdx.x * 512 + tid; e < NG * SP; e += gridDim.x * 512) {
        const int g = e >> 6, p = e & 63;
        const float ar = AL[e * 2], ai = AL[e * 2 + 1];
        float hr = 0.f, hi = 0.f;
#pragma unroll 1
        for (int c0 = 0; c0 < 128; c0 += 16) {
            float2 ev[16];
#pragma unroll
            for (int k = 0; k < 16; ++k) ev[k] = *(const float2*)(E + (size_t)(g * 128 + c0 + k) * 128 + 2 * p);
#pragma unroll
            for (int k = 0; k < 16; ++k) {
                HP[(size_t)(g * 128 + c0 + k) * 64 + p] = pack2(hr, hi);
                const float nr = ar * hr - ai * hi + ev[k].x, ni = ar * hi + ai * hr + ev[k].y;
                hr = nr; hi = ni;
            }
        }
    }
}

DEVI void phase4(const Args& a, char* lds, int tid, int wid, int lane) {
    const u16* PROJ = (const u16*)(a.ws + WS_PROJ);
    u16* MIX = (u16*)(a.ws + WS_MIX);
#pragma unroll 1
    for (int u = blockIdx.x; u < 768; u += gridDim.x) {
        { int lq = lane; asm volatile("" : "+v"(lq)); lane = lq; tid = wid * 64 + lq; }
        const int fr = lane & 15, fq = lane >> 4;
        __syncthreads();
        if (u < 256) {
            const int g = u >> 2, cb = u & 3;
            char* U = lds; char* KTl = lds + 32 * USTR;
            s5_fill_U(PROJ, g, cb, U, tid);
            {
                const uint4* src = (const uint4*)((const u16*)(a.ws + WS_S5K) + (size_t)g * 16384);
                uint4* dst = (uint4*)KTl;
                for (int k = 0; k < 4; ++k) dst[tid + 512 * k] = src[tid + 512 * k];
            }
            __syncthreads();
            f32x4 acc[8][2];
#pragma unroll
            for (int tt = 0; tt < 8; ++tt) { acc[tt][0] = f32x4{0.f, 0.f, 0.f, 0.f}; acc[tt][1] = f32x4{0.f, 0.f, 0.f, 0.f}; }
            const int sl = fq >> 1, m0 = (fq & 1) * 8;
            const char* kbase = KTl + ((wid - sl) * 256 + fr * 16 + m0) * 2;
#pragma unroll 1
            for (int j = 0; j < 32; ++j) {
                const bf16x8 a0 = *(const bf16x8*)(U + fr * USTR + (j * 32 + fq * 8) * 2);
                const bf16x8 a1 = *(const bf16x8*)(U + (16 + fr) * USTR + (j * 32 + fq * 8) * 2);
                const char* kb = kbase - j * 1024;
#pragma unroll
                for (int tt = 0; tt < 8; ++tt) {
                    const int t = wid + 8 * tt;
                    if (t >= 2 * j) {
                        bf16x8 bf = *(const bf16x8*)(kb + tt * 4096);
                        if (t == 2 * j && sl == 1) bf = bf16x8{0, 0, 0, 0, 0, 0, 0, 0};
                        acc[tt][0] = __builtin_amdgcn_mfma_f32_16x16x32_bf16(a0, bf, acc[tt][0], 0, 0, 0);
                        acc[tt][1] = __builtin_amdgcn_mfma_f32_16x16x32_bf16(a1, bf, acc[tt][1], 0, 0, 0);
                    }
                }
            }
            const u16* HP = (const u16*)(a.ws + WS_S5H); const u16* VV = (const u16*)(a.ws + WS_S5V);
#pragma unroll 1
            for (int kp = 0; kp < 2; ++kp) {
                bf16x8 a0[2], a1[2], bfv[2][8];
#pragma unroll
                for (int k2 = 0; k2 < 2; ++k2) {
                    const int ks = kp * 2 + k2;
                    a0[k2] = *(const bf16x8*)(HP + (size_t)(g * 128 + cb * 32 + fr) * 128 + ks * 32 + fq * 8);
                    a1[k2] = *(const bf16x8*)(HP + (size_t)(g * 128 + cb * 32 + 16 + fr) * 128 + ks * 32 + fq * 8);
#pragma unroll
                    for (int tt = 0; tt < 8; ++tt)
                        bfv[k2][tt] = *(const bf16x8*)(VV + (size_t)(g * 1024 + (wid + 8 * tt) * 16 + fr) * 128 + ks * 32 + fq * 8);
                }
#pragma unroll
                for (int k2 = 0; k2 < 2; ++k2)
#pragma unroll
                    for (int tt = 0; tt < 8; ++tt) {
                        acc[tt][0] = __builtin_amdgcn_mfma_f32_16x16x32_bf16(a0[k2], bfv[k2][tt], acc[tt][0], 0, 0, 0);
                        acc[tt][1] = __builtin_amdgcn_mfma_f32_16x16x32_bf16(a1[k2], bfv[k2][tt], acc[tt][1], 0, 0, 0);
                    }
            }
            const float dsk = a.in[12][g * 16 + fr];
            u16* Z = (u16*)(a.ws + WS_Z);
#pragma unroll
            for (int tt = 0; tt < 8; ++tt) {
                const int t = wid + 8 * tt;
#pragma unroll
                for (int mf = 0; mf < 2; ++mf)
#pragma unroll
                    for (int j = 0; j < 4; ++j) {
                        const int cl = mf * 16 + fq * 4 + j;
                        const float uv = bf2f(*(const u16*)(U + cl * USTR + (t * 16 + fr) * 2));
                        const float y = acc[tt][mf][j] + dsk * uv;
                        Z[(size_t)((cb * 32 + cl) * 64 + t) * SW + g * 16 + fr] = f2bf(gelu_tanh(y));
                    }
            }
        } else {
            const int uu = u - 256, n = uu >> 2, h = uu & 3, t0 = n * 64;
            char* vT = lds;
            char* qI = lds + 32768;
            char* kI = lds + 49152;
            char* pI = lds + 65536;
            float* glr = (float*)(lds + 73728);
            float* tot = glr + 1024;
            float* rss = tot + 512;
            char* sT = lds + 81920;
            {
                const u16* STg = (const u16*)(a.ws + WS_ST) + (size_t)(n * 4 + h) * (HV * HK);
#pragma unroll
                for (int p = 0; p < 8; ++p) {
                    const int row = p * 32 + wid * 4 + (lane >> 4), chunk = ((lane & 15) ^ row) & 15;
                    __builtin_amdgcn_global_load_lds((const unsigned*)(STg + (size_t)row * 128 + chunk * 8), (LAS unsigned*)(sT + p * 8192 + wid * 1024), 16, 0, 0);
                }
            }
            float b[16], blast;
            gla_gate(a, n, h, tid, glr, tot, b, blast);
            const int ch = tid & 127, tq = tid >> 7;
            {
                const int qb0 = (tq * 4 + (ch >> 5)) * 1024 + (ch & 31) * 2, qb1 = qb0 ^ 32;
                const u16* src = PROJ + (size_t)(t0 + tq * 16) * PJ + h * 128 + ch;
#pragma unroll
                for (int tt = 0; tt < 16; ++tt) {
                    const float qv = bf2f(src[(size_t)tt * PJ]);
                    const float kv = bf2f(src[(size_t)tt * PJ + 512]);
                    const int off = (tt < 8 ? qb0 : qb1) + tt * 64;
                    *(u16*)(qI + off) = f2bf(qv * __expf(b[tt]));
                    *(u16*)(kI + off) = f2bf(kv * __expf(-b[tt]));
                }
            }
            gla_stage_vT(PROJ, t0, 1024 + h * 256, vT, tid);
            __syncthreads();
            {
                const int mf = wid & 3, nb = (wid >> 2) * 2;
                f32x4 s0 = {0.f, 0.f, 0.f, 0.f}, s1 = {0.f, 0.f, 0.f, 0.f};
#pragma unroll
                for (int ks = 0; ks < 4; ++ks) {
                    const bf16x8 af = *(const bf16x8*)(qI + lds_byte<4>(mf * 16 + fr, ks * 32 + fq * 8));
                    const bf16x8 b0 = *(const bf16x8*)(kI + lds_byte<4>(nb * 16 + fr, ks * 32 + fq * 8));
                    const bf16x8 b1 = *(const bf16x8*)(kI + lds_byte<4>((nb + 1) * 16 + fr, ks * 32 + fq * 8));
                    s0 = __builtin_amdgcn_mfma_f32_16x16x32_bf16(af, b0, s0, 0, 0, 0);
                    s1 = __builtin_amdgcn_mfma_f32_16x16x32_bf16(af, b1, s1, 0, 0, 0);
                }
#pragma unroll
                for (int j = 0; j < 4; ++j) {
                    const int t = mf * 16 + fq * 4 + j, sA = nb * 16 + fr, sB = sA + 16;
                    *(u16*)(pI + lds_byte<2>(t, sA)) = f2bf(sA <= t ? s0[j] : 0.f);
                    *(u16*)(pI + lds_byte<2>(t, sB)) = f2bf(sB <= t ? s1[j] : 0.f);
                }
            }
            __syncthreads();
            const int mf = wid & 3, nh = wid >> 2;
            f32x4 acc[8];
#pragma unroll
            for (int nn = 0; nn < 8; ++nn) acc[nn] = f32x4{0.f, 0.f, 0.f, 0.f};
#pragma unroll
            for (int ks = 0; ks < 2; ++ks) {
                const bf16x8 af = *(const bf16x8*)(pI + lds_byte<2>(mf * 16 + fr, ks * 32 + fq * 8));
#pragma unroll
                for (int nn = 0; nn < 8; ++nn) {
                    const bf16x8 bf = *(const bf16x8*)(vT + lds_byte<2>(nh * 128 + nn * 16 + fr, ks * 32 + fq * 8));
                    acc[nn] = __builtin_amdgcn_mfma_f32_16x16x32_bf16(af, bf, acc[nn], 0, 0, 0);
                }
            }
#pragma unroll
            for (int ks = 0; ks < 4; ++ks) {
                const bf16x8 af = *(const bf16x8*)(qI + lds_byte<4>(mf * 16 + fr, ks * 32 + fq * 8));
#pragma unroll
                for (int nn = 0; nn < 8; ++nn) {
                    const bf16x8 bf = *(const bf16x8*)(sT + (nh * 128 + nn * 16 + fr) * 256 + ((((ks * 4 + fq) ^ fr) & 15) << 4));
                    acc[nn] = __builtin_amdgcn_mfma_f32_16x16x32_bf16(af, bf, acc[nn], 0, 0, 0);
                }
            }
            u16 rraw[4][8];
#pragma unroll
            for (int j = 0; j < 4; ++j)
#pragma unroll
                for (int nn = 0; nn < 8; ++nn) rraw[j][nn] = PROJ[(size_t)(t0 + mf * 16 + fq * 4 + j) * PJ + 2048 + h * 256 + nh * 128 + nn * 16 + fr];
            float ss[4];
#pragma unroll
            for (int j = 0; j < 4; ++j) {
                float s = 0.f;
#pragma unroll
                for (int nn = 0; nn < 8; ++nn) s += acc[nn][j] * acc[nn][j];
                ss[j] = sum16(s);
            }
            if (fr == 0) {
#pragma unroll
                for (int j = 0; j < 4; ++j) rss[nh * 64 + mf * 16 + fq * 4 + j] = ss[j];
            }
            __syncthreads();
            const float* gn = a.in[5];
#pragma unroll
            for (int j = 0; j < 4; ++j) {
                const int t = mf * 16 + fq * 4 + j;
                const float rstd = rsqrtf((rss[t] + rss[64 + t]) * (1.0f / 256.0f) + EPS);
#pragma unroll
                for (int nn = 0; nn < 8; ++nn) {
                    const int jc = nh * 128 + nn * 16 + fr;
                    const float rv = bf2f(rraw[j][nn]);
                    const float o = acc[nn][j] * rstd * gn[jc] * (rv * sigmoidf_(rv));
                    MIX[(size_t)(t0 + t) * D + h * 256 + jc] = f2bf(o);
                }
            }
        }
    }
}

DEVI void phase5(const Args& a, char* lds, int tid, int wid, int lane) {
    const unsigned char* Zb = a.ws + WS_Z; const unsigned char* GT = a.ws + WS_GLUT;
    const u16* Z = (const u16*)(a.ws + WS_Z); u16* MIX = (u16*)(a.ws + WS_MIX); float* SSQ = (float*)(a.ws + WS_SSQ);
    const float* gbias = a.in[15]; const float* sng = a.in[16];
    const int wr = wid >> 2, wc = wid & 3;
    if (blockIdx.x >= 128) {
        const int c_lo = 8192 + (blockIdx.x - 128) * 22;
        convert_range(a, lds, c_lo, c_lo + 22, tid, wid, lane);
    }
    for (int u = blockIdx.x; u < 128; u += gridDim.x) {
        const int mt = u & 31, nt = u >> 5;
        unsigned aoff[2], boffv[2];
        bf_offsets(aoff, wid, lane, mt * 256, SW); bf_offsets(boffv, wid, lane, nt * 256, SW);
        f8_prefetch(lds, Zb, aoff, GT, boffv, wid);
        f32x4 acc[4][8]; zero_acc16(acc);
        bf_mainloop<32>(lds, Zb, aoff, GT, boffv, wid, lane, acc);
        int lz = lane; asm volatile("" : "+v"(lz));
        const int l15 = lz & 15, q = lz >> 4;
        const int cb = nt * 256 + wc * 64 + 4 * q;
#pragma unroll
        for (int m8 = 0; m8 < 8; ++m8) {
            const int row = mt * 256 + wr * 128 + m8 * 16 + l15;
            float sq = 0.f;
#pragma unroll
            for (int n4 = 0; n4 < 4; ++n4) {
                const int c = cb + n4 * 16;
                const uint2 zv = *(const uint2*)(Z + (size_t)row * SW + c);
                const f32x4 gb = *(const f32x4*)(gbias + c), sg = *(const f32x4*)(sng + c);
                const float z0 = bflo(zv.x), z1 = bfhi(zv.x), z2 = bflo(zv.y), z3 = bfhi(zv.y);
                const float y0 = z0 * sigmoidf_(acc[n4][m8][0] + gb[0]), y1 = z1 * sigmoidf_(acc[n4][m8][1] + gb[1]);
                const float y2 = z2 * sigmoidf_(acc[n4][m8][2] + gb[2]), y3 = z3 * sigmoidf_(acc[n4][m8][3] + gb[3]);
                sq += y0 * y0 + y1 * y1 + y2 * y2 + y3 * y3;
                uint2 pk; pk.x = pack2(y0 * sg[0], y1 * sg[1]); pk.y = pack2(y2 * sg[2], y3 * sg[3]);
                *(uint2*)(MIX + (size_t)row * D + 1024 + c) = pk;
            }
            sq += __shfl_xor(sq, 16); sq += __shfl_xor(sq, 32);
            if (q == 0) atomicAdd(&SSQ[row], sq);
        }
    }
    if (blockIdx.x < 128) { const int c_lo = 11008 + blockIdx.x * 6; convert_range(a, lds, c_lo, c_lo + 6, tid, wid, lane); }
    convert_pool(a, lds, 1, 11776, 13312, tid, wid, lane);
}

DEVI void phase6(const Args& a, char* lds, int tid, int wid, int lane) {
    const unsigned char* MIXb = a.ws + WS_MIX; const unsigned char* WT = a.ws + WS_WOUTT;
    float* H1 = (float*)(a.ws + WS_H1); const float* SSQ = (const float*)(a.ws + WS_SSQ);
    const float* x = a.in[0];
    const int wr = wid >> 2, wc = wid & 3;
    const int c6_lo = 13312 + blockIdx.x * 8, c6_hi = c6_lo + 8;
    if ((blockIdx.x >> 3) & 1) convert_range(a, lds, c6_lo, c6_hi, tid, wid, lane);
    for (int uu = blockIdx.x; uu < 256; uu += gridDim.x) {
        const int u = (uu & 7) * 32 + (uu >> 3);
        const int mt = u & 31, nt = u >> 5;
        unsigned aoff[2], boffv[2], aoff2[2], boff2[2];
        bf_offsets(aoff, wid, lane, mt * 256, D); bf_offsets(boffv, wid, lane, nt * 256, D);
#pragma unroll
        for (int i = 0; i < 2; ++i) { aoff2[i] = aoff[i] + 2048u; boff2[i] = boffv[i] + 2048u; }
        f8_prefetch(lds, MIXb, aoff2, WT, boff2, wid);
        f32x4 acc[4][8]; zero_acc16(acc);
        bf_mainloop<32>(lds, MIXb, aoff2, WT, boff2, wid, lane, acc);
        f8_prefetch(lds, MIXb, aoff, WT, boffv, wid);
        {
            int lq = lane; asm volatile("" : "+v"(lq));
#pragma unroll
            for (int m8 = 0; m8 < 8; ++m8) {
                const float rs = rsqrtf(SSQ[mt * 256 + wr * 128 + m8 * 16 + (lq & 15)] * (1.0f / SW) + EPS);
#pragma unroll
                for (int n4 = 0; n4 < 4; ++n4)
#pragma unroll
                    for (int r = 0; r < 4; ++r) acc[n4][m8][r] *= rs;
            }
        }
        bf_mainloop<32>(lds, MIXb, aoff, WT, boffv, wid, lane, acc);
        int lz = lane; asm volatile("" : "+v"(lz));
        const int l15 = lz & 15, q = lz >> 4;
#pragma unroll
        for (int m8 = 0; m8 < 8; ++m8) {
            const size_t base = (size_t)(mt * 256 + wr * 128 + m8 * 16 + l15) * D + nt * 256 + wc * 64 + 4 * q;
#pragma unroll
            for (int n4 = 0; n4 < 4; ++n4) {
                const f32x4 xv = *(const f32x4*)(x + base + n4 * 16);
                f32x4 o;
#pragma unroll
                for (int i = 0; i < 4; ++i) o[i] = xv[i] + acc[n4][m8][i];
                *(f32x4*)(H1 + base + n4 * 16) = o;
            }
        }
    }
    if (!((blockIdx.x >> 3) & 1)) convert_range(a, lds, c6_lo, c6_hi, tid, wid, lane);
    convert_pool(a, lds, 2, 15360, 16384, tid, wid, lane);
}

DEVI void phase7(const Args& a, char* lds, int tid, int wid, int lane) {
    const float* H1 = (const float*)(a.ws + WS_H1); unsigned char* HN8 = a.ws + WS_HN2;
    const float* g2 = a.in[18]; const float* rw = a.in[19]; const float* rb = a.in[20];
    int* CNT = (int*)(a.ws + WS_CNT); int* LTOK = (int*)(a.ws + WS_LTOK); float* LGATE = (float*)(a.ws + WS_LGATE); int* TSLOT = (int*)(a.ws + WS_TSLOT);
    float* hn = (float*)lds;
    float* red = hn + 8 * 2048;
    float* lg = red + 8 * 8 * 32;
    for (int u = blockIdx.x; u < 256; u += gridDim.x) {
#pragma unroll 1
        for (int ps = 0; ps < 4; ++ps) {
            const int tok0 = u * 32 + ps * 8;
            { int lq = lane; asm volatile("" : "+v"(lq)); lane = lq; tid = wid * 64 + lq; }
            __syncthreads();
            {
                const int tl = wid, tok = tok0 + tl;
                f32x4 xv[8]; float ss = 0.f;
#pragma unroll
                for (int i = 0; i < 8; ++i) { xv[i] = *(const f32x4*)(H1 + (size_t)tok * D + 256 * i + 4 * lane);
#pragma unroll
                    for (int c = 0; c < 4; ++c) ss += xv[i][c] * xv[i][c]; }
                ss = wave_sum(ss);
                const float r = rsqrtf(ss * (1.0f / D) + EPS);
#pragma unroll
                for (int i = 0; i < 8; ++i) {
                    const f32x4 g = *(const f32x4*)(g2 + 256 * i + 4 * lane);
                    f32x4 o;
#pragma unroll
                    for (int c = 0; c < 4; ++c) o[c] = xv[i][c] * r * g[c];
                    *(f32x4*)(hn + tl * 2048 + 256 * i + 4 * lane) = o;
                    *(unsigned*)(HN8 + (size_t)tok * D + 256 * i + 4 * lane) = cvt4_fp8(o[0] * 16.f, o[1] * 16.f, o[2] * 16.f, o[3] * 16.f);
                }
            }
            __syncthreads();
            {
                const int e = tid & 31, dsl = tid >> 5;
                float acc[8];
#pragma unroll
                for (int k = 0; k < 8; ++k) acc[k] = 0.f;
#pragma unroll 1
                for (int d16 = 0; d16 < 8; ++d16) {
                    float w[16];
#pragma unroll
                    for (int q = 0; q < 16; ++q) w[q] = rw[(dsl * 128 + d16 * 16 + q) * 32 + e];
#pragma unroll
                    for (int q4 = 0; q4 < 4; ++q4) {
                        const int d = dsl * 128 + d16 * 16 + q4 * 4;
#pragma unroll
                        for (int k = 0; k < 8; ++k) {
                            const f32x4 hv = *(const f32x4*)(hn + k * 2048 + d);
                            acc[k] += hv[0] * w[q4 * 4] + hv[1] * w[q4 * 4 + 1] + hv[2] * w[q4 * 4 + 2] + hv[3] * w[q4 * 4 + 3];
                        }
                    }
                }
#pragma unroll
                for (int k = 0; k < 8; ++k) { acc[k] += __shfl_xor(acc[k], 32); }
                if (lane < 32) {
#pragma unroll
                    for (int k = 0; k < 8; ++k) red[(wid * 8 + k) * 32 + e] = acc[k];
                }
            }
            __syncthreads();
            if (tid < 256) {
                const int k = tid >> 5, e = tid & 31;
                float s = rb[e];
#pragma unroll
                for (int w = 0; w < 8; ++w) s += red[(w * 8 + k) * 32 + e];
                lg[k * 32 + e] = s;
            }
            __syncthreads();
            {
                const int tok = tok0 + wid, e = lane & 31;
                float x = lg[wid * 32 + e];
                float v[4]; int id[4];
#pragma unroll
                for (int j = 0; j < 4; ++j) {
                    float bv = x; int bi = e;
#pragma unroll
                    for (int o = 16; o >= 1; o >>= 1) {
                        const float ov = __shfl_xor(bv, o); const int oi = __shfl_xor(bi, o);
                        if (ov > bv || (ov == bv && oi < bi)) { bv = ov; bi = oi; }
                    }
                    v[j] = bv; id[j] = bi;
                    if (e == bi) x = -3.0e38f;
                }
                float ex[4], sum = 0.f;
#pragma unroll
                for (int j = 0; j < 4; ++j) { ex[j] = __expf(v[j] - v[0]); sum += ex[j]; }
                const float inv = 1.0f / sum;
                if (lane < 4) {
                    const int myid = lane == 0 ? id[0] : lane == 1 ? id[1] : lane == 2 ? id[2] : id[3];
                    const float myg = (lane == 0 ? ex[0] : lane == 1 ? ex[1] : lane == 2 ? ex[2] : ex[3]) * inv;
                    const int slot = atomicAdd(&CNT[myid], 1);
                    LTOK[myid * CAP + slot] = tok;
                    LGATE[myid * CAP + slot] = myg;
                    TSLOT[tok * 4 + lane] = myid * CAP + slot;
                }
            }
        }
    }
}

struct MoeTab { int cnt[32]; int off[33]; int ord[32]; int xe[4]; int xub[5]; };
DEVI void moe_tables(const Args& a, MoeTab* tb, int tid, int ntn) {
    __syncthreads();
    if (tid < 32) tb->cnt[tid] = ((const int*)(a.ws + WS_CNT))[tid];
    __syncthreads();
    if (tid < 32) {
        const int me = (tb->cnt[tid] + 255) >> 8;
        int rank = 0, o = 0;
        for (int k = 0; k < 32; ++k) {
            const int c = tb->cnt[k], mk = (c + 255) >> 8;
            rank += (mk > me || (mk == me && k < tid)) ? 1 : 0;
            o += (k < tid) ? c : 0;
        }
        tb->ord[rank] = tid; tb->off[tid] = o;
        if (tid == 31) tb->off[32] = o + tb->cnt[31];
    }
    __syncthreads();
    if (tid == 0) {
        const int xcd = blockIdx.x & 7;
        int ub = 0;
        for (int r = 0; r < 4; ++r) {
            const int e = tb->ord[r * 8 + ((r & 1) ? 7 - xcd : xcd)];
            tb->xe[r] = e; tb->xub[r] = ub;
            ub += ((tb->cnt[e] + 255) >> 8) * ntn;
        }
        tb->xub[4] = ub;
    }
    __syncthreads();
}

struct MoeUnit { int e, nt, r0, rows, grow0, cnt; };
DEVI MoeUnit moe_decode(const MoeTab* tb, int u) {
    int k = 0;
    for (int q = 1; q < 4; ++q) if (u >= tb->xub[q]) k = q;
    MoeUnit d; d.e = tb->xe[k];
    d.cnt = tb->cnt[d.e];
    const int mte = (d.cnt + 255) >> 8, ul = u - tb->xub[k];
    d.nt = ul / mte; const int mi = ul - d.nt * mte;
    d.r0 = mi * 256; d.rows = min(256, d.cnt - d.r0); d.grow0 = tb->off[d.e] + d.r0;
    return d;
}
DEVI void phase8(const Args& a, char* lds, MoeTab* tb, int tid, int wid, int lane) {
    const unsigned char* HN8 = a.ws + WS_HN2; unsigned char* ACT = a.ws + WS_ACT;
    const unsigned char* W1T = a.ws + WS_W1T;
    const int* LTOK = (const int*)(a.ws + WS_LTOK);
    const float* b1 = a.in[22];
    const int wr = wid >> 2, wc = wid & 3;
    moe_tables(a, tb, tid, 16);
    const int nun = tb->xub[4], nper = gridDim.x >> 3;
    int u = blockIdx.x >> 3;
    const int cpos = (blockIdx.x >> 3) % 3, c_lo = 16384 + blockIdx.x * 24, c_hi = c_lo + 24;
    if (u >= nun) { convert_range(a, lds, c_lo, c_hi, tid, wid, lane); convert_pool(a, lds, 3, 22528, 24576, tid, wid, lane); return; }
    if (cpos == 0) convert_range(a, lds, c_lo, c_hi, tid, wid, lane);
    int it = 0;
    MoeUnit d = moe_decode(tb, u);
    unsigned aoff[2], boffv[2];
    auto addrs = [&](const MoeUnit& q, const int (&tok)[2], unsigned (&ao)[2], unsigned (&bo)[2]) {
#pragma unroll
        for (int i = 0; i < 2; ++i) {
            int R, CB; f8_stage_rb(wid, lane, i, R, CB);
            ao[i] = (unsigned)tok[i] * D + CB;
            bo[i] = (unsigned)((q.e * 32 + i * 16 + q.nt) * 512) * 512u + (unsigned)(wid * 64 + lane) * 16u;
        }
    };
    auto toks = [&](const MoeUnit& q, int (&tok)[2]) {
#pragma unroll
        for (int i = 0; i < 2; ++i) { int R, CB; f8_stage_rb(wid, lane, i, R, CB); tok[i] = LTOK[q.e * CAP + min(q.r0 + R, q.cnt - 1)]; }
    };
    {
        int tok[2]; toks(d, tok); addrs(d, tok, aoff, boffv);
        q8_prefetch(lds, HN8, aoff, W1T, boffv, wid);
    }
    while (true) {
        const int un = u + nper;
        const bool has_next = un < nun;
        MoeUnit dn = d; int tokn[2] = {0, 0};
        if (has_next) { dn = moe_decode(tb, un); toks(dn, tokn); }
        f32x16 acc[2][4]; zero_acc32(acc);
        f8_mainloop<32, 0x7b7b7b7b, 0x77777777, true>(lds, HN8, aoff, W1T, boffv, wid, lane, acc);
        int lz = lane; asm volatile("" : "+v"(lz));
        const int l31 = lz & 31, hh = lz >> 5;
        const float* bb = b1 + (size_t)d.e * 4096 + d.nt * 128 + wc * 32 + 4 * hh;
        f32x4 bg[4], bl[4];
#pragma unroll
        for (int rq = 0; rq < 4; ++rq) { bg[rq] = *(const f32x4*)(bb + 8 * rq); bl[rq] = *(const f32x4*)(bb + 2048 + 8 * rq); }
#pragma unroll
        for (int rq = 0; rq < 4; ++rq) { touch4(bg[rq]); touch4(bl[rq]); }
        if (has_next) { addrs(dn, tokn, aoff, boffv); q8_prefetch(lds, HN8, aoff, W1T, boffv, wid); }
#pragma unroll
        for (int m = 0; m < 4; ++m) {
            const int row = wr * 128 + m * 32 + l31;
            const int orow = (row < d.rows) ? d.grow0 + row : T * 4 + row;
            unsigned char* dst = ACT + (size_t)orow * FF + d.nt * 128 + wc * 32 + 4 * hh;
#pragma unroll
            for (int rq = 0; rq < 4; ++rq) {
                float av[4];
#pragma unroll
                for (int i = 0; i < 4; ++i) {
                    const float gl = fminf(acc[0][m][rq * 4 + i] + bg[rq][i], 7.0f);
                    const float ln = fminf(fmaxf(acc[1][m][rq * 4 + i] + bl[rq][i], -7.0f), 7.0f);
                    av[i] = gl * sigmoidf_(1.702f * gl) * (ln + 1.0f) * 4.0f;
                }
                *(unsigned*)(dst + 8 * rq) = cvt4_fp8(av[0], av[1], av[2], av[3]);
            }
        }
        if (cpos == 1 && it == 3) convert_range(a, lds, c_lo, c_hi, tid, wid, lane);
        ++it;
        if (!has_next) break;
        u = un; d = dn;
    }
    if (cpos == 2 || (cpos == 1 && it <= 3)) convert_range(a, lds, c_lo, c_hi, tid, wid, lane);
    convert_pool(a, lds, 3, 22528, 24576, tid, wid, lane);
}

DEVI void phase9(const Args& a, char* lds, MoeTab* tb, int tid, int wid, int lane) {
    const unsigned char* ACT = a.ws + WS_ACT; u16* Y = (u16*)(a.ws + WS_Y);
    const unsigned char* W2T = a.ws + WS_W2T;
    const float* LGATE = (const float*)(a.ws + WS_LGATE);
    const float* b2 = a.in[24];
    const int wr = wid >> 2, wc = wid & 3;
    moe_tables(a, tb, tid, 8);
    const int nun = tb->xub[4], nper = gridDim.x >> 3;
    int u = blockIdx.x >> 3;
    if (u >= nun) return;
    MoeUnit d = moe_decode(tb, u);
    unsigned aoff[2], boffv[2];
    auto addrs = [&](const MoeUnit& q, unsigned (&ao)[2], unsigned (&bo)[2]) {
#pragma unroll
        for (int i = 0; i < 2; ++i) {
            int R, CB; f8_stage_rb(wid, lane, i, R, CB);
            ao[i] = (unsigned)(q.grow0 + R) * FF + CB;
            bo[i] = (unsigned)((q.e * 16 + q.nt * 2 + i) * 512) * 512u + (unsigned)(wid * 64 + lane) * 16u;
        }
    };
    addrs(d, aoff, boffv);
    q8_prefetch(lds, ACT, aoff, W2T, boffv, wid);
    while (true) {
        const int un = u + nper;
        const bool has_next = un < nun;
        MoeUnit dn = d;
        if (has_next) dn = moe_decode(tb, un);
        f32x16 acc[2][4]; zero_acc32(acc);
        f8_mainloop<32, 0x7d7d7d7d, 0x77777777, false>(lds, ACT, aoff, W2T, boffv, wid, lane, acc);
        int lz = lane; asm volatile("" : "+v"(lz));
        const int l31 = lz & 31, hh = lz >> 5;
        const float* bb = b2 + (size_t)d.e * D + d.nt * 256 + wc * 64 + 4 * hh;
        float gt[4];
#pragma unroll
        for (int m = 0; m < 4; ++m) { const int row = wr * 128 + m * 32 + l31; gt[m] = LGATE[d.e * CAP + d.r0 + min(row, d.rows - 1)]; }
        f32x4 bv[2][4];
#pragma unroll
        for (int n = 0; n < 2; ++n)
#pragma unroll
            for (int rq = 0; rq < 4; ++rq) bv[n][rq] = *(const f32x4*)(bb + n * 32 + 8 * rq);
#pragma unroll
        for (int m = 0; m < 4; ++m) touchf(gt[m]);
#pragma unroll
        for (int n = 0; n < 2; ++n)
#pragma unroll
            for (int rq = 0; rq < 4; ++rq) touch4(bv[n][rq]);
        if (has_next) { addrs(dn, aoff, boffv); q8_prefetch(lds, ACT, aoff, W2T, boffv, wid); }
#pragma unroll
        for (int m = 0; m < 4; ++m) {
            const int row = wr * 128 + m * 32 + l31;
            const int orow = (row < d.rows) ? d.grow0 + row : T * 4 + row;
            u16* dst = Y + (size_t)orow * D + d.nt * 256 + wc * 64 + 4 * hh;
#pragma unroll
            for (int n = 0; n < 2; ++n)
#pragma unroll
                for (int rq = 0; rq < 4; ++rq) {
                    uint2 pk;
                    pk.x = pack2((acc[n][m][rq * 4 + 0] + bv[n][rq][0]) * gt[m], (acc[n][m][rq * 4 + 1] + bv[n][rq][1]) * gt[m]);
                    pk.y = pack2((acc[n][m][rq * 4 + 2] + bv[n][rq][2]) * gt[m], (acc[n][m][rq * 4 + 3] + bv[n][rq][3]) * gt[m]);
                    *(uint2*)(dst + n * 32 + 8 * rq) = pk;
                }
        }
        if (!has_next) break;
        u = un; d = dn;
    }
}

DEVI void phase10(const Args& a, MoeTab* tb, int tid, int wid, int lane) {
    const float* H1 = (const float*)(a.ws + WS_H1); const u16* Y = (const u16*)(a.ws + WS_Y); const int* TSLOT = (const int*)(a.ws + WS_TSLOT);
    const float* fg = a.in[25];
    moe_tables(a, tb, tid, 8);
    for (int tok = blockIdx.x * 8 + wid; tok < T; tok += gridDim.x * 8) {
        int rowi[4];
#pragma unroll
        for (int j = 0; j < 4; ++j) { const int ts = TSLOT[tok * 4 + j]; rowi[j] = tb->off[ts >> 13] + (ts & (CAP - 1)); }
        f32x4 hv[8]; float ss = 0.f;
#pragma unroll
        for (int i = 0; i < 8; ++i) {
            hv[i] = *(const f32x4*)(H1 + (size_t)tok * D + 256 * i + 4 * lane);
#pragma unroll
            for (int j = 0; j < 4; ++j) {
                const uint2 yv = *(const uint2*)(Y + (size_t)rowi[j] * D + 256 * i + 4 * lane);
                hv[i][0] += bflo(yv.x); hv[i][1] += bfhi(yv.x); hv[i][2] += bflo(yv.y); hv[i][3] += bfhi(yv.y);
            }
#pragma unroll
            for (int c = 0; c < 4; ++c) ss += hv[i][c] * hv[i][c];
        }
        ss = wave_sum(ss);
        const float r = rsqrtf(ss * (1.0f / D) + EPS);
#pragma unroll
        for (int i = 0; i < 8; ++i) {
            const f32x4 g = *(const f32x4*)(fg + 256 * i + 4 * lane);
            f32x4 o;
#pragma unroll
            for (int c = 0; c < 4; ++c) o[c] = hv[i][c] * r * g[c];
            *(f32x4*)(a.out + (size_t)tok * D + 256 * i + 4 * lane) = o;
        }
    }
}

constexpr int NPHASE = 11;
__global__ void __launch_bounds__(512, 2) mega_fwd(Args a) {
    extern __shared__ __attribute__((aligned(1024))) char smem[];
    const int wid_s = __builtin_amdgcn_readfirstlane((int)threadIdx.x >> 6);
    if (threadIdx.x == 0) *(uint4*)smem = make_uint4(0u, 0u, 0u, 0u);
    __syncthreads();
    XcdBarrier bar = xcd_barrier_post((unsigned*)(a.ws + WS_BAR), (volatile LAS unsigned*)smem);
    char* lds = smem + LDS_BASE;
    MoeTab* tb = (MoeTab*)(smem + 64);
#ifndef REP_MASK
#define REP_MASK 0
#endif
#define PHASE(k, call) if (a.ph_lo <= (k) && (k) < a.ph_hi) { if (a.ph_lo < (k)) xcd_barrier(bar); \
        int lane = (int)__builtin_amdgcn_mbcnt_hi(~0u, __builtin_amdgcn_mbcnt_lo(~0u, 0u)); asm volatile("" : "+v"(lane)); \
        const int wid = wid_s, tid = wid_s * 64 + lane; \
        call; if ((REP_MASK >> (k)) & 1) { __syncthreads(); call; } }
    PHASE(0, phase0(a, lds, tid, wid, lane))
    PHASE(1, phase1(a, lds, tid, wid, lane))
    PHASE(2, phase2(a, lds, tid, wid, lane))
    PHASE(3, phase3(a, tid))
    PHASE(4, phase4(a, lds, tid, wid, lane))
    PHASE(5, phase5(a, lds, tid, wid, lane))
    PHASE(6, phase6(a, lds, tid, wid, lane))
    PHASE(7, phase7(a, lds, tid, wid, lane))
    PHASE(8, phase8(a, lds, tb, tid, wid, lane))
    PHASE(9, phase9(a, lds, tb, tid, wid, lane))
    PHASE(10, phase10(a, tb, tid, wid, lane))
#undef PHASE
}

extern "C" void kernel_launch(void* const* d_in, const int* in_sizes, int n_in, void* d_out, int out_size, void* d_ws, size_t ws_size, hipStream_t stream) {
    static int grid = 0;
    if (grid == 0) {
        if (n_in != 26 || out_size != T * D || ws_size < WS_END) { fprintf(stderr, "kernel_launch: unexpected shapes (n_in %d out %d ws %zu need %zu)\n", n_in, out_size, ws_size, (size_t)WS_END); grid = -1; return; }
        int dev = 0, cus = 0, per_cu = 0;
        if (hipGetDevice(&dev) != hipSuccess || hipDeviceGetAttribute(&cus, hipDeviceAttributeMultiprocessorCount, dev) != hipSuccess) { grid = -1; return; }
        if (hipFuncSetAttribute((const void*)mega_fwd, hipFuncAttributeMaxDynamicSharedMemorySize, LDS_BYTES) != hipSuccess) { fprintf(stderr, "kernel_launch: hipFuncSetAttribute failed\n"); grid = -1; return; }
        if (hipOccupancyMaxActiveBlocksPerMultiprocessor(&per_cu, (const void*)mega_fwd, 512, LDS_BYTES) != hipSuccess || per_cu < 1)
            fprintf(stderr, "kernel_launch: occupancy query reports %d blocks per CU\n", per_cu);
        (void)hipGetLastError();
        grid = cus;
    }
    if (grid < 0) return;
    Args a{};
    for (int i = 0; i < 26; ++i) a.in[i] = (const float*)d_in[i];
    a.out = (float*)d_out; a.ws = (unsigned char*)d_ws;
#if N_LAUNCH_SPLIT
    for (int k = 0; k < NPHASE; ++k) {
        (void)hipMemsetAsync((char*)d_ws + WS_BAR, 0, XCD_BAR_WORDS * sizeof(unsigned), stream);
        a.ph_lo = k; a.ph_hi = k + 1;
        hipLaunchKernelGGL(mega_fwd, dim3(grid), dim3(512), LDS_BYTES, stream, a);
    }
#else
    (void)hipMemsetAsync((char*)d_ws + WS_BAR, 0, XCD_BAR_WORDS * sizeof(unsigned), stream);
    a.ph_lo = 0; a.ph_hi = NPHASE;
    hipLaunchKernelGGL(mega_fwd, dim3(grid), dim3(512), LDS_BYTES, stream, a);
#endif
}
```

```cpp
#include <hip/hip_runtime.h>
#include <hip/hip_bf16.h>
#include <stdint.h>
#include <stdio.h>

#ifndef N_LAUNCH_SPLIT
#define N_LAUNCH_SPLIT 0
#endif

#define DEVI __device__ __forceinline__
typedef __attribute__((ext_vector_type(8))) short bf16x8;
typedef __attribute__((ext_vector_type(4))) float f32x4;
typedef __attribute__((ext_vector_type(4))) int i32x4;
typedef __attribute__((ext_vector_type(2))) float f2v;
typedef __attribute__((ext_vector_type(2))) __bf16 b2v;
typedef unsigned short u16;

constexpr int T = 8192, D = 2048, PW = 4112;
constexpr int NH = 4, HK = 128, HV = 256, CH = 64, NCH = 128, RANK = 16;
constexpr int SW = 1024, SG = 16, NG = 64, SP = 64;
constexpr int NE = 32, FF = 2048, CAP = 8192;
constexpr int PJ = 4096;
constexpr float EPS = 1e-6f;

constexpr size_t WS_BAR   = 0;
constexpr size_t WS_CNT   = 32768;
constexpr size_t WS_SSQ   = 65536;
constexpr size_t WS_GLR   = WS_SSQ + 65536;
constexpr size_t WS_DEC   = WS_GLR + (size_t)T * 16 * 4;
constexpr size_t WS_S5AL  = WS_DEC + (size_t)NCH * NH * HK * 4;
constexpr size_t WS_TSLOT = WS_S5AL + 65536;
constexpr size_t WS_LTOK  = WS_TSLOT + (size_t)T * 4 * 4;
constexpr size_t WS_LGATE = WS_LTOK + (size_t)NE * CAP * 4;
constexpr size_t WS_S5K   = WS_LGATE + (size_t)NE * CAP * 4;
constexpr size_t WS_S5WE  = WS_S5K + (size_t)NG * 64 * 256 * 2;
constexpr size_t WS_S5V   = WS_S5WE + (size_t)NG * 128 * 1024 * 2;
constexpr size_t WS_S5E   = WS_S5V + (size_t)NG * 1024 * 128 * 2;
constexpr size_t WS_S5H   = WS_S5E + (size_t)NG * 128 * 128 * 4;
constexpr size_t WS_HN    = WS_S5H + (size_t)NG * 128 * 128 * 2;
constexpr size_t WS_PROJ  = WS_HN + (size_t)T * D * 2;
constexpr size_t WS_KV    = WS_PROJ + (size_t)T * PJ * 2;
constexpr size_t WS_ST    = WS_KV + (size_t)NCH * NH * HV * HK * 4;
constexpr size_t WS_Z     = WS_ST + (size_t)NCH * NH * HV * HK * 2;
constexpr size_t WS_MIX   = WS_Z + (size_t)T * SW * 2;
constexpr size_t WS_H1    = WS_MIX + (size_t)T * D * 2;
constexpr size_t WS_HN2   = WS_H1 + (size_t)T * D * 4;
constexpr size_t WS_ACT   = WS_HN2 + (size_t)T * D * 2;
constexpr size_t WS_Y     = WS_ACT + (size_t)(T * 4 + 256) * FF * 2;
constexpr size_t WS_W1T   = WS_Y + (size_t)(T * 4 + 256) * D * 2;
constexpr size_t WS_W2T   = WS_W1T + (size_t)NE * 4096 * D;
constexpr size_t WS_WINT  = WS_W2T + (size_t)NE * D * FF;
constexpr size_t WS_GLUT  = WS_WINT + (size_t)PJ * D * 2;
constexpr size_t WS_WOUTT = WS_GLUT + (size_t)SW * SW * 2;
constexpr size_t WS_END   = WS_WOUTT + (size_t)D * D * 2;

constexpr int LDS_BYTES = 163840;
constexpr int LDS_CONV = 131072;
constexpr int LDS_BASE = 1024;

DEVI unsigned pack2(float a, float b) { f2v v = {a, b}; b2v r = __builtin_convertvector(v, b2v); return __builtin_bit_cast(unsigned, r); }
DEVI u16 f2bf(float a) { __bf16 r = (__bf16)a; return __builtin_bit_cast(u16, r); }
DEVI float bf2f(u16 h) { return __uint_as_float(((unsigned)h) << 16); }
DEVI float bflo(unsigned w) { return __uint_as_float(w << 16); }
DEVI float bfhi(unsigned w) { return __uint_as_float(w & 0xffff0000u); }
DEVI float wave_sum(float v) {
#pragma unroll
    for (int o = 32; o >= 1; o >>= 1) v += __shfl_xor(v, o);
    return v;
}
DEVI float sum16(float v) {
#pragma unroll
    for (int o = 8; o >= 1; o >>= 1) v += __shfl_xor(v, o);
    return v;
}
DEVI float sigmoidf_(float x) { return __builtin_amdgcn_rcpf(1.0f + __expf(-x)); }
DEVI float logsigmoid_(float x) { return fminf(x, 0.0f) - __logf(1.0f + __expf(-fabsf(x))); }
DEVI float gelu_tanh(float x) {
    const float a = 0.7978845608028654f * (x + 0.044715f * x * x * x);
    return x * __builtin_amdgcn_rcpf(1.0f + __expf(-2.0f * a));
}

#define WAIT_V0() asm volatile("s_waitcnt vmcnt(0)" ::: "memory")
#define WAIT_L0() asm volatile("s_waitcnt lgkmcnt(0)" ::: "memory")

#define XB_TMO      128
#define XB_XCNT(j)  (256  + 64 * (j))
#define XB_XSUB(j)  (1280 + 64 * (j))
#define XB_XGEN(j)  (2304 + 64 * (j))
#define XB_TOP      3328
#define XB_TOPGEN   3392
#define XCD_BAR_WORDS 3456
#define XB_SPIN_CAP (1u << 20)
#define LAS __attribute__((address_space(3)))

DEVI unsigned xb_ld(unsigned* p)              { return __hip_atomic_load(p, __ATOMIC_RELAXED, __HIP_MEMORY_SCOPE_AGENT); }
DEVI unsigned xb_add(unsigned* p, unsigned v) { return __hip_atomic_fetch_add(p, v, __ATOMIC_RELAXED, __HIP_MEMORY_SCOPE_AGENT); }
DEVI unsigned xb_xcc_id() { return (unsigned)__builtin_amdgcn_s_getreg((3 << 11) | 20) & 0xFu; }
#define XB_SPIN(cond, bar) do { unsigned _sp = 0; while (cond) { __builtin_amdgcn_s_sleep(1); \
    if ((++_sp & 255u) == 0u) { if (xb_ld(&(bar)[XB_TMO])) break; if (_sp > XB_SPIN_CAP) { atomicAdd(&(bar)[XB_TMO], 1u); break; } } } } while (0)

struct XcdBarrier { unsigned* bar; unsigned x; volatile LAS unsigned* st; };

DEVI XcdBarrier xcd_barrier_post(unsigned* bar, volatile LAS unsigned* st) {
    XcdBarrier b; b.bar = bar; b.x = xb_xcc_id(); b.st = st;
    if (threadIdx.x == 0) (void)xb_add(&bar[XB_XCNT(b.x)], 1u);
    return b;
}
DEVI void xcd_barrier_complete(unsigned* bar, unsigned x, unsigned& nloc, unsigned& nx) {
    const unsigned G = gridDim.x * gridDim.y * gridDim.z;
    unsigned sum, cnt, mine, sp = 0u;
    for (;;) {
        sum = 0u; cnt = 0u; mine = 0u;
#pragma unroll
        for (unsigned j = 0; j < 16; ++j) { const unsigned c = xb_ld(&bar[XB_XCNT(j)]); sum += c; cnt += (c > 0u) ? 1u : 0u; mine = (j == x) ? c : mine; }
        if (sum == G) break;
        __builtin_amdgcn_s_sleep(1);
        if ((++sp & 255u) == 0u) { if (xb_ld(&bar[XB_TMO])) break; if (sp > XB_SPIN_CAP) { atomicAdd(&bar[XB_TMO], 1u); break; } }
    }
    nloc = mine > 0u ? mine : 1u; nx = cnt > 0u ? cnt : 1u;
}
DEVI void xcd_barrier(const XcdBarrier& b) {
    asm volatile("s_waitcnt vmcnt(0)" ::: "memory");
    __syncthreads();
    if (threadIdx.x == 0) {
        unsigned* bar = b.bar;
        __builtin_amdgcn_s_waitcnt(0);
        unsigned nloc = b.st[0], nx = b.st[1];
        if (nloc == 0u) { xcd_barrier_complete(bar, b.x, nloc, nx); b.st[0] = nloc; b.st[1] = nx; }
        const unsigned old = xb_add(&bar[XB_XSUB(b.x)], 1u);
        const unsigned gen = old / nloc;
        if (old + 1u == (gen + 1u) * nloc) {
            __builtin_amdgcn_fence(__ATOMIC_RELEASE, "agent");
            asm volatile("s_waitcnt vmcnt(0)" ::: "memory");
            const unsigned og = xb_add(&bar[XB_TOP], 1u);
            const unsigned tg = og / nx;
            if (og + 1u == (tg + 1u) * nx) xb_add(&bar[XB_TOPGEN], 1u);
            else XB_SPIN(xb_ld(&bar[XB_TOPGEN]) == tg, bar);
            __builtin_amdgcn_fence(__ATOMIC_ACQUIRE, "agent");
            xb_add(&bar[XB_XGEN(b.x)], 1u);
            asm volatile("s_waitcnt vmcnt(0)" ::: "memory");
        } else {
            XB_SPIN(xb_ld(&bar[XB_XGEN(b.x)]) == gen, bar);
            __builtin_amdgcn_fence(__ATOMIC_ACQUIRE, "agent");
            asm volatile("s_waitcnt vmcnt(0)" ::: "memory");
        }
    }
    __syncthreads();
}

struct Args {
    const float* in[26];
    float* out;
    unsigned char* ws;
    int ph_lo, ph_hi;
};

template <int KS> DEVI int lds_byte(int r, int c) {
    int st = (r >> 4) * KS + (c >> 5), ob = (r & 15) * 64 + (c & 31) * 2;
    return st * 1024 + (ob ^ (((ob >> 9) & 1) << 5));
}
typedef __attribute__((ext_vector_type(16))) float f32x16;
typedef __attribute__((ext_vector_type(8))) int i32x8;
DEVI void f8_stage_rb(int wid, int lane, int i, int& R, int& CB) {
    R = wid * 16 + i * 128 + (lane >> 2);
    CB = (((lane & 3) ^ (R >> 2)) & 3) * 16;
}
DEVI int acc_row32(int wr, int m, int r, int lane) { return wr * 128 + m * 32 + (r & 3) + 8 * (r >> 2) + 4 * (lane >> 5); }
DEVI unsigned cvt4_fp8(float a, float b, float c, float d) {
    int r = 0;
    r = __builtin_amdgcn_cvt_pk_fp8_f32(a, b, r, false);
    r = __builtin_amdgcn_cvt_pk_fp8_f32(c, d, r, true);
    return (unsigned)r;
}
#define WAIT_VN(n) asm volatile("s_waitcnt vmcnt(" #n ")" ::: "memory")
DEVI void f8_stage(char* lds, const unsigned char* __restrict__ A, const unsigned (&aoff)[2], const unsigned char* __restrict__ B, const unsigned (&boffv)[2], int wid, int t) {
    char* sb = lds + (t & 3) * 32768 + wid * 1024;
#pragma unroll
    for (int i = 0; i < 2; ++i) {
        __builtin_amdgcn_global_load_lds((const unsigned*)(A + aoff[i] + t * 64), (LAS unsigned*)(sb + i * 8192), 16, 0, 0);
        __builtin_amdgcn_global_load_lds((const unsigned*)(B + boffv[i] + t * 64), (LAS unsigned*)(sb + 16384 + i * 8192), 16, 0, 0);
    }
}
DEVI void f8_prefetch(char* lds, const unsigned char* __restrict__ A, const unsigned (&aoff)[2], const unsigned char* __restrict__ B, const unsigned (&boffv)[2], int wid) {
    f8_stage(lds, A, aoff, B, boffv, wid, 0); f8_stage(lds, A, aoff, B, boffv, wid, 1); f8_stage(lds, A, aoff, B, boffv, wid, 2);
}
DEVI void q8_stage(char* lds, const unsigned char* __restrict__ A, const unsigned (&aoff)[2], const unsigned char* __restrict__ B, const unsigned (&boffv)[2], int wid, int t) {
    char* sb = lds + (t & 3) * 32768 + wid * 1024;
#pragma unroll
    for (int i = 0; i < 2; ++i) {
        __builtin_amdgcn_global_load_lds((const unsigned*)(A + aoff[i] + t * 64), (LAS unsigned*)(sb + i * 8192), 16, 0, 0);
        __builtin_amdgcn_global_load_lds((const unsigned*)(B + boffv[i] + t * 8192), (LAS unsigned*)(sb + 16384 + i * 8192), 16, 0, 0);
    }
}
DEVI void q8_prefetch(char* lds, const unsigned char* __restrict__ A, const unsigned (&aoff)[2], const unsigned char* __restrict__ B, const unsigned (&boffv)[2], int wid) {
    q8_stage(lds, A, aoff, B, boffv, wid, 0); q8_stage(lds, A, aoff, B, boffv, wid, 1); q8_stage(lds, A, aoff, B, boffv, wid, 2);
}
template <int NT, int SCALE_A, int SCALE_B, bool MOE1>
DEVI void f8_mainloop(char* lds, const unsigned char* __restrict__ A, const unsigned (&aoff)[2], const unsigned char* __restrict__ B, const unsigned (&boffv)[2],
                      int wid, int lane, f32x16 (&acc)[2][4]) {
    const int wr = wid >> 2, wc = wid & 3, l31 = lane & 31, hh = lane >> 5;
    const int xs = (l31 >> 2) & 3;
    const int p0 = ((2 * hh) ^ xs) << 4, p1 = ((2 * hh + 1) ^ xs) << 4;
    const int a_lo = (wr * 128 + l31) * 64 + p0, a_hi = (wr * 128 + l31) * 64 + p1;
    int b_rd[2];
#pragma unroll
    for (int nf = 0; nf < 2; ++nf) {
        const int ntile = MOE1 ? nf : (wc >> 1), nbase = MOE1 ? wc * 32 : (wc & 1) * 64 + nf * 32;
        b_rd[nf] = 16384 + ntile * 8192 + (8 * hh) * 512 + (nbase + l31) * 4;
    }
    auto ldfrag = [&](const char* sa, int lo, int hi) -> i32x8 {
        const i32x4 x = *(const i32x4*)(sa + lo), y = *(const i32x4*)(sa + hi);
        i32x8 r; r[0] = x[0]; r[1] = x[1]; r[2] = x[2]; r[3] = x[3]; r[4] = y[0]; r[5] = y[1]; r[6] = y[2]; r[7] = y[3];
        return r;
    };
    auto compute = [&](int t) {
        const char* sa = lds + (t & 3) * 32768;
        i32x8 fa[4], fb[2];
#pragma unroll
        for (int m = 0; m < 4; ++m) fa[m] = ldfrag(sa + m * 2048, a_lo, a_hi);
#pragma unroll
        for (int n = 0; n < 2; ++n)
#pragma unroll
            for (int j = 0; j < 8; ++j) fb[n][j] = *(const int*)(sa + b_rd[n] + j * 512);
#pragma unroll
        for (int m = 0; m < 4; ++m)
#pragma unroll
            for (int n = 0; n < 2; ++n)
                acc[n][m] = __builtin_amdgcn_mfma_scale_f32_32x32x64_f8f6f4(fb[n], fa[m], acc[n][m], 0, 0, 0, SCALE_B, 0, SCALE_A);
    };
    WAIT_V0(); __builtin_amdgcn_s_barrier();
#pragma unroll 1
    for (int t = 0; t < NT; ++t) {
        if (t + 3 < NT) q8_stage(lds, A, aoff, B, boffv, wid, t + 3);
        compute(t);
        if (t + 3 < NT) { WAIT_VN(8); } else if (t + 2 < NT) { WAIT_VN(4); } else { WAIT_V0(); }
        WAIT_L0(); __builtin_amdgcn_s_barrier();
    }
}
DEVI void touch4(const f32x4& v) { asm volatile("" :: "v"(v)); }
DEVI void touchf(float v) { asm volatile("" :: "v"(v)); }
DEVI void zero_acc32(f32x16 (&acc)[2][4]) {
#pragma unroll
    for (int n = 0; n < 2; ++n)
#pragma unroll
        for (int m = 0; m < 4; ++m)
#pragma unroll
            for (int r = 0; r < 16; ++r) acc[n][m][r] = 0.f;
}

DEVI void bf_stage_rb(int wid, int lane, int i, int& R, int& CB) {
    R = wid * 16 + i * 128 + (lane >> 2);
    CB = (((lane & 3) ^ (R >> 1)) & 3) * 16;
}
template <int NT>
DEVI void bf_mainloop(char* lds, const unsigned char* __restrict__ A, const unsigned (&aoff)[2], const unsigned char* __restrict__ B, const unsigned (&boffv)[2],
                      int wid, int lane, f32x4 (&acc)[4][8]) {
    const int wr = wid >> 2, wc = wid & 3, l15 = lane & 15, q = lane >> 4;
    const int cp = (q ^ ((l15 >> 1) & 3)) << 4;
    const int t_rd = (wr * 128 + l15) * 64 + cp;
    const int w_rd = 16384 + (wc * 64 + l15) * 64 + cp;
    auto compute = [&](int t) {
        const char* sa = lds + (t & 3) * 32768;
        bf16x8 tf[8], wf[4];
#pragma unroll
        for (int nt = 0; nt < 4; ++nt) wf[nt] = *(const bf16x8*)(sa + w_rd + nt * 1024);
#pragma unroll
        for (int mt = 0; mt < 8; ++mt) tf[mt] = *(const bf16x8*)(sa + t_rd + mt * 1024);
#pragma unroll
        for (int mt = 0; mt < 8; ++mt)
#pragma unroll
            for (int nt = 0; nt < 4; ++nt)
                acc[nt][mt] = __builtin_amdgcn_mfma_f32_16x16x32_bf16(wf[nt], tf[mt], acc[nt][mt], 0, 0, 0);
    };
    WAIT_V0(); __builtin_amdgcn_s_barrier();
#pragma unroll 1
    for (int t = 0; t < NT; ++t) {
        if (t + 3 < NT) f8_stage(lds, A, aoff, B, boffv, wid, t + 3);
        compute(t);
        if (t + 3 < NT) { WAIT_VN(8); } else if (t + 2 < NT) { WAIT_VN(4); } else { WAIT_V0(); }
        WAIT_L0(); __builtin_amdgcn_s_barrier();
    }
}
DEVI void zero_acc16(f32x4 (&acc)[4][8]) {
#pragma unroll
    for (int nt = 0; nt < 4; ++nt)
#pragma unroll
        for (int mt = 0; mt < 8; ++mt) acc[nt][mt] = f32x4{0.f, 0.f, 0.f, 0.f};
}
DEVI void bf_offsets(unsigned (&off)[2], int wid, int lane, int row0, int ld) {
#pragma unroll
    for (int i = 0; i < 2; ++i) { int R, CB; bf_stage_rb(wid, lane, i, R, CB); off[i] = ((unsigned)(row0 + R) * ld) * 2u + CB; }
}

DEVI void dense_convert(const Args& a, char* lds, int tid, int wid, int lane) {
    constexpr int RS = 132;
    unsigned* L = (unsigned*)lds;
    const int kq = tid >> 5, nq = tid & 31;
    auto tile = [&](int tl, const float*& src, int& ld, int& ldo, u16*& dst) {
        if (tl < 512) { const int kt = tl & 15, nt = tl >> 4; const int c0 = (nt < 24) ? nt * 128 : 3088 + (nt - 24) * 128;
            src = a.in[2] + (size_t)(kt * 128) * PW + c0; ld = PW; ldo = D; dst = (u16*)(a.ws + WS_WINT) + (size_t)(nt * 128) * D + kt * 128; }
        else if (tl < 576) { const int t2 = tl - 512, kt = t2 & 7, nt = t2 >> 3;
            src = a.in[14] + (size_t)(kt * 128) * SW + nt * 128; ld = SW; ldo = SW; dst = (u16*)(a.ws + WS_GLUT) + (size_t)(nt * 128) * SW + kt * 128; }
        else { const int t2 = tl - 576, kt = t2 & 15, nt = t2 >> 4;
            src = a.in[17] + (size_t)(kt * 128) * D + nt * 128; ld = D; ldo = D; dst = (u16*)(a.ws + WS_WOUTT) + (size_t)(nt * 128) * D + kt * 128; }
    };
    f32x4 v[2][4];
    auto issue = [&](int tl) {
        const float* src; int ld, ldo; u16* dst; tile(tl, src, ld, ldo, dst);
#pragma unroll
        for (int h = 0; h < 2; ++h)
#pragma unroll
            for (int r = 0; r < 4; ++r) v[h][r] = *(const f32x4*)(src + (size_t)(4 * (kq + 16 * h) + r) * ld + 4 * nq);
    };
    if ((int)blockIdx.x < 832) issue(blockIdx.x);
#pragma unroll 1
    for (int tl = blockIdx.x; tl < 832; tl += gridDim.x) {
        const float* src; int ld, ldo; u16* dst; tile(tl, src, ld, ldo, dst);
        __syncthreads();
#pragma unroll
        for (int h = 0; h < 2; ++h) {
            i32x4 d0, d1;
#pragma unroll
            for (int c = 0; c < 4; ++c) { d0[c] = (int)pack2(v[h][0][c], v[h][1][c]); d1[c] = (int)pack2(v[h][2][c], v[h][3][c]); }
            *(i32x4*)(L + (2 * (kq + 16 * h)) * RS + 4 * nq) = d0;
            *(i32x4*)(L + (2 * (kq + 16 * h) + 1) * RS + 4 * nq) = d1;
        }
        if (tl + (int)gridDim.x < 832) issue(tl + gridDim.x);
        __syncthreads();
        {
            const int part = wid & 3, n = (wid >> 2) * 64 + lane;
            unsigned o[16];
#pragma unroll
            for (int j = 0; j < 16; ++j) o[j] = L[(16 * part + j) * RS + n];
            uint4* dp = (uint4*)(dst + (size_t)n * ldo + 32 * part);
            dp[0] = make_uint4(o[0], o[1], o[2], o[3]); dp[1] = make_uint4(o[4], o[5], o[6], o[7]);
            dp[2] = make_uint4(o[8], o[9], o[10], o[11]); dp[3] = make_uint4(o[12], o[13], o[14], o[15]);
        }
    }
}

DEVI void convert_range(const Args& a, char* lds, int t_lo, int t_hi, int tid, int wid, int lane) {
    const float* w1 = a.in[21]; const float* w2 = a.in[23];
    unsigned char* W1Q = a.ws + WS_W1T; unsigned char* W2Q = a.ws + WS_W2T;
    { int lq = lane; asm volatile("" : "+v"(lq)); lane = lq; tid = wid * 64 + lq; }
    const int kq0 = tid >> 5, n4 = tid & 31;
    auto tile_src = [&](int tl, const float*& src, int& ld, unsigned char*& dst) {
        if (tl < 16384) { const int kt = tl & 15, nt = (tl >> 4) & 31, e = tl >> 9;
            src = w1 + (size_t)e * D * 4096 + (size_t)(kt * 128) * 4096 + nt * 128; ld = 4096;
            dst = W1Q + ((size_t)(e * 32 + nt) * 512 + kt * 32) * 512; }
        else { const int t2 = tl - 16384, kt = t2 & 15, nt = (t2 >> 4) & 15, e = t2 >> 8;
            src = w2 + (size_t)e * FF * D + (size_t)(kt * 128) * D + nt * 128; ld = D;
            dst = W2Q + ((size_t)(e * 16 + nt) * 512 + kt * 32) * 512; }
    };
    f32x4 va[2][4], vb[2][4];
    auto issue = [&](int tl, f32x4 (&v)[2][4]) {
        const float* src; int ld; unsigned char* dst; tile_src(tl, src, ld, dst);
#pragma unroll
        for (int h = 0; h < 2; ++h)
#pragma unroll
            for (int r = 0; r < 4; ++r) v[h][r] = __builtin_nontemporal_load((const f32x4*)(src + (size_t)(4 * (kq0 + 16 * h) + r) * ld + 4 * n4));
    };
    auto finish = [&](int tl, f32x4 (&v)[2][4], int tnext) {
        const float* src; int ld; unsigned char* dst; tile_src(tl, src, ld, dst);
        uint4 o[2];
#pragma unroll
        for (int h = 0; h < 2; ++h) {
            o[h].x = cvt4_fp8(v[h][0][0] * 256.f, v[h][1][0] * 256.f, v[h][2][0] * 256.f, v[h][3][0] * 256.f);
            o[h].y = cvt4_fp8(v[h][0][1] * 256.f, v[h][1][1] * 256.f, v[h][2][1] * 256.f, v[h][3][1] * 256.f);
            o[h].z = cvt4_fp8(v[h][0][2] * 256.f, v[h][1][2] * 256.f, v[h][2][2] * 256.f, v[h][3][2] * 256.f);
            o[h].w = cvt4_fp8(v[h][0][3] * 256.f, v[h][1][3] * 256.f, v[h][2][3] * 256.f, v[h][3][3] * 256.f);
        }
        if (tnext < t_hi) issue(tnext, v);
#pragma unroll
        for (int h = 0; h < 2; ++h) *(uint4*)(dst + ((size_t)(kq0 + 16 * h) * 128 + 4 * n4) * 4) = o[h];
    };
    if (t_lo < t_hi) issue(t_lo, va);
    if (t_lo + 1 < t_hi) issue(t_lo + 1, vb);
#pragma unroll 1
    for (int tl = t_lo; tl < t_hi; tl += 2) {
        finish(tl, va, tl + 2);
        if (tl + 1 < t_hi) finish(tl + 1, vb, tl + 3);
    }
}

DEVI void convert_pool(const Args& a, char* lds, int which, int p_lo, int p_hi, int tid, int wid, int lane) {
    int* cur = (int*)(a.ws + WS_CNT) + 64 + which;
    volatile int* bc = (volatile int*)(lds - LDS_BASE + 32);
#pragma unroll 1
    while (true) {
        __syncthreads();
        if (tid == 0) *bc = atomicAdd(cur, 4);
        __syncthreads();
        const int t = p_lo + *bc;
        if (t >= p_hi) break;
        convert_range(a, lds, t, min(t + 4, p_hi), tid, wid, lane);
    }
}

DEVI void phase0(const Args& a, char* lds, int tid, int wid, int lane) {
    const float* x = a.in[0]; const float* g1 = a.in[1]; const float* w_in = a.in[2];
    u16* HN = (u16*)(a.ws + WS_HN); float* GLR = (float*)(a.ws + WS_GLR);
    constexpr int RSB = 4096 + 16;
    char* Wb = lds;
    char* Hb = lds + 16 * RSB;
    float* red = (float*)(lds + 32 * RSB);
    for (int u = blockIdx.x; u < 256; u += gridDim.x) {
        __syncthreads();
        for (int k = 0; k < 4; ++k) {
            const int d = (tid + 512 * k + 8 * (int)blockIdx.x) & 2047;
            const f32x4* src = (const f32x4*)(w_in + (size_t)d * PW + 3072);
#pragma unroll
            for (int q = 0; q < 4; ++q) { f32x4 v = src[q];
#pragma unroll
                for (int c = 0; c < 4; ++c) *(u16*)(Wb + (q * 4 + c) * RSB + d * 2) = f2bf(v[c]); }
        }
        if (tid < 32) ((float*)(a.ws + WS_SSQ))[u * 32 + tid] = 0.f;
        if (u == 0 && tid < 32) { ((int*)(a.ws + WS_CNT))[tid] = 0; ((int*)(a.ws + WS_CNT))[64 + tid] = 0; }
#pragma unroll 1
        for (int ps = 0; ps < 2; ++ps) {
            const int tok0 = u * 32 + ps * 16;
            {
                const int tokA = tok0 + wid * 2, tokB = tokA + 1;
                f32x4 xa[8], xb[8];
                float ssa = 0.f, ssb = 0.f;
#pragma unroll
                for (int i = 0; i < 8; ++i) {
                    xa[i] = *(const f32x4*)(x + (size_t)tokA * D + 256 * i + 4 * lane);
                    xb[i] = *(const f32x4*)(x + (size_t)tokB * D + 256 * i + 4 * lane);
#pragma unroll
                    for (int c = 0; c < 4; ++c) { ssa += xa[i][c] * xa[i][c]; ssb += xb[i][c] * xb[i][c]; }
                }
                ssa = wave_sum(ssa); ssb = wave_sum(ssb);
                const float ra = rsqrtf(ssa * (1.0f / D) + EPS), rb = rsqrtf(ssb * (1.0f / D) + EPS);
#pragma unroll
                for (int i = 0; i < 8; ++i) {
                    const f32x4 g = *(const f32x4*)(g1 + 256 * i + 4 * lane);
                    uint2 pa, pb;
                    pa.x = pack2(xa[i][0] * ra * g[0], xa[i][1] * ra * g[1]); pa.y = pack2(xa[i][2] * ra * g[2], xa[i][3] * ra * g[3]);
                    pb.x = pack2(xb[i][0] * rb * g[0], xb[i][1] * rb * g[1]); pb.y = pack2(xb[i][2] * rb * g[2], xb[i][3] * rb * g[3]);
                    *(uint2*)(HN + (size_t)tokA * D + 256 * i + 4 * lane) = pa;
                    *(uint2*)(HN + (size_t)tokB * D + 256 * i + 4 * lane) = pb;
                    *(uint2*)(Hb + (wid * 2) * RSB + (256 * i + 4 * lane) * 2) = pa;
                    *(uint2*)(Hb + (wid * 2 + 1) * RSB + (256 * i + 4 * lane) * 2) = pb;
                }
            }
            __syncthreads();
            {
                const int l15 = lane & 15, q = lane >> 4;
                f32x4 acc = {0.f, 0.f, 0.f, 0.f};
#pragma unroll
                for (int ks = 0; ks < 8; ++ks) {
                    const int kb = (wid * 256 + ks * 32 + q * 8) * 2;
                    const bf16x8 av = *(const bf16x8*)(Hb + l15 * RSB + kb);
                    const bf16x8 bv = *(const bf16x8*)(Wb + l15 * RSB + kb);
                    acc = __builtin_amdgcn_mfma_f32_16x16x32_bf16(av, bv, acc, 0, 0, 0);
                }
#pragma unroll
                for (int j = 0; j < 4; ++j) red[(wid * 16 + 4 * q + j) * 16 + l15] = acc[j];
            }
            __syncthreads();
            if (tid < 256) {
                float sacc = 0.f;
#pragma unroll
                for (int w = 0; w < 8; ++w) sacc += red[w * 256 + tid];
                GLR[(size_t)(tok0 + (tid >> 4)) * 16 + (tid & 15)] = sacc;
            }
        }
    }
    const float* a_re = a.in[6]; const float* a_im = a.in[7]; const float* b_re = a.in[8]; const float* b_im = a.in[9];
    const float* c_re = a.in[10]; const float* c_im = a.in[11]; const float* lstep = a.in[13];
    u16* KT = (u16*)(a.ws + WS_S5K); u16* WE = (u16*)(a.ws + WS_S5WE); u16* VV = (u16*)(a.ws + WS_S5V); float* AL = (float*)(a.ws + WS_S5AL);
    float* Bre = (float*)lds;
    float* Bim = Bre + 1024;
    float* Cre = Bim + 1024;
    float* Cim = Cre + 1024;
    float* Pre = Cim + 1024;
    float* Pim = Pre + 65 * 64;
    for (int u = blockIdx.x; u < 256; u += gridDim.x) {
        const int g = u >> 2, q = u & 3;
        __syncthreads();
        const float delta = __expf(lstep[g]);
        if (tid < 64) {
            const int p = tid;
            const float ar = a_re[g * 64 + p], ai = a_im[g * 64 + p];
            const float ea = expf(ar * delta);
            float sn, cs; sincosf(ai * delta, &sn, &cs);
            const float xr = ea * cs - 1.0f, xi = ea * sn;
            const float den = 1.0f / (ar * ar + ai * ai);
            const float cr = (xr * ar + xi * ai) * den, ci = (xi * ar - xr * ai) * den;
#pragma unroll
            for (int m = 0; m < 16; ++m) {
                const float br = b_re[(g * 64 + p) * 16 + m], bi = b_im[(g * 64 + p) * 16 + m];
                Bre[p * 16 + m] = cr * br - ci * bi;
                Bim[p * 16 + m] = cr * bi + ci * br;
            }
        }
        for (int i = tid; i < 1024; i += 512) { Cre[i] = c_re[g * 1024 + i]; Cim[i] = c_im[g * 1024 + i]; }
        for (int i = tid; i < 65 * 64; i += 512) {
            const int tau = i >> 6, p = i & 63;
            const float ar = a_re[g * 64 + p], ai = a_im[g * 64 + p];
            const float e = expf((float)tau * ar * delta);
            float sn, cs; sincosf((float)tau * (ai * delta), &sn, &cs);
            Pre[i] = e * cs; Pim[i] = e * sn;
        }
        __syncthreads();
        if (q == 0 && tid < 64) { AL[(g * 64 + tid) * 2] = Pre[64 * 64 + tid]; AL[(g * 64 + tid) * 2 + 1] = Pim[64 * 64 + tid]; }
        if (tid < 256) {
            const int tau = q * 16 + (tid >> 4), n = tid & 15;
            float acc[16];
#pragma unroll
            for (int m = 0; m < 16; ++m) acc[m] = 0.f;
#pragma unroll 2
            for (int p = 0; p < 64; ++p) {
                const float cr = Cre[n * 64 + p], ci = Cim[n * 64 + p], pr = Pre[tau * 64 + p], pi = Pim[tau * 64 + p];
                const float xr = cr * pr - ci * pi, xi = cr * pi + ci * pr;
#pragma unroll
                for (int m4 = 0; m4 < 4; ++m4) {
                    const f32x4 br = *(const f32x4*)(Bre + p * 16 + m4 * 4), bi = *(const f32x4*)(Bim + p * 16 + m4 * 4);
#pragma unroll
                    for (int c = 0; c < 4; ++c) acc[m4 * 4 + c] += xr * br[c] - xi * bi[c];
                }
            }
            uint4 o0, o1;
            o0.x = pack2(acc[0], acc[1]); o0.y = pack2(acc[2], acc[3]); o0.z = pack2(acc[4], acc[5]); o0.w = pack2(acc[6], acc[7]);
            o1.x = pack2(acc[8], acc[9]); o1.y = pack2(acc[10], acc[11]); o1.z = pack2(acc[12], acc[13]); o1.w = pack2(acc[14], acc[15]);
            uint4* dst = (uint4*)(KT + ((size_t)(g * 64 + tau) * 16 + n) * 16);
            dst[0] = o0; dst[1] = o1;
        }
        {
            const int p = tid >> 3;
#pragma unroll
            for (int ss = 0; ss < 2; ++ss) {
                const int s = q * 16 + (tid & 7) * 2 + ss;
                const float pr = Pre[(63 - s) * 64 + p], pi = Pim[(63 - s) * 64 + p];
                float vr[16], vi[16];
#pragma unroll
                for (int m = 0; m < 16; ++m) { const float br = Bre[p * 16 + m], bi = Bim[p * 16 + m]; vr[m] = pr * br - pi * bi; vi[m] = pr * bi + pi * br; }
                uint4 r0, r1, i0, i1;
                r0.x = pack2(vr[0], vr[1]); r0.y = pack2(vr[2], vr[3]); r0.z = pack2(vr[4], vr[5]); r0.w = pack2(vr[6], vr[7]);
                r1.x = pack2(vr[8], vr[9]); r1.y = pack2(vr[10], vr[11]); r1.z = pack2(vr[12], vr[13]); r1.w = pack2(vr[14], vr[15]);
                i0.x = pack2(vi[0], vi[1]); i0.y = pack2(vi[2], vi[3]); i0.z = pack2(vi[4], vi[5]); i0.w = pack2(vi[6], vi[7]);
                i1.x = pack2(vi[8], vi[9]); i1.y = pack2(vi[10], vi[11]); i1.z = pack2(vi[12], vi[13]); i1.w = pack2(vi[14], vi[15]);
                uint4* dr = (uint4*)(WE + ((size_t)(g * 128 + 2 * p) * 1024 + s * 16));
                uint4* di = (uint4*)(WE + ((size_t)(g * 128 + 2 * p + 1) * 1024 + s * 16));
                dr[0] = r0; dr[1] = r1; di[0] = i0; di[1] = i1;
            }
        }
        {
            const int tau = q * 16 + (tid >> 5), n = (tid >> 1) & 15, ph = tid & 1;
            unsigned* dst = (unsigned*)(VV + ((size_t)(g * 1024 + tau * 16 + n) * 128 + ph * 64));
#pragma unroll 4
            for (int pp = 0; pp < 32; ++pp) {
                const int p = ph * 32 + pp;
                const float cr = Cre[n * 64 + p], ci = Cim[n * 64 + p], pr = Pre[(tau + 1) * 64 + p], pi = Pim[(tau + 1) * 64 + p];
                dst[pp] = pack2(cr * pr - ci * pi, -(cr * pi + ci * pr));
            }
        }
    }
    __syncthreads();
    dense_convert(a, lds, tid, wid, lane);
}

DEVI void phase1(const Args& a, char* lds, int tid, int wid, int lane) {
    const unsigned char* HN = a.ws + WS_HN; const unsigned char* WT = a.ws + WS_WINT; u16* PROJ = (u16*)(a.ws + WS_PROJ);
    const int wr = wid >> 2, wc = wid & 3;
    auto unit = [&](int uu, int& mt, int& nt) { const int u = (uu & 7) * 64 + (uu >> 3); mt = u & 31; nt = u >> 5; };
    int uu = blockIdx.x;
    const int cpos = blockIdx.x % 3, c_lo = blockIdx.x * 24, c_hi = c_lo + 24;
    if (cpos == 0) convert_range(a, lds, c_lo, c_hi, tid, wid, lane);
    int mt, nt; unit(uu, mt, nt);
    unsigned aoff[2], boffv[2];
    bf_offsets(aoff, wid, lane, mt * 256, D); bf_offsets(boffv, wid, lane, nt * 256, D);
    f8_prefetch(lds, HN, aoff, WT, boffv, wid);
    int it = 0;
    while (true) {
        const int un = uu + gridDim.x;
        const bool has_next = un < 512;
        f32x4 acc[4][8]; zero_acc16(acc);
        bf_mainloop<64>(lds, HN, aoff, WT, boffv, wid, lane, acc);
        int lz = lane; asm volatile("" : "+v"(lz));
        const int l15 = lz & 15, q = lz >> 4;
        const int mtc = mt, ntc = nt;
        if (has_next) { unit(un, mt, nt); bf_offsets(aoff, wid, lz, mt * 256, D); bf_offsets(boffv, wid, lz, nt * 256, D); f8_prefetch(lds, HN, aoff, WT, boffv, wid); }
        const float sc = (ntc < 2) ? 0.08838834764831845f : 1.0f;
#pragma unroll
        for (int m8 = 0; m8 < 8; ++m8) {
            u16* dst = PROJ + (size_t)(mtc * 256 + wr * 128 + m8 * 16 + l15) * PJ + ntc * 256 + wc * 64 + 4 * q;
#pragma unroll
            for (int n4 = 0; n4 < 4; ++n4) {
                uint2 pk;
                pk.x = pack2(acc[n4][m8][0] * sc, acc[n4][m8][1] * sc);
                pk.y = pack2(acc[n4][m8][2] * sc, acc[n4][m8][3] * sc);
                *(uint2*)(dst + n4 * 16) = pk;
            }
        }
        if (cpos == 1 && it == 0) convert_range(a, lds, c_lo, c_hi, tid, wid, lane);
        ++it;
        if (!has_next) break;
        uu = un;
    }
    if (cpos == 2) convert_range(a, lds, c_lo, c_hi, tid, wid, lane);
    convert_pool(a, lds, 0, 6144, 8192, tid, wid, lane);
}

DEVI void gla_gate(const Args& a, int n, int h, int tid, float* glr, float* tot, float (&b)[16], float& blast) {
    const float* GLR = (const float*)(a.ws + WS_GLR);
    const float* W2 = a.in[3]; const float* gb = a.in[4];
    for (int i = tid; i < 1024; i += 512) glr[i] = GLR[(size_t)n * 64 * 16 + i];
    const int ch = tid & 127, tq = tid >> 7;
    float w[16];
#pragma unroll
    for (int r = 0; r < 16; ++r) w[r] = W2[r * 512 + h * 128 + ch];
    const float bias = gb[h * 128 + ch];
    __syncthreads();
    float run = 0.f;
#pragma unroll
    for (int tt = 0; tt < 16; ++tt) {
        const int t = tq * 16 + tt;
        float s = bias;
#pragma unroll
        for (int r4 = 0; r4 < 4; ++r4) {
            const f32x4 gv = *(const f32x4*)(glr + t * 16 + r4 * 4);
            s += gv[0] * w[r4 * 4] + gv[1] * w[r4 * 4 + 1] + gv[2] * w[r4 * 4 + 2] + gv[3] * w[r4 * 4 + 3];
        }
        run += logsigmoid_(s) * (1.0f / 16.0f);
        b[tt] = run;
    }
    tot[tq * 128 + ch] = run;
    __syncthreads();
    float pre = 0.f;
#pragma unroll
    for (int k = 0; k < 4; ++k) { const float v = tot[k * 128 + ch]; if (k < tq) pre += v; }
    blast = tot[ch] + tot[128 + ch] + tot[256 + ch] + tot[384 + ch];
#pragma unroll
    for (int tt = 0; tt < 16; ++tt) b[tt] += pre;
}
DEVI void gla_stage_vT(const u16* PROJ, int t0, int vcol0, char* img, int tid) {
    if (tid < 256) {
        const int tb = tid >> 5, jb = tid & 31;
        unsigned R[8][4];
#pragma unroll
        for (int tt = 0; tt < 8; ++tt) {
            const uint4 v = *(const uint4*)(PROJ + (size_t)(t0 + tb * 8 + tt) * PJ + vcol0 + jb * 8);
            R[tt][0] = v.x; R[tt][1] = v.y; R[tt][2] = v.z; R[tt][3] = v.w;
        }
#pragma unroll
        for (int jj = 0; jj < 8; ++jj) {
            unsigned o[4];
#pragma unroll
            for (int d = 0; d < 4; ++d) {
                const unsigned lo = R[2 * d][jj >> 1], hi = R[2 * d + 1][jj >> 1];
                o[d] = (jj & 1) ? ((lo >> 16) | (hi & 0xffff0000u)) : ((lo & 0xffffu) | (hi << 16));
            }
            *(uint4*)(img + lds_byte<2>(jb * 8 + jj, tb * 8)) = make_uint4(o[0], o[1], o[2], o[3]);
        }
    }
}

constexpr int USTR = 2048 + 16;
DEVI void s5_fill_U(const u16* PROJ, int g, int cb, char* U, int tid) {
    for (int k = 0; k < 4; ++k) {
        const int idx = tid + 512 * k, c = idx >> 6, s = idx & 63;
        const uint4* src = (const uint4*)(PROJ + (size_t)((cb * 32 + c) * 64 + s) * PJ + 3072 + g * 16);
        uint4* dst = (uint4*)(U + c * USTR + s * 32);
        dst[0] = src[0]; dst[1] = src[1];
    }
}
DEVI void phase2(const Args& a, char* lds, int tid, int wid, int lane) {
    const u16* PROJ = (const u16*)(a.ws + WS_PROJ);
#pragma unroll 1
    for (int u = blockIdx.x; u < 768; u += gridDim.x) {
        { int lq = lane; asm volatile("" : "+v"(lq)); lane = lq; tid = wid * 64 + lq; }
        const int fr = lane & 15, fq = lane >> 4;
        __syncthreads();
        if (u < 256) {
            const int g = u >> 2, cb = u & 3;
            s5_fill_U(PROJ, g, cb, lds, tid);
            __syncthreads();
            const u16* WE = (const u16*)(a.ws + WS_S5WE) + (size_t)(g * 128 + wid * 16 + fr) * 1024 + fq * 8;
            f32x4 acc0 = {0.f, 0.f, 0.f, 0.f}, acc1 = {0.f, 0.f, 0.f, 0.f};
#pragma unroll 8
            for (int ks = 0; ks < 32; ++ks) {
                const bf16x8 bf = *(const bf16x8*)(WE + ks * 32);
                const bf16x8 a0 = *(const bf16x8*)(lds + fr * USTR + (ks * 32 + fq * 8) * 2);
                const bf16x8 a1 = *(const bf16x8*)(lds + (16 + fr) * USTR + (ks * 32 + fq * 8) * 2);
                acc0 = __builtin_amdgcn_mfma_f32_16x16x32_bf16(a0, bf, acc0, 0, 0, 0);
                acc1 = __builtin_amdgcn_mfma_f32_16x16x32_bf16(a1, bf, acc1, 0, 0, 0);
            }
            float* E = (float*)(a.ws + WS_S5E);
#pragma unroll
            for (int j = 0; j < 4; ++j) {
                E[(size_t)(g * 128 + cb * 32 + fq * 4 + j) * 128 + wid * 16 + fr] = acc0[j];
                E[(size_t)(g * 128 + cb * 32 + 16 + fq * 4 + j) * 128 + wid * 16 + fr] = acc1[j];
            }
        } else {
            const int uu = u - 256, n = uu >> 2, h = uu & 3, t0 = n * 64;
            char* vT = lds;
            char* kT = lds + 32768;
            float* glr = (float*)(lds + 49152);
            float* tot = glr + 1024;
            float b[16], blast;
            gla_gate(a, n, h, tid, glr, tot, b, blast);
            const int ch = tid & 127, tq = tid >> 7;
            {
                unsigned pk[8];
#pragma unroll
                for (int tt = 0; tt < 16; tt += 2) {
                    const float k0 = bf2f(PROJ[(size_t)(t0 + tq * 16 + tt) * PJ + 512 + h * 128 + ch]);
                    const float k1 = bf2f(PROJ[(size_t)(t0 + tq * 16 + tt + 1) * PJ + 512 + h * 128 + ch]);
                    pk[tt >> 1] = pack2(k0 * __expf(blast - b[tt]), k1 * __expf(blast - b[tt + 1]));
                }
                *(uint4*)(kT + lds_byte<2>(ch, tq * 16)) = make_uint4(pk[0], pk[1], pk[2], pk[3]);
                *(uint4*)(kT + lds_byte<2>(ch, tq * 16 + 8)) = make_uint4(pk[4], pk[5], pk[6], pk[7]);
                if (tq == 3) ((float*)(a.ws + WS_DEC))[(size_t)(n * 4 + h) * 128 + ch] = __expf(blast);
            }
            gla_stage_vT(PROJ, t0, 1024 + h * 256, vT, tid);
            __syncthreads();
            const int wr = wid >> 1, wc = wid & 1;
            f32x4 acc[4][4];
#pragma unroll
            for (int m = 0; m < 4; ++m)
#pragma unroll
                for (int nn = 0; nn < 4; ++nn) acc[m][nn] = f32x4{0.f, 0.f, 0.f, 0.f};
#pragma unroll
            for (int ks = 0; ks < 2; ++ks) {
                bf16x8 Af[4], Bf[4];
#pragma unroll
                for (int m = 0; m < 4; ++m) Af[m] = *(const bf16x8*)(vT + lds_byte<2>(wr * 64 + m * 16 + fr, ks * 32 + fq * 8));
#pragma unroll
                for (int nn = 0; nn < 4; ++nn) Bf[nn] = *(const bf16x8*)(kT + lds_byte<2>(wc * 64 + nn * 16 + fr, ks * 32 + fq * 8));
#pragma unroll
                for (int m = 0; m < 4; ++m)
#pragma unroll
                    for (int nn = 0; nn < 4; ++nn) acc[m][nn] = __builtin_amdgcn_mfma_f32_16x16x32_bf16(Af[m], Bf[nn], acc[m][nn], 0, 0, 0);
            }
            float* KV = (float*)(a.ws + WS_KV) + (size_t)(n * 4 + h) * (HV * HK);
#pragma unroll
            for (int m = 0; m < 4; ++m)
#pragma unroll
                for (int nn = 0; nn < 4; ++nn)
#pragma unroll
                    for (int j = 0; j < 4; ++j)
                        KV[(size_t)(wr * 64 + m * 16 + fq * 4 + j) * 128 + wc * 64 + nn * 16 + fr] = acc[m][nn][j];
        }
    }
}

DEVI void phase3(const Args& a, int tid) {
    const float* KV = (const float*)(a.ws + WS_KV); u16* ST = (u16*)(a.ws + WS_ST); const float* DEC = (const float*)(a.ws + WS_DEC);
    for (int e = blockIdx.x * 512 + tid; e < NH * HV * HK; e += gridDim.x * 512) {
        const int h = e >> 15, rem = e & 32767, i = e & 127;
        float S = 0.f;
#pragma unroll 1
        for (int n0 = 0; n0 < NCH; n0 += 16) {
            float kv[16], dc[16];
#pragma unroll
            for (int k = 0; k < 16; ++k) { kv[k] = KV[(size_t)((n0 + k) * 4 + h) * 32768 + rem]; dc[k] = DEC[(size_t)((n0 + k) * 4 + h) * 128 + i]; }
#pragma unroll
            for (int k = 0; k < 16; ++k) { ST[(size_t)((n0 + k) * 4 + h) * 32768 + rem] = f2bf(S); S = dc[k] * S + kv[k]; }
        }
    }
    const float* E = (const float*)(a.ws + WS_S5E); const float* AL = (const float*)(a.ws + WS_S5AL); unsigned* HP = (unsigned*)(a.ws + WS_S5H);
    for (int e = blockIdx.x * 512 + tid; e < NG * SP; e += gridDim.x * 512) {
        const int g = e >> 6, p = e & 63;
        const float ar = AL[e * 2], ai = AL[e * 2 + 1];
        float hr = 0.f, hi = 0.f;
#pragma unroll 1
        for (int c0 = 0; c0 < 128; c0 += 16) {
            float2 ev[16];
#pragma unroll
            for (int k = 0; k < 16; ++k) ev[k] = *(const float2*)(E + (size_t)(g * 128 + c0 + k) * 128 + 2 * p);
#pragma unroll
            for (int k = 0; k < 16; ++k) {
                HP[(size_t)(g * 128 + c0 + k) * 64 + p] = pack2(hr, hi);
                const float nr = ar * hr - ai * hi + ev[k].x, ni = ar * hi + ai * hr + ev[k].y;
                hr = nr; hi = ni;
            }
        }
    }
}

DEVI void phase4(const Args& a, char* lds, int tid, int wid, int lane) {
    const u16* PROJ = (const u16*)(a.ws + WS_PROJ);
    u16* MIX = (u16*)(a.ws + WS_MIX);
#pragma unroll 1
    for (int u = blockIdx.x; u < 768; u += gridDim.x) {
        { int lq = lane; asm volatile("" : "+v"(lq)); lane = lq; tid = wid * 64 + lq; }
        const int fr = lane & 15, fq = lane >> 4;
        __syncthreads();
        if (u < 256) {
            const int g = u >> 2, cb = u & 3;
            char* U = lds; char* KTl = lds + 32 * USTR;
            s5_fill_U(PROJ, g, cb, U, tid);
            {
                const uint4* src = (const uint4*)((const u16*)(a.ws + WS_S5K) + (size_t)g * 16384);
                uint4* dst = (uint4*)KTl;
                for (int k = 0; k < 4; ++k) dst[tid + 512 * k] = src[tid + 512 * k];
            }
            __syncthreads();
            f32x4 acc[8][2];
#pragma unroll
            for (int tt = 0; tt < 8; ++tt) { acc[tt][0] = f32x4{0.f, 0.f, 0.f, 0.f}; acc[tt][1] = f32x4{0.f, 0.f, 0.f, 0.f}; }
            const int sl = fq >> 1, m0 = (fq & 1) * 8;
            const char* kbase = KTl + ((wid - sl) * 256 + fr * 16 + m0) * 2;
#pragma unroll 1
            for (int j = 0; j < 32; ++j) {
                const bf16x8 a0 = *(const bf16x8*)(U + fr * USTR + (j * 32 + fq * 8) * 2);
                const bf16x8 a1 = *(const bf16x8*)(U + (16 + fr) * USTR + (j * 32 + fq * 8) * 2);
                const char* kb = kbase - j * 1024;
#pragma unroll
                for (int tt = 0; tt < 8; ++tt) {
                    const int t = wid + 8 * tt;
                    if (t >= 2 * j) {
                        bf16x8 bf = *(const bf16x8*)(kb + tt * 4096);
                        if (t == 2 * j && sl == 1) bf = bf16x8{0, 0, 0, 0, 0, 0, 0, 0};
                        acc[tt][0] = __builtin_amdgcn_mfma_f32_16x16x32_bf16(a0, bf, acc[tt][0], 0, 0, 0);
                        acc[tt][1] = __builtin_amdgcn_mfma_f32_16x16x32_bf16(a1, bf, acc[tt][1], 0, 0, 0);
                    }
                }
            }
            const u16* HP = (const u16*)(a.ws + WS_S5H); const u16* VV = (const u16*)(a.ws + WS_S5V);
#pragma unroll 1
            for (int kp = 0; kp < 2; ++kp) {
                bf16x8 a0[2], a1[2], bfv[2][8];
#pragma unroll
                for (int k2 = 0; k2 < 2; ++k2) {
                    const int ks = kp * 2 + k2;
                    a0[k2] = *(const bf16x8*)(HP + (size_t)(g * 128 + cb * 32 + fr) * 128 + ks * 32 + fq * 8);
                    a1[k2] = *(const bf16x8*)(HP + (size_t)(g * 128 + cb * 32 + 16 + fr) * 128 + ks * 32 + fq * 8);
#pragma unroll
                    for (int tt = 0; tt < 8; ++tt)
                        bfv[k2][tt] = *(const bf16x8*)(VV + (size_t)(g * 1024 + (wid + 8 * tt) * 16 + fr) * 128 + ks * 32 + fq * 8);
                }
#pragma unroll
                for (int k2 = 0; k2 < 2; ++k2)
#pragma unroll
                    for (int tt = 0; tt < 8; ++tt) {
                        acc[tt][0] = __builtin_amdgcn_mfma_f32_16x16x32_bf16(a0[k2], bfv[k2][tt], acc[tt][0], 0, 0, 0);
                        acc[tt][1] = __builtin_amdgcn_mfma_f32_16x16x32_bf16(a1[k2], bfv[k2][tt], acc[tt][1], 0, 0, 0);
                    }
            }
            const float dsk = a.in[12][g * 16 + fr];
            u16* Z = (u16*)(a.ws + WS_Z);
#pragma unroll
            for (int tt = 0; tt < 8; ++tt) {
                const int t = wid + 8 * tt;
#pragma unroll
                for (int mf = 0; mf < 2; ++mf)
#pragma unroll
                    for (int j = 0; j < 4; ++j) {
                        const int cl = mf * 16 + fq * 4 + j;
                        const float uv = bf2f(*(const u16*)(U + cl * USTR + (t * 16 + fr) * 2));
                        const float y = acc[tt][mf][j] + dsk * uv;
                        Z[(size_t)((cb * 32 + cl) * 64 + t) * SW + g * 16 + fr] = f2bf(gelu_tanh(y));
                    }
            }
        } else {
            const int uu = u - 256, n = uu >> 2, h = uu & 3, t0 = n * 64;
            char* vT = lds;
            char* qI = lds + 32768;
            char* kI = lds + 49152;
            char* pI = lds + 65536;
            float* glr = (float*)(lds + 73728);
            float* tot = glr + 1024;
            float* rss = tot + 512;
            char* sT = lds + 81920;
            {
                const u16* STg = (const u16*)(a.ws + WS_ST) + (size_t)(n * 4 + h) * (HV * HK);
#pragma unroll
                for (int p = 0; p < 8; ++p) {
                    const int row = p * 32 + wid * 4 + (lane >> 4), chunk = ((lane & 15) ^ row) & 15;
                    __builtin_amdgcn_global_load_lds((const unsigned*)(STg + (size_t)row * 128 + chunk * 8), (LAS unsigned*)(sT + p * 8192 + wid * 1024), 16, 0, 0);
                }
            }
            float b[16], blast;
            gla_gate(a, n, h, tid, glr, tot, b, blast);
            const int ch = tid & 127, tq = tid >> 7;
            {
                const int qb0 = (tq * 4 + (ch >> 5)) * 1024 + (ch & 31) * 2, qb1 = qb0 ^ 32;
                const u16* src = PROJ + (size_t)(t0 + tq * 16) * PJ + h * 128 + ch;
#pragma unroll
                for (int tt = 0; tt < 16; ++tt) {
                    const float qv = bf2f(src[(size_t)tt * PJ]);
                    const float kv = bf2f(src[(size_t)tt * PJ + 512]);
                    const int off = (tt < 8 ? qb0 : qb1) + tt * 64;
                    *(u16*)(qI + off) = f2bf(qv * __expf(b[tt]));
                    *(u16*)(kI + off) = f2bf(kv * __expf(-b[tt]));
                }
            }
            gla_stage_vT(PROJ, t0, 1024 + h * 256, vT, tid);
            __syncthreads();
            {
                const int mf = wid & 3, nb = (wid >> 2) * 2;
                f32x4 s0 = {0.f, 0.f, 0.f, 0.f}, s1 = {0.f, 0.f, 0.f, 0.f};
#pragma unroll
                for (int ks = 0; ks < 4; ++ks) {
                    const bf16x8 af = *(const bf16x8*)(qI + lds_byte<4>(mf * 16 + fr, ks * 32 + fq * 8));
                    const bf16x8 b0 = *(const bf16x8*)(kI + lds_byte<4>(nb * 16 + fr, ks * 32 + fq * 8));
                    const bf16x8 b1 = *(const bf16x8*)(kI + lds_byte<4>((nb + 1) * 16 + fr, ks * 32 + fq * 8));
                    s0 = __builtin_amdgcn_mfma_f32_16x16x32_bf16(af, b0, s0, 0, 0, 0);
                    s1 = __builtin_amdgcn_mfma_f32_16x16x32_bf16(af, b1, s1, 0, 0, 0);
                }
#pragma unroll
                for (int j = 0; j < 4; ++j) {
                    const int t = mf * 16 + fq * 4 + j, sA = nb * 16 + fr, sB = sA + 16;
                    *(u16*)(pI + lds_byte<2>(t, sA)) = f2bf(sA <= t ? s0[j] : 0.f);
                    *(u16*)(pI + lds_byte<2>(t, sB)) = f2bf(sB <= t ? s1[j] : 0.f);
                }
            }
            __syncthreads();
            const int mf = wid & 3, nh = wid >> 2;
            f32x4 acc[8];
#pragma unroll
            for (int nn = 0; nn < 8; ++nn) acc[nn] = f32x4{0.f, 0.f, 0.f, 0.f};
#pragma unroll
            for (int ks = 0; ks < 2; ++ks) {
                const bf16x8 af = *(const bf16x8*)(pI + lds_byte<2>(mf * 16 + fr, ks * 32 + fq * 8));
#pragma unroll
                for (int nn = 0; nn < 8; ++nn) {
                    const bf16x8 bf = *(const bf16x8*)(vT + lds_byte<2>(nh * 128 + nn * 16 + fr, ks * 32 + fq * 8));
                    acc[nn] = __builtin_amdgcn_mfma_f32_16x16x32_bf16(af, bf, acc[nn], 0, 0, 0);
                }
            }
#pragma unroll
            for (int ks = 0; ks < 4; ++ks) {
                const bf16x8 af = *(const bf16x8*)(qI + lds_byte<4>(mf * 16 + fr, ks * 32 + fq * 8));
#pragma unroll
                for (int nn = 0; nn < 8; ++nn) {
                    const bf16x8 bf = *(const bf16x8*)(sT + (nh * 128 + nn * 16 + fr) * 256 + ((((ks * 4 + fq) ^ fr) & 15) << 4));
                    acc[nn] = __builtin_amdgcn_mfma_f32_16x16x32_bf16(af, bf, acc[nn], 0, 0, 0);
                }
            }
            u16 rraw[4][8];
#pragma unroll
            for (int j = 0; j < 4; ++j)
#pragma unroll
                for (int nn = 0; nn < 8; ++nn) rraw[j][nn] = PROJ[(size_t)(t0 + mf * 16 + fq * 4 + j) * PJ + 2048 + h * 256 + nh * 128 + nn * 16 + fr];
            float ss[4];
#pragma unroll
            for (int j = 0; j < 4; ++j) {
                float s = 0.f;
#pragma unroll
                for (int nn = 0; nn < 8; ++nn) s += acc[nn][j] * acc[nn][j];
                ss[j] = sum16(s);
            }
            if (fr == 0) {
#pragma unroll
                for (int j = 0; j < 4; ++j) rss[nh * 64 + mf * 16 + fq * 4 + j] = ss[j];
            }
            __syncthreads();
            const float* gn = a.in[5];
#pragma unroll
            for (int j = 0; j < 4; ++j) {
                const int t = mf * 16 + fq * 4 + j;
                const float rstd = rsqrtf((rss[t] + rss[64 + t]) * (1.0f / 256.0f) + EPS);
#pragma unroll
                for (int nn = 0; nn < 8; ++nn) {
                    const int jc = nh * 128 + nn * 16 + fr;
                    const float rv = bf2f(rraw[j][nn]);
                    const float o = acc[nn][j] * rstd * gn[jc] * (rv * sigmoidf_(rv));
                    MIX[(size_t)(t0 + t) * D + h * 256 + jc] = f2bf(o);
                }
            }
        }
    }
}

DEVI void phase5(const Args& a, char* lds, int tid, int wid, int lane) {
    const unsigned char* Zb = a.ws + WS_Z; const unsigned char* GT = a.ws + WS_GLUT;
    const u16* Z = (const u16*)(a.ws + WS_Z); u16* MIX = (u16*)(a.ws + WS_MIX); float* SSQ = (float*)(a.ws + WS_SSQ);
    const float* gbias = a.in[15]; const float* sng = a.in[16];
    const int wr = wid >> 2, wc = wid & 3;
    if (blockIdx.x >= 128) {
        const int c_lo = 8192 + (blockIdx.x - 128) * 22;
        convert_range(a, lds, c_lo, c_lo + 22, tid, wid, lane);
    }
    for (int u = blockIdx.x; u < 128; u += gridDim.x) {
        const int mt = u & 31, nt = u >> 5;
        unsigned aoff[2], boffv[2];
        bf_offsets(aoff, wid, lane, mt * 256, SW); bf_offsets(boffv, wid, lane, nt * 256, SW);
        f8_prefetch(lds, Zb, aoff, GT, boffv, wid);
        f32x4 acc[4][8]; zero_acc16(acc);
        bf_mainloop<32>(lds, Zb, aoff, GT, boffv, wid, lane, acc);
        int lz = lane; asm volatile("" : "+v"(lz));
        const int l15 = lz & 15, q = lz >> 4;
        const int cb = nt * 256 + wc * 64 + 4 * q;
#pragma unroll
        for (int m8 = 0; m8 < 8; ++m8) {
            const int row = mt * 256 + wr * 128 + m8 * 16 + l15;
            float sq = 0.f;
#pragma unroll
            for (int n4 = 0; n4 < 4; ++n4) {
                const int c = cb + n4 * 16;
                const uint2 zv = *(const uint2*)(Z + (size_t)row * SW + c);
                const f32x4 gb = *(const f32x4*)(gbias + c), sg = *(const f32x4*)(sng + c);
                const float z0 = bflo(zv.x), z1 = bfhi(zv.x), z2 = bflo(zv.y), z3 = bfhi(zv.y);
                const float y0 = z0 * sigmoidf_(acc[n4][m8][0] + gb[0]), y1 = z1 * sigmoidf_(acc[n4][m8][1] + gb[1]);
                const float y2 = z2 * sigmoidf_(acc[n4][m8][2] + gb[2]), y3 = z3 * sigmoidf_(acc[n4][m8][3] + gb[3]);
                sq += y0 * y0 + y1 * y1 + y2 * y2 + y3 * y3;
                uint2 pk; pk.x = pack2(y0 * sg[0], y1 * sg[1]); pk.y = pack2(y2 * sg[2], y3 * sg[3]);
                *(uint2*)(MIX + (size_t)row * D + 1024 + c) = pk;
            }
            sq += __shfl_xor(sq, 16); sq += __shfl_xor(sq, 32);
            if (q == 0) atomicAdd(&SSQ[row], sq);
        }
    }
    if (blockIdx.x < 128) { const int c_lo = 11008 + blockIdx.x * 6; convert_range(a, lds, c_lo, c_lo + 6, tid, wid, lane); }
    convert_pool(a, lds, 1, 11776, 13312, tid, wid, lane);
}

DEVI void phase6(const Args& a, char* lds, int tid, int wid, int lane) {
    const unsigned char* MIXb = a.ws + WS_MIX; const unsigned char* WT = a.ws + WS_WOUTT;
    float* H1 = (float*)(a.ws + WS_H1); const float* SSQ = (const float*)(a.ws + WS_SSQ);
    const float* x = a.in[0];
    const int wr = wid >> 2, wc = wid & 3;
    const int c6_lo = 13312 + blockIdx.x * 8, c6_hi = c6_lo + 8;
    if ((blockIdx.x >> 3) & 1) convert_range(a, lds, c6_lo, c6_hi, tid, wid, lane);
    for (int uu = blockIdx.x; uu < 256; uu += gridDim.x) {
        const int u = (uu & 7) * 32 + (uu >> 3);
        const int mt = u & 31, nt = u >> 5;
        unsigned aoff[2], boffv[2], aoff2[2], boff2[2];
        bf_offsets(aoff, wid, lane, mt * 256, D); bf_offsets(boffv, wid, lane, nt * 256, D);
#pragma unroll
        for (int i = 0; i < 2; ++i) { aoff2[i] = aoff[i] + 2048u; boff2[i] = boffv[i] + 2048u; }
        f8_prefetch(lds, MIXb, aoff2, WT, boff2, wid);
        f32x4 acc[4][8]; zero_acc16(acc);
        bf_mainloop<32>(lds, MIXb, aoff2, WT, boff2, wid, lane, acc);
        f8_prefetch(lds, MIXb, aoff, WT, boffv, wid);
        {
            int lq = lane; asm volatile("" : "+v"(lq));
#pragma unroll
            for (int m8 = 0; m8 < 8; ++m8) {
                const float rs = rsqrtf(SSQ[mt * 256 + wr * 128 + m8 * 16 + (lq & 15)] * (1.0f / SW) + EPS);
#pragma unroll
                for (int n4 = 0; n4 < 4; ++n4)
#pragma unroll
                    for (int r = 0; r < 4; ++r) acc[n4][m8][r] *= rs;
            }
        }
        bf_mainloop<32>(lds, MIXb, aoff, WT, boffv, wid, lane, acc);
        int lz = lane; asm volatile("" : "+v"(lz));
        const int l15 = lz & 15, q = lz >> 4;
#pragma unroll
        for (int m8 = 0; m8 < 8; ++m8) {
            const size_t base = (size_t)(mt * 256 + wr * 128 + m8 * 16 + l15) * D + nt * 256 + wc * 64 + 4 * q;
#pragma unroll
            for (int n4 = 0; n4 < 4; ++n4) {
                const f32x4 xv = *(const f32x4*)(x + base + n4 * 16);
                f32x4 o;
#pragma unroll
                for (int i = 0; i < 4; ++i) o[i] = xv[i] + acc[n4][m8][i];
                *(f32x4*)(H1 + base + n4 * 16) = o;
            }
        }
    }
    if (!((blockIdx.x >> 3) & 1)) convert_range(a, lds, c6_lo, c6_hi, tid, wid, lane);
    convert_pool(a, lds, 2, 15360, 16384, tid, wid, lane);
}

DEVI void phase7(const Args& a, char* lds, int tid, int wid, int lane) {
    const float* H1 = (const float*)(a.ws + WS_H1); unsigned char* HN8 = a.ws + WS_HN2;
    const float* g2 = a.in[18]; const float* rw = a.in[19]; const float* rb = a.in[20];
    int* CNT = (int*)(a.ws + WS_CNT); int* LTOK = (int*)(a.ws + WS_LTOK); float* LGATE = (float*)(a.ws + WS_LGATE); int* TSLOT = (int*)(a.ws + WS_TSLOT);
    float* hn = (float*)lds;
    float* red = hn + 8 * 2048;
    float* lg = red + 8 * 8 * 32;
    for (int u = blockIdx.x; u < 256; u += gridDim.x) {
#pragma unroll 1
        for (int ps = 0; ps < 4; ++ps) {
            const int tok0 = u * 32 + ps * 8;
            { int lq = lane; asm volatile("" : "+v"(lq)); lane = lq; tid = wid * 64 + lq; }
            __syncthreads();
            {
                const int tl = wid, tok = tok0 + tl;
                f32x4 xv[8]; float ss = 0.f;
#pragma unroll
                for (int i = 0; i < 8; ++i) { xv[i] = *(const f32x4*)(H1 + (size_t)tok * D + 256 * i + 4 * lane);
#pragma unroll
                    for (int c = 0; c < 4; ++c) ss += xv[i][c] * xv[i][c]; }
                ss = wave_sum(ss);
                const float r = rsqrtf(ss * (1.0f / D) + EPS);
#pragma unroll
                for (int i = 0; i < 8; ++i) {
                    const f32x4 g = *(const f32x4*)(g2 + 256 * i + 4 * lane);
                    f32x4 o;
#pragma unroll
                    for (int c = 0; c < 4; ++c) o[c] = xv[i][c] * r * g[c];
                    *(f32x4*)(hn + tl * 2048 + 256 * i + 4 * lane) = o;
                    *(unsigned*)(HN8 + (size_t)tok * D + 256 * i + 4 * lane) = cvt4_fp8(o[0] * 16.f, o[1] * 16.f, o[2] * 16.f, o[3] * 16.f);
                }
            }
            __syncthreads();
            {
                const int e = tid & 31, dsl = tid >> 5;
                float acc[8];
#pragma unroll
                for (int k = 0; k < 8; ++k) acc[k] = 0.f;
#pragma unroll 1
                for (int d16 = 0; d16 < 8; ++d16) {
                    float w[16];
#pragma unroll
                    for (int q = 0; q < 16; ++q) w[q] = rw[(dsl * 128 + d16 * 16 + q) * 32 + e];
#pragma unroll
                    for (int q4 = 0; q4 < 4; ++q4) {
                        const int d = dsl * 128 + d16 * 16 + q4 * 4;
#pragma unroll
                        for (int k = 0; k < 8; ++k) {
                            const f32x4 hv = *(const f32x4*)(hn + k * 2048 + d);
                            acc[k] += hv[0] * w[q4 * 4] + hv[1] * w[q4 * 4 + 1] + hv[2] * w[q4 * 4 + 2] + hv[3] * w[q4 * 4 + 3];
                        }
                    }
                }
#pragma unroll
                for (int k = 0; k < 8; ++k) { acc[k] += __shfl_xor(acc[k], 32); }
                if (lane < 32) {
#pragma unroll
                    for (int k = 0; k < 8; ++k) red[(wid * 8 + k) * 32 + e] = acc[k];
                }
            }
            __syncthreads();
            if (tid < 256) {
                const int k = tid >> 5, e = tid & 31;
                float s = rb[e];
#pragma unroll
                for (int w = 0; w < 8; ++w) s += red[(w * 8 + k) * 32 + e];
                lg[k * 32 + e] = s;
            }
            __syncthreads();
            {
                const int tok = tok0 + wid, e = lane & 31;
                float x = lg[wid * 32 + e];
                float v[4]; int id[4];
#pragma unroll
                for (int j = 0; j < 4; ++j) {
                    float bv = x; int bi = e;
#pragma unroll
                    for (int o = 16; o >= 1; o >>= 1) {
                        const float ov = __shfl_xor(bv, o); const int oi = __shfl_xor(bi, o);
                        if (ov > bv || (ov == bv && oi < bi)) { bv = ov; bi = oi; }
                    }
                    v[j] = bv; id[j] = bi;
                    if (e == bi) x = -3.0e38f;
                }
                float ex[4], sum = 0.f;
#pragma unroll
                for (int j = 0; j < 4; ++j) { ex[j] = __expf(v[j] - v[0]); sum += ex[j]; }
                const float inv = 1.0f / sum;
                if (lane < 4) {
                    const int myid = lane == 0 ? id[0] : lane == 1 ? id[1] : lane == 2 ? id[2] : id[3];
                    const float myg = (lane == 0 ? ex[0] : lane == 1 ? ex[1] : lane == 2 ? ex[2] : ex[3]) * inv;
                    const int slot = atomicAdd(&CNT[myid], 1);
                    LTOK[myid * CAP + slot] = tok;
                    LGATE[myid * CAP + slot] = myg;
                    TSLOT[tok * 4 + lane] = myid * CAP + slot;
                }
            }
        }
    }
}

struct MoeTab { int cnt[32]; int off[33]; int ord[32]; int xe[4]; int xub[5]; };
DEVI void moe_tables(const Args& a, MoeTab* tb, int tid, int ntn) {
    __syncthreads();
    if (tid < 32) tb->cnt[tid] = ((const int*)(a.ws + WS_CNT))[tid];
    __syncthreads();
    if (tid < 32) {
        const int me = (tb->cnt[tid] + 255) >> 8;
        int rank = 0, o = 0;
        for (int k = 0; k < 32; ++k) {
            const int c = tb->cnt[k], mk = (c + 255) >> 8;
            rank += (mk > me || (mk == me && k < tid)) ? 1 : 0;
            o += (k < tid) ? c : 0;
        }
        tb->ord[rank] = tid; tb->off[tid] = o;
        if (tid == 31) tb->off[32] = o + tb->cnt[31];
    }
    __syncthreads();
    if (tid == 0) {
        const int xcd = blockIdx.x & 7;
        int ub = 0;
        for (int r = 0; r < 4; ++r) {
            const int e = tb->ord[r * 8 + ((r & 1) ? 7 - xcd : xcd)];
            tb->xe[r] = e; tb->xub[r] = ub;
            ub += ((tb->cnt[e] + 255) >> 8) * ntn;
        }
        tb->xub[4] = ub;
    }
    __syncthreads();
}

struct MoeUnit { int e, nt, r0, rows, grow0, cnt; };
DEVI MoeUnit moe_decode(const MoeTab* tb, int u) {
    int k = 0;
    for (int q = 1; q < 4; ++q) if (u >= tb->xub[q]) k = q;
    MoeUnit d; d.e = tb->xe[k];
    d.cnt = tb->cnt[d.e];
    const int mte = (d.cnt + 255) >> 8, ul = u - tb->xub[k];
    d.nt = ul / mte; const int mi = ul - d.nt * mte;
    d.r0 = mi * 256; d.rows = min(256, d.cnt - d.r0); d.grow0 = tb->off[d.e] + d.r0;
    return d;
}
DEVI void phase8(const Args& a, char* lds, MoeTab* tb, int tid, int wid, int lane) {
    const unsigned char* HN8 = a.ws + WS_HN2; unsigned char* ACT = a.ws + WS_ACT;
    const unsigned char* W1T = a.ws + WS_W1T;
    const int* LTOK = (const int*)(a.ws + WS_LTOK);
    const float* b1 = a.in[22];
    const int wr = wid >> 2, wc = wid & 3;
    moe_tables(a, tb, tid, 16);
    const int nun = tb->xub[4], nper = gridDim.x >> 3;
    int u = blockIdx.x >> 3;
    const int cpos = (blockIdx.x >> 3) % 3, c_lo = 16384 + blockIdx.x * 24, c_hi = c_lo + 24;
    if (u >= nun) { convert_range(a, lds, c_lo, c_hi, tid, wid, lane); convert_pool(a, lds, 3, 22528, 24576, tid, wid, lane); return; }
    if (cpos == 0) convert_range(a, lds, c_lo, c_hi, tid, wid, lane);
    int it = 0;
    MoeUnit d = moe_decode(tb, u);
    unsigned aoff[2], boffv[2];
    auto addrs = [&](const MoeUnit& q, const int (&tok)[2], unsigned (&ao)[2], unsigned (&bo)[2]) {
#pragma unroll
        for (int i = 0; i < 2; ++i) {
            int R, CB; f8_stage_rb(wid, lane, i, R, CB);
            ao[i] = (unsigned)tok[i] * D + CB;
            bo[i] = (unsigned)((q.e * 32 + i * 16 + q.nt) * 512) * 512u + (unsigned)(wid * 64 + lane) * 16u;
        }
    };
    auto toks = [&](const MoeUnit& q, int (&tok)[2]) {
#pragma unroll
        for (int i = 0; i < 2; ++i) { int R, CB; f8_stage_rb(wid, lane, i, R, CB); tok[i] = LTOK[q.e * CAP + min(q.r0 + R, q.cnt - 1)]; }
    };
    {
        int tok[2]; toks(d, tok); addrs(d, tok, aoff, boffv);
        q8_prefetch(lds, HN8, aoff, W1T, boffv, wid);
    }
    while (true) {
        const int un = u + nper;
        const bool has_next = un < nun;
        MoeUnit dn = d; int tokn[2] = {0, 0};
        if (has_next) { dn = moe_decode(tb, un); toks(dn, tokn); }
        f32x16 acc[2][4]; zero_acc32(acc);
        f8_mainloop<32, 0x7b7b7b7b, 0x77777777, true>(lds, HN8, aoff, W1T, boffv, wid, lane, acc);
        int lz = lane; asm volatile("" : "+v"(lz));
        const int l31 = lz & 31, hh = lz >> 5;
        const float* bb = b1 + (size_t)d.e * 4096 + d.nt * 128 + wc * 32 + 4 * hh;
        f32x4 bg[4], bl[4];
#pragma unroll
        for (int rq = 0; rq < 4; ++rq) { bg[rq] = *(const f32x4*)(bb + 8 * rq); bl[rq] = *(const f32x4*)(bb + 2048 + 8 * rq); }
#pragma unroll
        for (int rq = 0; rq < 4; ++rq) { touch4(bg[rq]); touch4(bl[rq]); }
        if (has_next) { addrs(dn, tokn, aoff, boffv); q8_prefetch(lds, HN8, aoff, W1T, boffv, wid); }
#pragma unroll
        for (int m = 0; m < 4; ++m) {
            const int row = wr * 128 + m * 32 + l31;
            const int orow = (row < d.rows) ? d.grow0 + row : T * 4 + row;
            unsigned char* dst = ACT + (size_t)orow * FF + d.nt * 128 + wc * 32 + 4 * hh;
#pragma unroll
            for (int rq = 0; rq < 4; ++rq) {
                float av[4];
#pragma unroll
                for (int i = 0; i < 4; ++i) {
                    const float gl = fminf(acc[0][m][rq * 4 + i] + bg[rq][i], 7.0f);
                    const float ln = fminf(fmaxf(acc[1][m][rq * 4 + i] + bl[rq][i], -7.0f), 7.0f);
                    av[i] = gl * sigmoidf_(1.702f * gl) * (ln + 1.0f) * 4.0f;
                }
                *(unsigned*)(dst + 8 * rq) = cvt4_fp8(av[0], av[1], av[2], av[3]);
            }
        }
        if (cpos == 1 && it == 3) convert_range(a, lds, c_lo, c_hi, tid, wid, lane);
        ++it;
        if (!has_next) break;
        u = un; d = dn;
    }
    if (cpos == 2 || (cpos == 1 && it <= 3)) convert_range(a, lds, c_lo, c_hi, tid, wid, lane);
    convert_pool(a, lds, 3, 22528, 24576, tid, wid, lane);
}

DEVI void phase9(const Args& a, char* lds, MoeTab* tb, int tid, int wid, int lane) {
    const unsigned char* ACT = a.ws + WS_ACT; u16* Y = (u16*)(a.ws + WS_Y);
    const unsigned char* W2T = a.ws + WS_W2T;
    const float* LGATE = (const float*)(a.ws + WS_LGATE);
    const float* b2 = a.in[24];
    const int wr = wid >> 2, wc = wid & 3;
    moe_tables(a, tb, tid, 8);
    const int nun = tb->xub[4], nper = gridDim.x >> 3;
    int u = blockIdx.x >> 3;
    if (u >= nun) return;
    MoeUnit d = moe_decode(tb, u);
    unsigned aoff[2], boffv[2];
    auto addrs = [&](const MoeUnit& q, unsigned (&ao)[2], unsigned (&bo)[2]) {
#pragma unroll
        for (int i = 0; i < 2; ++i) {
            int R, CB; f8_stage_rb(wid, lane, i, R, CB);
            ao[i] = (unsigned)(q.grow0 + R) * FF + CB;
            bo[i] = (unsigned)((q.e * 16 + q.nt * 2 + i) * 512) * 512u + (unsigned)(wid * 64 + lane) * 16u;
        }
    };
    addrs(d, aoff, boffv);
    q8_prefetch(lds, ACT, aoff, W2T, boffv, wid);
    while (true) {
        const int un = u + nper;
        const bool has_next = un < nun;
        MoeUnit dn = d;
        if (has_next) dn = moe_decode(tb, un);
        f32x16 acc[2][4]; zero_acc32(acc);
        f8_mainloop<32, 0x7d7d7d7d, 0x77777777, false>(lds, ACT, aoff, W2T, boffv, wid, lane, acc);
        int lz = lane; asm volatile("" : "+v"(lz));
        const int l31 = lz & 31, hh = lz >> 5;
        const float* bb = b2 + (size_t)d.e * D + d.nt * 256 + wc * 64 + 4 * hh;
        float gt[4];
#pragma unroll
        for (int m = 0; m < 4; ++m) { const int row = wr * 128 + m * 32 + l31; gt[m] = LGATE[d.e * CAP + d.r0 + min(row, d.rows - 1)]; }
        f32x4 bv[2][4];
#pragma unroll
        for (int n = 0; n < 2; ++n)
#pragma unroll
            for (int rq = 0; rq < 4; ++rq) bv[n][rq] = *(const f32x4*)(bb + n * 32 + 8 * rq);
#pragma unroll
        for (int m = 0; m < 4; ++m) touchf(gt[m]);
#pragma unroll
        for (int n = 0; n < 2; ++n)
#pragma unroll
            for (int rq = 0; rq < 4; ++rq) touch4(bv[n][rq]);
        if (has_next) { addrs(dn, aoff, boffv); q8_prefetch(lds, ACT, aoff, W2T, boffv, wid); }
#pragma unroll
        for (int m = 0; m < 4; ++m) {
            const int row = wr * 128 + m * 32 + l31;
            const int orow = (row < d.rows) ? d.grow0 + row : T * 4 + row;
            u16* dst = Y + (size_t)orow * D + d.nt * 256 + wc * 64 + 4 * hh;
#pragma unroll
            for (int n = 0; n < 2; ++n)
#pragma unroll
                for (int rq = 0; rq < 4; ++rq) {
                    uint2 pk;
                    pk.x = pack2((acc[n][m][rq * 4 + 0] + bv[n][rq][0]) * gt[m], (acc[n][m][rq * 4 + 1] + bv[n][rq][1]) * gt[m]);
                    pk.y = pack2((acc[n][m][rq * 4 + 2] + bv[n][rq][2]) * gt[m], (acc[n][m][rq * 4 + 3] + bv[n][rq][3]) * gt[m]);
                    *(uint2*)(dst + n * 32 + 8 * rq) = pk;
                }
        }
        if (!has_next) break;
        u = un; d = dn;
    }
}

DEVI void phase10(const Args& a, MoeTab* tb, int tid, int wid, int lane) {
    const float* H1 = (const float*)(a.ws + WS_H1); const u16* Y = (const u16*)(a.ws + WS_Y); const int* TSLOT = (const int*)(a.ws + WS_TSLOT);
    const float* fg = a.in[25];
    moe_tables(a, tb, tid, 8);
    for (int tok = blockIdx.x * 8 + wid; tok < T; tok += gridDim.x * 8) {
        int rowi[4];
#pragma unroll
        for (int j = 0; j < 4; ++j) { const int ts = TSLOT[tok * 4 + j]; rowi[j] = tb->off[ts >> 13] + (ts & (CAP - 1)); }
        f32x4 hv[8]; float ss = 0.f;
#pragma unroll
        for (int i = 0; i < 8; ++i) {
            hv[i] = *(const f32x4*)(H1 + (size_t)tok * D + 256 * i + 4 * lane);
#pragma unroll
            for (int j = 0; j < 4; ++j) {
                const uint2 yv = *(const uint2*)(Y + (size_t)rowi[j] * D + 256 * i + 4 * lane);
                hv[i][0] += bflo(yv.x); hv[i][1] += bfhi(yv.x); hv[i][2] += bflo(yv.y); hv[i][3] += bfhi(yv.y);
            }
#pragma unroll
            for (int c = 0; c < 4; ++c) ss += hv[i][c] * hv[i][c];
        }
        ss = wave_sum(ss);
        const float r = rsqrtf(ss * (1.0f / D) + EPS);
#pragma unroll
        for (int i = 0; i < 8; ++i) {
            const f32x4 g = *(const f32x4*)(fg + 256 * i + 4 * lane);
            f32x4 o;
#pragma unroll
            for (int c = 0; c < 4; ++c) o[c] = hv[i][c] * r * g[c];
            *(f32x4*)(a.out + (size_t)tok * D + 256 * i + 4 * lane) = o;
        }
    }
}

constexpr int NPHASE = 11;
__global__ void __launch_bounds__(512, 2) mega_fwd(Args a) {
    extern __shared__ __attribute__((aligned(1024))) char smem[];
    const int wid_s = __builtin_amdgcn_readfirstlane((int)threadIdx.x >> 6);
    if (threadIdx.x == 0) *(uint4*)smem = make_uint4(0u, 0u, 0u, 0u);
    __syncthreads();
    XcdBarrier bar = xcd_barrier_post((unsigned*)(a.ws + WS_BAR), (volatile LAS unsigned*)smem);
    char* lds = smem + LDS_BASE;
    MoeTab* tb = (MoeTab*)(smem + 64);
#ifndef REP_MASK
#define REP_MASK 0
#endif
#define PHASE(k, call) if (a.ph_lo <= (k) && (k) < a.ph_hi) { if (a.ph_lo < (k)) xcd_barrier(bar); \
        int lane = (int)__builtin_amdgcn_mbcnt_hi(~0u, __builtin_amdgcn_mbcnt_lo(~0u, 0u)); asm volatile("" : "+v"(lane)); \
        const int wid = wid_s, tid = wid_s * 64 + lane; \
        call; if ((REP_MASK >> (k)) & 1) { __syncthreads(); call; } }
    PHASE(0, phase0(a, lds, tid, wid, lane))
    PHASE(1, phase1(a, lds, tid, wid, lane))
    PHASE(2, phase2(a, lds, tid, wid, lane))
    PHASE(3, phase3(a, tid))
    PHASE(4, phase4(a, lds, tid, wid, lane))
    PHASE(5, phase5(a, lds, tid, wid, lane))
    PHASE(6, phase6(a, lds, tid, wid, lane))
    PHASE(7, phase7(a, lds, tid, wid, lane))
    PHASE(8, phase8(a, lds, tb, tid, wid, lane))
    PHASE(9, phase9(a, lds, tb, tid, wid, lane))
    PHASE(10, phase10(a, tb, tid, wid, lane))
#undef PHASE
}

extern "C" void kernel_launch(void* const* d_in, const int* in_sizes, int n_in, void* d_out, int out_size, void* d_ws, size_t ws_size, hipStream_t stream) {
    static int grid = 0;
    if (grid == 0) {
        if (n_in != 26 || out_size != T * D || ws_size < WS_END) { fprintf(stderr, "kernel_launch: unexpected shapes (n_in %d out %d ws %zu need %zu)\n", n_in, out_size, ws_size, (size_t)WS_END); grid = -1; return; }
        int dev = 0, cus = 0, per_cu = 0;
        if (hipGetDevice(&dev) != hipSuccess || hipDeviceGetAttribute(&cus, hipDeviceAttributeMultiprocessorCount, dev) != hipSuccess) { grid = -1; return; }
        if (hipFuncSetAttribute((const void*)mega_fwd, hipFuncAttributeMaxDynamicSharedMemorySize, LDS_BYTES) != hipSuccess) { fprintf(stderr, "kernel_launch: hipFuncSetAttribute failed\n"); grid = -1; return; }
        if (hipOccupancyMaxActiveBlocksPerMultiprocessor(&per_cu, (const void*)mega_fwd, 512, LDS_BYTES) != hipSuccess || per_cu < 1)
            fprintf(stderr, "kernel_launch: occupancy query reports %d blocks per CU\n", per_cu);
        (void)hipGetLastError();
        grid = cus;
    }
    if (grid < 0) return;
    Args a{};
    for (int i = 0; i < 26; ++i) a.in[i] = (const float*)d_in[i];
    a.out = (float*)d_out; a.ws = (unsigned char*)d_ws;
#if N_LAUNCH_SPLIT
    for (int k = 0; k < NPHASE; ++k) {
        (void)hipMemsetAsync((char*)d_ws + WS_BAR, 0, XCD_BAR_WORDS * sizeof(unsigned), stream);
        a.ph_lo = k; a.ph_hi = k + 1;
        hipLaunchKernelGGL(mega_fwd, dim3(grid), dim3(512), LDS_BYTES, stream, a);
    }
#else
    (void)hipMemsetAsync((char*)d_ws + WS_BAR, 0, XCD_BAR_WORDS * sizeof(unsigned), stream);
    a.ph_lo = 0; a.ph_hi = NPHASE;
    hipLaunchKernelGGL(mega_fwd, dim3(grid), dim3(512), LDS_BYTES, stream, a);
#endif
}
```

```cpp
#include <hip/hip_runtime.h>
#include <hip/hip_bf16.h>
#include <stdint.h>
#include <stdio.h>

#ifndef N_LAUNCH_SPLIT
#define N_LAUNCH_SPLIT 0
#endif

#define DEVI __device__ __forceinline__
typedef __attribute__((ext_vector_type(8))) short bf16x8;
typedef __attribute__((ext_vector_type(4))) float f32x4;
typedef __attribute__((ext_vector_type(4))) int i32x4;
typedef __attribute__((ext_vector_type(2))) float f2v;
typedef __attribute__((ext_vector_type(2))) __bf16 b2v;
typedef unsigned short u16;

constexpr int T = 8192, D = 2048, PW = 4112;
constexpr int NH = 4, HK = 128, HV = 256, CH = 64, NCH = 128, RANK = 16;
constexpr int SW = 1024, SG = 16, NG = 64, SP = 64;
constexpr int NE = 32, FF = 2048, CAP = 8192;
constexpr int PJ = 4096;
constexpr float EPS = 1e-6f;

constexpr size_t WS_BAR   = 0;
constexpr size_t WS_CNT   = 32768;
constexpr size_t WS_SSQ   = 65536;
constexpr size_t WS_GLR   = WS_SSQ + 65536;
constexpr size_t WS_DEC   = WS_GLR + (size_t)T * 16 * 4;
constexpr size_t WS_S5AL  = WS_DEC + (size_t)NCH * NH * HK * 4;
constexpr size_t WS_TSLOT = WS_S5AL + 65536;
constexpr size_t WS_LTOK  = WS_TSLOT + (size_t)T * 4 * 4;
constexpr size_t WS_LGATE = WS_LTOK + (size_t)NE * CAP * 4;
constexpr size_t WS_S5K   = WS_LGATE + (size_t)NE * CAP * 4;
constexpr size_t WS_S5WE  = WS_S5K + (size_t)NG * 64 * 256 * 2;
constexpr size_t WS_S5V   = WS_S5WE + (size_t)NG * 128 * 1024 * 2;
constexpr size_t WS_S5E   = WS_S5V + (size_t)NG * 1024 * 128 * 2;
constexpr size_t WS_S5H   = WS_S5E + (size_t)NG * 128 * 128 * 4;
constexpr size_t WS_HN    = WS_S5H + (size_t)NG * 128 * 128 * 2;
constexpr size_t WS_PROJ  = WS_HN + (size_t)T * D * 2;
constexpr size_t WS_KV    = WS_PROJ + (size_t)T * PJ * 2;
constexpr size_t WS_ST    = WS_KV + (size_t)NCH * NH * HV * HK * 4;
constexpr size_t WS_Z     = WS_ST + (size_t)NCH * NH * HV * HK * 2;
constexpr size_t WS_MIX   = WS_Z + (size_t)T * SW * 2;
constexpr size_t WS_H1    = WS_MIX + (size_t)T * D * 2;
constexpr size_t WS_HN2   = WS_H1 + (size_t)T * D * 4;
constexpr size_t WS_ACT   = WS_HN2 + (size_t)T * D * 2;
constexpr size_t WS_Y     = WS_ACT + (size_t)(T * 4 + 256) * FF * 2;
constexpr size_t WS_W1T   = WS_Y + (size_t)(T * 4 + 256) * D * 2;
constexpr size_t WS_W2T   = WS_W1T + (size_t)NE * 4096 * D;
constexpr size_t WS_WINT  = WS_W2T + (size_t)NE * D * FF;
constexpr size_t WS_GLUT  = WS_WINT + (size_t)PJ * D * 2;
constexpr size_t WS_WOUTT = WS_GLUT + (size_t)SW * SW * 2;
constexpr size_t WS_END   = WS_WOUTT + (size_t)D * D * 2;

constexpr int LDS_BYTES = 163840;
constexpr int LDS_CONV = 131072;
constexpr int LDS_BASE = 1024;

DEVI unsigned pack2(float a, float b) { f2v v = {a, b}; b2v r = __builtin_convertvector(v, b2v); return __builtin_bit_cast(unsigned, r); }
DEVI u16 f2bf(float a) { __bf16 r = (__bf16)a; return __builtin_bit_cast(u16, r); }
DEVI float bf2f(u16 h) { return __uint_as_float(((unsigned)h) << 16); }
DEVI float bflo(unsigned w) { return __uint_as_float(w << 16); }
DEVI float bfhi(unsigned w) { return __uint_as_float(w & 0xffff0000u); }
DEVI float wave_sum(float v) {
#pragma unroll
    for (int o = 32; o >= 1; o >>= 1) v += __shfl_xor(v, o);
    return v;
}
DEVI float sum16(float v) {
#pragma unroll
    for (int o = 8; o >= 1; o >>= 1) v += __shfl_xor(v, o);
    return v;
}
DEVI float sigmoidf_(float x) { return __builtin_amdgcn_rcpf(1.0f + __expf(-x)); }
DEVI float logsigmoid_(float x) { return fminf(x, 0.0f) - __logf(1.0f + __expf(-fabsf(x))); }
DEVI float gelu_tanh(float x) {
    const float a = 0.7978845608028654f * (x + 0.044715f * x * x * x);
    return x * __builtin_amdgcn_rcpf(1.0f + __expf(-2.0f * a));
}

#define WAIT_V0() asm volatile("s_waitcnt vmcnt(0)" ::: "memory")
#define WAIT_L0() asm volatile("s_waitcnt lgkmcnt(0)" ::: "memory")

#define XB_TMO      128
#define XB_XCNT(j)  (256  + 64 * (j))
#define XB_XSUB(j)  (1280 + 64 * (j))
#define XB_XGEN(j)  (2304 + 64 * (j))
#define XB_TOP      3328
#define XB_TOPGEN   3392
#define XCD_BAR_WORDS 3456
#define XB_SPIN_CAP (1u << 20)
#define LAS __attribute__((address_space(3)))

DEVI unsigned xb_ld(unsigned* p)              { return __hip_atomic_load(p, __ATOMIC_RELAXED, __HIP_MEMORY_SCOPE_AGENT); }
DEVI unsigned xb_add(unsigned* p, unsigned v) { return __hip_atomic_fetch_add(p, v, __ATOMIC_RELAXED, __HIP_MEMORY_SCOPE_AGENT); }
DEVI unsigned xb_xcc_id() { return (unsigned)__builtin_amdgcn_s_getreg((3 << 11) | 20) & 0xFu; }
#define XB_SPIN(cond, bar) do { unsigned _sp = 0; while (cond) { __builtin_amdgcn_s_sleep(1); \
    if ((++_sp & 255u) == 0u) { if (xb_ld(&(bar)[XB_TMO])) break; if (_sp > XB_SPIN_CAP) { atomicAdd(&(bar)[XB_TMO], 1u); break; } } } } while (0)

struct XcdBarrier { unsigned* bar; unsigned x; volatile LAS unsigned* st; };

DEVI XcdBarrier xcd_barrier_post(unsigned* bar, volatile LAS unsigned* st) {
    XcdBarrier b; b.bar = bar; b.x = xb_xcc_id(); b.st = st;
    if (threadIdx.x == 0) (void)xb_add(&bar[XB_XCNT(b.x)], 1u);
    return b;
}
DEVI void xcd_barrier_complete(unsigned* bar, unsigned x, unsigned& nloc, unsigned& nx) {
    const unsigned G = gridDim.x * gridDim.y * gridDim.z;
    unsigned sum, cnt, mine, sp = 0u;
    for (;;) {
        sum = 0u; cnt = 0u; mine = 0u;
#pragma unroll
        for (unsigned j = 0; j < 16; ++j) { const unsigned c = xb_ld(&bar[XB_XCNT(j)]); sum += c; cnt += (c > 0u) ? 1u : 0u; mine = (j == x) ? c : mine; }
        if (sum == G) break;
        __builtin_amdgcn_s_sleep(1);
        if ((++sp & 255u) == 0u) { if (xb_ld(&bar[XB_TMO])) break; if (sp > XB_SPIN_CAP) { atomicAdd(&bar[XB_TMO], 1u); break; } }
    }
    nloc = mine > 0u ? mine : 1u; nx = cnt > 0u ? cnt : 1u;
}
DEVI void xcd_barrier(const XcdBarrier& b) {
    asm volatile("s_waitcnt vmcnt(0)" ::: "memory");
    __syncthreads();
    if (threadIdx.x == 0) {
        unsigned* bar = b.bar;
        __builtin_amdgcn_s_waitcnt(0);
        unsigned nloc = b.st[0], nx = b.st[1];
        if (nloc == 0u) { xcd_barrier_complete(bar, b.x, nloc, nx); b.st[0] = nloc; b.st[1] = nx; }
        const unsigned old = xb_add(&bar[XB_XSUB(b.x)], 1u);
        const unsigned gen = old / nloc;
        if (old + 1u == (gen + 1u) * nloc) {
            __builtin_amdgcn_fence(__ATOMIC_RELEASE, "agent");
            asm volatile("s_waitcnt vmcnt(0)" ::: "memory");
            const unsigned og = xb_add(&bar[XB_TOP], 1u);
            const unsigned tg = og / nx;
            if (og + 1u == (tg + 1u) * nx) xb_add(&bar[XB_TOPGEN], 1u);
            else XB_SPIN(xb_ld(&bar[XB_TOPGEN]) == tg, bar);
            __builtin_amdgcn_fence(__ATOMIC_ACQUIRE, "agent");
            xb_add(&bar[XB_XGEN(b.x)], 1u);
            asm volatile("s_waitcnt vmcnt(0)" ::: "memory");
        } else {
            XB_SPIN(xb_ld(&bar[XB_XGEN(b.x)]) == gen, bar);
            __builtin_amdgcn_fence(__ATOMIC_ACQUIRE, "agent");
            asm volatile("s_waitcnt vmcnt(0)" ::: "memory");
        }
    }
    __syncthreads();
}

struct Args {
    const float* in[26];
    float* out;
    unsigned char* ws;
    int ph_lo, ph_hi;
};

template <int KS> DEVI int lds_byte(int r, int c) {
    int st = (r >> 4) * KS + (c >> 5), ob = (r & 15) * 64 + (c & 31) * 2;
    return st * 1024 + (ob ^ (((ob >> 9) & 1) << 5));
}
typedef __attribute__((ext_vector_type(16))) float f32x16;
typedef __attribute__((ext_vector_type(8))) int i32x8;
DEVI void f8_stage_rb(int wid, int lane, int i, int& R, int& CB) {
    R = wid * 16 + i * 128 + (lane >> 2);
    CB = (((lane & 3) ^ (R >> 2)) & 3) * 16;
}
DEVI int acc_row32(int wr, int m, int r, int lane) { return wr * 128 + m * 32 + (r & 3) + 8 * (r >> 2) + 4 * (lane >> 5); }
DEVI unsigned cvt4_fp8(float a, float b, float c, float d) {
    int r = 0;
    r = __builtin_amdgcn_cvt_pk_fp8_f32(a, b, r, false);
    r = __builtin_amdgcn_cvt_pk_fp8_f32(c, d, r, true);
    return (unsigned)r;
}
#define WAIT_VN(n) asm volatile("s_waitcnt vmcnt(" #n ")" ::: "memory")
DEVI void f8_stage(char* lds, const unsigned char* __restrict__ A, const unsigned (&aoff)[2], const unsigned char* __restrict__ B, const unsigned (&boffv)[2], int wid, int t) {
    char* sb = lds + (t & 3) * 32768 + wid * 1024;
#pragma unroll
    for (int i = 0; i < 2; ++i) {
        __builtin_amdgcn_global_load_lds((const unsigned*)(A + aoff[i] + t * 64), (LAS unsigned*)(sb + i * 8192), 16, 0, 0);
        __builtin_amdgcn_global_load_lds((const unsigned*)(B + boffv[i] + t * 64), (LAS unsigned*)(sb + 16384 + i * 8192), 16, 0, 0);
    }
}
DEVI void f8_prefetch(char* lds, const unsigned char* __restrict__ A, const unsigned (&aoff)[2], const unsigned char* __restrict__ B, const unsigned (&boffv)[2], int wid) {
    f8_stage(lds, A, aoff, B, boffv, wid, 0); f8_stage(lds, A, aoff, B, boffv, wid, 1); f8_stage(lds, A, aoff, B, boffv, wid, 2);
}
DEVI void q8_stage(char* lds, const unsigned char* __restrict__ A, const unsigned (&aoff)[2], const unsigned char* __restrict__ B, const unsigned (&boffv)[2], int wid, int t) {
    char* sb = lds + (t & 3) * 32768 + wid * 1024;
#pragma unroll
    for (int i = 0; i < 2; ++i) {
        __builtin_amdgcn_global_load_lds((const unsigned*)(A + aoff[i] + t * 64), (LAS unsigned*)(sb + i * 8192), 16, 0, 0);
        __builtin_amdgcn_global_load_lds((const unsigned*)(B + boffv[i] + t * 8192), (LAS unsigned*)(sb + 16384 + i * 8192), 16, 0, 0);
    }
}
DEVI void q8_prefetch(char* lds, const unsigned char* __restrict__ A, const unsigned (&aoff)[2], const unsigned char* __restrict__ B, const unsigned (&boffv)[2], int wid) {
    q8_stage(lds, A, aoff, B, boffv, wid, 0); q8_stage(lds, A, aoff, B, boffv, wid, 1); q8_stage(lds, A, aoff, B, boffv, wid, 2);
}
template <int NT, int SCALE_A, int SCALE_B, bool MOE1>
DEVI void f8_mainloop(char* lds, const unsigned char* __restrict__ A, const unsigned (&aoff)[2], const unsigned char* __restrict__ B, const unsigned (&boffv)[2],
                      int wid, int lane, f32x16 (&acc)[2][4]) {
    const int wr = wid >> 2, wc = wid & 3, l31 = lane & 31, hh = lane >> 5;
    const int xs = (l31 >> 2) & 3;
    const int p0 = ((2 * hh) ^ xs) << 4, p1 = ((2 * hh + 1) ^ xs) << 4;
    const int a_lo = (wr * 128 + l31) * 64 + p0, a_hi = (wr * 128 + l31) * 64 + p1;
    int b_rd[2];
#pragma unroll
    for (int nf = 0; nf < 2; ++nf) {
        const int ntile = MOE1 ? nf : (wc >> 1), nbase = MOE1 ? wc * 32 : (wc & 1) * 64 + nf * 32;
        b_rd[nf] = 16384 + ntile * 8192 + (8 * hh) * 512 + (nbase + l31) * 4;
    }
    auto ldfrag = [&](const char* sa, int lo, int hi) -> i32x8 {
        const i32x4 x = *(const i32x4*)(sa + lo), y = *(const i32x4*)(sa + hi);
        i32x8 r; r[0] = x[0]; r[1] = x[1]; r[2] = x[2]; r[3] = x[3]; r[4] = y[0]; r[5] = y[1]; r[6] = y[2]; r[7] = y[3];
        return r;
    };
    auto compute = [&](int t) {
        const char* sa = lds + (t & 3) * 32768;
        i32x8 fa[4], fb[2];
#pragma unroll
        for (int m = 0; m < 4; ++m) fa[m] = ldfrag(sa + m * 2048, a_lo, a_hi);
#pragma unroll
        for (int n = 0; n < 2; ++n)
#pragma unroll
            for (int j = 0; j < 8; ++j) fb[n][j] = *(const int*)(sa + b_rd[n] + j * 512);
#pragma unroll
        for (int m = 0; m < 4; ++m)
#pragma unroll
            for (int n = 0; n < 2; ++n)
                acc[n][m] = __builtin_amdgcn_mfma_scale_f32_32x32x64_f8f6f4(fb[n], fa[m], acc[n][m], 0, 0, 0, SCALE_B, 0, SCALE_A);
    };
    WAIT_V0(); __builtin_amdgcn_s_barrier();
#pragma unroll 1
    for (int t = 0; t < NT; ++t) {
        if (t + 3 < NT) q8_stage(lds, A, aoff, B, boffv, wid, t + 3);
        compute(t);
        if (t + 3 < NT) { WAIT_VN(8); } else if (t + 2 < NT) { WAIT_VN(4); } else { WAIT_V0(); }
        WAIT_L0(); __builtin_amdgcn_s_barrier();
    }
}
DEVI void touch4(const f32x4& v) { asm volatile("" :: "v"(v)); }
DEVI void touchf(float v) { asm volatile("" :: "v"(v)); }
DEVI void zero_acc32(f32x16 (&acc)[2][4]) {
#pragma unroll
    for (int n = 0; n < 2; ++n)
#pragma unroll
        for (int m = 0; m < 4; ++m)
#pragma unroll
            for (int r = 0; r < 16; ++r) acc[n][m][r] = 0.f;
}

DEVI void bf_stage_rb(int wid, int lane, int i, int& R, int& CB) {
    R = wid * 16 + i * 128 + (lane >> 2);
    CB = (((lane & 3) ^ (R >> 1)) & 3) * 16;
}
template <int NT>
DEVI void bf_mainloop(char* lds, const unsigned char* __restrict__ A, const unsigned (&aoff)[2], const unsigned char* __restrict__ B, const unsigned (&boffv)[2],
                      int wid, int lane, f32x4 (&acc)[4][8]) {
    const int wr = wid >> 2, wc = wid & 3, l15 = lane & 15, q = lane >> 4;
    const int cp = (q ^ ((l15 >> 1) & 3)) << 4;
    const int t_rd = (wr * 128 + l15) * 64 + cp;
    const int w_rd = 16384 + (wc * 64 + l15) * 64 + cp;
    auto compute = [&](int t) {
        const char* sa = lds + (t & 3) * 32768;
        bf16x8 tf[8], wf[4];
#pragma unroll
        for (int nt = 0; nt < 4; ++nt) wf[nt] = *(const bf16x8*)(sa + w_rd + nt * 1024);
#pragma unroll
        for (int mt = 0; mt < 8; ++mt) tf[mt] = *(const bf16x8*)(sa + t_rd + mt * 1024);
#pragma unroll
        for (int mt = 0; mt < 8; ++mt)
#pragma unroll
            for (int nt = 0; nt < 4; ++nt)
                acc[nt][mt] = __builtin_amdgcn_mfma_f32_16x16x32_bf16(wf[nt], tf[mt], acc[nt][mt], 0, 0, 0);
    };
    WAIT_V0(); __builtin_amdgcn_s_barrier();
#pragma unroll 1
    for (int t = 0; t < NT; ++t) {
        if (t + 3 < NT) f8_stage(lds, A, aoff, B, boffv, wid, t + 3);
        compute(t);
        if (t + 3 < NT) { WAIT_VN(8); } else if (t + 2 < NT) { WAIT_VN(4); } else { WAIT_V0(); }
        WAIT_L0(); __builtin_amdgcn_s_barrier();
    }
}
DEVI void zero_acc16(f32x4 (&acc)[4][8]) {
#pragma unroll
    for (int nt = 0; nt < 4; ++nt)
#pragma unroll
        for (int mt = 0; mt < 8; ++mt) acc[nt][mt] = f32x4{0.f, 0.f, 0.f, 0.f};
}
DEVI void bf_offsets(unsigned (&off)[2], int wid, int lane, int row0, int ld) {
#pragma unroll
    for (int i = 0; i < 2; ++i) { int R, CB; bf_stage_rb(wid, lane, i, R, CB); off[i] = ((unsigned)(row0 + R) * ld) * 2u + CB; }
}

DEVI void dense_convert(const Args& a, char* lds, int tid, int wid, int lane) {
    constexpr int RS = 132;
    unsigned* L = (unsigned*)lds;
    const int kq = tid >> 5, nq = tid & 31;
    auto tile = [&](int tl, const float*& src, int& ld, int& ldo, u16*& dst) {
        if (tl < 512) { const int kt = tl & 15, nt = tl >> 4; const int c0 = (nt < 24) ? nt * 128 : 3088 + (nt - 24) * 128;
            src = a.in[2] + (size_t)(kt * 128) * PW + c0; ld = PW; ldo = D; dst = (u16*)(a.ws + WS_WINT) + (size_t)(nt * 128) * D + kt * 128; }
        else if (tl < 576) { const int t2 = tl - 512, kt = t2 & 7, nt = t2 >> 3;
            src = a.in[14] + (size_t)(kt * 128) * SW + nt * 128; ld = SW; ldo = SW; dst = (u16*)(a.ws + WS_GLUT) + (size_t)(nt * 128) * SW + kt * 128; }
        else { const int t2 = tl - 576, kt = t2 & 15, nt = t2 >> 4;
            src = a.in[17] + (size_t)(kt * 128) * D + nt * 128; ld = D; ldo = D; dst = (u16*)(a.ws + WS_WOUTT) + (size_t)(nt * 128) * D + kt * 128; }
    };
    f32x4 v[2][4];
    auto issue = [&](int tl) {
        const float* src; int ld, ldo; u16* dst; tile(tl, src, ld, ldo, dst);
#pragma unroll
        for (int h = 0; h < 2; ++h)
#pragma unroll
            for (int r = 0; r < 4; ++r) v[h][r] = *(const f32x4*)(src + (size_t)(4 * (kq + 16 * h) + r) * ld + 4 * nq);
    };
    if ((int)blockIdx.x < 832) issue(blockIdx.x);
#pragma unroll 1
    for (int tl = blockIdx.x; tl < 832; tl += gridDim.x) {
        const float* src; int ld, ldo; u16* dst; tile(tl, src, ld, ldo, dst);
        __syncthreads();
#pragma unroll
        for (int h = 0; h < 2; ++h) {
            i32x4 d0, d1;
#pragma unroll
            for (int c = 0; c < 4; ++c) { d0[c] = (int)pack2(v[h][0][c], v[h][1][c]); d1[c] = (int)pack2(v[h][2][c], v[h][3][c]); }
            *(i32x4*)(L + (2 * (kq + 16 * h)) * RS + 4 * nq) = d0;
            *(i32x4*)(L + (2 * (kq + 16 * h) + 1) * RS + 4 * nq) = d1;
        }
        if (tl + (int)gridDim.x < 832) issue(tl + gridDim.x);
        __syncthreads();
        {
            const int part = wid & 3, n = (wid >> 2) * 64 + lane;
            unsigned o[16];
#pragma unroll
            for (int j = 0; j < 16; ++j) o[j] = L[(16 * part + j) * RS + n];
            uint4* dp = (uint4*)(dst + (size_t)n * ldo + 32 * part);
            dp[0] = make_uint4(o[0], o[1], o[2], o[3]); dp[1] = make_uint4(o[4], o[5], o[6], o[7]);
            dp[2] = make_uint4(o[8], o[9], o[10], o[11]); dp[3] = make_uint4(o[12], o[13], o[14], o[15]);
        }
    }
}

DEVI void convert_range(const Args& a, char* lds, int t_lo, int t_hi, int tid, int wid, int lane) {
    const float* w1 = a.in[21]; const float* w2 = a.in[23];
    unsigned char* W1Q = a.ws + WS_W1T; unsigned char* W2Q = a.ws + WS_W2T;
    { int lq = lane; asm volatile("" : "+v"(lq)); lane = lq; tid = wid * 64 + lq; }
    const int kq0 = tid >> 5, n4 = tid & 31;
    auto tile_src = [&](int tl, const float*& src, int& ld, unsigned char*& dst) {
        if (tl < 16384) { const int kt = tl & 15, nt = (tl >> 4) & 31, e = tl >> 9;
            src = w1 + (size_t)e * D * 4096 + (size_t)(kt * 128) * 4096 + nt * 128; ld = 4096;
            dst = W1Q + ((size_t)(e * 32 + nt) * 512 + kt * 32) * 512; }
        else { const int t2 = tl - 16384, kt = t2 & 15, nt = (t2 >> 4) & 15, e = t2 >> 8;
            src = w2 + (size_t)e * FF * D + (size_t)(kt * 128) * D + nt * 128; ld = D;
            dst = W2Q + ((size_t)(e * 16 + nt) * 512 + kt * 32) * 512; }
    };
    f32x4 va[2][4], vb[2][4];
    auto issue = [&](int tl, f32x4 (&v)[2][4]) {
        const float* src; int ld; unsigned char* dst; tile_src(tl, src, ld, dst);
#pragma unroll
        for (int h = 0; h < 2; ++h)
#pragma unroll
            for (int r = 0; r < 4; ++r) v[h][r] = __builtin_nontemporal_load((const f32x4*)(src + (size_t)(4 * (kq0 + 16 * h) + r) * ld + 4 * n4));
    };
    auto finish = [&](int tl, f32x4 (&v)[2][4], int tnext) {
        const float* src; int ld; unsigned char* dst; tile_src(tl, src, ld, dst);
        uint4 o[2];
#pragma unroll
        for (int h = 0; h < 2; ++h) {
            o[h].x = cvt4_fp8(v[h][0][0] * 256.f, v[h][1][0] * 256.f, v[h][2][0] * 256.f, v[h][3][0] * 256.f);
            o[h].y = cvt4_fp8(v[h][0][1] * 256.f, v[h][1][1] * 256.f, v[h][2][1] * 256.f, v[h][3][1] * 256.f);
            o[h].z = cvt4_fp8(v[h][0][2] * 256.f, v[h][1][2] * 256.f, v[h][2][2] * 256.f, v[h][3][2] * 256.f);
            o[h].w = cvt4_fp8(v[h][0][3] * 256.f, v[h][1][3] * 256.f, v[h][2][3] * 256.f, v[h][3][3] * 256.f);
        }
        if (tnext < t_hi) issue(tnext, v);
#pragma unroll
        for (int h = 0; h < 2; ++h) *(uint4*)(dst + ((size_t)(kq0 + 16 * h) * 128 + 4 * n4) * 4) = o[h];
    };
    if (t_lo < t_hi) issue(t_lo, va);
    if (t_lo + 1 < t_hi) issue(t_lo + 1, vb);
#pragma unroll 1
    for (int tl = t_lo; tl < t_hi; tl += 2) {
        finish(tl, va, tl + 2);
        if (tl + 1 < t_hi) finish(tl + 1, vb, tl + 3);
    }
}

DEVI void convert_pool(const Args& a, char* lds, int which, int p_lo, int p_hi, int tid, int wid, int lane) {
    int* cur = (int*)(a.ws + WS_CNT) + 64 + which;
    volatile int* bc = (volatile int*)(lds - LDS_BASE + 32);
#pragma unroll 1
    while (true) {
        __syncthreads();
        if (tid == 0) *bc = atomicAdd(cur, 4);
        __syncthreads();
        const int t = p_lo + *bc;
        if (t >= p_hi) break;
        convert_range(a, lds, t, min(t + 4, p_hi), tid, wid, lane);
    }
}

DEVI void phase0(const Args& a, char* lds, int tid, int wid, int lane) {
    const float* x = a.in[0]; const float* g1 = a.in[1]; const float* w_in = a.in[2];
    u16* HN = (u16*)(a.ws + WS_HN); float* GLR = (float*)(a.ws + WS_GLR);
    constexpr int RSB = 4096 + 16;
    char* Wb = lds;
    char* Hb = lds + 16 * RSB;
    float* red = (float*)(lds + 32 * RSB);
    for (int u = blockIdx.x; u < 256; u += gridDim.x) {
        __syncthreads();
        for (int k = 0; k < 4; ++k) {
            const int d = (tid + 512 * k + 8 * (int)blockIdx.x) & 2047;
            const f32x4* src = (const f32x4*)(w_in + (size_t)d * PW + 3072);
#pragma unroll
            for (int q = 0; q < 4; ++q) { f32x4 v = src[q];
#pragma unroll
                for (int c = 0; c < 4; ++c) *(u16*)(Wb + (q * 4 + c) * RSB + d * 2) = f2bf(v[c]); }
        }
        if (tid < 32) ((float*)(a.ws + WS_SSQ))[u * 32 + tid] = 0.f;
        if (u == 0 && tid < 32) { ((int*)(a.ws + WS_CNT))[tid] = 0; ((int*)(a.ws + WS_CNT))[64 + tid] = 0; }
#pragma unroll 1
        for (int ps = 0; ps < 2; ++ps) {
            const int tok0 = u * 32 + ps * 16;
            {
                const int tokA = tok0 + wid * 2, tokB = tokA + 1;
                f32x4 xa[8], xb[8];
                float ssa = 0.f, ssb = 0.f;
#pragma unroll
                for (int i = 0; i < 8; ++i) {
                    xa[i] = *(const f32x4*)(x + (size_t)tokA * D + 256 * i + 4 * lane);
                    xb[i] = *(const f32x4*)(x + (size_t)tokB * D + 256 * i + 4 * lane);
#pragma unroll
                    for (int c = 0; c < 4; ++c) { ssa += xa[i][c] * xa[i][c]; ssb += xb[i][c] * xb[i][c]; }
                }
                ssa = wave_sum(ssa); ssb = wave_sum(ssb);
                const float ra = rsqrtf(ssa * (1.0f / D) + EPS), rb = rsqrtf(ssb * (1.0f / D) + EPS);
#pragma unroll
                for (int i = 0; i < 8; ++i) {
                    const f32x4 g = *(const f32x4*)(g1 + 256 * i + 4 * lane);
                    uint2 pa, pb;
                    pa.x = pack2(xa[i][0] * ra * g[0], xa[i][1] * ra * g[1]); pa.y = pack2(xa[i][2] * ra * g[2], xa[i][3] * ra * g[3]);
                    pb.x = pack2(xb[i][0] * rb * g[0], xb[i][1] * rb * g[1]); pb.y = pack2(xb[i][2] * rb * g[2], xb[i][3] * rb * g[3]);
                    *(uint2*)(HN + (size_t)tokA * D + 256 * i + 4 * lane) = pa;
                    *(uint2*)(HN + (size_t)tokB * D + 256 * i + 4 * lane) = pb;
                    *(uint2*)(Hb + (wid * 2) * RSB + (256 * i + 4 * lane) * 2) = pa;
                    *(uint2*)(Hb + (wid * 2 + 1) * RSB + (256 * i + 4 * lane) * 2) = pb;
                }
            }
            __syncthreads();
            {
                const int l15 = lane & 15, q = lane >> 4;
                f32x4 acc = {0.f, 0.f, 0.f, 0.f};
#pragma unroll
                for (int ks = 0; ks < 8; ++ks) {
                    const int kb = (wid * 256 + ks * 32 + q * 8) * 2;
                    const bf16x8 av = *(const bf16x8*)(Hb + l15 * RSB + kb);
                    const bf16x8 bv = *(const bf16x8*)(Wb + l15 * RSB + kb);
                    acc = __builtin_amdgcn_mfma_f32_16x16x32_bf16(av, bv, acc, 0, 0, 0);
                }
#pragma unroll
                for (int j = 0; j < 4; ++j) red[(wid * 16 + 4 * q + j) * 16 + l15] = acc[j];
            }
            __syncthreads();
            if (tid < 256) {
                float sacc = 0.f;
#pragma unroll
                for (int w = 0; w < 8; ++w) sacc += red[w * 256 + tid];
                GLR[(size_t)(tok0 + (tid >> 4)) * 16 + (tid & 15)] = sacc;
            }
        }
    }
    const float* a_re = a.in[6]; const float* a_im = a.in[7]; const float* b_re = a.in[8]; const float* b_im = a.in[9];
    const float* c_re = a.in[10]; const float* c_im = a.in[11]; const float* lstep = a.in[13];
    u16* KT = (u16*)(a.ws + WS_S5K); u16* WE = (u16*)(a.ws + WS_S5WE); u16* VV = (u16*)(a.ws + WS_S5V); float* AL = (float*)(a.ws + WS_S5AL);
    float* Bre = (float*)lds;
    float* Bim = Bre + 1024;
    float* Cre = Bim + 1024;
    float* Cim = Cre + 1024;
    float* Pre = Cim + 1024;
    float* Pim = Pre + 65 * 64;
    for (int u = blockIdx.x; u < 256; u += gridDim.x) {
        const int g = u >> 2, q = u & 3;
        __syncthreads();
        const float delta = __expf(lstep[g]);
        if (tid < 64) {
            const int p = tid;
            const float ar = a_re[g * 64 + p], ai = a_im[g * 64 + p];
            const float ea = expf(ar * delta);
            float sn, cs; sincosf(ai * delta, &sn, &cs);
            const float xr = ea * cs - 1.0f, xi = ea * sn;
            const float den = 1.0f / (ar * ar + ai * ai);
            const float cr = (xr * ar + xi * ai) * den, ci = (xi * ar - xr * ai) * den;
#pragma unroll
            for (int m = 0; m < 16; ++m) {
                const float br = b_re[(g * 64 + p) * 16 + m], bi = b_im[(g * 64 + p) * 16 + m];
                Bre[p * 16 + m] = cr * br - ci * bi;
                Bim[p * 16 + m] = cr * bi + ci * br;
            }
        }
        for (int i = tid; i < 1024; i += 512) { Cre[i] = c_re[g * 1024 + i]; Cim[i] = c_im[g * 1024 + i]; }
        for (int i = tid; i < 65 * 64; i += 512) {
            const int tau = i >> 6, p = i & 63;
            const float ar = a_re[g * 64 + p], ai = a_im[g * 64 + p];
            const float e = expf((float)tau * ar * delta);
            float sn, cs; sincosf((float)tau * (ai * delta), &sn, &cs);
            Pre[i] = e * cs; Pim[i] = e * sn;
        }
        __syncthreads();
        if (q == 0 && tid < 64) { AL[(g * 64 + tid) * 2] = Pre[64 * 64 + tid]; AL[(g * 64 + tid) * 2 + 1] = Pim[64 * 64 + tid]; }
        if (tid < 256) {
            const int tau = q * 16 + (tid >> 4), n = tid & 15;
            float acc[16];
#pragma unroll
            for (int m = 0; m < 16; ++m) acc[m] = 0.f;
#pragma unroll 2
            for (int p = 0; p < 64; ++p) {
                const float cr = Cre[n * 64 + p], ci = Cim[n * 64 + p], pr = Pre[tau * 64 + p], pi = Pim[tau * 64 + p];
                const float xr = cr * pr - ci * pi, xi = cr * pi + ci * pr;
#pragma unroll
                for (int m4 = 0; m4 < 4; ++m4) {
                    const f32x4 br = *(const f32x4*)(Bre + p * 16 + m4 * 4), bi = *(const f32x4*)(Bim + p * 16 + m4 * 4);
#pragma unroll
                    for (int c = 0; c < 4; ++c) acc[m4 * 4 + c] += xr * br[c] - xi * bi[c];
                }
            }
            uint4 o0, o1;
            o0.x = pack2(acc[0], acc[1]); o0.y = pack2(acc[2], acc[3]); o0.z = pack2(acc[4], acc[5]); o0.w = pack2(acc[6], acc[7]);
            o1.x = pack2(acc[8], acc[9]); o1.y = pack2(acc[10], acc[11]); o1.z = pack2(acc[12], acc[13]); o1.w = pack2(acc[14], acc[15]);
            uint4* dst = (uint4*)(KT + ((size_t)(g * 64 + tau) * 16 + n) * 16);
            dst[0] = o0; dst[1] = o1;
        }
        {
            const int p = tid >> 3;
#pragma unroll
            for (int ss = 0; ss < 2; ++ss) {
                const int s = q * 16 + (tid & 7) * 2 + ss;
                const float pr = Pre[(63 - s) * 64 + p], pi = Pim[(63 - s) * 64 + p];
                float vr[16], vi[16];
#pragma unroll
                for (int m = 0; m < 16; ++m) { const float br = Bre[p * 16 + m], bi = Bim[p * 16 + m]; vr[m] = pr * br - pi * bi; vi[m] = pr * bi + pi * br; }
                uint4 r0, r1, i0, i1;
                r0.x = pack2(vr[0], vr[1]); r0.y = pack2(vr[2], vr[3]); r0.z = pack2(vr[4], vr[5]); r0.w = pack2(vr[6], vr[7]);
                r1.x = pack2(vr[8], vr[9]); r1.y = pack2(vr[10], vr[11]); r1.z = pack2(vr[12], vr[13]); r1.w = pack2(vr[14], vr[15]);
                i0.x = pack2(vi[0], vi[1]); i0.y = pack2(vi[2], vi[3]); i0.z = pack2(vi[4], vi[5]); i0.w = pack2(vi[6], vi[7]);
                i1.x = pack2(vi[8], vi[9]); i1.y = pack2(vi[10], vi[11]); i1.z = pack2(vi[12], vi[13]); i1.w = pack2(vi[14], vi[15]);
                uint4* dr = (uint4*)(WE + ((size_t)(g * 128 + 2 * p) * 1024 + s * 16));
                uint4* di = (uint4*)(WE + ((size_t)(g * 128 + 2 * p + 1) * 1024 + s * 16));
                dr[0] = r0; dr[1] = r1; di[0] = i0; di[1] = i1;
            }
        }
        {
            const int tau = q * 16 + (tid >> 5), n = (tid >> 1) & 15, ph = tid & 1;
            unsigned* dst = (unsigned*)(VV + ((size_t)(g * 1024 + tau * 16 + n) * 128 + ph * 64));
#pragma unroll 4
            for (int pp = 0; pp < 32; ++pp) {
                const int p = ph * 32 + pp;
                const float cr = Cre[n * 64 + p], ci = Cim[n * 64 + p], pr = Pre[(tau + 1) * 64 + p], pi = Pim[(tau + 1) * 64 + p];
                dst[pp] = pack2(cr * pr - ci * pi, -(cr * pi + ci * pr));
            }
        }
    }
    __syncthreads();
    dense_convert(a, lds, tid, wid, lane);
}


namespace pg8 {
#define PG8_LAS __attribute__((address_space(3)))
constexpr int BM = 256, BK = 64, HALF = 128, HTB = HALF * BK * 2, NXCD = 8, WGM = 8;
DEVI int lds_byte(int r, int c) { const int st = (r >> 4) * 2 + (c >> 5), rr = r & 15, cc = c & 31, ob = rr * 64 + cc * 2; return st * 1024 + (ob ^ (((ob >> 9) & 1) << 5)); }
DEVI void stage_rc(int b, int& R, int& C) { const int st = b / 1024, sb = b % 1024, swz = sb ^ (((sb >> 9) & 1) << 5); R = (st >> 1) * 16 + swz / 64; C = (st & 1) * 32 + (swz % 64) / 2; }
DEVI int perm32(int rho) { const int n = rho >> 4, i = rho & 15; return 8 * (i >> 2) + 4 * n + (i & 3); }
struct Unit { int pm, pn, kofs, cont; };
struct Gemm { const void* A; const void* Bt; int ld, K; };
struct StaticOrder {
    int nM, nN, nwg, G, c;
    DEVI void init(int M, int N, int G_, int c_) { nM = M / BM; nN = N / BM; nwg = nM * nN; G = G_; c = c_; }
    DEVI bool tile(int i, Unit& u) const {
        const long L = (long)i * G + c; if (L >= nwg) return false;
        int wgid = (int)L; { const int q = nwg / NXCD, r = nwg % NXCD, xcd = wgid % NXCD, off = wgid / NXCD; wgid = (xcd < r ? xcd * (q + 1) : r * (q + 1) + (xcd - r) * q) + off; }
        const int nig = WGM * nN, gid = wgid / nig, fm = gid * WGM, gsz = (nM - fm) < WGM ? (nM - fm) : WGM;
        u.pm = fm + ((wgid % nig) % gsz); u.pn = (wgid % nig) / gsz; return true;
    }
    DEVI bool next(int i, Unit& u) const { u.kofs = 0; u.cont = 0; return tile(i, u); }
};
struct SplitKOrder : StaticOrder {
    int khalf;
    DEVI bool next(int i, Unit& u) const { if (i >= 2) return false; u.kofs = i == 0 ? khalf : 0; u.cont = i; return tile(0, u); }
};

template <class Epi, class Sched>
DEVI void gemm_phase(PG8_LAS unsigned char* lds, const Gemm g, const Sched& S, const Epi& E) {
    const int tid = threadIdx.x, wid = __builtin_amdgcn_readfirstlane(tid >> 6), lane = tid & 63, wr = wid >> 2, wc = wid & 3, fr = lane & 15, fq = lane >> 4;
    const int ld = g.ld, nt = g.K / BK;
    unsigned voffA[2], voffB[2];
#pragma unroll
    for (int i = 0; i < 2; ++i) { int R, C; stage_rc(tid * 16 + i * 8192, R, C); const int Rb = Epi::PERM ? ((R & ~31) + perm32(R & 31)) : R;
        voffA[i] = (unsigned)(R * ld + C) * 2u; voffB[i] = (unsigned)(Rb * ld + C) * 2u; }
    const size_t kstep = (size_t)(BK * 2);
    const size_t hstep = (size_t)HALF * ld * 2;
    const size_t tstep = 2 * hstep;
    const unsigned ldsw = (unsigned)wid * 1024u;
    const int aoff = lds_byte(wr * 64 + fr, fq * 8), boff = lds_byte(wc * 32 + fr, fq * 8);
#define PG8_SA(b, h) (((b) * 2 + (h)) * HTB)
#define PG8_SB(b, h) ((4 + (b) * 2 + (h)) * HTB)
#define PG8_STAGE(bufoff, gbase, voff) do { _Pragma("unroll") for (int _i = 0; _i < 2; ++_i) \
        __builtin_amdgcn_global_load_lds((const unsigned*)((const char*)(gbase) + (voff)[_i]), (PG8_LAS unsigned*)(lds + (bufoff) + ldsw + _i * 8192), 16, 0, 0); } while (0)
#define PG8_LDA(dst, b, h) do { _Pragma("unroll") for (int m = 0; m < 4; ++m) _Pragma("unroll") for (int k = 0; k < 2; ++k) dst[m][k] = *(const PG8_LAS bf16x8*)(lds + PG8_SA(b, h) + aoff + m * 2048 + k * 1024); } while (0)
#define PG8_LDB(dst, b, h) do { _Pragma("unroll") for (int n = 0; n < 2; ++n) _Pragma("unroll") for (int k = 0; k < 2; ++k) dst[n][k] = *(const PG8_LAS bf16x8*)(lds + PG8_SB(b, h) + boff + n * 2048 + k * 1024); } while (0)
#define PG8_MMA(ai, bj, At, Bt) do { __builtin_amdgcn_s_setprio(1); _Pragma("unroll") for (int m = 0; m < 4; ++m) _Pragma("unroll") for (int n = 0; n < 2; ++n) _Pragma("unroll") for (int k = 0; k < 2; ++k) \
        acc[ai][bj][m][n] = __builtin_amdgcn_mfma_f32_16x16x32_bf16(Bt[n][k], At[m][k], acc[ai][bj][m][n], 0, 0, 0); __builtin_amdgcn_s_setprio(0); } while (0)
#define PG8_WAIT_V(n) asm volatile("s_waitcnt vmcnt(" #n ")" ::: "memory")
#define PG8_WAIT_L(n) asm volatile("s_waitcnt lgkmcnt(" #n ")" ::: "memory")
#define PG8_BAR __builtin_amdgcn_s_barrier()
#define PG8_SCHED __builtin_amdgcn_sched_barrier(0)
#define PG8_ZERO() do { _Pragma("unroll") for (int a_ = 0; a_ < 2; ++a_) _Pragma("unroll") for (int b_ = 0; b_ < 2; ++b_) _Pragma("unroll") for (int m_ = 0; m_ < 4; ++m_) _Pragma("unroll") for (int n_ = 0; n_ < 2; ++n_) \
        acc[a_][b_][m_][n_] = (f32x4){0.f, 0.f, 0.f, 0.f}; } while (0)
    Unit cur, nxt; int ui = 0;
    if (!S.next(0, cur)) return;
    f32x4 acc[2][2][4][2];
    PG8_ZERO();
    bf16x8 At[4][2], B0[2][2], B1[2][2];
    const char* cA = (const char*)g.A + (size_t)cur.pm * tstep + cur.kofs; const char* cB = (const char*)g.Bt + (size_t)cur.pn * tstep + cur.kofs;
    PG8_STAGE(PG8_SB(0, 0), cB, voffB); PG8_STAGE(PG8_SA(0, 0), cA, voffA); PG8_STAGE(PG8_SB(0, 1), cB + hstep, voffB); PG8_STAGE(PG8_SA(0, 1), cA + hstep, voffA);
    if (wr == 1) PG8_BAR;
    PG8_WAIT_V(4); PG8_BAR;
    PG8_STAGE(PG8_SB(1, 0), cB + kstep, voffB); PG8_STAGE(PG8_SA(1, 0), cA + kstep, voffA); PG8_STAGE(PG8_SB(1, 1), cB + hstep + kstep, voffB);
    PG8_WAIT_V(6); PG8_BAR;
    for (;;) {
        const bool has_next = S.next(ui + 1, nxt);
        const char* nA = has_next ? (const char*)g.A + (size_t)nxt.pm * tstep + nxt.kofs : cA; const char* nB = has_next ? (const char*)g.Bt + (size_t)nxt.pn * tstep + nxt.kofs : cB;
        for (int t = 0; t < nt; t += 2) {
            const bool last = (t == nt - 2);
            const char* a1 = cA + (size_t)(t + 1) * kstep;
            const char* a2 = last ? nA : cA + (size_t)(t + 2) * kstep; const char* b2 = last ? nB : cB + (size_t)(t + 2) * kstep;
            const char* a3 = a2 + kstep; const char* b3 = b2 + kstep;
            PG8_LDB(B0, 0, 0); PG8_SCHED; PG8_LDA(At, 0, 0); PG8_STAGE(PG8_SA(1, 1), a1 + hstep, voffA);
            PG8_WAIT_L(8); PG8_BAR; PG8_WAIT_L(0); PG8_MMA(0, 0, At, B0); PG8_BAR; PG8_SCHED;
            PG8_LDB(B1, 0, 1); PG8_STAGE(PG8_SB(0, 0), b2, voffB);
            PG8_BAR; PG8_WAIT_L(0); PG8_MMA(0, 1, At, B1); PG8_BAR;
            PG8_LDA(At, 0, 1); PG8_STAGE(PG8_SA(0, 0), a2, voffA);
            PG8_BAR; PG8_WAIT_L(0); PG8_MMA(1, 0, At, B0); PG8_BAR; PG8_SCHED;
            PG8_STAGE(PG8_SB(0, 1), b2 + hstep, voffB);
            PG8_WAIT_V(6); PG8_BAR; PG8_MMA(1, 1, At, B1); PG8_BAR;
            PG8_LDB(B0, 1, 0); PG8_SCHED; PG8_LDA(At, 1, 0); PG8_STAGE(PG8_SA(0, 1), a2 + hstep, voffA);
            PG8_WAIT_L(8); PG8_BAR; PG8_WAIT_L(0); PG8_MMA(0, 0, At, B0); PG8_BAR; PG8_SCHED;
            PG8_LDB(B1, 1, 1); PG8_STAGE(PG8_SB(1, 0), b3, voffB);
            PG8_BAR; PG8_WAIT_L(0); PG8_MMA(0, 1, At, B1); PG8_BAR;
            PG8_LDA(At, 1, 1); PG8_STAGE(PG8_SA(1, 0), a3, voffA);
            PG8_BAR; PG8_WAIT_L(0); PG8_MMA(1, 0, At, B0); PG8_BAR; PG8_SCHED;
            PG8_STAGE(PG8_SB(1, 1), b3 + hstep, voffB);
            PG8_WAIT_V(6); PG8_BAR; PG8_MMA(1, 1, At, B1); PG8_BAR;
        }
        E(acc, cur, wr, wc, fr, fq);
        if (!has_next) break;
        if (!nxt.cont) PG8_ZERO();
        cur = nxt; cA = nA; cB = nB; ++ui;
    }
    PG8_WAIT_V(0);
    if (wr == 0) PG8_BAR;
    PG8_BAR;
#undef PG8_SA
#undef PG8_SB
#undef PG8_STAGE
#undef PG8_LDA
#undef PG8_LDB
#undef PG8_MMA
#undef PG8_WAIT_V
#undef PG8_WAIT_L
#undef PG8_BAR
#undef PG8_SCHED
#undef PG8_ZERO
}
}

struct EpiProj {
    static constexpr bool PERM = true;
    u16* out;
    DEVI void operator()(f32x4 (&acc)[2][2][4][2], const pg8::Unit& u, int wr, int wc, int fr, int fq) const {
        const float sc = (u.pn < 2) ? 0.08838834764831845f : 1.0f;
        const int row0 = u.pm * 256 + wr * 64 + fr, col0 = u.pn * 256 + wc * 32 + 8 * fq;
#pragma unroll
        for (int ai = 0; ai < 2; ++ai)
#pragma unroll
            for (int m = 0; m < 4; ++m) {
                u16* rowp = out + (size_t)(row0 + ai * 128 + m * 16) * PJ + col0;
#pragma unroll
                for (int bj = 0; bj < 2; ++bj) {
                    const f32x4 v0 = acc[ai][bj][m][0], v1 = acc[ai][bj][m][1];
                    uint4 w; w.x = pack2(v0[0] * sc, v0[1] * sc); w.y = pack2(v0[2] * sc, v0[3] * sc); w.z = pack2(v1[0] * sc, v1[1] * sc); w.w = pack2(v1[2] * sc, v1[3] * sc);
                    *(uint4*)(rowp + bj * 128) = w;
                }
            }
    }
};
struct EpiGlu {
    static constexpr bool PERM = true;
    const u16* Z; u16* MIX; float* SSQ; const float* gbias; const float* sng;
    DEVI void operator()(f32x4 (&acc)[2][2][4][2], const pg8::Unit& u, int wr, int wc, int fr, int fq) const {
        const int row0 = u.pm * 256 + wr * 64 + fr, col0 = u.pn * 256 + wc * 32 + 8 * fq;
#pragma unroll
        for (int ai = 0; ai < 2; ++ai)
#pragma unroll
            for (int m = 0; m < 4; ++m) {
                const int row = row0 + ai * 128 + m * 16;
                float sq = 0.f;
#pragma unroll
                for (int bj = 0; bj < 2; ++bj) {
                    const int c = col0 + bj * 128;
                    const uint4 zv = *(const uint4*)(Z + (size_t)row * SW + c);
                    const unsigned zw[4] = {zv.x, zv.y, zv.z, zv.w};
                    unsigned ow[4];
#pragma unroll
                    for (int n = 0; n < 2; ++n) {
                        const f32x4 gb = *(const f32x4*)(gbias + c + 4 * n), sg = *(const f32x4*)(sng + c + 4 * n);
                        const f32x4 v = acc[ai][bj][m][n];
                        const float y0 = bflo(zw[2 * n]) * sigmoidf_(v[0] + gb[0]), y1 = bfhi(zw[2 * n]) * sigmoidf_(v[1] + gb[1]);
                        const float y2 = bflo(zw[2 * n + 1]) * sigmoidf_(v[2] + gb[2]), y3 = bfhi(zw[2 * n + 1]) * sigmoidf_(v[3] + gb[3]);
                        sq += y0 * y0 + y1 * y1 + y2 * y2 + y3 * y3;
                        ow[2 * n] = pack2(y0 * sg[0], y1 * sg[1]); ow[2 * n + 1] = pack2(y2 * sg[2], y3 * sg[3]);
                    }
                    uint4 w; w.x = ow[0]; w.y = ow[1]; w.z = ow[2]; w.w = ow[3];
                    *(uint4*)(MIX + (size_t)row * D + 1024 + c) = w;
                }
                sq += __shfl_xor(sq, 16); sq += __shfl_xor(sq, 32);
                if (fq == 0) atomicAdd(&SSQ[row], sq);
            }
    }
};
struct EpiOut {
    static constexpr bool PERM = false;
    const float* x; float* H1; const float* SSQ;
    DEVI void operator()(f32x4 (&acc)[2][2][4][2], const pg8::Unit& u, int wr, int wc, int fr, int fq) const {
        const int row0 = u.pm * 256 + wr * 64 + fr, col0 = u.pn * 256 + wc * 32 + 4 * fq;
        if (u.cont == 0) {
#pragma unroll
            for (int ai = 0; ai < 2; ++ai)
#pragma unroll
                for (int m = 0; m < 4; ++m) {
                    const float rs = rsqrtf(SSQ[row0 + ai * 128 + m * 16] * (1.0f / SW) + EPS);
#pragma unroll
                    for (int bj = 0; bj < 2; ++bj)
#pragma unroll
                        for (int n = 0; n < 2; ++n) acc[ai][bj][m][n] *= rs;
                }
        } else {
#pragma unroll
            for (int ai = 0; ai < 2; ++ai)
#pragma unroll
                for (int m = 0; m < 4; ++m) {
                    const size_t base = (size_t)(row0 + ai * 128 + m * 16) * D + col0;
#pragma unroll
                    for (int bj = 0; bj < 2; ++bj)
#pragma unroll
                        for (int n = 0; n < 2; ++n) {
                            const f32x4 xv = *(const f32x4*)(x + base + bj * 128 + n * 16);
                            *(f32x4*)(H1 + base + bj * 128 + n * 16) = xv + acc[ai][bj][m][n];
                        }
                }
        }
    }
};

DEVI void phase1(const Args& a, char* lds, int tid, int wid, int lane) {
    extern __shared__ __attribute__((aligned(16))) char smem_pg8[];
    const int cpos = blockIdx.x % 3, c_lo = blockIdx.x * 24, c_hi = c_lo + 24;
    if (cpos == 0) convert_range(a, lds, c_lo, c_hi, tid, wid, lane);
    {
        pg8::Gemm g; g.A = a.ws + WS_HN; g.Bt = a.ws + WS_WINT; g.ld = D; g.K = D;
        pg8::StaticOrder S; S.init(T, PJ, (int)gridDim.x, (int)blockIdx.x);
        EpiProj E; E.out = (u16*)(a.ws + WS_PROJ);
        pg8::gemm_phase(( PG8_LAS unsigned char*)(smem_pg8 + 1024), g, S, E);
    }
    if (cpos != 0) convert_range(a, lds, c_lo, c_hi, tid, wid, lane);
    convert_pool(a, lds, 0, 6144, 8192, tid, wid, lane);
}

DEVI void gla_gate(const Args& a, int n, int h, int tid, float* glr, float* tot, float (&b)[16], float& blast) {
    const float* GLR = (const float*)(a.ws + WS_GLR);
    const float* W2 = a.in[3]; const float* gb = a.in[4];
    for (int i = tid; i < 1024; i += 512) glr[i] = GLR[(size_t)n * 64 * 16 + i];
    const int ch = tid & 127, tq = tid >> 7;
    float w[16];
#pragma unroll
    for (int r = 0; r < 16; ++r) w[r] = W2[r * 512 + h * 128 + ch];
    const float bias = gb[h * 128 + ch];
    __syncthreads();
    float run = 0.f;
#pragma unroll
    for (int tt = 0; tt < 16; ++tt) {
        const int t = tq * 16 + tt;
        float s = bias;
#pragma unroll
        for (int r4 = 0; r4 < 4; ++r4) {
            const f32x4 gv = *(const f32x4*)(glr + t * 16 + r4 * 4);
            s += gv[0] * w[r4 * 4] + gv[1] * w[r4 * 4 + 1] + gv[2] * w[r4 * 4 + 2] + gv[3] * w[r4 * 4 + 3];
        }
        run += logsigmoid_(s) * (1.0f / 16.0f);
        b[tt] = run;
    }
    tot[tq * 128 + ch] = run;
    __syncthreads();
    float pre = 0.f;
#pragma unroll
    for (int k = 0; k < 4; ++k) { const float v = tot[k * 128 + ch]; if (k < tq) pre += v; }
    blast = tot[ch] + tot[128 + ch] + tot[256 + ch] + tot[384 + ch];
#pragma unroll
    for (int tt = 0; tt < 16; ++tt) b[tt] += pre;
}
DEVI void gla_stage_vT(const u16* PROJ, int t0, int vcol0, char* img, int tid) {
    if (tid < 256) {
        const int tb = tid >> 5, jb = tid & 31;
        unsigned R[8][4];
#pragma unroll
        for (int tt = 0; tt < 8; ++tt) {
            const uint4 v = *(const uint4*)(PROJ + (size_t)(t0 + tb * 8 + tt) * PJ + vcol0 + jb * 8);
            R[tt][0] = v.x; R[tt][1] = v.y; R[tt][2] = v.z; R[tt][3] = v.w;
        }
#pragma unroll
        for (int jj = 0; jj < 8; ++jj) {
            unsigned o[4];
#pragma unroll
            for (int d = 0; d < 4; ++d) {
                const unsigned lo = R[2 * d][jj >> 1], hi = R[2 * d + 1][jj >> 1];
                o[d] = (jj & 1) ? ((lo >> 16) | (hi & 0xffff0000u)) : ((lo & 0xffffu) | (hi << 16));
            }
            *(uint4*)(img + lds_byte<2>(jb * 8 + jj, tb * 8)) = make_uint4(o[0], o[1], o[2], o[3]);
        }
    }
}

constexpr int USTR = 2048 + 16;
DEVI void s5_fill_U(const u16* PROJ, int g, int cb, char* U, int tid) {
    for (int k = 0; k < 4; ++k) {
        const int idx = tid + 512 * k, c = idx >> 6, s = idx & 63;
        const uint4* src = (const uint4*)(PROJ + (size_t)((cb * 32 + c) * 64 + s) * PJ + 3072 + g * 16);
        uint4* dst = (uint4*)(U + c * USTR + s * 32);
        dst[0] = src[0]; dst[1] = src[1];
    }
}
DEVI void phase2(const Args& a, char* lds, int tid, int wid, int lane) {
    const u16* PROJ = (const u16*)(a.ws + WS_PROJ);
#pragma unroll 1
    for (int u = blockIdx.x; u < 768; u += gridDim.x) {
        { int lq = lane; asm volatile("" : "+v"(lq)); lane = lq; tid = wid * 64 + lq; }
        const int fr = lane & 15, fq = lane >> 4;
        __syncthreads();
        if (u < 256) {
            const int g = u >> 2, cb = u & 3;
            s5_fill_U(PROJ, g, cb, lds, tid);
            __syncthreads();
            const u16* WE = (const u16*)(a.ws + WS_S5WE) + (size_t)(g * 128 + wid * 16 + fr) * 1024 + fq * 8;
            f32x4 acc0 = {0.f, 0.f, 0.f, 0.f}, acc1 = {0.f, 0.f, 0.f, 0.f};
#pragma unroll 8
            for (int ks = 0; ks < 32; ++ks) {
                const bf16x8 bf = *(const bf16x8*)(WE + ks * 32);
                const bf16x8 a0 = *(const bf16x8*)(lds + fr * USTR + (ks * 32 + fq * 8) * 2);
                const bf16x8 a1 = *(const bf16x8*)(lds + (16 + fr) * USTR + (ks * 32 + fq * 8) * 2);
                acc0 = __builtin_amdgcn_mfma_f32_16x16x32_bf16(a0, bf, acc0, 0, 0, 0);
                acc1 = __builtin_amdgcn_mfma_f32_16x16x32_bf16(a1, bf, acc1, 0, 0, 0);
            }
            float* E = (float*)(a.ws + WS_S5E);
#pragma unroll
            for (int j = 0; j < 4; ++j) {
                E[(size_t)(g * 128 + cb * 32 + fq * 4 + j) * 128 + wid * 16 + fr] = acc0[j];
                E[(size_t)(g * 128 + cb * 32 + 16 + fq * 4 + j) * 128 + wid * 16 + fr] = acc1[j];
            }
        } else {
            const int uu = u - 256, n = uu >> 2, h = uu & 3, t0 = n * 64;
            char* vT = lds;
            char* kT = lds + 32768;
            float* glr = (float*)(lds + 49152);
            float* tot = glr + 1024;
            float b[16], blast;
            gla_gate(a, n, h, tid, glr, tot, b, blast);
            const int ch = tid & 127, tq = tid >> 7;
            {
                unsigned pk[8];
#pragma unroll
                for (int tt = 0; tt < 16; tt += 2) {
                    const float k0 = bf2f(PROJ[(size_t)(t0 + tq * 16 + tt) * PJ + 512 + h * 128 + ch]);
                    const float k1 = bf2f(PROJ[(size_t)(t0 + tq * 16 + tt + 1) * PJ + 512 + h * 128 + ch]);
                    pk[tt >> 1] = pack2(k0 * __expf(blast - b[tt]), k1 * __expf(blast - b[tt + 1]));
                }
                *(uint4*)(kT + lds_byte<2>(ch, tq * 16)) = make_uint4(pk[0], pk[1], pk[2], pk[3]);
                *(uint4*)(kT + lds_byte<2>(ch, tq * 16 + 8)) = make_uint4(pk[4], pk[5], pk[6], pk[7]);
                if (tq == 3) ((float*)(a.ws + WS_DEC))[(size_t)(n * 4 + h) * 128 + ch] = __expf(blast);
            }
            gla_stage_vT(PROJ, t0, 1024 + h * 256, vT, tid);
            __syncthreads();
            const int wr = wid >> 1, wc = wid & 1;
            f32x4 acc[4][4];
#pragma unroll
            for (int m = 0; m < 4; ++m)
#pragma unroll
                for (int nn = 0; nn < 4; ++nn) acc[m][nn] = f32x4{0.f, 0.f, 0.f, 0.f};
#pragma unroll
            for (int ks = 0; ks < 2; ++ks) {
                bf16x8 Af[4], Bf[4];
#pragma unroll
                for (int m = 0; m < 4; ++m) Af[m] = *(const bf16x8*)(vT + lds_byte<2>(wr * 64 + m * 16 + fr, ks * 32 + fq * 8));
#pragma unroll
                for (int nn = 0; nn < 4; ++nn) Bf[nn] = *(const bf16x8*)(kT + lds_byte<2>(wc * 64 + nn * 16 + fr, ks * 32 + fq * 8));
#pragma unroll
                for (int m = 0; m < 4; ++m)
#pragma unroll
                    for (int nn = 0; nn < 4; ++nn) acc[m][nn] = __builtin_amdgcn_mfma_f32_16x16x32_bf16(Af[m], Bf[nn], acc[m][nn], 0, 0, 0);
            }
            float* KV = (float*)(a.ws + WS_KV) + (size_t)(n * 4 + h) * (HV * HK);
#pragma unroll
            for (int m = 0; m < 4; ++m)
#pragma unroll
                for (int nn = 0; nn < 4; ++nn)
#pragma unroll
                    for (int j = 0; j < 4; ++j)
                        KV[(size_t)(wr * 64 + m * 16 + fq * 4 + j) * 128 + wc * 64 + nn * 16 + fr] = acc[m][nn][j];
        }
    }
}

DEVI void phase3(const Args& a, int tid) {
    const float* KV = (const float*)(a.ws + WS_KV); u16* ST = (u16*)(a.ws + WS_ST); const float* DEC = (const float*)(a.ws + WS_DEC);
    for (int e = blockIdx.x * 512 + tid; e < NH * HV * HK; e += gridDim.x * 512) {
        const int h = e >> 15, rem = e & 32767, i = e & 127;
        float S = 0.f;
#pragma unroll 1
        for (int n0 = 0; n0 < NCH; n0 += 16) {
            float kv[16], dc[16];
#pragma unroll
            for (int k = 0; k < 16; ++k) { kv[k] = KV[(size_t)((n0 + k) * 4 + h) * 32768 + rem]; dc[k] = DEC[(size_t)((n0 + k) * 4 + h) * 128 + i]; }
#pragma unroll
            for (int k = 0; k < 16; ++k) { ST[(size_t)((n0 + k) * 4 + h) * 32768 + rem] = f2bf(S); S = dc[k] * S + kv[k]; }
        }
    }
    const float* E = (const float*)(a.ws + WS_S5E); const float* AL = (const float*)(a.ws + WS_S5AL); unsigned* HP = (unsigned*)(a.ws + WS_S5H);
    for (int e = blockIdx.x * 512 + tid; e < NG * SP; e += gridDim.x * 512) {
        const int g = e >> 6, p = e & 63;
        const float ar = AL[e * 2], ai = AL[e * 2 + 1];
        float hr = 0.f, hi = 0.f;
#pragma unroll 1
        for (int c0 = 0; c0 < 128; c0 += 16) {
            float2 ev[16];
#pragma unroll
            for (int k = 0; k < 16; ++k) ev[k] = *(const float2*)(E + (size_t)(g * 128 + c0 + k) * 128 + 2 * p);
#pragma unroll
            for (int k = 0; k < 16; ++k) {
                HP[(size_t)(g * 128 + c0 + k) * 64 + p] = pack2(hr, hi);
                const float nr = ar * hr - ai * hi + ev[k].x, ni = ar * hi + ai * hr + ev[k].y;
                hr = nr; hi = ni;
            }
        }
    }
}

DEVI void phase4(const Args& a, char* lds, int tid, int wid, int lane) {
    const u16* PROJ = (const u16*)(a.ws + WS_PROJ);
    u16* MIX = (u16*)(a.ws + WS_MIX);
#pragma unroll 1
    for (int u = blockIdx.x; u < 768; u += gridDim.x) {
        { int lq = lane; asm volatile("" : "+v"(lq)); lane = lq; tid = wid * 64 + lq; }
        const int fr = lane & 15, fq = lane >> 4;
        __syncthreads();
        if (u < 256) {
            const int g = u >> 2, cb = u & 3;
            char* U = lds; char* KTl = lds + 32 * USTR;
            s5_fill_U(PROJ, g, cb, U, tid);
            {
                const uint4* src = (const uint4*)((const u16*)(a.ws + WS_S5K) + (size_t)g * 16384);
                uint4* dst = (uint4*)KTl;
                for (int k = 0; k < 4; ++k) dst[tid + 512 * k] = src[tid + 512 * k];
            }
            __syncthreads();
            f32x4 acc[8][2];
#pragma unroll
            for (int tt = 0; tt < 8; ++tt) { acc[tt][0] = f32x4{0.f, 0.f, 0.f, 0.f}; acc[tt][1] = f32x4{0.f, 0.f, 0.f, 0.f}; }
            const int sl = fq >> 1, m0 = (fq & 1) * 8;
            const char* kbase = KTl + ((wid - sl) * 256 + fr * 16 + m0) * 2;
#pragma unroll 1
            for (int j = 0; j < 32; ++j) {
                const bf16x8 a0 = *(const bf16x8*)(U + fr * USTR + (j * 32 + fq * 8) * 2);
                const bf16x8 a1 = *(const bf16x8*)(U + (16 + fr) * USTR + (j * 32 + fq * 8) * 2);
                const char* kb = kbase - j * 1024;
#pragma unroll
                for (int tt = 0; tt < 8; ++tt) {
                    const int t = wid + 8 * tt;
                    if (t >= 2 * j) {
                        bf16x8 bf = *(const bf16x8*)(kb + tt * 4096);
                        if (t == 2 * j && sl == 1) bf = bf16x8{0, 0, 0, 0, 0, 0, 0, 0};
                        acc[tt][0] = __builtin_amdgcn_mfma_f32_16x16x32_bf16(a0, bf, acc[tt][0], 0, 0, 0);
                        acc[tt][1] = __builtin_amdgcn_mfma_f32_16x16x32_bf16(a1, bf, acc[tt][1], 0, 0, 0);
                    }
                }
            }
            const u16* HP = (const u16*)(a.ws + WS_S5H); const u16* VV = (const u16*)(a.ws + WS_S5V);
#pragma unroll 1
            for (int kp = 0; kp < 2; ++kp) {
                bf16x8 a0[2], a1[2], bfv[2][8];
#pragma unroll
                for (int k2 = 0; k2 < 2; ++k2) {
                    const int ks = kp * 2 + k2;
                    a0[k2] = *(const bf16x8*)(HP + (size_t)(g * 128 + cb * 32 + fr) * 128 + ks * 32 + fq * 8);
                    a1[k2] = *(const bf16x8*)(HP + (size_t)(g * 128 + cb * 32 + 16 + fr) * 128 + ks * 32 + fq * 8);
#pragma unroll
                    for (int tt = 0; tt < 8; ++tt)
                        bfv[k2][tt] = *(const bf16x8*)(VV + (size_t)(g * 1024 + (wid + 8 * tt) * 16 + fr) * 128 + ks * 32 + fq * 8);
                }
#pragma unroll
                for (int k2 = 0; k2 < 2; ++k2)
#pragma unroll
                    for (int tt = 0; tt < 8; ++tt) {
                        acc[tt][0] = __builtin_amdgcn_mfma_f32_16x16x32_bf16(a0[k2], bfv[k2][tt], acc[tt][0], 0, 0, 0);
                        acc[tt][1] = __builtin_amdgcn_mfma_f32_16x16x32_bf16(a1[k2], bfv[k2][tt], acc[tt][1], 0, 0, 0);
                    }
            }
            const float dsk = a.in[12][g * 16 + fr];
            u16* Z = (u16*)(a.ws + WS_Z);
#pragma unroll
            for (int tt = 0; tt < 8; ++tt) {
                const int t = wid + 8 * tt;
#pragma unroll
                for (int mf = 0; mf < 2; ++mf)
#pragma unroll
                    for (int j = 0; j < 4; ++j) {
                        const int cl = mf * 16 + fq * 4 + j;
                        const float uv = bf2f(*(const u16*)(U + cl * USTR + (t * 16 + fr) * 2));
                        const float y = acc[tt][mf][j] + dsk * uv;
                        Z[(size_t)((cb * 32 + cl) * 64 + t) * SW + g * 16 + fr] = f2bf(gelu_tanh(y));
                    }
            }
        } else {
            const int uu = u - 256, n = uu >> 2, h = uu & 3, t0 = n * 64;
            char* vT = lds;
            char* qI = lds + 32768;
            char* kI = lds + 49152;
            char* pI = lds + 65536;
            float* glr = (float*)(lds + 73728);
            float* tot = glr + 1024;
            float* rss = tot + 512;
            char* sT = lds + 81920;
            {
                const u16* STg = (const u16*)(a.ws + WS_ST) + (size_t)(n * 4 + h) * (HV * HK);
#pragma unroll
                for (int p = 0; p < 8; ++p) {
                    const int row = p * 32 + wid * 4 + (lane >> 4), chunk = ((lane & 15) ^ row) & 15;
                    __builtin_amdgcn_global_load_lds((const unsigned*)(STg + (size_t)row * 128 + chunk * 8), (LAS unsigned*)(sT + p * 8192 + wid * 1024), 16, 0, 0);
                }
            }
            float b[16], blast;
            gla_gate(a, n, h, tid, glr, tot, b, blast);
            const int ch = tid & 127, tq = tid >> 7;
            {
                const int qb0 = (tq * 4 + (ch >> 5)) * 1024 + (ch & 31) * 2, qb1 = qb0 ^ 32;
                const u16* src = PROJ + (size_t)(t0 + tq * 16) * PJ + h * 128 + ch;
#pragma unroll
                for (int tt = 0; tt < 16; ++tt) {
                    const float qv = bf2f(src[(size_t)tt * PJ]);
                    const float kv = bf2f(src[(size_t)tt * PJ + 512]);
                    const int off = (tt < 8 ? qb0 : qb1) + tt * 64;
                    *(u16*)(qI + off) = f2bf(qv * __expf(b[tt]));
                    *(u16*)(kI + off) = f2bf(kv * __expf(-b[tt]));
                }
            }
            gla_stage_vT(PROJ, t0, 1024 + h * 256, vT, tid);
            __syncthreads();
            {
                const int mf = wid & 3, nb = (wid >> 2) * 2;
                f32x4 s0 = {0.f, 0.f, 0.f, 0.f}, s1 = {0.f, 0.f, 0.f, 0.f};
#pragma unroll
                for (int ks = 0; ks < 4; ++ks) {
                    const bf16x8 af = *(const bf16x8*)(qI + lds_byte<4>(mf * 16 + fr, ks * 32 + fq * 8));
                    const bf16x8 b0 = *(const bf16x8*)(kI + lds_byte<4>(nb * 16 + fr, ks * 32 + fq * 8));
                    const bf16x8 b1 = *(const bf16x8*)(kI + lds_byte<4>((nb + 1) * 16 + fr, ks * 32 + fq * 8));
                    s0 = __builtin_amdgcn_mfma_f32_16x16x32_bf16(af, b0, s0, 0, 0, 0);
                    s1 = __builtin_amdgcn_mfma_f32_16x16x32_bf16(af, b1, s1, 0, 0, 0);
                }
#pragma unroll
                for (int j = 0; j < 4; ++j) {
                    const int t = mf * 16 + fq * 4 + j, sA = nb * 16 + fr, sB = sA + 16;
                    *(u16*)(pI + lds_byte<2>(t, sA)) = f2bf(sA <= t ? s0[j] : 0.f);
                    *(u16*)(pI + lds_byte<2>(t, sB)) = f2bf(sB <= t ? s1[j] : 0.f);
                }
            }
            __syncthreads();
            const int mf = wid & 3, nh = wid >> 2;
            f32x4 acc[8];
#pragma unroll
            for (int nn = 0; nn < 8; ++nn) acc[nn] = f32x4{0.f, 0.f, 0.f, 0.f};
#pragma unroll
            for (int ks = 0; ks < 2; ++ks) {
                const bf16x8 af = *(const bf16x8*)(pI + lds_byte<2>(mf * 16 + fr, ks * 32 + fq * 8));
#pragma unroll
                for (int nn = 0; nn < 8; ++nn) {
                    const bf16x8 bf = *(const bf16x8*)(vT + lds_byte<2>(nh * 128 + nn * 16 + fr, ks * 32 + fq * 8));
                    acc[nn] = __builtin_amdgcn_mfma_f32_16x16x32_bf16(af, bf, acc[nn], 0, 0, 0);
                }
            }
#pragma unroll
            for (int ks = 0; ks < 4; ++ks) {
                const bf16x8 af = *(const bf16x8*)(qI + lds_byte<4>(mf * 16 + fr, ks * 32 + fq * 8));
#pragma unroll
                for (int nn = 0; nn < 8; ++nn) {
                    const bf16x8 bf = *(const bf16x8*)(sT + (nh * 128 + nn * 16 + fr) * 256 + ((((ks * 4 + fq) ^ fr) & 15) << 4));
                    acc[nn] = __builtin_amdgcn_mfma_f32_16x16x32_bf16(af, bf, acc[nn], 0, 0, 0);
                }
            }
            u16 rraw[4][8];
#pragma unroll
            for (int j = 0; j < 4; ++j)
#pragma unroll
                for (int nn = 0; nn < 8; ++nn) rraw[j][nn] = PROJ[(size_t)(t0 + mf * 16 + fq * 4 + j) * PJ + 2048 + h * 256 + nh * 128 + nn * 16 + fr];
            float ss[4];
#pragma unroll
            for (int j = 0; j < 4; ++j) {
                float s = 0.f;
#pragma unroll
                for (int nn = 0; nn < 8; ++nn) s += acc[nn][j] * acc[nn][j];
                ss[j] = sum16(s);
            }
            if (fr == 0) {
#pragma unroll
                for (int j = 0; j < 4; ++j) rss[nh * 64 + mf * 16 + fq * 4 + j] = ss[j];
            }
            __syncthreads();
            const float* gn = a.in[5];
#pragma unroll
            for (int j = 0; j < 4; ++j) {
                const int t = mf * 16 + fq * 4 + j;
                const float rstd = rsqrtf((rss[t] + rss[64 + t]) * (1.0f / 256.0f) + EPS);
#pragma unroll
                for (int nn = 0; nn < 8; ++nn) {
                    const int jc = nh * 128 + nn * 16 + fr;
                    const float rv = bf2f(rraw[j][nn]);
                    const float o = acc[nn][j] * rstd * gn[jc] * (rv * sigmoidf_(rv));
                    MIX[(size_t)(t0 + t) * D + h * 256 + jc] = f2bf(o);
                }
            }
        }
    }
}

DEVI void phase5(const Args& a, char* lds, int tid, int wid, int lane) {
    extern __shared__ __attribute__((aligned(16))) char smem_pg8[];
    if (blockIdx.x >= 128) {
        const int c_lo = 8192 + (blockIdx.x - 128) * 22;
        convert_range(a, lds, c_lo, c_lo + 22, tid, wid, lane);
    } else {
        pg8::Gemm g; g.A = a.ws + WS_Z; g.Bt = a.ws + WS_GLUT; g.ld = SW; g.K = SW;
        pg8::StaticOrder S; S.init(T, SW, 128, (int)blockIdx.x);
        EpiGlu E; E.Z = (const u16*)(a.ws + WS_Z); E.MIX = (u16*)(a.ws + WS_MIX); E.SSQ = (float*)(a.ws + WS_SSQ); E.gbias = a.in[15]; E.sng = a.in[16];
        pg8::gemm_phase((PG8_LAS unsigned char*)(smem_pg8 + 1024), g, S, E);
        const int c_lo = 11008 + blockIdx.x * 6; convert_range(a, lds, c_lo, c_lo + 6, tid, wid, lane);
    }
    convert_pool(a, lds, 1, 11776, 13312, tid, wid, lane);
}

DEVI void phase6(const Args& a, char* lds, int tid, int wid, int lane) {
    extern __shared__ __attribute__((aligned(16))) char smem_pg8[];
    const int c6_lo = 13312 + blockIdx.x * 8, c6_hi = c6_lo + 8;
    if ((blockIdx.x >> 3) & 1) convert_range(a, lds, c6_lo, c6_hi, tid, wid, lane);
    if (blockIdx.x < 256) {
        pg8::Gemm g; g.A = a.ws + WS_MIX; g.Bt = a.ws + WS_WOUTT; g.ld = D; g.K = 1024;
        pg8::SplitKOrder S; S.init(T, D, 256, (int)blockIdx.x); S.khalf = 2048;
        EpiOut E; E.x = a.in[0]; E.H1 = (float*)(a.ws + WS_H1); E.SSQ = (const float*)(a.ws + WS_SSQ);
        pg8::gemm_phase((PG8_LAS unsigned char*)(smem_pg8 + 1024), g, S, E);
    }
    if (!((blockIdx.x >> 3) & 1)) convert_range(a, lds, c6_lo, c6_hi, tid, wid, lane);
    convert_pool(a, lds, 2, 15360, 16384, tid, wid, lane);
}

DEVI void phase7(const Args& a, char* lds, int tid, int wid, int lane) {
    const float* H1 = (const float*)(a.ws + WS_H1); unsigned char* HN8 = a.ws + WS_HN2;
    const float* g2 = a.in[18]; const float* rw = a.in[19]; const float* rb = a.in[20];
    int* CNT = (int*)(a.ws + WS_CNT); int* LTOK = (int*)(a.ws + WS_LTOK); float* LGATE = (float*)(a.ws + WS_LGATE); int* TSLOT = (int*)(a.ws + WS_TSLOT);
    float* hn = (float*)lds;
    float* red = hn + 8 * 2048;
    float* lg = red + 8 * 8 * 32;
    for (int u = blockIdx.x; u < 256; u += gridDim.x) {
#pragma unroll 1
        for (int ps = 0; ps < 4; ++ps) {
            const int tok0 = u * 32 + ps * 8;
            { int lq = lane; asm volatile("" : "+v"(lq)); lane = lq; tid = wid * 64 + lq; }
            __syncthreads();
            {
                const int tl = wid, tok = tok0 + tl;
                f32x4 xv[8]; float ss = 0.f;
#pragma unroll
                for (int i = 0; i < 8; ++i) { xv[i] = *(const f32x4*)(H1 + (size_t)tok * D + 256 * i + 4 * lane);
#pragma unroll
                    for (int c = 0; c < 4; ++c) ss += xv[i][c] * xv[i][c]; }
                ss = wave_sum(ss);
                const float r = rsqrtf(ss * (1.0f / D) + EPS);
#pragma unroll
                for (int i = 0; i < 8; ++i) {
                    const f32x4 g = *(const f32x4*)(g2 + 256 * i + 4 * lane);
                    f32x4 o;
#pragma unroll
                    for (int c = 0; c < 4; ++c) o[c] = xv[i][c] * r * g[c];
                    *(f32x4*)(hn + tl * 2048 + 256 * i + 4 * lane) = o;
                    *(unsigned*)(HN8 + (size_t)tok * D + 256 * i + 4 * lane) = cvt4_fp8(o[0] * 16.f, o[1] * 16.f, o[2] * 16.f, o[3] * 16.f);
                }
            }
            __syncthreads();
            {
                const int e = tid & 31, dsl = tid >> 5;
                float acc[8];
#pragma unroll
                for (int k = 0; k < 8; ++k) acc[k] = 0.f;
#pragma unroll 1
                for (int d16 = 0; d16 < 8; ++d16) {
                    float w[16];
#pragma unroll
                    for (int q = 0; q < 16; ++q) w[q] = rw[(dsl * 128 + d16 * 16 + q) * 32 + e];
#pragma unroll
                    for (int q4 = 0; q4 < 4; ++q4) {
                        const int d = dsl * 128 + d16 * 16 + q4 * 4;
#pragma unroll
                        for (int k = 0; k < 8; ++k) {
                            const f32x4 hv = *(const f32x4*)(hn + k * 2048 + d);
                            acc[k] += hv[0] * w[q4 * 4] + hv[1] * w[q4 * 4 + 1] + hv[2] * w[q4 * 4 + 2] + hv[3] * w[q4 * 4 + 3];
                        }
                    }
                }
#pragma unroll
                for (int k = 0; k < 8; ++k) { acc[k] += __shfl_xor(acc[k], 32); }
                if (lane < 32) {
#pragma unroll
                    for (int k = 0; k < 8; ++k) red[(wid * 8 + k) * 32 + e] = acc[k];
                }
            }
            __syncthreads();
            if (tid < 256) {
                const int k = tid >> 5, e = tid & 31;
                float s = rb[e];
#pragma unroll
                for (int w = 0; w < 8; ++w) s += red[(w * 8 + k) * 32 + e];
                lg[k * 32 + e] = s;
            }
            __syncthreads();
            {
                const int tok = tok0 + wid, e = lane & 31;
                float x = lg[wid * 32 + e];
                float v[4]; int id[4];
#pragma unroll
                for (int j = 0; j < 4; ++j) {
                    float bv = x; int bi = e;
#pragma unroll
                    for (int o = 16; o >= 1; o >>= 1) {
                        const float ov = __shfl_xor(bv, o); const int oi = __shfl_xor(bi, o);
                        if (ov > bv || (ov == bv && oi < bi)) { bv = ov; bi = oi; }
                    }
                    v[j] = bv; id[j] = bi;
                    if (e == bi) x = -3.0e38f;
                }
                float ex[4], sum = 0.f;
#pragma unroll
                for (int j = 0; j < 4; ++j) { ex[j] = __expf(v[j] - v[0]); sum += ex[j]; }
                const float inv = 1.0f / sum;
                if (lane < 4) {
                    const int myid = lane == 0 ? id[0] : lane == 1 ? id[1] : lane == 2 ? id[2] : id[3];
                    const float myg = (lane == 0 ? ex[0] : lane == 1 ? ex[1] : lane == 2 ? ex[2] : ex[3]) * inv;
                    const int slot = atomicAdd(&CNT[myid], 1);
                    LTOK[myid * CAP + slot] = tok;
                    LGATE[myid * CAP + slot] = myg;
                    TSLOT[tok * 4 + lane] = myid * CAP + slot;
                }
            }
        }
    }
}

struct MoeTab { int cnt[32]; int off[33]; int ord[32]; int xe[4]; int xub[5]; };
DEVI void moe_tables(const Args& a, MoeTab* tb, int tid, int ntn) {
    __syncthreads();
    if (tid < 32) tb->cnt[tid] = ((const int*)(a.ws + WS_CNT))[tid];
    __syncthreads();
    if (tid < 32) {
        const int me = (tb->cnt[tid] + 255) >> 8;
        int rank = 0, o = 0;
        for (int k = 0; k < 32; ++k) {
            const int c = tb->cnt[k], mk = (c + 255) >> 8;
            rank += (mk > me || (mk == me && k < tid)) ? 1 : 0;
            o += (k < tid) ? c : 0;
        }
        tb->ord[rank] = tid; tb->off[tid] = o;
        if (tid == 31) tb->off[32] = o + tb->cnt[31];
    }
    __syncthreads();
    if (tid == 0) {
        const int xcd = blockIdx.x & 7;
        int ub = 0;
        for (int r = 0; r < 4; ++r) {
            const int e = tb->ord[r * 8 + ((r & 1) ? 7 - xcd : xcd)];
            tb->xe[r] = e; tb->xub[r] = ub;
            ub += ((tb->cnt[e] + 255) >> 8) * ntn;
        }
        tb->xub[4] = ub;
    }
    __syncthreads();
}

struct MoeUnit { int e, nt, r0, rows, grow0, cnt; };
DEVI MoeUnit moe_decode(const MoeTab* tb, int u) {
    int k = 0;
    for (int q = 1; q < 4; ++q) if (u >= tb->xub[q]) k = q;
    MoeUnit d; d.e = tb->xe[k];
    d.cnt = tb->cnt[d.e];
    const int mte = (d.cnt + 255) >> 8, ul = u - tb->xub[k];
    d.nt = ul / mte; const int mi = ul - d.nt * mte;
    d.r0 = mi * 256; d.rows = min(256, d.cnt - d.r0); d.grow0 = tb->off[d.e] + d.r0;
    return d;
}
DEVI void phase8(const Args& a, char* lds, MoeTab* tb, int tid, int wid, int lane) {
    const unsigned char* HN8 = a.ws + WS_HN2; unsigned char* ACT = a.ws + WS_ACT;
    const unsigned char* W1T = a.ws + WS_W1T;
    const int* LTOK = (const int*)(a.ws + WS_LTOK);
    const float* b1 = a.in[22];
    const int wr = wid >> 2, wc = wid & 3;
    moe_tables(a, tb, tid, 16);
    const int nun = tb->xub[4], nper = gridDim.x >> 3;
    int u = blockIdx.x >> 3;
    const int cpos = (blockIdx.x >> 3) % 3, c_lo = 16384 + blockIdx.x * 24, c_hi = c_lo + 24;
    if (u >= nun) { convert_range(a, lds, c_lo, c_hi, tid, wid, lane); convert_pool(a, lds, 3, 22528, 24576, tid, wid, lane); return; }
    if (cpos == 0) convert_range(a, lds, c_lo, c_hi, tid, wid, lane);
    int it = 0;
    MoeUnit d = moe_decode(tb, u);
    unsigned aoff[2], boffv[2];
    auto addrs = [&](const MoeUnit& q, const int (&tok)[2], unsigned (&ao)[2], unsigned (&bo)[2]) {
#pragma unroll
        for (int i = 0; i < 2; ++i) {
            int R, CB; f8_stage_rb(wid, lane, i, R, CB);
            ao[i] = (unsigned)tok[i] * D + CB;
            bo[i] = (unsigned)((q.e * 32 + i * 16 + q.nt) * 512) * 512u + (unsigned)(wid * 64 + lane) * 16u;
        }
    };
    auto toks = [&](const MoeUnit& q, int (&tok)[2]) {
#pragma unroll
        for (int i = 0; i < 2; ++i) { int R, CB; f8_stage_rb(wid, lane, i, R, CB); tok[i] = LTOK[q.e * CAP + min(q.r0 + R, q.cnt - 1)]; }
    };
    {
        int tok[2]; toks(d, tok); addrs(d, tok, aoff, boffv);
        q8_prefetch(lds, HN8, aoff, W1T, boffv, wid);
    }
    while (true) {
        const int un = u + nper;
        const bool has_next = un < nun;
        MoeUnit dn = d; int tokn[2] = {0, 0};
        if (has_next) { dn = moe_decode(tb, un); toks(dn, tokn); }
        f32x16 acc[2][4]; zero_acc32(acc);
        f8_mainloop<32, 0x7b7b7b7b, 0x77777777, true>(lds, HN8, aoff, W1T, boffv, wid, lane, acc);
        int lz = lane; asm volatile("" : "+v"(lz));
        const int l31 = lz & 31, hh = lz >> 5;
        const float* bb = b1 + (size_t)d.e * 4096 + d.nt * 128 + wc * 32 + 4 * hh;
        f32x4 bg[4], bl[4];
#pragma unroll
        for (int rq = 0; rq < 4; ++rq) { bg[rq] = *(const f32x4*)(bb + 8 * rq); bl[rq] = *(const f32x4*)(bb + 2048 + 8 * rq); }
#pragma unroll
        for (int rq = 0; rq < 4; ++rq) { touch4(bg[rq]); touch4(bl[rq]); }
        if (has_next) { addrs(dn, tokn, aoff, boffv); q8_prefetch(lds, HN8, aoff, W1T, boffv, wid); }
#pragma unroll
        for (int m = 0; m < 4; ++m) {
            const int row = wr * 128 + m * 32 + l31;
            const int orow = (row < d.rows) ? d.grow0 + row : T * 4 + row;
            unsigned char* dst = ACT + (size_t)orow * FF + d.nt * 128 + wc * 32 + 4 * hh;
#pragma unroll
            for (int rq = 0; rq < 4; ++rq) {
                float av[4];
#pragma unroll
                for (int i = 0; i < 4; ++i) {
                    const float gl = fminf(acc[0][m][rq * 4 + i] + bg[rq][i], 7.0f);
                    const float ln = fminf(fmaxf(acc[1][m][rq * 4 + i] + bl[rq][i], -7.0f), 7.0f);
                    av[i] = gl * sigmoidf_(1.702f * gl) * (ln + 1.0f) * 4.0f;
                }
                *(unsigned*)(dst + 8 * rq) = cvt4_fp8(av[0], av[1], av[2], av[3]);
            }
        }
        if (cpos == 1 && it == 3) convert_range(a, lds, c_lo, c_hi, tid, wid, lane);
        ++it;
        if (!has_next) break;
        u = un; d = dn;
    }
    if (cpos == 2 || (cpos == 1 && it <= 3)) convert_range(a, lds, c_lo, c_hi, tid, wid, lane);
    convert_pool(a, lds, 3, 22528, 24576, tid, wid, lane);
}

DEVI void phase9(const Args& a, char* lds, MoeTab* tb, int tid, int wid, int lane) {
    const unsigned char* ACT = a.ws + WS_ACT; u16* Y = (u16*)(a.ws + WS_Y);
    const unsigned char* W2T = a.ws + WS_W2T;
    const float* LGATE = (const float*)(a.ws + WS_LGATE);
    const float* b2 = a.in[24];
    const int wr = wid >> 2, wc = wid & 3;
    moe_tables(a, tb, tid, 8);
    const int nun = tb->xub[4], nper = gridDim.x >> 3;
    int u = blockIdx.x >> 3;
    if (u >= nun) return;
    MoeUnit d = moe_decode(tb, u);
    unsigned aoff[2], boffv[2];
    auto addrs = [&](const MoeUnit& q, unsigned (&ao)[2], unsigned (&bo)[2]) {
#pragma unroll
        for (int i = 0; i < 2; ++i) {
            int R, CB; f8_stage_rb(wid, lane, i, R, CB);
            ao[i] = (unsigned)(q.grow0 + R) * FF + CB;
            bo[i] = (unsigned)((q.e * 16 + q.nt * 2 + i) * 512) * 512u + (unsigned)(wid * 64 + lane) * 16u;
        }
    };
    addrs(d, aoff, boffv);
    q8_prefetch(lds, ACT, aoff, W2T, boffv, wid);
    while (true) {
        const int un = u + nper;
        const bool has_next = un < nun;
        MoeUnit dn = d;
        if (has_next) dn = moe_decode(tb, un);
        f32x16 acc[2][4]; zero_acc32(acc);
        f8_mainloop<32, 0x7d7d7d7d, 0x77777777, false>(lds, ACT, aoff, W2T, boffv, wid, lane, acc);
        int lz = lane; asm volatile("" : "+v"(lz));
        const int l31 = lz & 31, hh = lz >> 5;
        const float* bb = b2 + (size_t)d.e * D + d.nt * 256 + wc * 64 + 4 * hh;
        float gt[4];
#pragma unroll
        for (int m = 0; m < 4; ++m) { const int row = wr * 128 + m * 32 + l31; gt[m] = LGATE[d.e * CAP + d.r0 + min(row, d.rows - 1)]; }
        f32x4 bv[2][4];
#pragma unroll
        for (int n = 0; n < 2; ++n)
#pragma unroll
            for (int rq = 0; rq < 4; ++rq) bv[n][rq] = *(const f32x4*)(bb + n * 32 + 8 * rq);
#pragma unroll
        for (int m = 0; m < 4; ++m) touchf(gt[m]);
#pragma unroll
        for (int n = 0; n < 2; ++n)
#pragma unroll
            for (int rq = 0; rq < 4; ++rq) touch4(bv[n][rq]);
        if (has_next) { addrs(dn, aoff, boffv); q8_prefetch(lds, ACT, aoff, W2T, boffv, wid); }
#pragma unroll
        for (int m = 0; m < 4; ++m) {
            const int row = wr * 128 + m * 32 + l31;
            const int orow = (row < d.rows) ? d.grow0 + row : T * 4 + row;
            u16* dst = Y + (size_t)orow * D + d.nt * 256 + wc * 64 + 4 * hh;
#pragma unroll
            for (int n = 0; n < 2; ++n)
#pragma unroll
                for (int rq = 0; rq < 4; ++rq) {
                    uint2 pk;
                    pk.x = pack2((acc[n][m][rq * 4 + 0] + bv[n][rq][0]) * gt[m], (acc[n][m][rq * 4 + 1] + bv[n][rq][1]) * gt[m]);
                    pk.y = pack2((acc[n][m][rq * 4 + 2] + bv[n][rq][2]) * gt[m], (acc[n][m][rq * 4 + 3] + bv[n][rq][3]) * gt[m]);
                    *(uint2*)(dst + n * 32 + 8 * rq) = pk;
                }
        }
        if (!has_next) break;
        u = un; d = dn;
    }
}

DEVI void phase10(const Args& a, MoeTab* tb, int tid, int wid, int lane) {
    const float* H1 = (const float*)(a.ws + WS_H1); const u16* Y = (const u16*)(a.ws + WS_Y); const int* TSLOT = (const int*)(a.ws + WS_TSLOT);
    const float* fg = a.in[25];
    moe_tables(a, tb, tid, 8);
    for (int tok = blockIdx.x * 8 + wid; tok < T; tok += gridDim.x * 8) {
        int rowi[4];
#pragma unroll
        for (int j = 0; j < 4; ++j) { const int ts = TSLOT[tok * 4 + j]; rowi[j] = tb->off[ts >> 13] + (ts & (CAP - 1)); }
        f32x4 hv[8]; float ss = 0.f;
#pragma unroll
        for (int i = 0; i < 8; ++i) {
            hv[i] = *(const f32x4*)(H1 + (size_t)tok * D + 256 * i + 4 * lane);
#pragma unroll
            for (int j = 0; j < 4; ++j) {
                const uint2 yv = *(const uint2*)(Y + (size_t)rowi[j] * D + 256 * i + 4 * lane);
                hv[i][0] += bflo(yv.x); hv[i][1] += bfhi(yv.x); hv[i][2] += bflo(yv.y); hv[i][3] += bfhi(yv.y);
            }
#pragma unroll
            for (int c = 0; c < 4; ++c) ss += hv[i][c] * hv[i][c];
        }
        ss = wave_sum(ss);
        const float r = rsqrtf(ss * (1.0f / D) + EPS);
#pragma unroll
        for (int i = 0; i < 8; ++i) {
            const f32x4 g = *(const f32x4*)(fg + 256 * i + 4 * lane);
            f32x4 o;
#pragma unroll
            for (int c = 0; c < 4; ++c) o[c] = hv[i][c] * r * g[c];
            *(f32x4*)(a.out + (size_t)tok * D + 256 * i + 4 * lane) = o;
        }
    }
}

constexpr int NPHASE = 11;
__global__ void __launch_bounds__(512, 2) mega_fwd(Args a) {
    extern __shared__ __attribute__((aligned(1024))) char smem[];
    const int wid_s = __builtin_amdgcn_readfirstlane((int)threadIdx.x >> 6);
    if (threadIdx.x == 0) *(uint4*)smem = make_uint4(0u, 0u, 0u, 0u);
    __syncthreads();
    XcdBarrier bar = xcd_barrier_post((unsigned*)(a.ws + WS_BAR), (volatile LAS unsigned*)smem);
    char* lds = smem + LDS_BASE;
    MoeTab* tb = (MoeTab*)(smem + 64);
#ifndef REP_MASK
#define REP_MASK 0
#endif
#define PHASE(k, call) if (a.ph_lo <= (k) && (k) < a.ph_hi) { if (a.ph_lo < (k)) xcd_barrier(bar); \
        int lane = (int)__builtin_amdgcn_mbcnt_hi(~0u, __builtin_amdgcn_mbcnt_lo(~0u, 0u)); asm volatile("" : "+v"(lane)); \
        const int wid = wid_s, tid = wid_s * 64 + lane; \
        call; if ((REP_MASK >> (k)) & 1) { __syncthreads(); call; } }
    PHASE(0, phase0(a, lds, tid, wid, lane))
    PHASE(1, phase1(a, lds, tid, wid, lane))
    PHASE(2, phase2(a, lds, tid, wid, lane))
    PHASE(3, phase3(a, tid))
    PHASE(4, phase4(a, lds, tid, wid, lane))
    PHASE(5, phase5(a, lds, tid, wid, lane))
    PHASE(6, phase6(a, lds, tid, wid, lane))
    PHASE(7, phase7(a, lds, tid, wid, lane))
    PHASE(8, phase8(a, lds, tb, tid, wid, lane))
    PHASE(9, phase9(a, lds, tb, tid, wid, lane))
    PHASE(10, phase10(a, tb, tid, wid, lane))
#undef PHASE
}

extern "C" void kernel_launch(void* const* d_in, const int* in_sizes, int n_in, void* d_out, int out_size, void* d_ws, size_t ws_size, hipStream_t stream) {
    static int grid = 0;
    if (grid == 0) {
        if (n_in != 26 || out_size != T * D || ws_size < WS_END) { fprintf(stderr, "kernel_launch: unexpected shapes (n_in %d out %d ws %zu need %zu)\n", n_in, out_size, ws_size, (size_t)WS_END); grid = -1; return; }
        int dev = 0, cus = 0, per_cu = 0;
        if (hipGetDevice(&dev) != hipSuccess || hipDeviceGetAttribute(&cus, hipDeviceAttributeMultiprocessorCount, dev) != hipSuccess) { grid = -1; return; }
        if (hipFuncSetAttribute((const void*)mega_fwd, hipFuncAttributeMaxDynamicSharedMemorySize, LDS_BYTES) != hipSuccess) { fprintf(stderr, "kernel_launch: hipFuncSetAttribute failed\n"); grid = -1; return; }
        if (hipOccupancyMaxActiveBlocksPerMultiprocessor(&per_cu, (const void*)mega_fwd, 512, LDS_BYTES) != hipSuccess || per_cu < 1)
            fprintf(stderr, "kernel_launch: occupancy query reports %d blocks per CU\n", per_cu);
        (void)hipGetLastError();
        grid = cus;
    }
    if (grid < 0) return;
    Args a{};
    for (int i = 0; i < 26; ++i) a.in[i] = (const float*)d_in[i];
    a.out = (float*)d_out; a.ws = (unsigned char*)d_ws;
#if N_LAUNCH_SPLIT
    for (int k = 0; k < NPHASE; ++k) {
        (void)hipMemsetAsync((char*)d_ws + WS_BAR, 0, XCD_BAR_WORDS * sizeof(unsigned), stream);
        a.ph_lo = k; a.ph_hi = k + 1;
        hipLaunchKernelGGL(mega_fwd, dim3(grid), dim3(512), LDS_BYTES, stream, a);
    }
#else
    (void)hipMemsetAsync((char*)d_ws + WS_BAR, 0, XCD_BAR_WORDS * sizeof(unsigned), stream);
    a.ph_lo = 0; a.ph_hi = NPHASE;
    hipLaunchKernelGGL(mega_fwd, dim3(grid), dim3(512), LDS_BYTES, stream, a);
#endif
}
```

```cpp
#include <hip/hip_runtime.h>
#include <hip/hip_bf16.h>
#include <stdint.h>
#include <stdio.h>

#ifndef N_LAUNCH_SPLIT
#define N_LAUNCH_SPLIT 0
#endif

#define DEVI __device__ __forceinline__
typedef __attribute__((ext_vector_type(8))) short bf16x8;
typedef __attribute__((ext_vector_type(4))) float f32x4;
typedef __attribute__((ext_vector_type(4))) int i32x4;
typedef __attribute__((ext_vector_type(2))) float f2v;
typedef __attribute__((ext_vector_type(2))) __bf16 b2v;
typedef unsigned short u16;

constexpr int T = 8192, D = 2048, PW = 4112;
constexpr int NH = 4, HK = 128, HV = 256, CH = 64, NCH = 128, RANK = 16;
constexpr int SW = 1024, SG = 16, NG = 64, SP = 64;
constexpr int NE = 32, FF = 2048, CAP = 8192;
constexpr int PJ = 4096;
constexpr float EPS = 1e-6f;

constexpr size_t WS_BAR   = 0;
constexpr size_t WS_CNT   = 32768;
constexpr size_t WS_SSQ   = 65536;
constexpr size_t WS_GLR   = WS_SSQ + 65536;
constexpr size_t WS_DEC   = WS_GLR + (size_t)T * 16 * 4;
constexpr size_t WS_S5AL  = WS_DEC + (size_t)NCH * NH * HK * 4;
constexpr size_t WS_TSLOT = WS_S5AL + 65536;
constexpr size_t WS_LTOK  = WS_TSLOT + (size_t)T * 4 * 4;
constexpr size_t WS_LGATE = WS_LTOK + (size_t)NE * CAP * 4;
constexpr size_t WS_S5K   = WS_LGATE + (size_t)NE * CAP * 4;
constexpr size_t WS_S5WE  = WS_S5K + (size_t)NG * 64 * 256 * 2;
constexpr size_t WS_S5V   = WS_S5WE + (size_t)NG * 128 * 1024 * 2;
constexpr size_t WS_S5E   = WS_S5V + (size_t)NG * 1024 * 128 * 2;
constexpr size_t WS_S5H   = WS_S5E + (size_t)NG * 128 * 128 * 4;
constexpr size_t WS_HN    = WS_S5H + (size_t)NG * 128 * 128 * 2;
constexpr size_t WS_PROJ  = WS_HN + (size_t)T * D * 2;
constexpr size_t WS_KV    = WS_PROJ + (size_t)T * PJ * 2;
constexpr size_t WS_ST    = WS_KV + (size_t)NCH * NH * HV * HK * 4;
constexpr size_t WS_Z     = WS_ST + (size_t)NCH * NH * HV * HK * 2;
constexpr size_t WS_MIX   = WS_Z + (size_t)T * SW * 2;
constexpr size_t WS_H1    = WS_MIX + (size_t)T * D * 2;
constexpr size_t WS_HN2   = WS_H1 + (size_t)T * D * 4;
constexpr size_t WS_ACT   = WS_HN2 + (size_t)T * D * 2;
constexpr size_t WS_Y     = WS_ACT + (size_t)(T * 4 + 256) * FF * 2;
constexpr size_t WS_W1T   = WS_Y + (size_t)(T * 4 + 256) * D * 2;
constexpr size_t WS_W2T   = WS_W1T + (size_t)NE * 4096 * D;
constexpr size_t WS_WINT  = WS_W2T + (size_t)NE * D * FF;
constexpr size_t WS_GLUT  = WS_WINT + (size_t)PJ * D * 2;
constexpr size_t WS_WOUTT = WS_GLUT + (size_t)SW * SW * 2;
constexpr size_t WS_XG    = WS_WOUTT + (size_t)D * D * 2;
constexpr size_t WS_END   = WS_XG + (size_t)NE * 8192 * D;

constexpr int LDS_BYTES = 163840;
constexpr int LDS_CONV = 131072;
constexpr int LDS_BASE = 1024;

DEVI unsigned pack2(float a, float b) { f2v v = {a, b}; b2v r = __builtin_convertvector(v, b2v); return __builtin_bit_cast(unsigned, r); }
DEVI u16 f2bf(float a) { __bf16 r = (__bf16)a; return __builtin_bit_cast(u16, r); }
DEVI float bf2f(u16 h) { return __uint_as_float(((unsigned)h) << 16); }
DEVI float bflo(unsigned w) { return __uint_as_float(w << 16); }
DEVI float bfhi(unsigned w) { return __uint_as_float(w & 0xffff0000u); }
DEVI float wave_sum(float v) {
#pragma unroll
    for (int o = 32; o >= 1; o >>= 1) v += __shfl_xor(v, o);
    return v;
}
DEVI float sum16(float v) {
#pragma unroll
    for (int o = 8; o >= 1; o >>= 1) v += __shfl_xor(v, o);
    return v;
}
DEVI float sigmoidf_(float x) { return __builtin_amdgcn_rcpf(1.0f + __expf(-x)); }
DEVI float logsigmoid_(float x) { return fminf(x, 0.0f) - __logf(1.0f + __expf(-fabsf(x))); }
DEVI float gelu_tanh(float x) {
    const float a = 0.7978845608028654f * (x + 0.044715f * x * x * x);
    return x * __builtin_amdgcn_rcpf(1.0f + __expf(-2.0f * a));
}

#define WAIT_V0() asm volatile("s_waitcnt vmcnt(0)" ::: "memory")
#define WAIT_L0() asm volatile("s_waitcnt lgkmcnt(0)" ::: "memory")

#define XB_TMO      128
#define XB_XCNT(j)  (256  + 64 * (j))
#define XB_XSUB(j)  (1280 + 64 * (j))
#define XB_XGEN(j)  (2304 + 64 * (j))
#define XB_TOP      3328
#define XB_TOPGEN   3392
#define XCD_BAR_WORDS 3456
#define XB_SPIN_CAP (1u << 20)
#define LAS __attribute__((address_space(3)))

DEVI unsigned xb_ld(unsigned* p)              { return __hip_atomic_load(p, __ATOMIC_RELAXED, __HIP_MEMORY_SCOPE_AGENT); }
DEVI unsigned xb_add(unsigned* p, unsigned v) { return __hip_atomic_fetch_add(p, v, __ATOMIC_RELAXED, __HIP_MEMORY_SCOPE_AGENT); }
DEVI unsigned xb_xcc_id() { return (unsigned)__builtin_amdgcn_s_getreg((3 << 11) | 20) & 0xFu; }
#define XB_SPIN(cond, bar) do { unsigned _sp = 0; while (cond) { __builtin_amdgcn_s_sleep(1); \
    if ((++_sp & 255u) == 0u) { if (xb_ld(&(bar)[XB_TMO])) break; if (_sp > XB_SPIN_CAP) { atomicAdd(&(bar)[XB_TMO], 1u); break; } } } } while (0)

struct XcdBarrier { unsigned* bar; unsigned x; volatile LAS unsigned* st; };

DEVI XcdBarrier xcd_barrier_post(unsigned* bar, volatile LAS unsigned* st) {
    XcdBarrier b; b.bar = bar; b.x = xb_xcc_id(); b.st = st;
    if (threadIdx.x == 0) (void)xb_add(&bar[XB_XCNT(b.x)], 1u);
    return b;
}
DEVI void xcd_barrier_complete(unsigned* bar, unsigned x, unsigned& nloc, unsigned& nx) {
    const unsigned G = gridDim.x * gridDim.y * gridDim.z;
    unsigned sum, cnt, mine, sp = 0u;
    for (;;) {
        sum = 0u; cnt = 0u; mine = 0u;
#pragma unroll
        for (unsigned j = 0; j < 16; ++j) { const unsigned c = xb_ld(&bar[XB_XCNT(j)]); sum += c; cnt += (c > 0u) ? 1u : 0u; mine = (j == x) ? c : mine; }
        if (sum == G) break;
        __builtin_amdgcn_s_sleep(1);
        if ((++sp & 255u) == 0u) { if (xb_ld(&bar[XB_TMO])) break; if (sp > XB_SPIN_CAP) { atomicAdd(&bar[XB_TMO], 1u); break; } }
    }
    nloc = mine > 0u ? mine : 1u; nx = cnt > 0u ? cnt : 1u;
}
DEVI void xcd_barrier(const XcdBarrier& b) {
    asm volatile("s_waitcnt vmcnt(0)" ::: "memory");
    __syncthreads();
    if (threadIdx.x == 0) {
        unsigned* bar = b.bar;
        __builtin_amdgcn_s_waitcnt(0);
        unsigned nloc = b.st[0], nx = b.st[1];
        if (nloc == 0u) { xcd_barrier_complete(bar, b.x, nloc, nx); b.st[0] = nloc; b.st[1] = nx; }
        const unsigned old = xb_add(&bar[XB_XSUB(b.x)], 1u);
        const unsigned gen = old / nloc;
        if (old + 1u == (gen + 1u) * nloc) {
            __builtin_amdgcn_fence(__ATOMIC_RELEASE, "agent");
            asm volatile("s_waitcnt vmcnt(0)" ::: "memory");
            const unsigned og = xb_add(&bar[XB_TOP], 1u);
            const unsigned tg = og / nx;
            if (og + 1u == (tg + 1u) * nx) xb_add(&bar[XB_TOPGEN], 1u);
            else XB_SPIN(xb_ld(&bar[XB_TOPGEN]) == tg, bar);
            __builtin_amdgcn_fence(__ATOMIC_ACQUIRE, "agent");
            xb_add(&bar[XB_XGEN(b.x)], 1u);
            asm volatile("s_waitcnt vmcnt(0)" ::: "memory");
        } else {
            XB_SPIN(xb_ld(&bar[XB_XGEN(b.x)]) == gen, bar);
            __builtin_amdgcn_fence(__ATOMIC_ACQUIRE, "agent");
            asm volatile("s_waitcnt vmcnt(0)" ::: "memory");
        }
    }
    __syncthreads();
}

struct Args {
    const float* in[26];
    float* out;
    unsigned char* ws;
    int ph_lo, ph_hi;
};

template <int KS> DEVI int lds_byte(int r, int c) {
    int st = (r >> 4) * KS + (c >> 5), ob = (r & 15) * 64 + (c & 31) * 2;
    return st * 1024 + (ob ^ (((ob >> 9) & 1) << 5));
}
typedef __attribute__((ext_vector_type(16))) float f32x16;
typedef __attribute__((ext_vector_type(8))) int i32x8;
DEVI void f8_stage_rb(int wid, int lane, int i, int& R, int& CB) {
    R = wid * 16 + i * 128 + (lane >> 2);
    CB = (((lane & 3) ^ (R >> 2)) & 3) * 16;
}
DEVI int acc_row32(int wr, int m, int r, int lane) { return wr * 128 + m * 32 + (r & 3) + 8 * (r >> 2) + 4 * (lane >> 5); }
DEVI unsigned cvt4_fp8(float a, float b, float c, float d) {
    int r = 0;
    r = __builtin_amdgcn_cvt_pk_fp8_f32(a, b, r, false);
    r = __builtin_amdgcn_cvt_pk_fp8_f32(c, d, r, true);
    return (unsigned)r;
}
#define WAIT_VN(n) asm volatile("s_waitcnt vmcnt(" #n ")" ::: "memory")
DEVI void f8_stage(char* lds, const unsigned char* __restrict__ A, const unsigned (&aoff)[2], const unsigned char* __restrict__ B, const unsigned (&boffv)[2], int wid, int t) {
    char* sb = lds + (t & 3) * 32768 + wid * 1024;
#pragma unroll
    for (int i = 0; i < 2; ++i) {
        __builtin_amdgcn_global_load_lds((const unsigned*)(A + aoff[i] + t * 64), (LAS unsigned*)(sb + i * 8192), 16, 0, 0);
        __builtin_amdgcn_global_load_lds((const unsigned*)(B + boffv[i] + t * 64), (LAS unsigned*)(sb + 16384 + i * 8192), 16, 0, 0);
    }
}
DEVI void f8_prefetch(char* lds, const unsigned char* __restrict__ A, const unsigned (&aoff)[2], const unsigned char* __restrict__ B, const unsigned (&boffv)[2], int wid) {
    f8_stage(lds, A, aoff, B, boffv, wid, 0); f8_stage(lds, A, aoff, B, boffv, wid, 1); f8_stage(lds, A, aoff, B, boffv, wid, 2);
}
DEVI void q8_stage(char* lds, const unsigned char* __restrict__ A, const unsigned (&aoff)[2], const unsigned char* __restrict__ B, const unsigned (&boffv)[2], int wid, int t) {
    char* sb = lds + (t & 3) * 32768 + wid * 1024;
#pragma unroll
    for (int i = 0; i < 2; ++i) {
        __builtin_amdgcn_global_load_lds((const unsigned*)(A + aoff[i] + t * 64), (LAS unsigned*)(sb + i * 8192), 16, 0, 0);
        __builtin_amdgcn_global_load_lds((const unsigned*)(B + boffv[i] + t * 8192), (LAS unsigned*)(sb + 16384 + i * 8192), 16, 0, 0);
    }
}
DEVI void q8_prefetch(char* lds, const unsigned char* __restrict__ A, const unsigned (&aoff)[2], const unsigned char* __restrict__ B, const unsigned (&boffv)[2], int wid) {
    q8_stage(lds, A, aoff, B, boffv, wid, 0); q8_stage(lds, A, aoff, B, boffv, wid, 1); q8_stage(lds, A, aoff, B, boffv, wid, 2);
}
template <int NT, int SCALE_A, int SCALE_B, bool MOE1>
DEVI void f8_mainloop(char* lds, const unsigned char* __restrict__ A, const unsigned (&aoff)[2], const unsigned char* __restrict__ B, const unsigned (&boffv)[2],
                      int wid, int lane, f32x16 (&acc)[2][4]) {
    const int wr = wid >> 2, wc = wid & 3, l31 = lane & 31, hh = lane >> 5;
    const int xs = (l31 >> 2) & 3;
    const int p0 = ((2 * hh) ^ xs) << 4, p1 = ((2 * hh + 1) ^ xs) << 4;
    const int a_lo = (wr * 128 + l31) * 64 + p0, a_hi = (wr * 128 + l31) * 64 + p1;
    int b_rd[2];
#pragma unroll
    for (int nf = 0; nf < 2; ++nf) {
        const int ntile = MOE1 ? nf : (wc >> 1), nbase = MOE1 ? wc * 32 : (wc & 1) * 64 + nf * 32;
        b_rd[nf] = 16384 + ntile * 8192 + (8 * hh) * 512 + (nbase + l31) * 4;
    }
    auto ldfrag = [&](const char* sa, int lo, int hi) -> i32x8 {
        const i32x4 x = *(const i32x4*)(sa + lo), y = *(const i32x4*)(sa + hi);
        i32x8 r; r[0] = x[0]; r[1] = x[1]; r[2] = x[2]; r[3] = x[3]; r[4] = y[0]; r[5] = y[1]; r[6] = y[2]; r[7] = y[3];
        return r;
    };
    auto compute = [&](int t) {
        const char* sa = lds + (t & 3) * 32768;
        i32x8 fa[4], fb[2];
#pragma unroll
        for (int m = 0; m < 4; ++m) fa[m] = ldfrag(sa + m * 2048, a_lo, a_hi);
#pragma unroll
        for (int n = 0; n < 2; ++n)
#pragma unroll
            for (int j = 0; j < 8; ++j) fb[n][j] = *(const int*)(sa + b_rd[n] + j * 512);
#pragma unroll
        for (int m = 0; m < 4; ++m)
#pragma unroll
            for (int n = 0; n < 2; ++n)
                acc[n][m] = __builtin_amdgcn_mfma_scale_f32_32x32x64_f8f6f4(fb[n], fa[m], acc[n][m], 0, 0, 0, SCALE_B, 0, SCALE_A);
    };
    WAIT_V0(); __builtin_amdgcn_s_barrier();
#pragma unroll 1
    for (int t = 0; t < NT; ++t) {
        if (t + 3 < NT) q8_stage(lds, A, aoff, B, boffv, wid, t + 3);
        compute(t);
        if (t + 3 < NT) { WAIT_VN(8); } else if (t + 2 < NT) { WAIT_VN(4); } else { WAIT_V0(); }
        WAIT_L0(); __builtin_amdgcn_s_barrier();
    }
}
DEVI void touch4(const f32x4& v) { asm volatile("" :: "v"(v)); }
DEVI void touchf(float v) { asm volatile("" :: "v"(v)); }
DEVI void zero_acc32(f32x16 (&acc)[2][4]) {
#pragma unroll
    for (int n = 0; n < 2; ++n)
#pragma unroll
        for (int m = 0; m < 4; ++m)
#pragma unroll
            for (int r = 0; r < 16; ++r) acc[n][m][r] = 0.f;
}

DEVI void bf_stage_rb(int wid, int lane, int i, int& R, int& CB) {
    R = wid * 16 + i * 128 + (lane >> 2);
    CB = (((lane & 3) ^ (R >> 1)) & 3) * 16;
}
template <int NT>
DEVI void bf_mainloop(char* lds, const unsigned char* __restrict__ A, const unsigned (&aoff)[2], const unsigned char* __restrict__ B, const unsigned (&boffv)[2],
                      int wid, int lane, f32x4 (&acc)[4][8]) {
    const int wr = wid >> 2, wc = wid & 3, l15 = lane & 15, q = lane >> 4;
    const int cp = (q ^ ((l15 >> 1) & 3)) << 4;
    const int t_rd = (wr * 128 + l15) * 64 + cp;
    const int w_rd = 16384 + (wc * 64 + l15) * 64 + cp;
    auto compute = [&](int t) {
        const char* sa = lds + (t & 3) * 32768;
        bf16x8 tf[8], wf[4];
#pragma unroll
        for (int nt = 0; nt < 4; ++nt) wf[nt] = *(const bf16x8*)(sa + w_rd + nt * 1024);
#pragma unroll
        for (int mt = 0; mt < 8; ++mt) tf[mt] = *(const bf16x8*)(sa + t_rd + mt * 1024);
#pragma unroll
        for (int mt = 0; mt < 8; ++mt)
#pragma unroll
            for (int nt = 0; nt < 4; ++nt)
                acc[nt][mt] = __builtin_amdgcn_mfma_f32_16x16x32_bf16(wf[nt], tf[mt], acc[nt][mt], 0, 0, 0);
    };
    WAIT_V0(); __builtin_amdgcn_s_barrier();
#pragma unroll 1
    for (int t = 0; t < NT; ++t) {
        if (t + 3 < NT) f8_stage(lds, A, aoff, B, boffv, wid, t + 3);
        compute(t);
        if (t + 3 < NT) { WAIT_VN(8); } else if (t + 2 < NT) { WAIT_VN(4); } else { WAIT_V0(); }
        WAIT_L0(); __builtin_amdgcn_s_barrier();
    }
}
DEVI void zero_acc16(f32x4 (&acc)[4][8]) {
#pragma unroll
    for (int nt = 0; nt < 4; ++nt)
#pragma unroll
        for (int mt = 0; mt < 8; ++mt) acc[nt][mt] = f32x4{0.f, 0.f, 0.f, 0.f};
}
DEVI void bf_offsets(unsigned (&off)[2], int wid, int lane, int row0, int ld) {
#pragma unroll
    for (int i = 0; i < 2; ++i) { int R, CB; bf_stage_rb(wid, lane, i, R, CB); off[i] = ((unsigned)(row0 + R) * ld) * 2u + CB; }
}

DEVI void dense_convert(const Args& a, char* lds, int tid, int wid, int lane) {
    constexpr int RS = 132;
    unsigned* L = (unsigned*)lds;
    const int kq = tid >> 5, nq = tid & 31;
    auto tile = [&](int tl, const float*& src, int& ld, int& ldo, u16*& dst) {
        if (tl < 512) { const int kt = tl & 15, nt = tl >> 4; const int c0 = (nt < 24) ? nt * 128 : 3088 + (nt - 24) * 128;
            src = a.in[2] + (size_t)(kt * 128) * PW + c0; ld = PW; ldo = D; dst = (u16*)(a.ws + WS_WINT) + (size_t)(nt * 128) * D + kt * 128; }
        else if (tl < 576) { const int t2 = tl - 512, kt = t2 & 7, nt = t2 >> 3;
            src = a.in[14] + (size_t)(kt * 128) * SW + nt * 128; ld = SW; ldo = SW; dst = (u16*)(a.ws + WS_GLUT) + (size_t)(nt * 128) * SW + kt * 128; }
        else { const int t2 = tl - 576, kt = t2 & 15, nt = t2 >> 4;
            src = a.in[17] + (size_t)(kt * 128) * D + nt * 128; ld = D; ldo = D; dst = (u16*)(a.ws + WS_WOUTT) + (size_t)(nt * 128) * D + kt * 128; }
    };
    f32x4 v[2][4];
    auto issue = [&](int tl) {
        const float* src; int ld, ldo; u16* dst; tile(tl, src, ld, ldo, dst);
#pragma unroll
        for (int h = 0; h < 2; ++h)
#pragma unroll
            for (int r = 0; r < 4; ++r) v[h][r] = *(const f32x4*)(src + (size_t)(4 * (kq + 16 * h) + r) * ld + 4 * nq);
    };
    if ((int)blockIdx.x < 832) issue(blockIdx.x);
#pragma unroll 1
    for (int tl = blockIdx.x; tl < 832; tl += gridDim.x) {
        const float* src; int ld, ldo; u16* dst; tile(tl, src, ld, ldo, dst);
        __syncthreads();
#pragma unroll
        for (int h = 0; h < 2; ++h) {
            i32x4 d0, d1;
#pragma unroll
            for (int c = 0; c < 4; ++c) { d0[c] = (int)pack2(v[h][0][c], v[h][1][c]); d1[c] = (int)pack2(v[h][2][c], v[h][3][c]); }
            *(i32x4*)(L + (2 * (kq + 16 * h)) * RS + 4 * nq) = d0;
            *(i32x4*)(L + (2 * (kq + 16 * h) + 1) * RS + 4 * nq) = d1;
        }
        if (tl + (int)gridDim.x < 832) issue(tl + gridDim.x);
        __syncthreads();
        {
            const int part = wid & 3, n = (wid >> 2) * 64 + lane;
            unsigned o[16];
#pragma unroll
            for (int j = 0; j < 16; ++j) o[j] = L[(16 * part + j) * RS + n];
            uint4* dp = (uint4*)(dst + (size_t)n * ldo + 32 * part);
            dp[0] = make_uint4(o[0], o[1], o[2], o[3]); dp[1] = make_uint4(o[4], o[5], o[6], o[7]);
            dp[2] = make_uint4(o[8], o[9], o[10], o[11]); dp[3] = make_uint4(o[12], o[13], o[14], o[15]);
        }
    }
}

DEVI void convert_range(const Args& a, char* lds, int t_lo, int t_hi, int tid, int wid, int lane) {
    const float* w1 = a.in[21]; const float* w2 = a.in[23];
    unsigned char* W1Q = a.ws + WS_W1T; unsigned char* W2Q = a.ws + WS_W2T;
    { int lq = lane; asm volatile("" : "+v"(lq)); lane = lq; tid = wid * 64 + lq; }
    const int kq0 = tid >> 5, n4 = tid & 31;
    auto tile_src = [&](int tl, const float*& src, int& ld, unsigned char*& dst) {
        if (tl < 16384) { const int kt = tl & 15, nt = (tl >> 4) & 31, e = tl >> 9;
            src = w1 + (size_t)e * D * 4096 + (size_t)(kt * 128) * 4096 + nt * 128; ld = 4096;
            dst = W1Q + ((size_t)(e * 32 + nt) * 512 + kt * 32) * 512; }
        else { const int t2 = tl - 16384, kt = t2 & 15, nt = (t2 >> 4) & 15, e = t2 >> 8;
            src = w2 + (size_t)e * FF * D + (size_t)(kt * 128) * D + nt * 128; ld = D;
            dst = W2Q + ((size_t)(e * 16 + nt) * 512 + kt * 32) * 512; }
    };
    f32x4 va[2][4], vb[2][4];
    auto issue = [&](int tl, f32x4 (&v)[2][4]) {
        const float* src; int ld; unsigned char* dst; tile_src(tl, src, ld, dst);
#pragma unroll
        for (int h = 0; h < 2; ++h)
#pragma unroll
            for (int r = 0; r < 4; ++r) v[h][r] = __builtin_nontemporal_load((const f32x4*)(src + (size_t)(4 * (kq0 + 16 * h) + r) * ld + 4 * n4));
    };
    auto finish = [&](int tl, f32x4 (&v)[2][4], int tnext) {
        const float* src; int ld; unsigned char* dst; tile_src(tl, src, ld, dst);
        uint4 o[2];
#pragma unroll
        for (int h = 0; h < 2; ++h) {
            o[h].x = cvt4_fp8(v[h][0][0] * 256.f, v[h][1][0] * 256.f, v[h][2][0] * 256.f, v[h][3][0] * 256.f);
            o[h].y = cvt4_fp8(v[h][0][1] * 256.f, v[h][1][1] * 256.f, v[h][2][1] * 256.f, v[h][3][1] * 256.f);
            o[h].z = cvt4_fp8(v[h][0][2] * 256.f, v[h][1][2] * 256.f, v[h][2][2] * 256.f, v[h][3][2] * 256.f);
            o[h].w = cvt4_fp8(v[h][0][3] * 256.f, v[h][1][3] * 256.f, v[h][2][3] * 256.f, v[h][3][3] * 256.f);
        }
        if (tnext < t_hi) issue(tnext, v);
#pragma unroll
        for (int h = 0; h < 2; ++h) *(uint4*)(dst + ((size_t)(kq0 + 16 * h) * 128 + 4 * n4) * 4) = o[h];
    };
    if (t_lo < t_hi) issue(t_lo, va);
    if (t_lo + 1 < t_hi) issue(t_lo + 1, vb);
#pragma unroll 1
    for (int tl = t_lo; tl < t_hi; tl += 2) {
        finish(tl, va, tl + 2);
        if (tl + 1 < t_hi) finish(tl + 1, vb, tl + 3);
    }
}

DEVI void convert_pool(const Args& a, char* lds, int which, int p_lo, int p_hi, int tid, int wid, int lane) {
    int* cur = (int*)(a.ws + WS_CNT) + 64 + which;
    volatile int* bc = (volatile int*)(lds - LDS_BASE + 32);
#pragma unroll 1
    while (true) {
        __syncthreads();
        if (tid == 0) *bc = atomicAdd(cur, 4);
        __syncthreads();
        const int t = p_lo + *bc;
        if (t >= p_hi) break;
        convert_range(a, lds, t, min(t + 4, p_hi), tid, wid, lane);
    }
}

DEVI void phase0(const Args& a, char* lds, int tid, int wid, int lane) {
    const float* x = a.in[0]; const float* g1 = a.in[1]; const float* w_in = a.in[2];
    u16* HN = (u16*)(a.ws + WS_HN); float* GLR = (float*)(a.ws + WS_GLR);
    constexpr int RSB = 4096 + 16;
    char* Wb = lds;
    char* Hb = lds + 16 * RSB;
    float* red = (float*)(lds + 32 * RSB);
    for (int u = blockIdx.x; u < 256; u += gridDim.x) {
        __syncthreads();
        for (int k = 0; k < 4; ++k) {
            const int d = (tid + 512 * k + 8 * (int)blockIdx.x) & 2047;
            const f32x4* src = (const f32x4*)(w_in + (size_t)d * PW + 3072);
#pragma unroll
            for (int q = 0; q < 4; ++q) { f32x4 v = src[q];
#pragma unroll
                for (int c = 0; c < 4; ++c) *(u16*)(Wb + (q * 4 + c) * RSB + d * 2) = f2bf(v[c]); }
        }
        if (tid < 32) ((float*)(a.ws + WS_SSQ))[u * 32 + tid] = 0.f;
        if (u == 0 && tid < 32) { ((int*)(a.ws + WS_CNT))[tid] = 0; ((int*)(a.ws + WS_CNT))[64 + tid] = 0; }
#pragma unroll 1
        for (int ps = 0; ps < 2; ++ps) {
            const int tok0 = u * 32 + ps * 16;
            {
                const int tokA = tok0 + wid * 2, tokB = tokA + 1;
                f32x4 xa[8], xb[8];
                float ssa = 0.f, ssb = 0.f;
#pragma unroll
                for (int i = 0; i < 8; ++i) {
                    xa[i] = *(const f32x4*)(x + (size_t)tokA * D + 256 * i + 4 * lane);
                    xb[i] = *(const f32x4*)(x + (size_t)tokB * D + 256 * i + 4 * lane);
#pragma unroll
                    for (int c = 0; c < 4; ++c) { ssa += xa[i][c] * xa[i][c]; ssb += xb[i][c] * xb[i][c]; }
                }
                ssa = wave_sum(ssa); ssb = wave_sum(ssb);
                const float ra = rsqrtf(ssa * (1.0f / D) + EPS), rb = rsqrtf(ssb * (1.0f / D) + EPS);
#pragma unroll
                for (int i = 0; i < 8; ++i) {
                    const f32x4 g = *(const f32x4*)(g1 + 256 * i + 4 * lane);
                    uint2 pa, pb;
                    pa.x = pack2(xa[i][0] * ra * g[0], xa[i][1] * ra * g[1]); pa.y = pack2(xa[i][2] * ra * g[2], xa[i][3] * ra * g[3]);
                    pb.x = pack2(xb[i][0] * rb * g[0], xb[i][1] * rb * g[1]); pb.y = pack2(xb[i][2] * rb * g[2], xb[i][3] * rb * g[3]);
                    *(uint2*)(HN + (size_t)tokA * D + 256 * i + 4 * lane) = pa;
                    *(uint2*)(HN + (size_t)tokB * D + 256 * i + 4 * lane) = pb;
                    *(uint2*)(Hb + (wid * 2) * RSB + (256 * i + 4 * lane) * 2) = pa;
                    *(uint2*)(Hb + (wid * 2 + 1) * RSB + (256 * i + 4 * lane) * 2) = pb;
                }
            }
            __syncthreads();
            {
                const int l15 = lane & 15, q = lane >> 4;
                f32x4 acc = {0.f, 0.f, 0.f, 0.f};
#pragma unroll
                for (int ks = 0; ks < 8; ++ks) {
                    const int kb = (wid * 256 + ks * 32 + q * 8) * 2;
                    const bf16x8 av = *(const bf16x8*)(Hb + l15 * RSB + kb);
                    const bf16x8 bv = *(const bf16x8*)(Wb + l15 * RSB + kb);
                    acc = __builtin_amdgcn_mfma_f32_16x16x32_bf16(av, bv, acc, 0, 0, 0);
                }
#pragma unroll
                for (int j = 0; j < 4; ++j) red[(wid * 16 + 4 * q + j) * 16 + l15] = acc[j];
            }
            __syncthreads();
            if (tid < 256) {
                float sacc = 0.f;
#pragma unroll
                for (int w = 0; w < 8; ++w) sacc += red[w * 256 + tid];
                GLR[(size_t)(tok0 + (tid >> 4)) * 16 + (tid & 15)] = sacc;
            }
        }
    }
    const float* a_re = a.in[6]; const float* a_im = a.in[7]; const float* b_re = a.in[8]; const float* b_im = a.in[9];
    const float* c_re = a.in[10]; const float* c_im = a.in[11]; const float* lstep = a.in[13];
    u16* KT = (u16*)(a.ws + WS_S5K); u16* WE = (u16*)(a.ws + WS_S5WE); u16* VV = (u16*)(a.ws + WS_S5V); float* AL = (float*)(a.ws + WS_S5AL);
    float* Bre = (float*)lds;
    float* Bim = Bre + 1024;
    float* Cre = Bim + 1024;
    float* Cim = Cre + 1024;
    float* Pre = Cim + 1024;
    float* Pim = Pre + 65 * 64;
    for (int u = blockIdx.x; u < 256; u += gridDim.x) {
        const int g = u >> 2, q = u & 3;
        __syncthreads();
        const float delta = __expf(lstep[g]);
        if (tid < 64) {
            const int p = tid;
            const float ar = a_re[g * 64 + p], ai = a_im[g * 64 + p];
            const float ea = expf(ar * delta);
            float sn, cs; sincosf(ai * delta, &sn, &cs);
            const float xr = ea * cs - 1.0f, xi = ea * sn;
            const float den = 1.0f / (ar * ar + ai * ai);
            const float cr = (xr * ar + xi * ai) * den, ci = (xi * ar - xr * ai) * den;
#pragma unroll
            for (int m = 0; m < 16; ++m) {
                const float br = b_re[(g * 64 + p) * 16 + m], bi = b_im[(g * 64 + p) * 16 + m];
                Bre[p * 16 + m] = cr * br - ci * bi;
                Bim[p * 16 + m] = cr * bi + ci * br;
            }
        }
        for (int i = tid; i < 1024; i += 512) { Cre[i] = c_re[g * 1024 + i]; Cim[i] = c_im[g * 1024 + i]; }
        for (int i = tid; i < 65 * 64; i += 512) {
            const int tau = i >> 6, p = i & 63;
            const float ar = a_re[g * 64 + p], ai = a_im[g * 64 + p];
            const float e = expf((float)tau * ar * delta);
            float sn, cs; sincosf((float)tau * (ai * delta), &sn, &cs);
            Pre[i] = e * cs; Pim[i] = e * sn;
        }
        __syncthreads();
        if (q == 0 && tid < 64) { AL[(g * 64 + tid) * 2] = Pre[64 * 64 + tid]; AL[(g * 64 + tid) * 2 + 1] = Pim[64 * 64 + tid]; }
        if (tid < 256) {
            const int tau = q * 16 + (tid >> 4), n = tid & 15;
            float acc[16];
#pragma unroll
            for (int m = 0; m < 16; ++m) acc[m] = 0.f;
#pragma unroll 2
            for (int p = 0; p < 64; ++p) {
                const float cr = Cre[n * 64 + p], ci = Cim[n * 64 + p], pr = Pre[tau * 64 + p], pi = Pim[tau * 64 + p];
                const float xr = cr * pr - ci * pi, xi = cr * pi + ci * pr;
#pragma unroll
                for (int m4 = 0; m4 < 4; ++m4) {
                    const f32x4 br = *(const f32x4*)(Bre + p * 16 + m4 * 4), bi = *(const f32x4*)(Bim + p * 16 + m4 * 4);
#pragma unroll
                    for (int c = 0; c < 4; ++c) acc[m4 * 4 + c] += xr * br[c] - xi * bi[c];
                }
            }
            uint4 o0, o1;
            o0.x = pack2(acc[0], acc[1]); o0.y = pack2(acc[2], acc[3]); o0.z = pack2(acc[4], acc[5]); o0.w = pack2(acc[6], acc[7]);
            o1.x = pack2(acc[8], acc[9]); o1.y = pack2(acc[10], acc[11]); o1.z = pack2(acc[12], acc[13]); o1.w = pack2(acc[14], acc[15]);
            uint4* dst = (uint4*)(KT + ((size_t)(g * 64 + tau) * 16 + n) * 16);
            dst[0] = o0; dst[1] = o1;
        }
        {
            const int p = tid >> 3;
#pragma unroll
            for (int ss = 0; ss < 2; ++ss) {
                const int s = q * 16 + (tid & 7) * 2 + ss;
                const float pr = Pre[(63 - s) * 64 + p], pi = Pim[(63 - s) * 64 + p];
                float vr[16], vi[16];
#pragma unroll
                for (int m = 0; m < 16; ++m) { const float br = Bre[p * 16 + m], bi = Bim[p * 16 + m]; vr[m] = pr * br - pi * bi; vi[m] = pr * bi + pi * br; }
                uint4 r0, r1, i0, i1;
                r0.x = pack2(vr[0], vr[1]); r0.y = pack2(vr[2], vr[3]); r0.z = pack2(vr[4], vr[5]); r0.w = pack2(vr[6], vr[7]);
                r1.x = pack2(vr[8], vr[9]); r1.y = pack2(vr[10], vr[11]); r1.z = pack2(vr[12], vr[13]); r1.w = pack2(vr[14], vr[15]);
                i0.x = pack2(vi[0], vi[1]); i0.y = pack2(vi[2], vi[3]); i0.z = pack2(vi[4], vi[5]); i0.w = pack2(vi[6], vi[7]);
                i1.x = pack2(vi[8], vi[9]); i1.y = pack2(vi[10], vi[11]); i1.z = pack2(vi[12], vi[13]); i1.w = pack2(vi[14], vi[15]);
                uint4* dr = (uint4*)(WE + ((size_t)(g * 128 + 2 * p) * 1024 + s * 16));
                uint4* di = (uint4*)(WE + ((size_t)(g * 128 + 2 * p + 1) * 1024 + s * 16));
                dr[0] = r0; dr[1] = r1; di[0] = i0; di[1] = i1;
            }
        }
        {
            const int tau = q * 16 + (tid >> 5), n = (tid >> 1) & 15, ph = tid & 1;
            unsigned* dst = (unsigned*)(VV + ((size_t)(g * 1024 + tau * 16 + n) * 128 + ph * 64));
#pragma unroll 4
            for (int pp = 0; pp < 32; ++pp) {
                const int p = ph * 32 + pp;
                const float cr = Cre[n * 64 + p], ci = Cim[n * 64 + p], pr = Pre[(tau + 1) * 64 + p], pi = Pim[(tau + 1) * 64 + p];
                dst[pp] = pack2(cr * pr - ci * pi, -(cr * pi + ci * pr));
            }
        }
    }
    __syncthreads();
    dense_convert(a, lds, tid, wid, lane);
}


namespace pg8 {
#define PG8_LAS __attribute__((address_space(3)))
constexpr int BM = 256, BK = 64, HALF = 128, HTB = HALF * BK * 2, NXCD = 8, WGM = 8;
DEVI int lds_byte(int r, int c) { const int st = (r >> 4) * 2 + (c >> 5), rr = r & 15, cc = c & 31, ob = rr * 64 + cc * 2; return st * 1024 + (ob ^ (((ob >> 9) & 1) << 5)); }
DEVI void stage_rc(int b, int& R, int& C) { const int st = b / 1024, sb = b % 1024, swz = sb ^ (((sb >> 9) & 1) << 5); R = (st >> 1) * 16 + swz / 64; C = (st & 1) * 32 + (swz % 64) / 2; }
DEVI int perm32(int rho) { const int n = rho >> 4, i = rho & 15; return 8 * (i >> 2) + 4 * n + (i & 3); }
struct Unit { int pm, pn, kofs, cont; };
struct Gemm { const void* A; const void* Bt; int ld, K; };
struct StaticOrder {
    int nM, nN, nwg, G, c;
    DEVI void init(int M, int N, int G_, int c_) { nM = M / BM; nN = N / BM; nwg = nM * nN; G = G_; c = c_; }
    DEVI bool tile(int i, Unit& u) const {
        const long L = (long)i * G + c; if (L >= nwg) return false;
        int wgid = (int)L; { const int q = nwg / NXCD, r = nwg % NXCD, xcd = wgid % NXCD, off = wgid / NXCD; wgid = (xcd < r ? xcd * (q + 1) : r * (q + 1) + (xcd - r) * q) + off; }
        const int nig = WGM * nN, gid = wgid / nig, fm = gid * WGM, gsz = (nM - fm) < WGM ? (nM - fm) : WGM;
        u.pm = fm + ((wgid % nig) % gsz); u.pn = (wgid % nig) / gsz; return true;
    }
    DEVI bool next(int i, Unit& u) const { u.kofs = 0; u.cont = 0; return tile(i, u); }
};
struct SplitKOrder : StaticOrder {
    int khalf;
    DEVI bool next(int i, Unit& u) const { if (i >= 2) return false; u.kofs = i == 0 ? khalf : 0; u.cont = i; return tile(0, u); }
};

template <class Epi, class Sched>
DEVI void gemm_phase(PG8_LAS unsigned char* lds, const Gemm g, const Sched& S, const Epi& E) {
    const int tid = threadIdx.x, wid = __builtin_amdgcn_readfirstlane(tid >> 6), lane = tid & 63, wr = wid >> 2, wc = wid & 3, fr = lane & 15, fq = lane >> 4;
    const int ld = g.ld, nt = g.K / BK;
    unsigned voffA[2], voffB[2];
#pragma unroll
    for (int i = 0; i < 2; ++i) { int R, C; stage_rc(tid * 16 + i * 8192, R, C); const int Rb = Epi::PERM ? ((R & ~31) + perm32(R & 31)) : R;
        voffA[i] = (unsigned)(R * ld + C) * 2u; voffB[i] = (unsigned)(Rb * ld + C) * 2u; }
    const size_t kstep = (size_t)(BK * 2);
    const size_t hstep = (size_t)HALF * ld * 2;
    const size_t tstep = 2 * hstep;
    const unsigned ldsw = (unsigned)wid * 1024u;
    const int aoff = lds_byte(wr * 64 + fr, fq * 8), boff = lds_byte(wc * 32 + fr, fq * 8);
#define PG8_SA(b, h) (((b) * 2 + (h)) * HTB)
#define PG8_SB(b, h) ((4 + (b) * 2 + (h)) * HTB)
#define PG8_STAGE(bufoff, gbase, voff) do { _Pragma("unroll") for (int _i = 0; _i < 2; ++_i) \
        __builtin_amdgcn_global_load_lds((const unsigned*)((const char*)(gbase) + (voff)[_i]), (PG8_LAS unsigned*)(lds + (bufoff) + ldsw + _i * 8192), 16, 0, 0); } while (0)
#define PG8_LDA(dst, b, h) do { _Pragma("unroll") for (int m = 0; m < 4; ++m) _Pragma("unroll") for (int k = 0; k < 2; ++k) dst[m][k] = *(const PG8_LAS bf16x8*)(lds + PG8_SA(b, h) + aoff + m * 2048 + k * 1024); } while (0)
#define PG8_LDB(dst, b, h) do { _Pragma("unroll") for (int n = 0; n < 2; ++n) _Pragma("unroll") for (int k = 0; k < 2; ++k) dst[n][k] = *(const PG8_LAS bf16x8*)(lds + PG8_SB(b, h) + boff + n * 2048 + k * 1024); } while (0)
#define PG8_MMA(ai, bj, At, Bt) do { __builtin_amdgcn_s_setprio(1); _Pragma("unroll") for (int m = 0; m < 4; ++m) _Pragma("unroll") for (int n = 0; n < 2; ++n) _Pragma("unroll") for (int k = 0; k < 2; ++k) \
        acc[ai][bj][m][n] = __builtin_amdgcn_mfma_f32_16x16x32_bf16(Bt[n][k], At[m][k], acc[ai][bj][m][n], 0, 0, 0); __builtin_amdgcn_s_setprio(0); } while (0)
#define PG8_WAIT_V(n) asm volatile("s_waitcnt vmcnt(" #n ")" ::: "memory")
#define PG8_WAIT_L(n) asm volatile("s_waitcnt lgkmcnt(" #n ")" ::: "memory")
#define PG8_BAR __builtin_amdgcn_s_barrier()
#define PG8_SCHED __builtin_amdgcn_sched_barrier(0)
#define PG8_ZERO() do { _Pragma("unroll") for (int a_ = 0; a_ < 2; ++a_) _Pragma("unroll") for (int b_ = 0; b_ < 2; ++b_) _Pragma("unroll") for (int m_ = 0; m_ < 4; ++m_) _Pragma("unroll") for (int n_ = 0; n_ < 2; ++n_) \
        acc[a_][b_][m_][n_] = (f32x4){0.f, 0.f, 0.f, 0.f}; } while (0)
    Unit cur, nxt; int ui = 0;
    if (!S.next(0, cur)) return;
    f32x4 acc[2][2][4][2];
    PG8_ZERO();
    bf16x8 At[4][2], B0[2][2], B1[2][2];
    const char* cA = (const char*)g.A + (size_t)cur.pm * tstep + cur.kofs; const char* cB = (const char*)g.Bt + (size_t)cur.pn * tstep + cur.kofs;
    PG8_STAGE(PG8_SB(0, 0), cB, voffB); PG8_STAGE(PG8_SA(0, 0), cA, voffA); PG8_STAGE(PG8_SB(0, 1), cB + hstep, voffB); PG8_STAGE(PG8_SA(0, 1), cA + hstep, voffA);
    if (wr == 1) PG8_BAR;
    PG8_WAIT_V(4); PG8_BAR;
    PG8_STAGE(PG8_SB(1, 0), cB + kstep, voffB); PG8_STAGE(PG8_SA(1, 0), cA + kstep, voffA); PG8_STAGE(PG8_SB(1, 1), cB + hstep + kstep, voffB);
    PG8_WAIT_V(6); PG8_BAR;
    for (;;) {
        const bool has_next = S.next(ui + 1, nxt);
        const char* nA = has_next ? (const char*)g.A + (size_t)nxt.pm * tstep + nxt.kofs : cA; const char* nB = has_next ? (const char*)g.Bt + (size_t)nxt.pn * tstep + nxt.kofs : cB;
        for (int t = 0; t < nt; t += 2) {
            const bool last = (t == nt - 2);
            const char* a1 = cA + (size_t)(t + 1) * kstep;
            const char* a2 = last ? nA : cA + (size_t)(t + 2) * kstep; const char* b2 = last ? nB : cB + (size_t)(t + 2) * kstep;
            const char* a3 = a2 + kstep; const char* b3 = b2 + kstep;
            PG8_LDB(B0, 0, 0); PG8_SCHED; PG8_LDA(At, 0, 0); PG8_STAGE(PG8_SA(1, 1), a1 + hstep, voffA);
            PG8_WAIT_L(8); PG8_BAR; PG8_WAIT_L(0); PG8_MMA(0, 0, At, B0); PG8_BAR; PG8_SCHED;
            PG8_LDB(B1, 0, 1); PG8_STAGE(PG8_SB(0, 0), b2, voffB);
            PG8_BAR; PG8_WAIT_L(0); PG8_MMA(0, 1, At, B1); PG8_BAR;
            PG8_LDA(At, 0, 1); PG8_STAGE(PG8_SA(0, 0), a2, voffA);
            PG8_BAR; PG8_WAIT_L(0); PG8_MMA(1, 0, At, B0); PG8_BAR; PG8_SCHED;
            PG8_STAGE(PG8_SB(0, 1), b2 + hstep, voffB);
            PG8_WAIT_V(6); PG8_BAR; PG8_MMA(1, 1, At, B1); PG8_BAR;
            PG8_LDB(B0, 1, 0); PG8_SCHED; PG8_LDA(At, 1, 0); PG8_STAGE(PG8_SA(0, 1), a2 + hstep, voffA);
            PG8_WAIT_L(8); PG8_BAR; PG8_WAIT_L(0); PG8_MMA(0, 0, At, B0); PG8_BAR; PG8_SCHED;
            PG8_LDB(B1, 1, 1); PG8_STAGE(PG8_SB(1, 0), b3, voffB);
            PG8_BAR; PG8_WAIT_L(0); PG8_MMA(0, 1, At, B1); PG8_BAR;
            PG8_LDA(At, 1, 1); PG8_STAGE(PG8_SA(1, 0), a3, voffA);
            PG8_BAR; PG8_WAIT_L(0); PG8_MMA(1, 0, At, B0); PG8_BAR; PG8_SCHED;
            PG8_STAGE(PG8_SB(1, 1), b3 + hstep, voffB);
            PG8_WAIT_V(6); PG8_BAR; PG8_MMA(1, 1, At, B1); PG8_BAR;
        }
        E(acc, cur, wr, wc, fr, fq);
        if (!has_next) break;
        if (!nxt.cont) PG8_ZERO();
        cur = nxt; cA = nA; cB = nB; ++ui;
    }
    PG8_WAIT_V(0);
    if (wr == 0) PG8_BAR;
    PG8_BAR;
#undef PG8_SA
#undef PG8_SB
#undef PG8_STAGE
#undef PG8_LDA
#undef PG8_LDB
#undef PG8_MMA
#undef PG8_WAIT_V
#undef PG8_WAIT_L
#undef PG8_BAR
#undef PG8_SCHED
#undef PG8_ZERO
}
}

struct EpiProj {
    static constexpr bool PERM = true;
    u16* out;
    DEVI void operator()(f32x4 (&acc)[2][2][4][2], const pg8::Unit& u, int wr, int wc, int fr, int fq) const {
        const float sc = (u.pn < 2) ? 0.08838834764831845f : 1.0f;
        const int row0 = u.pm * 256 + wr * 64 + fr, col0 = u.pn * 256 + wc * 32 + 8 * fq;
#pragma unroll
        for (int ai = 0; ai < 2; ++ai)
#pragma unroll
            for (int m = 0; m < 4; ++m) {
                u16* rowp = out + (size_t)(row0 + ai * 128 + m * 16) * PJ + col0;
#pragma unroll
                for (int bj = 0; bj < 2; ++bj) {
                    const f32x4 v0 = acc[ai][bj][m][0], v1 = acc[ai][bj][m][1];
                    uint4 w; w.x = pack2(v0[0] * sc, v0[1] * sc); w.y = pack2(v0[2] * sc, v0[3] * sc); w.z = pack2(v1[0] * sc, v1[1] * sc); w.w = pack2(v1[2] * sc, v1[3] * sc);
                    *(uint4*)(rowp + bj * 128) = w;
                }
            }
    }
};
struct EpiGlu {
    static constexpr bool PERM = true;
    const u16* Z; u16* MIX; float* SSQ; const float* gbias; const float* sng;
    DEVI void operator()(f32x4 (&acc)[2][2][4][2], const pg8::Unit& u, int wr, int wc, int fr, int fq) const {
        const int row0 = u.pm * 256 + wr * 64 + fr, col0 = u.pn * 256 + wc * 32 + 8 * fq;
#pragma unroll
        for (int ai = 0; ai < 2; ++ai)
#pragma unroll
            for (int m = 0; m < 4; ++m) {
                const int row = row0 + ai * 128 + m * 16;
                float sq = 0.f;
#pragma unroll
                for (int bj = 0; bj < 2; ++bj) {
                    const int c = col0 + bj * 128;
                    const uint4 zv = *(const uint4*)(Z + (size_t)row * SW + c);
                    const unsigned zw[4] = {zv.x, zv.y, zv.z, zv.w};
                    unsigned ow[4];
#pragma unroll
                    for (int n = 0; n < 2; ++n) {
                        const f32x4 gb = *(const f32x4*)(gbias + c + 4 * n), sg = *(const f32x4*)(sng + c + 4 * n);
                        const f32x4 v = acc[ai][bj][m][n];
                        const float y0 = bflo(zw[2 * n]) * sigmoidf_(v[0] + gb[0]), y1 = bfhi(zw[2 * n]) * sigmoidf_(v[1] + gb[1]);
                        const float y2 = bflo(zw[2 * n + 1]) * sigmoidf_(v[2] + gb[2]), y3 = bfhi(zw[2 * n + 1]) * sigmoidf_(v[3] + gb[3]);
                        sq += y0 * y0 + y1 * y1 + y2 * y2 + y3 * y3;
                        ow[2 * n] = pack2(y0 * sg[0], y1 * sg[1]); ow[2 * n + 1] = pack2(y2 * sg[2], y3 * sg[3]);
                    }
                    uint4 w; w.x = ow[0]; w.y = ow[1]; w.z = ow[2]; w.w = ow[3];
                    *(uint4*)(MIX + (size_t)row * D + 1024 + c) = w;
                }
                sq += __shfl_xor(sq, 16); sq += __shfl_xor(sq, 32);
                if (fq == 0) atomicAdd(&SSQ[row], sq);
            }
    }
};
struct EpiOut {
    static constexpr bool PERM = false;
    const float* x; float* H1; const float* SSQ;
    DEVI void operator()(f32x4 (&acc)[2][2][4][2], const pg8::Unit& u, int wr, int wc, int fr, int fq) const {
        const int row0 = u.pm * 256 + wr * 64 + fr, col0 = u.pn * 256 + wc * 32 + 4 * fq;
        if (u.cont == 0) {
#pragma unroll
            for (int ai = 0; ai < 2; ++ai)
#pragma unroll
                for (int m = 0; m < 4; ++m) {
                    const float rs = rsqrtf(SSQ[row0 + ai * 128 + m * 16] * (1.0f / SW) + EPS);
#pragma unroll
                    for (int bj = 0; bj < 2; ++bj)
#pragma unroll
                        for (int n = 0; n < 2; ++n) acc[ai][bj][m][n] *= rs;
                }
        } else {
#pragma unroll
            for (int ai = 0; ai < 2; ++ai)
#pragma unroll
                for (int m = 0; m < 4; ++m) {
                    const size_t base = (size_t)(row0 + ai * 128 + m * 16) * D + col0;
#pragma unroll
                    for (int bj = 0; bj < 2; ++bj)
#pragma unroll
                        for (int n = 0; n < 2; ++n) {
                            const f32x4 xv = *(const f32x4*)(x + base + bj * 128 + n * 16);
                            *(f32x4*)(H1 + base + bj * 128 + n * 16) = xv + acc[ai][bj][m][n];
                        }
                }
        }
    }
};

DEVI void phase1(const Args& a, char* lds, int tid, int wid, int lane) {
    extern __shared__ __attribute__((aligned(16))) char smem_pg8[];
    const int cpos = blockIdx.x % 3, c_lo = blockIdx.x * 24, c_hi = c_lo + 24;
    if (cpos == 0) convert_range(a, lds, c_lo, c_hi, tid, wid, lane);
    {
        pg8::Gemm g; g.A = a.ws + WS_HN; g.Bt = a.ws + WS_WINT; g.ld = D; g.K = D;
        pg8::StaticOrder S; S.init(T, PJ, (int)gridDim.x, (int)blockIdx.x);
        EpiProj E; E.out = (u16*)(a.ws + WS_PROJ);
        pg8::gemm_phase(( PG8_LAS unsigned char*)(smem_pg8 + 1024), g, S, E);
    }
    if (cpos != 0) convert_range(a, lds, c_lo, c_hi, tid, wid, lane);
    convert_pool(a, lds, 0, 6144, 8192, tid, wid, lane);
}

DEVI void gla_gate(const Args& a, int n, int h, int tid, float* glr, float* tot, float (&b)[16], float& blast) {
    const float* GLR = (const float*)(a.ws + WS_GLR);
    const float* W2 = a.in[3]; const float* gb = a.in[4];
    for (int i = tid; i < 1024; i += 512) glr[i] = GLR[(size_t)n * 64 * 16 + i];
    const int ch = tid & 127, tq = tid >> 7;
    float w[16];
#pragma unroll
    for (int r = 0; r < 16; ++r) w[r] = W2[r * 512 + h * 128 + ch];
    const float bias = gb[h * 128 + ch];
    __syncthreads();
    float run = 0.f;
#pragma unroll
    for (int tt = 0; tt < 16; ++tt) {
        const int t = tq * 16 + tt;
        float s = bias;
#pragma unroll
        for (int r4 = 0; r4 < 4; ++r4) {
            const f32x4 gv = *(const f32x4*)(glr + t * 16 + r4 * 4);
            s += gv[0] * w[r4 * 4] + gv[1] * w[r4 * 4 + 1] + gv[2] * w[r4 * 4 + 2] + gv[3] * w[r4 * 4 + 3];
        }
        run += logsigmoid_(s) * (1.0f / 16.0f);
        b[tt] = run;
    }
    tot[tq * 128 + ch] = run;
    __syncthreads();
    float pre = 0.f;
#pragma unroll
    for (int k = 0; k < 4; ++k) { const float v = tot[k * 128 + ch]; if (k < tq) pre += v; }
    blast = tot[ch] + tot[128 + ch] + tot[256 + ch] + tot[384 + ch];
#pragma unroll
    for (int tt = 0; tt < 16; ++tt) b[tt] += pre;
}
DEVI void gla_stage_vT(const u16* PROJ, int t0, int vcol0, char* img, int tid) {
    if (tid < 256) {
        const int tb = tid >> 5, jb = tid & 31;
        unsigned R[8][4];
#pragma unroll
        for (int tt = 0; tt < 8; ++tt) {
            const uint4 v = *(const uint4*)(PROJ + (size_t)(t0 + tb * 8 + tt) * PJ + vcol0 + jb * 8);
            R[tt][0] = v.x; R[tt][1] = v.y; R[tt][2] = v.z; R[tt][3] = v.w;
        }
#pragma unroll
        for (int jj = 0; jj < 8; ++jj) {
            unsigned o[4];
#pragma unroll
            for (int d = 0; d < 4; ++d) {
                const unsigned lo = R[2 * d][jj >> 1], hi = R[2 * d + 1][jj >> 1];
                o[d] = (jj & 1) ? ((lo >> 16) | (hi & 0xffff0000u)) : ((lo & 0xffffu) | (hi << 16));
            }
            *(uint4*)(img + lds_byte<2>(jb * 8 + jj, tb * 8)) = make_uint4(o[0], o[1], o[2], o[3]);
        }
    }
}

constexpr int USTR = 2048 + 16;
DEVI void s5_fill_U(const u16* PROJ, int g, int cb, char* U, int tid) {
    for (int k = 0; k < 4; ++k) {
        const int idx = tid + 512 * k, c = idx >> 6, s = idx & 63;
        const uint4* src = (const uint4*)(PROJ + (size_t)((cb * 32 + c) * 64 + s) * PJ + 3072 + g * 16);
        uint4* dst = (uint4*)(U + c * USTR + s * 32);
        dst[0] = src[0]; dst[1] = src[1];
    }
}
DEVI void phase2(const Args& a, char* lds, int tid, int wid, int lane) {
    const u16* PROJ = (const u16*)(a.ws + WS_PROJ);
#pragma unroll 1
    for (int u = blockIdx.x; u < 768; u += gridDim.x) {
        { int lq = lane; asm volatile("" : "+v"(lq)); lane = lq; tid = wid * 64 + lq; }
        const int fr = lane & 15, fq = lane >> 4;
        __syncthreads();
        if (u < 256) {
            const int g = u >> 2, cb = u & 3;
            s5_fill_U(PROJ, g, cb, lds, tid);
            __syncthreads();
            const u16* WE = (const u16*)(a.ws + WS_S5WE) + (size_t)(g * 128 + wid * 16 + fr) * 1024 + fq * 8;
            f32x4 acc0 = {0.f, 0.f, 0.f, 0.f}, acc1 = {0.f, 0.f, 0.f, 0.f};
#pragma unroll 8
            for (int ks = 0; ks < 32; ++ks) {
                const bf16x8 bf = *(const bf16x8*)(WE + ks * 32);
                const bf16x8 a0 = *(const bf16x8*)(lds + fr * USTR + (ks * 32 + fq * 8) * 2);
                const bf16x8 a1 = *(const bf16x8*)(lds + (16 + fr) * USTR + (ks * 32 + fq * 8) * 2);
                acc0 = __builtin_amdgcn_mfma_f32_16x16x32_bf16(a0, bf, acc0, 0, 0, 0);
                acc1 = __builtin_amdgcn_mfma_f32_16x16x32_bf16(a1, bf, acc1, 0, 0, 0);
            }
            float* E = (float*)(a.ws + WS_S5E);
#pragma unroll
            for (int j = 0; j < 4; ++j) {
                E[(size_t)(g * 128 + cb * 32 + fq * 4 + j) * 128 + wid * 16 + fr] = acc0[j];
                E[(size_t)(g * 128 + cb * 32 + 16 + fq * 4 + j) * 128 + wid * 16 + fr] = acc1[j];
            }
        } else {
            const int uu = u - 256, n = uu >> 2, h = uu & 3, t0 = n * 64;
            char* vT = lds;
            char* kT = lds + 32768;
            float* glr = (float*)(lds + 49152);
            float* tot = glr + 1024;
            float b[16], blast;
            gla_gate(a, n, h, tid, glr, tot, b, blast);
            const int ch = tid & 127, tq = tid >> 7;
            {
                unsigned pk[8];
#pragma unroll
                for (int tt = 0; tt < 16; tt += 2) {
                    const float k0 = bf2f(PROJ[(size_t)(t0 + tq * 16 + tt) * PJ + 512 + h * 128 + ch]);
                    const float k1 = bf2f(PROJ[(size_t)(t0 + tq * 16 + tt + 1) * PJ + 512 + h * 128 + ch]);
                    pk[tt >> 1] = pack2(k0 * __expf(blast - b[tt]), k1 * __expf(blast - b[tt + 1]));
                }
                *(uint4*)(kT + lds_byte<2>(ch, tq * 16)) = make_uint4(pk[0], pk[1], pk[2], pk[3]);
                *(uint4*)(kT + lds_byte<2>(ch, tq * 16 + 8)) = make_uint4(pk[4], pk[5], pk[6], pk[7]);
                if (tq == 3) ((float*)(a.ws + WS_DEC))[(size_t)(n * 4 + h) * 128 + ch] = __expf(blast);
            }
            gla_stage_vT(PROJ, t0, 1024 + h * 256, vT, tid);
            __syncthreads();
            const int wr = wid >> 1, wc = wid & 1;
            f32x4 acc[4][4];
#pragma unroll
            for (int m = 0; m < 4; ++m)
#pragma unroll
                for (int nn = 0; nn < 4; ++nn) acc[m][nn] = f32x4{0.f, 0.f, 0.f, 0.f};
#pragma unroll
            for (int ks = 0; ks < 2; ++ks) {
                bf16x8 Af[4], Bf[4];
#pragma unroll
                for (int m = 0; m < 4; ++m) Af[m] = *(const bf16x8*)(vT + lds_byte<2>(wr * 64 + m * 16 + fr, ks * 32 + fq * 8));
#pragma unroll
                for (int nn = 0; nn < 4; ++nn) Bf[nn] = *(const bf16x8*)(kT + lds_byte<2>(wc * 64 + nn * 16 + fr, ks * 32 + fq * 8));
#pragma unroll
                for (int m = 0; m < 4; ++m)
#pragma unroll
                    for (int nn = 0; nn < 4; ++nn) acc[m][nn] = __builtin_amdgcn_mfma_f32_16x16x32_bf16(Af[m], Bf[nn], acc[m][nn], 0, 0, 0);
            }
            float* KV = (float*)(a.ws + WS_KV) + (size_t)(n * 4 + h) * (HV * HK);
#pragma unroll
            for (int m = 0; m < 4; ++m)
#pragma unroll
                for (int nn = 0; nn < 4; ++nn)
#pragma unroll
                    for (int j = 0; j < 4; ++j)
                        KV[(size_t)(wr * 64 + m * 16 + fq * 4 + j) * 128 + wc * 64 + nn * 16 + fr] = acc[m][nn][j];
        }
    }
}

DEVI void phase3(const Args& a, int tid) {
    const float* KV = (const float*)(a.ws + WS_KV); u16* ST = (u16*)(a.ws + WS_ST); const float* DEC = (const float*)(a.ws + WS_DEC);
    for (int e = blockIdx.x * 512 + tid; e < NH * HV * HK; e += gridDim.x * 512) {
        const int h = e >> 15, rem = e & 32767, i = e & 127;
        float S = 0.f;
#pragma unroll 1
        for (int n0 = 0; n0 < NCH; n0 += 16) {
            float kv[16], dc[16];
#pragma unroll
            for (int k = 0; k < 16; ++k) { kv[k] = KV[(size_t)((n0 + k) * 4 + h) * 32768 + rem]; dc[k] = DEC[(size_t)((n0 + k) * 4 + h) * 128 + i]; }
#pragma unroll
            for (int k = 0; k < 16; ++k) { ST[(size_t)((n0 + k) * 4 + h) * 32768 + rem] = f2bf(S); S = dc[k] * S + kv[k]; }
        }
    }
    const float* E = (const float*)(a.ws + WS_S5E); const float* AL = (const float*)(a.ws + WS_S5AL); unsigned* HP = (unsigned*)(a.ws + WS_S5H);
    for (int e = blockIdx.x * 512 + tid; e < NG * SP; e += gridDim.x * 512) {
        const int g = e >> 6, p = e & 63;
        const float ar = AL[e * 2], ai = AL[e * 2 + 1];
        float hr = 0.f, hi = 0.f;
#pragma unroll 1
        for (int c0 = 0; c0 < 128; c0 += 16) {
            float2 ev[16];
#pragma unroll
            for (int k = 0; k < 16; ++k) ev[k] = *(const float2*)(E + (size_t)(g * 128 + c0 + k) * 128 + 2 * p);
#pragma unroll
            for (int k = 0; k < 16; ++k) {
                HP[(size_t)(g * 128 + c0 + k) * 64 + p] = pack2(hr, hi);
                const float nr = ar * hr - ai * hi + ev[k].x, ni = ar * hi + ai * hr + ev[k].y;
                hr = nr; hi = ni;
            }
        }
    }
}

DEVI void phase4(const Args& a, char* lds, int tid, int wid, int lane) {
    const u16* PROJ = (const u16*)(a.ws + WS_PROJ);
    u16* MIX = (u16*)(a.ws + WS_MIX);
#pragma unroll 1
    for (int u = blockIdx.x; u < 768; u += gridDim.x) {
        { int lq = lane; asm volatile("" : "+v"(lq)); lane = lq; tid = wid * 64 + lq; }
        const int fr = lane & 15, fq = lane >> 4;
        __syncthreads();
        if (u < 256) {
            const int g = u >> 2, cb = u & 3;
            char* U = lds; char* KTl = lds + 32 * USTR;
            s5_fill_U(PROJ, g, cb, U, tid);
            {
                const uint4* src = (const uint4*)((const u16*)(a.ws + WS_S5K) + (size_t)g * 16384);
                uint4* dst = (uint4*)KTl;
                for (int k = 0; k < 4; ++k) dst[tid + 512 * k] = src[tid + 512 * k];
            }
            __syncthreads();
            f32x4 acc[8][2];
#pragma unroll
            for (int tt = 0; tt < 8; ++tt) { acc[tt][0] = f32x4{0.f, 0.f, 0.f, 0.f}; acc[tt][1] = f32x4{0.f, 0.f, 0.f, 0.f}; }
            const int sl = fq >> 1, m0 = (fq & 1) * 8;
            const char* kbase = KTl + ((wid - sl) * 256 + fr * 16 + m0) * 2;
#pragma unroll 1
            for (int j = 0; j < 32; ++j) {
                const bf16x8 a0 = *(const bf16x8*)(U + fr * USTR + (j * 32 + fq * 8) * 2);
                const bf16x8 a1 = *(const bf16x8*)(U + (16 + fr) * USTR + (j * 32 + fq * 8) * 2);
                const char* kb = kbase - j * 1024;
#pragma unroll
                for (int tt = 0; tt < 8; ++tt) {
                    const int t = wid + 8 * tt;
                    if (t >= 2 * j) {
                        bf16x8 bf = *(const bf16x8*)(kb + tt * 4096);
                        if (t == 2 * j && sl == 1) bf = bf16x8{0, 0, 0, 0, 0, 0, 0, 0};
                        acc[tt][0] = __builtin_amdgcn_mfma_f32_16x16x32_bf16(a0, bf, acc[tt][0], 0, 0, 0);
                        acc[tt][1] = __builtin_amdgcn_mfma_f32_16x16x32_bf16(a1, bf, acc[tt][1], 0, 0, 0);
                    }
                }
            }
            const u16* HP = (const u16*)(a.ws + WS_S5H); const u16* VV = (const u16*)(a.ws + WS_S5V);
#pragma unroll 1
            for (int kp = 0; kp < 2; ++kp) {
                bf16x8 a0[2], a1[2], bfv[2][8];
#pragma unroll
                for (int k2 = 0; k2 < 2; ++k2) {
                    const int ks = kp * 2 + k2;
                    a0[k2] = *(const bf16x8*)(HP + (size_t)(g * 128 + cb * 32 + fr) * 128 + ks * 32 + fq * 8);
                    a1[k2] = *(const bf16x8*)(HP + (size_t)(g * 128 + cb * 32 + 16 + fr) * 128 + ks * 32 + fq * 8);
#pragma unroll
                    for (int tt = 0; tt < 8; ++tt)
                        bfv[k2][tt] = *(const bf16x8*)(VV + (size_t)(g * 1024 + (wid + 8 * tt) * 16 + fr) * 128 + ks * 32 + fq * 8);
                }
#pragma unroll
                for (int k2 = 0; k2 < 2; ++k2)
#pragma unroll
                    for (int tt = 0; tt < 8; ++tt) {
                        acc[tt][0] = __builtin_amdgcn_mfma_f32_16x16x32_bf16(a0[k2], bfv[k2][tt], acc[tt][0], 0, 0, 0);
                        acc[tt][1] = __builtin_amdgcn_mfma_f32_16x16x32_bf16(a1[k2], bfv[k2][tt], acc[tt][1], 0, 0, 0);
                    }
            }
            const float dsk = a.in[12][g * 16 + fr];
            u16* Z = (u16*)(a.ws + WS_Z);
#pragma unroll
            for (int tt = 0; tt < 8; ++tt) {
                const int t = wid + 8 * tt;
#pragma unroll
                for (int mf = 0; mf < 2; ++mf)
#pragma unroll
                    for (int j = 0; j < 4; ++j) {
                        const int cl = mf * 16 + fq * 4 + j;
                        const float uv = bf2f(*(const u16*)(U + cl * USTR + (t * 16 + fr) * 2));
                        const float y = acc[tt][mf][j] + dsk * uv;
                        Z[(size_t)((cb * 32 + cl) * 64 + t) * SW + g * 16 + fr] = f2bf(gelu_tanh(y));
                    }
            }
        } else {
            const int uu = u - 256, n = uu >> 2, h = uu & 3, t0 = n * 64;
            char* vT = lds;
            char* qI = lds + 32768;
            char* kI = lds + 49152;
            char* pI = lds + 65536;
            float* glr = (float*)(lds + 73728);
            float* tot = glr + 1024;
            float* rss = tot + 512;
            char* sT = lds + 81920;
            {
                const u16* STg = (const u16*)(a.ws + WS_ST) + (size_t)(n * 4 + h) * (HV * HK);
#pragma unroll
                for (int p = 0; p < 8; ++p) {
                    const int row = p * 32 + wid * 4 + (lane >> 4), chunk = ((lane & 15) ^ row) & 15;
                    __builtin_amdgcn_global_load_lds((const unsigned*)(STg + (size_t)row * 128 + chunk * 8), (LAS unsigned*)(sT + p * 8192 + wid * 1024), 16, 0, 0);
                }
            }
            float b[16], blast;
            gla_gate(a, n, h, tid, glr, tot, b, blast);
            const int ch = tid & 127, tq = tid >> 7;
            {
                const int qb0 = (tq * 4 + (ch >> 5)) * 1024 + (ch & 31) * 2, qb1 = qb0 ^ 32;
                const u16* src = PROJ + (size_t)(t0 + tq * 16) * PJ + h * 128 + ch;
#pragma unroll
                for (int tt = 0; tt < 16; ++tt) {
                    const float qv = bf2f(src[(size_t)tt * PJ]);
                    const float kv = bf2f(src[(size_t)tt * PJ + 512]);
                    const int off = (tt < 8 ? qb0 : qb1) + tt * 64;
                    *(u16*)(qI + off) = f2bf(qv * __expf(b[tt]));
                    *(u16*)(kI + off) = f2bf(kv * __expf(-b[tt]));
                }
            }
            gla_stage_vT(PROJ, t0, 1024 + h * 256, vT, tid);
            __syncthreads();
            {
                const int mf = wid & 3, nb = (wid >> 2) * 2;
                f32x4 s0 = {0.f, 0.f, 0.f, 0.f}, s1 = {0.f, 0.f, 0.f, 0.f};
#pragma unroll
                for (int ks = 0; ks < 4; ++ks) {
                    const bf16x8 af = *(const bf16x8*)(qI + lds_byte<4>(mf * 16 + fr, ks * 32 + fq * 8));
                    const bf16x8 b0 = *(const bf16x8*)(kI + lds_byte<4>(nb * 16 + fr, ks * 32 + fq * 8));
                    const bf16x8 b1 = *(const bf16x8*)(kI + lds_byte<4>((nb + 1) * 16 + fr, ks * 32 + fq * 8));
                    s0 = __builtin_amdgcn_mfma_f32_16x16x32_bf16(af, b0, s0, 0, 0, 0);
                    s1 = __builtin_amdgcn_mfma_f32_16x16x32_bf16(af, b1, s1, 0, 0, 0);
                }
#pragma unroll
                for (int j = 0; j < 4; ++j) {
                    const int t = mf * 16 + fq * 4 + j, sA = nb * 16 + fr, sB = sA + 16;
                    *(u16*)(pI + lds_byte<2>(t, sA)) = f2bf(sA <= t ? s0[j] : 0.f);
                    *(u16*)(pI + lds_byte<2>(t, sB)) = f2bf(sB <= t ? s1[j] : 0.f);
                }
            }
            __syncthreads();
            const int mf = wid & 3, nh = wid >> 2;
            f32x4 acc[8];
#pragma unroll
            for (int nn = 0; nn < 8; ++nn) acc[nn] = f32x4{0.f, 0.f, 0.f, 0.f};
#pragma unroll
            for (int ks = 0; ks < 2; ++ks) {
                const bf16x8 af = *(const bf16x8*)(pI + lds_byte<2>(mf * 16 + fr, ks * 32 + fq * 8));
#pragma unroll
                for (int nn = 0; nn < 8; ++nn) {
                    const bf16x8 bf = *(const bf16x8*)(vT + lds_byte<2>(nh * 128 + nn * 16 + fr, ks * 32 + fq * 8));
                    acc[nn] = __builtin_amdgcn_mfma_f32_16x16x32_bf16(af, bf, acc[nn], 0, 0, 0);
                }
            }
#pragma unroll
            for (int ks = 0; ks < 4; ++ks) {
                const bf16x8 af = *(const bf16x8*)(qI + lds_byte<4>(mf * 16 + fr, ks * 32 + fq * 8));
#pragma unroll
                for (int nn = 0; nn < 8; ++nn) {
                    const bf16x8 bf = *(const bf16x8*)(sT + (nh * 128 + nn * 16 + fr) * 256 + ((((ks * 4 + fq) ^ fr) & 15) << 4));
                    acc[nn] = __builtin_amdgcn_mfma_f32_16x16x32_bf16(af, bf, acc[nn], 0, 0, 0);
                }
            }
            u16 rraw[4][8];
#pragma unroll
            for (int j = 0; j < 4; ++j)
#pragma unroll
                for (int nn = 0; nn < 8; ++nn) rraw[j][nn] = PROJ[(size_t)(t0 + mf * 16 + fq * 4 + j) * PJ + 2048 + h * 256 + nh * 128 + nn * 16 + fr];
            float ss[4];
#pragma unroll
            for (int j = 0; j < 4; ++j) {
                float s = 0.f;
#pragma unroll
                for (int nn = 0; nn < 8; ++nn) s += acc[nn][j] * acc[nn][j];
                ss[j] = sum16(s);
            }
            if (fr == 0) {
#pragma unroll
                for (int j = 0; j < 4; ++j) rss[nh * 64 + mf * 16 + fq * 4 + j] = ss[j];
            }
            __syncthreads();
            const float* gn = a.in[5];
#pragma unroll
            for (int j = 0; j < 4; ++j) {
                const int t = mf * 16 + fq * 4 + j;
                const float rstd = rsqrtf((rss[t] + rss[64 + t]) * (1.0f / 256.0f) + EPS);
#pragma unroll
                for (int nn = 0; nn < 8; ++nn) {
                    const int jc = nh * 128 + nn * 16 + fr;
                    const float rv = bf2f(rraw[j][nn]);
                    const float o = acc[nn][j] * rstd * gn[jc] * (rv * sigmoidf_(rv));
                    MIX[(size_t)(t0 + t) * D + h * 256 + jc] = f2bf(o);
                }
            }
        }
    }
}

DEVI void phase5(const Args& a, char* lds, int tid, int wid, int lane) {
    extern __shared__ __attribute__((aligned(16))) char smem_pg8[];
    if (blockIdx.x >= 128) {
        const int c_lo = 8192 + (blockIdx.x - 128) * 22;
        convert_range(a, lds, c_lo, c_lo + 22, tid, wid, lane);
    } else {
        pg8::Gemm g; g.A = a.ws + WS_Z; g.Bt = a.ws + WS_GLUT; g.ld = SW; g.K = SW;
        pg8::StaticOrder S; S.init(T, SW, 128, (int)blockIdx.x);
        EpiGlu E; E.Z = (const u16*)(a.ws + WS_Z); E.MIX = (u16*)(a.ws + WS_MIX); E.SSQ = (float*)(a.ws + WS_SSQ); E.gbias = a.in[15]; E.sng = a.in[16];
        pg8::gemm_phase((PG8_LAS unsigned char*)(smem_pg8 + 1024), g, S, E);
        const int c_lo = 11008 + blockIdx.x * 6; convert_range(a, lds, c_lo, c_lo + 6, tid, wid, lane);
    }
    convert_pool(a, lds, 1, 11776, 13312, tid, wid, lane);
}

DEVI void phase6(const Args& a, char* lds, int tid, int wid, int lane) {
    extern __shared__ __attribute__((aligned(16))) char smem_pg8[];
    const int c6_lo = 13312 + blockIdx.x * 8, c6_hi = c6_lo + 8;
    if ((blockIdx.x >> 3) & 1) convert_range(a, lds, c6_lo, c6_hi, tid, wid, lane);
    if (blockIdx.x < 256) {
        pg8::Gemm g; g.A = a.ws + WS_MIX; g.Bt = a.ws + WS_WOUTT; g.ld = D; g.K = 1024;
        pg8::SplitKOrder S; S.init(T, D, 256, (int)blockIdx.x); S.khalf = 2048;
        EpiOut E; E.x = a.in[0]; E.H1 = (float*)(a.ws + WS_H1); E.SSQ = (const float*)(a.ws + WS_SSQ);
        pg8::gemm_phase((PG8_LAS unsigned char*)(smem_pg8 + 1024), g, S, E);
    }
    if (!((blockIdx.x >> 3) & 1)) convert_range(a, lds, c6_lo, c6_hi, tid, wid, lane);
    convert_pool(a, lds, 2, 15360, 16384, tid, wid, lane);
}

DEVI void phase7(const Args& a, char* lds, int tid, int wid, int lane) {
    const float* H1 = (const float*)(a.ws + WS_H1); unsigned char* HN8 = a.ws + WS_HN2;
    const float* g2 = a.in[18]; const float* rw = a.in[19]; const float* rb = a.in[20];
    int* CNT = (int*)(a.ws + WS_CNT); int* LTOK = (int*)(a.ws + WS_LTOK); float* LGATE = (float*)(a.ws + WS_LGATE); int* TSLOT = (int*)(a.ws + WS_TSLOT);
    float* hn = (float*)lds;
    float* red = hn + 8 * 2048;
    float* lg = red + 8 * 8 * 32;
    for (int u = blockIdx.x; u < 256; u += gridDim.x) {
#pragma unroll 1
        for (int ps = 0; ps < 4; ++ps) {
            const int tok0 = u * 32 + ps * 8;
            { int lq = lane; asm volatile("" : "+v"(lq)); lane = lq; tid = wid * 64 + lq; }
            __syncthreads();
            {
                const int tl = wid, tok = tok0 + tl;
                f32x4 xv[8]; float ss = 0.f;
#pragma unroll
                for (int i = 0; i < 8; ++i) { xv[i] = *(const f32x4*)(H1 + (size_t)tok * D + 256 * i + 4 * lane);
#pragma unroll
                    for (int c = 0; c < 4; ++c) ss += xv[i][c] * xv[i][c]; }
                ss = wave_sum(ss);
                const float r = rsqrtf(ss * (1.0f / D) + EPS);
#pragma unroll
                for (int i = 0; i < 8; ++i) {
                    const f32x4 g = *(const f32x4*)(g2 + 256 * i + 4 * lane);
                    f32x4 o;
#pragma unroll
                    for (int c = 0; c < 4; ++c) o[c] = xv[i][c] * r * g[c];
                    *(f32x4*)(hn + tl * 2048 + 256 * i + 4 * lane) = o;
                }
            }
            __syncthreads();
            {
                const int e = tid & 31, dsl = tid >> 5;
                float acc[8];
#pragma unroll
                for (int k = 0; k < 8; ++k) acc[k] = 0.f;
#pragma unroll 1
                for (int d16 = 0; d16 < 8; ++d16) {
                    float w[16];
#pragma unroll
                    for (int q = 0; q < 16; ++q) w[q] = rw[(dsl * 128 + d16 * 16 + q) * 32 + e];
#pragma unroll
                    for (int q4 = 0; q4 < 4; ++q4) {
                        const int d = dsl * 128 + d16 * 16 + q4 * 4;
#pragma unroll
                        for (int k = 0; k < 8; ++k) {
                            const f32x4 hv = *(const f32x4*)(hn + k * 2048 + d);
                            acc[k] += hv[0] * w[q4 * 4] + hv[1] * w[q4 * 4 + 1] + hv[2] * w[q4 * 4 + 2] + hv[3] * w[q4 * 4 + 3];
                        }
                    }
                }
#pragma unroll
                for (int k = 0; k < 8; ++k) { acc[k] += __shfl_xor(acc[k], 32); }
                if (lane < 32) {
#pragma unroll
                    for (int k = 0; k < 8; ++k) red[(wid * 8 + k) * 32 + e] = acc[k];
                }
            }
            __syncthreads();
            if (tid < 256) {
                const int k = tid >> 5, e = tid & 31;
                float s = rb[e];
#pragma unroll
                for (int w = 0; w < 8; ++w) s += red[(w * 8 + k) * 32 + e];
                lg[k * 32 + e] = s;
            }
            __syncthreads();
            {
                const int tok = tok0 + wid, e = lane & 31;
                float x = lg[wid * 32 + e];
                float v[4]; int id[4];
#pragma unroll
                for (int j = 0; j < 4; ++j) {
                    float bv = x; int bi = e;
#pragma unroll
                    for (int o = 16; o >= 1; o >>= 1) {
                        const float ov = __shfl_xor(bv, o); const int oi = __shfl_xor(bi, o);
                        if (ov > bv || (ov == bv && oi < bi)) { bv = ov; bi = oi; }
                    }
                    v[j] = bv; id[j] = bi;
                    if (e == bi) x = -3.0e38f;
                }
                float ex[4], sum = 0.f;
#pragma unroll
                for (int j = 0; j < 4; ++j) { ex[j] = __expf(v[j] - v[0]); sum += ex[j]; }
                const float inv = 1.0f / sum;
                int ri = 0;
                if (lane < 4) {
                    const int myid = lane == 0 ? id[0] : lane == 1 ? id[1] : lane == 2 ? id[2] : id[3];
                    const float myg = (lane == 0 ? ex[0] : lane == 1 ? ex[1] : lane == 2 ? ex[2] : ex[3]) * inv;
                    const int slot = atomicAdd(&CNT[myid], 1);
                    ri = myid * CAP + slot;
                    LTOK[ri] = tok;
                    LGATE[ri] = myg;
                    TSLOT[tok * 4 + lane] = ri;
                }
                {
                    unsigned char* XG = a.ws + WS_XG;
                    const int r0 = __builtin_amdgcn_readlane(ri, 0), r1 = __builtin_amdgcn_readlane(ri, 1), r2 = __builtin_amdgcn_readlane(ri, 2), r3 = __builtin_amdgcn_readlane(ri, 3);
#pragma unroll
                    for (int i = 0; i < 8; ++i) {
                        const f32x4 o = *(const f32x4*)(hn + wid * 2048 + 256 * i + 4 * lane);
                        const unsigned pk = cvt4_fp8(o[0] * 16.f, o[1] * 16.f, o[2] * 16.f, o[3] * 16.f);
                        const size_t co = 256 * i + 4 * lane;
                        *(unsigned*)(XG + (size_t)r0 * D + co) = pk; *(unsigned*)(XG + (size_t)r1 * D + co) = pk;
                        *(unsigned*)(XG + (size_t)r2 * D + co) = pk; *(unsigned*)(XG + (size_t)r3 * D + co) = pk;
                    }
                }
            }
        }
    }
}

struct MoeTab { int cnt[32]; int off[33]; int ord[32]; int xe[4]; int xub[5]; };
DEVI void moe_tables(const Args& a, MoeTab* tb, int tid, int ntn) {
    __syncthreads();
    if (tid < 32) tb->cnt[tid] = ((const int*)(a.ws + WS_CNT))[tid];
    __syncthreads();
    if (tid < 32) {
        const int me = (tb->cnt[tid] + 255) >> 8;
        int rank = 0, o = 0;
        for (int k = 0; k < 32; ++k) {
            const int c = tb->cnt[k], mk = (c + 255) >> 8;
            rank += (mk > me || (mk == me && k < tid)) ? 1 : 0;
            o += (k < tid) ? c : 0;
        }
        tb->ord[rank] = tid; tb->off[tid] = o;
        if (tid == 31) tb->off[32] = o + tb->cnt[31];
    }
    __syncthreads();
    if (tid == 0) {
        const int xcd = blockIdx.x & 7;
        int ub = 0;
        for (int r = 0; r < 4; ++r) {
            const int e = tb->ord[r * 8 + ((r & 1) ? 7 - xcd : xcd)];
            tb->xe[r] = e; tb->xub[r] = ub;
            ub += ((tb->cnt[e] + 255) >> 8) * ntn;
        }
        tb->xub[4] = ub;
    }
    __syncthreads();
}

struct MoeUnit { int e, nt, r0, rows, grow0, cnt; };
DEVI MoeUnit moe_decode(const MoeTab* tb, int u) {
    int k = 0;
    for (int q = 1; q < 4; ++q) if (u >= tb->xub[q]) k = q;
    MoeUnit d; d.e = tb->xe[k];
    d.cnt = tb->cnt[d.e];
    const int mte = (d.cnt + 255) >> 8, ul = u - tb->xub[k];
    d.nt = ul / mte; const int mi = ul - d.nt * mte;
    d.r0 = mi * 256; d.rows = min(256, d.cnt - d.r0); d.grow0 = tb->off[d.e] + d.r0;
    return d;
}

struct MoeUnit;
namespace pg8 {
struct MU { const char* A; const char* B0; const char* B1; int e, nt, r0, rows, grow0, cnt; };
template <int SCALE_A, int SCALE_B, class Epi, class Sched>
DEVI void f8_gemm_phase(PG8_LAS unsigned char* lds, const Sched& S, const Epi& E) {
    const int tid = threadIdx.x, wid = __builtin_amdgcn_readfirstlane(tid >> 6), lane = tid & 63, wr = wid >> 2, wc = wid & 3, fr = lane & 15, fq = lane >> 4;
    constexpr int nt = 16;
    unsigned voffA[2], voffB[2];
#pragma unroll
    for (int i = 0; i < 2; ++i) { int R, C; stage_rc(tid * 16 + i * 8192, R, C); voffA[i] = (unsigned)(R * 1024 + C) * 2u;
        const int L = wid * 1024 + i * 8192 + lane * 16, q = L >> 9, p0 = (lane & 31) * 4, pu = (p0 - 16 * ((q >> 2) & 3)) & 127;
        voffB[i] = (unsigned)(q * 512 + ((pu & ~31) + perm32(pu & 31)) * 4); }
    const size_t kstep = 128, bstep = 16384, hstep = (size_t)HALF * 2048;
    const unsigned ldsw = (unsigned)wid * 1024u;
    const int aoff = lds_byte(wr * 64 + fr, fq * 8);
    int boffn[2];
#pragma unroll
    for (int n = 0; n < 2; ++n) boffn[n] = (4 * fq) * 512 + ((wc * 32 + 16 * n + fr + 16 * fq) & 127) * 4;
#define PG8_SA(b, h) (((b) * 2 + (h)) * HTB)
#define PG8_SB(b, h) ((4 + (b) * 2 + (h)) * HTB)
#define PG8_STAGE(bufoff, gbase, voff) do { _Pragma("unroll") for (int _i = 0; _i < 2; ++_i) \
        __builtin_amdgcn_global_load_lds((const unsigned*)((const char*)(gbase) + (voff)[_i]), (PG8_LAS unsigned*)(lds + (bufoff) + ldsw + _i * 8192), 16, 0, 0); } while (0)
#define PG8_LDA(dst, b, h) do { _Pragma("unroll") for (int m = 0; m < 4; ++m) { const i32x4 _x = *(const PG8_LAS i32x4*)(lds + PG8_SA(b, h) + aoff + m * 2048), _y = *(const PG8_LAS i32x4*)(lds + PG8_SA(b, h) + aoff + m * 2048 + 1024); \
        dst[m][0] = _x[0]; dst[m][1] = _x[1]; dst[m][2] = _x[2]; dst[m][3] = _x[3]; dst[m][4] = _y[0]; dst[m][5] = _y[1]; dst[m][6] = _y[2]; dst[m][7] = _y[3]; } } while (0)
#define PG8_LDB(dst, b, h) do { _Pragma("unroll") for (int n = 0; n < 2; ++n) _Pragma("unroll") for (int d = 0; d < 8; ++d) dst[n][d] = *(const PG8_LAS int*)(lds + PG8_SB(b, h) + boffn[n] + (d & 3) * 512 + (d >> 2) * 8192); } while (0)
#define PG8_MMA(ai, bj, At, Bt) do { __builtin_amdgcn_s_setprio(1); _Pragma("unroll") for (int m = 0; m < 4; ++m) _Pragma("unroll") for (int n = 0; n < 2; ++n) \
        acc[ai][bj][m][n] = __builtin_amdgcn_mfma_scale_f32_16x16x128_f8f6f4(Bt[n], At[m], acc[ai][bj][m][n], 0, 0, 0, SCALE_B, 0, SCALE_A); __builtin_amdgcn_s_setprio(0); } while (0)
#define PG8_WAIT_V(n) asm volatile("s_waitcnt vmcnt(" #n ")" ::: "memory")
#define PG8_WAIT_L(n) asm volatile("s_waitcnt lgkmcnt(" #n ")" ::: "memory")
#define PG8_BAR __builtin_amdgcn_s_barrier()
#define PG8_SCHED __builtin_amdgcn_sched_barrier(0)
#define PG8_ZERO() do { _Pragma("unroll") for (int a_ = 0; a_ < 2; ++a_) _Pragma("unroll") for (int b_ = 0; b_ < 2; ++b_) _Pragma("unroll") for (int m_ = 0; m_ < 4; ++m_) _Pragma("unroll") for (int n_ = 0; n_ < 2; ++n_) \
        acc[a_][b_][m_][n_] = (f32x4){0.f, 0.f, 0.f, 0.f}; } while (0)
    MU cur, nxt; int ui = 0;
    if (!S.next(0, cur)) return;
    f32x4 acc[2][2][4][2];
    PG8_ZERO();
    i32x8 At[4], B0[2], B1[2];
    const char* cA = cur.A; const char* cB0 = cur.B0; const char* cB1 = cur.B1;
    PG8_STAGE(PG8_SB(0, 0), cB0, voffB); PG8_STAGE(PG8_SA(0, 0), cA, voffA); PG8_STAGE(PG8_SB(0, 1), cB1, voffB); PG8_STAGE(PG8_SA(0, 1), cA + hstep, voffA);
    if (wr == 1) PG8_BAR;
    PG8_WAIT_V(4); PG8_BAR;
    PG8_STAGE(PG8_SB(1, 0), cB0 + bstep, voffB); PG8_STAGE(PG8_SA(1, 0), cA + kstep, voffA); PG8_STAGE(PG8_SB(1, 1), cB1 + bstep, voffB);
    PG8_WAIT_V(6); PG8_BAR;
    for (;;) {
        const bool has_next = S.next(ui + 1, nxt);
        const char* nA = has_next ? nxt.A : cA; const char* nB0 = has_next ? nxt.B0 : cB0; const char* nB1 = has_next ? nxt.B1 : cB1;
#pragma unroll 1
        for (int t = 0; t < nt; t += 2) {
            const bool last = (t == nt - 2);
            const char* a1 = cA + (size_t)(t + 1) * kstep;
            const char* a2 = last ? nA : cA + (size_t)(t + 2) * kstep;
            const char* b20 = last ? nB0 : cB0 + (size_t)(t + 2) * bstep; const char* b21 = last ? nB1 : cB1 + (size_t)(t + 2) * bstep;
            const char* a3 = a2 + kstep; const char* b30 = b20 + bstep; const char* b31 = b21 + bstep;
            PG8_LDB(B0, 0, 0); PG8_SCHED; PG8_LDA(At, 0, 0); PG8_STAGE(PG8_SA(1, 1), a1 + hstep, voffA);
            PG8_WAIT_L(8); PG8_BAR; PG8_WAIT_L(0); PG8_MMA(0, 0, At, B0); PG8_BAR; PG8_SCHED;
            PG8_LDB(B1, 0, 1); PG8_STAGE(PG8_SB(0, 0), b20, voffB);
            PG8_BAR; PG8_WAIT_L(0); PG8_MMA(0, 1, At, B1); PG8_BAR;
            PG8_LDA(At, 0, 1); PG8_STAGE(PG8_SA(0, 0), a2, voffA);
            PG8_BAR; PG8_WAIT_L(0); PG8_MMA(1, 0, At, B0); PG8_BAR; PG8_SCHED;
            PG8_STAGE(PG8_SB(0, 1), b21, voffB);
            PG8_WAIT_V(6); PG8_BAR; PG8_MMA(1, 1, At, B1); PG8_BAR;
            PG8_LDB(B0, 1, 0); PG8_SCHED; PG8_LDA(At, 1, 0); PG8_STAGE(PG8_SA(0, 1), a2 + hstep, voffA);
            PG8_WAIT_L(8); PG8_BAR; PG8_WAIT_L(0); PG8_MMA(0, 0, At, B0); PG8_BAR; PG8_SCHED;
            PG8_LDB(B1, 1, 1); PG8_STAGE(PG8_SB(1, 0), b30, voffB);
            PG8_BAR; PG8_WAIT_L(0); PG8_MMA(0, 1, At, B1); PG8_BAR;
            PG8_LDA(At, 1, 1); PG8_STAGE(PG8_SA(1, 0), a3, voffA);
            PG8_BAR; PG8_WAIT_L(0); PG8_MMA(1, 0, At, B0); PG8_BAR; PG8_SCHED;
            PG8_STAGE(PG8_SB(1, 1), b31, voffB);
            PG8_WAIT_V(6); PG8_BAR; PG8_MMA(1, 1, At, B1); PG8_BAR;
        }
        E(acc, cur, wr, wc, fr, fq);
        if (!has_next) break;
        PG8_ZERO();
        cur = nxt; cA = nA; cB0 = nB0; cB1 = nB1; ++ui;
    }
    PG8_WAIT_V(0);
    if (wr == 0) PG8_BAR;
    PG8_BAR;
#undef PG8_SA
#undef PG8_SB
#undef PG8_STAGE
#undef PG8_LDA
#undef PG8_LDB
#undef PG8_MMA
#undef PG8_WAIT_V
#undef PG8_WAIT_L
#undef PG8_BAR
#undef PG8_SCHED
#undef PG8_ZERO
}
}

struct MoeSched {
    const MoeTab* tb; int nun, nper, u0; const char* Ab; const char* Wb; bool first;
    DEVI bool next(int i, pg8::MU& m) const {
        const int u = u0 + i * nper; if (u >= nun) return false;
        const MoeUnit d = moe_decode(tb, u);
        m.e = __builtin_amdgcn_readfirstlane(d.e); m.nt = __builtin_amdgcn_readfirstlane(d.nt); m.r0 = __builtin_amdgcn_readfirstlane(d.r0);
        m.rows = __builtin_amdgcn_readfirstlane(d.rows); m.grow0 = __builtin_amdgcn_readfirstlane(d.grow0); m.cnt = __builtin_amdgcn_readfirstlane(d.cnt);
        if (first) { m.A = Ab + ((size_t)m.e * CAP + m.r0) * D;
            m.B0 = Wb + (size_t)((m.e * 32 + m.nt) * 512) * 512; m.B1 = m.B0 + (size_t)(16 * 512) * 512; }
        else { m.A = Ab + (size_t)m.grow0 * FF;
            m.B0 = Wb + (size_t)((m.e * 16 + m.nt * 2) * 512) * 512; m.B1 = m.B0 + (size_t)512 * 512; }
        return true;
    }
};
struct EpiMoe1 {
    unsigned char* ACT; const float* b1;
    DEVI void operator()(f32x4 (&acc)[2][2][4][2], const pg8::MU& u, int wr, int wc, int fr, int fq) const {
        const float* bb = b1 + (size_t)u.e * 4096 + u.nt * 128 + wc * 32 + 8 * fq;
        f32x4 bg[2], bl[2];
#pragma unroll
        for (int n = 0; n < 2; ++n) { bg[n] = *(const f32x4*)(bb + 4 * n); bl[n] = *(const f32x4*)(bb + 2048 + 4 * n); }
#pragma unroll
        for (int ai = 0; ai < 2; ++ai)
#pragma unroll
            for (int m = 0; m < 4; ++m) {
                const int row = ai * 128 + wr * 64 + m * 16 + fr;
                const int orow = (row < u.rows) ? u.grow0 + row : T * 4 + row;
                unsigned w[2];
#pragma unroll
                for (int n = 0; n < 2; ++n) {
                    float av[4];
#pragma unroll
                    for (int i = 0; i < 4; ++i) {
                        const float gl = fminf(acc[ai][0][m][n][i] + bg[n][i], 7.0f);
                        const float ln = fminf(fmaxf(acc[ai][1][m][n][i] + bl[n][i], -7.0f), 7.0f);
                        av[i] = gl * sigmoidf_(1.702f * gl) * (ln + 1.0f) * 4.0f;
                    }
                    w[n] = cvt4_fp8(av[0], av[1], av[2], av[3]);
                }
                uint2 pk; pk.x = w[0]; pk.y = w[1];
                *(uint2*)(ACT + (size_t)orow * FF + u.nt * 128 + wc * 32 + 8 * fq) = pk;
            }
    }
};
struct EpiMoe2 {
    u16* Y; const float* b2; const float* LGATE;
    DEVI void operator()(f32x4 (&acc)[2][2][4][2], const pg8::MU& u, int wr, int wc, int fr, int fq) const {
        const float* bb = b2 + (size_t)u.e * D + u.nt * 256 + wc * 32 + 8 * fq;
        f32x4 bv[2][2];
#pragma unroll
        for (int bj = 0; bj < 2; ++bj)
#pragma unroll
            for (int n = 0; n < 2; ++n) bv[bj][n] = *(const f32x4*)(bb + bj * 128 + 4 * n);
#pragma unroll
        for (int ai = 0; ai < 2; ++ai)
#pragma unroll
            for (int m = 0; m < 4; ++m) {
                const int row = ai * 128 + wr * 64 + m * 16 + fr;
                const float gt = LGATE[u.e * CAP + u.r0 + min(row, u.rows - 1)];
                const int orow = (row < u.rows) ? u.grow0 + row : T * 4 + row;
                u16* dst = Y + (size_t)orow * D + u.nt * 256 + wc * 32 + 8 * fq;
#pragma unroll
                for (int bj = 0; bj < 2; ++bj) {
                    const f32x4 v0 = acc[ai][bj][m][0] + bv[bj][0], v1 = acc[ai][bj][m][1] + bv[bj][1];
                    uint4 pk; pk.x = pack2(v0[0] * gt, v0[1] * gt); pk.y = pack2(v0[2] * gt, v0[3] * gt); pk.z = pack2(v1[0] * gt, v1[1] * gt); pk.w = pack2(v1[2] * gt, v1[3] * gt);
                    *(uint4*)(dst + bj * 128) = pk;
                }
            }
    }
};
DEVI void phase8(const Args& a, char* lds, MoeTab* tb, int tid, int wid, int lane) {
    extern __shared__ __attribute__((aligned(16))) char smem_pg8[];
    moe_tables(a, tb, tid, 16);
    const int nun = tb->xub[4], nper = gridDim.x >> 3;
    const int u = blockIdx.x >> 3;
    const int cpos = (blockIdx.x >> 3) % 3, c_lo = 16384 + blockIdx.x * 24, c_hi = c_lo + 24;
    if (cpos == 0 || u >= nun) convert_range(a, lds, c_lo, c_hi, tid, wid, lane);
    if (u < nun) {
        MoeSched S; S.tb = tb; S.nun = nun; S.nper = nper; S.u0 = u; S.Ab = (const char*)(a.ws + WS_XG); S.Wb = (const char*)(a.ws + WS_W1T); S.first = true;
        EpiMoe1 E; E.ACT = a.ws + WS_ACT; E.b1 = a.in[22];
        pg8::f8_gemm_phase<0x7b7b7b7b, 0x77777777>((PG8_LAS unsigned char*)(smem_pg8 + 1024), S, E);
        if (cpos != 0) convert_range(a, lds, c_lo, c_hi, tid, wid, lane);
    }
    convert_pool(a, lds, 3, 22528, 24576, tid, wid, lane);
}

DEVI void phase9(const Args& a, char* lds, MoeTab* tb, int tid, int wid, int lane) {
    extern __shared__ __attribute__((aligned(16))) char smem_pg8[];
    moe_tables(a, tb, tid, 8);
    const int nun = tb->xub[4], nper = gridDim.x >> 3;
    const int u = blockIdx.x >> 3;
    if (u >= nun) return;
    MoeSched S; S.tb = tb; S.nun = nun; S.nper = nper; S.u0 = u; S.Ab = (const char*)(a.ws + WS_ACT); S.Wb = (const char*)(a.ws + WS_W2T); S.first = false;
    EpiMoe2 E; E.Y = (u16*)(a.ws + WS_Y); E.b2 = a.in[24]; E.LGATE = (const float*)(a.ws + WS_LGATE);
    pg8::f8_gemm_phase<0x7d7d7d7d, 0x77777777>((PG8_LAS unsigned char*)(smem_pg8 + 1024), S, E);
}

DEVI void phase10(const Args& a, MoeTab* tb, int tid, int wid, int lane) {
    const float* H1 = (const float*)(a.ws + WS_H1); const u16* Y = (const u16*)(a.ws + WS_Y); const int* TSLOT = (const int*)(a.ws + WS_TSLOT);
    const float* fg = a.in[25];
    moe_tables(a, tb, tid, 8);
    for (int tok = blockIdx.x * 8 + wid; tok < T; tok += gridDim.x * 8) {
        int rowi[4];
#pragma unroll
        for (int j = 0; j < 4; ++j) { const int ts = TSLOT[tok * 4 + j]; rowi[j] = tb->off[ts >> 13] + (ts & (CAP - 1)); }
        f32x4 hv[8]; float ss = 0.f;
#pragma unroll
        for (int i = 0; i < 8; ++i) {
            hv[i] = *(const f32x4*)(H1 + (size_t)tok * D + 256 * i + 4 * lane);
#pragma unroll
            for (int j = 0; j < 4; ++j) {
                const uint2 yv = *(const uint2*)(Y + (size_t)rowi[j] * D + 256 * i + 4 * lane);
                hv[i][0] += bflo(yv.x); hv[i][1] += bfhi(yv.x); hv[i][2] += bflo(yv.y); hv[i][3] += bfhi(yv.y);
            }
#pragma unroll
            for (int c = 0; c < 4; ++c) ss += hv[i][c] * hv[i][c];
        }
        ss = wave_sum(ss);
        const float r = rsqrtf(ss * (1.0f / D) + EPS);
#pragma unroll
        for (int i = 0; i < 8; ++i) {
            const f32x4 g = *(const f32x4*)(fg + 256 * i + 4 * lane);
            f32x4 o;
#pragma unroll
            for (int c = 0; c < 4; ++c) o[c] = hv[i][c] * r * g[c];
            *(f32x4*)(a.out + (size_t)tok * D + 256 * i + 4 * lane) = o;
        }
    }
}

constexpr int NPHASE = 11;
__global__ void __launch_bounds__(512, 2) mega_fwd(Args a) {
    extern __shared__ __attribute__((aligned(1024))) char smem[];
    const int wid_s = __builtin_amdgcn_readfirstlane((int)threadIdx.x >> 6);
    if (threadIdx.x == 0) *(uint4*)smem = make_uint4(0u, 0u, 0u, 0u);
    __syncthreads();
    XcdBarrier bar = xcd_barrier_post((unsigned*)(a.ws + WS_BAR), (volatile LAS unsigned*)smem);
    char* lds = smem + LDS_BASE;
    MoeTab* tb = (MoeTab*)(smem + 64);
#ifndef REP_MASK
#define REP_MASK 0
#endif
#define PHASE(k, call) if (a.ph_lo <= (k) && (k) < a.ph_hi) { if (a.ph_lo < (k)) xcd_barrier(bar); \
        int lane = (int)__builtin_amdgcn_mbcnt_hi(~0u, __builtin_amdgcn_mbcnt_lo(~0u, 0u)); asm volatile("" : "+v"(lane)); \
        const int wid = wid_s, tid = wid_s * 64 + lane; \
        call; if ((REP_MASK >> (k)) & 1) { __syncthreads(); call; } }
    PHASE(0, phase0(a, lds, tid, wid, lane))
    PHASE(1, phase1(a, lds, tid, wid, lane))
    PHASE(2, phase2(a, lds, tid, wid, lane))
    PHASE(3, phase3(a, tid))
    PHASE(4, phase4(a, lds, tid, wid, lane))
    PHASE(5, phase5(a, lds, tid, wid, lane))
    PHASE(6, phase6(a, lds, tid, wid, lane))
    PHASE(7, phase7(a, lds, tid, wid, lane))
    PHASE(8, phase8(a, lds, tb, tid, wid, lane))
    PHASE(9, phase9(a, lds, tb, tid, wid, lane))
    PHASE(10, phase10(a, tb, tid, wid, lane))
#undef PHASE
}

extern "C" void kernel_launch(void* const* d_in, const int* in_sizes, int n_in, void* d_out, int out_size, void* d_ws, size_t ws_size, hipStream_t stream) {
    static int grid = 0;
    if (grid == 0) {
        if (n_in != 26 || out_size != T * D || ws_size < WS_END) { fprintf(stderr, "kernel_launch: unexpected shapes (n_in %d out %d ws %zu need %zu)\n", n_in, out_size, ws_size, (size_t)WS_END); grid = -1; return; }
        int dev = 0, cus = 0, per_cu = 0;
        if (hipGetDevice(&dev) != hipSuccess || hipDeviceGetAttribute(&cus, hipDeviceAttributeMultiprocessorCount, dev) != hipSuccess) { grid = -1; return; }
        if (hipFuncSetAttribute((const void*)mega_fwd, hipFuncAttributeMaxDynamicSharedMemorySize, LDS_BYTES) != hipSuccess) { fprintf(stderr, "kernel_launch: hipFuncSetAttribute failed\n"); grid = -1; return; }
        if (hipOccupancyMaxActiveBlocksPerMultiprocessor(&per_cu, (const void*)mega_fwd, 512, LDS_BYTES) != hipSuccess || per_cu < 1)
            fprintf(stderr, "kernel_launch: occupancy query reports %d blocks per CU\n", per_cu);
        (void)hipGetLastError();
        grid = cus;
    }
    if (grid < 0) return;
    Args a{};
    for (int i = 0; i < 26; ++i) a.in[i] = (const float*)d_in[i];
    a.out = (float*)d_out; a.ws = (unsigned char*)d_ws;
#if N_LAUNCH_SPLIT
    for (int k = 0; k < NPHASE; ++k) {
        (void)hipMemsetAsync((char*)d_ws + WS_BAR, 0, XCD_BAR_WORDS * sizeof(unsigned), stream);
        a.ph_lo = k; a.ph_hi = k + 1;
        hipLaunchKernelGGL(mega_fwd, dim3(grid), dim3(512), LDS_BYTES, stream, a);
    }
#else
    (void)hipMemsetAsync((char*)d_ws + WS_BAR, 0, XCD_BAR_WORDS * sizeof(unsigned), stream);
    a.ph_lo = 0; a.ph_hi = NPHASE;
    hipLaunchKernelGGL(mega_fwd, dim3(grid), dim3(512), LDS_BYTES, stream, a);
#endif
}
```

```cpp
#include <hip/hip_runtime.h>
#include <hip/hip_bf16.h>
#include <stdint.h>
#include <stdio.h>

#ifndef N_LAUNCH_SPLIT
#define N_LAUNCH_SPLIT 0
#endif

#define DEVI __device__ __forceinline__
typedef __attribute__((ext_vector_type(8))) short bf16x8;
typedef __attribute__((ext_vector_type(4))) float f32x4;
typedef __attribute__((ext_vector_type(4))) int i32x4;
typedef __attribute__((ext_vector_type(2))) float f2v;
typedef __attribute__((ext_vector_type(2))) __bf16 b2v;
typedef unsigned short u16;

constexpr int T = 8192, D = 2048, PW = 4112;
constexpr int NH = 4, HK = 128, HV = 256, CH = 64, NCH = 128, RANK = 16;
constexpr int SW = 1024, SG = 16, NG = 64, SP = 64;
constexpr int NE = 32, FF = 2048, CAP = 8192;
constexpr int PJ = 4096;
constexpr float EPS = 1e-6f;

constexpr size_t WS_BAR   = 0;
constexpr size_t WS_CNT   = 32768;
constexpr size_t WS_SSQ   = 65536;
constexpr size_t WS_GLR   = WS_SSQ + 65536;
constexpr size_t WS_DEC   = WS_GLR + (size_t)T * 16 * 4;
constexpr size_t WS_S5AL  = WS_DEC + (size_t)NCH * NH * HK * 4;
constexpr size_t WS_TSLOT = WS_S5AL + 65536;
constexpr size_t WS_LTOK  = WS_TSLOT + (size_t)T * 4 * 4;
constexpr size_t WS_LGATE = WS_LTOK + (size_t)NE * CAP * 4;
constexpr size_t WS_S5K   = WS_LGATE + (size_t)NE * CAP * 4;
constexpr size_t WS_S5WE  = WS_S5K + (size_t)NG * 64 * 256 * 2;
constexpr size_t WS_S5V   = WS_S5WE + (size_t)NG * 128 * 1024 * 2;
constexpr size_t WS_S5E   = WS_S5V + (size_t)NG * 1024 * 128 * 2;
constexpr size_t WS_S5H   = WS_S5E + (size_t)NG * 128 * 128 * 4;
constexpr size_t WS_HN    = WS_S5H + (size_t)NG * 128 * 128 * 2;
constexpr size_t WS_PROJ  = WS_HN + (size_t)T * D * 2;
constexpr size_t WS_KV    = WS_PROJ + (size_t)T * PJ * 2;
constexpr size_t WS_ST    = WS_KV + (size_t)NCH * NH * HV * HK * 4;
constexpr size_t WS_Z     = WS_ST + (size_t)NCH * NH * HV * HK * 2;
constexpr size_t WS_MIX   = WS_Z + (size_t)T * SW * 2;
constexpr size_t WS_H1    = WS_MIX + (size_t)T * D * 2;
constexpr size_t WS_HN2   = WS_H1 + (size_t)T * D * 4;
constexpr size_t WS_ACT   = WS_HN2 + (size_t)T * D * 2;
constexpr size_t WS_Y     = WS_ACT + (size_t)(T * 4 + 256) * FF * 2;
constexpr size_t WS_W1T   = WS_Y + (size_t)(T * 4 + 256) * D * 2;
constexpr size_t WS_W2T   = WS_W1T + (size_t)NE * 4096 * D;
constexpr size_t WS_WINT  = WS_W2T + (size_t)NE * D * FF;
constexpr size_t WS_GLUT  = WS_WINT + (size_t)PJ * D * 2;
constexpr size_t WS_WOUTT = WS_GLUT + (size_t)SW * SW * 2;
constexpr size_t WS_XG    = WS_WOUTT + (size_t)D * D * 2;
constexpr size_t WS_END   = WS_XG + (size_t)NE * 8192 * D;

constexpr int LDS_BYTES = 163840;
constexpr int LDS_CONV = 131072;
constexpr int LDS_BASE = 1024;

DEVI unsigned pack2(float a, float b) { f2v v = {a, b}; b2v r = __builtin_convertvector(v, b2v); return __builtin_bit_cast(unsigned, r); }
DEVI u16 f2bf(float a) { __bf16 r = (__bf16)a; return __builtin_bit_cast(u16, r); }
DEVI float bf2f(u16 h) { return __uint_as_float(((unsigned)h) << 16); }
DEVI float bflo(unsigned w) { return __uint_as_float(w << 16); }
DEVI float bfhi(unsigned w) { return __uint_as_float(w & 0xffff0000u); }
DEVI float wave_sum(float v) {
#pragma unroll
    for (int o = 32; o >= 1; o >>= 1) v += __shfl_xor(v, o);
    return v;
}
DEVI float sum16(float v) {
#pragma unroll
    for (int o = 8; o >= 1; o >>= 1) v += __shfl_xor(v, o);
    return v;
}
DEVI float sigmoidf_(float x) { return __builtin_amdgcn_rcpf(1.0f + __expf(-x)); }
DEVI float logsigmoid_(float x) { return fminf(x, 0.0f) - __logf(1.0f + __expf(-fabsf(x))); }
DEVI float gelu_tanh(float x) {
    const float a = 0.7978845608028654f * (x + 0.044715f * x * x * x);
    return x * __builtin_amdgcn_rcpf(1.0f + __expf(-2.0f * a));
}

#define WAIT_V0() asm volatile("s_waitcnt vmcnt(0)" ::: "memory")
#define WAIT_L0() asm volatile("s_waitcnt lgkmcnt(0)" ::: "memory")

#define XB_TMO      128
#define XB_XCNT(j)  (256  + 64 * (j))
#define XB_XSUB(j)  (1280 + 64 * (j))
#define XB_XGEN(j)  (2304 + 64 * (j))
#define XB_TOP      3328
#define XB_TOPGEN   3392
#define XCD_BAR_WORDS 3456
#define XB_SPIN_CAP (1u << 20)
#define LAS __attribute__((address_space(3)))

DEVI unsigned xb_ld(unsigned* p)              { return __hip_atomic_load(p, __ATOMIC_RELAXED, __HIP_MEMORY_SCOPE_AGENT); }
DEVI unsigned xb_add(unsigned* p, unsigned v) { return __hip_atomic_fetch_add(p, v, __ATOMIC_RELAXED, __HIP_MEMORY_SCOPE_AGENT); }
DEVI unsigned xb_xcc_id() { return (unsigned)__builtin_amdgcn_s_getreg((3 << 11) | 20) & 0xFu; }
#define XB_SPIN(cond, bar) do { unsigned _sp = 0; while (cond) { __builtin_amdgcn_s_sleep(1); \
    if ((++_sp & 255u) == 0u) { if (xb_ld(&(bar)[XB_TMO])) break; if (_sp > XB_SPIN_CAP) { atomicAdd(&(bar)[XB_TMO], 1u); break; } } } } while (0)

struct XcdBarrier { unsigned* bar; unsigned x; volatile LAS unsigned* st; };

DEVI XcdBarrier xcd_barrier_post(unsigned* bar, volatile LAS unsigned* st) {
    XcdBarrier b; b.bar = bar; b.x = xb_xcc_id(); b.st = st;
    if (threadIdx.x == 0) (void)xb_add(&bar[XB_XCNT(b.x)], 1u);
    return b;
}
DEVI void xcd_barrier_complete(unsigned* bar, unsigned x, unsigned& nloc, unsigned& nx) {
    const unsigned G = gridDim.x * gridDim.y * gridDim.z;
    unsigned sum, cnt, mine, sp = 0u;
    for (;;) {
        sum = 0u; cnt = 0u; mine = 0u;
#pragma unroll
        for (unsigned j = 0; j < 16; ++j) { const unsigned c = xb_ld(&bar[XB_XCNT(j)]); sum += c; cnt += (c > 0u) ? 1u : 0u; mine = (j == x) ? c : mine; }
        if (sum == G) break;
        __builtin_amdgcn_s_sleep(1);
        if ((++sp & 255u) == 0u) { if (xb_ld(&bar[XB_TMO])) break; if (sp > XB_SPIN_CAP) { atomicAdd(&bar[XB_TMO], 1u); break; } }
    }
    nloc = mine > 0u ? mine : 1u; nx = cnt > 0u ? cnt : 1u;
}
DEVI void xcd_barrier(const XcdBarrier& b) {
    asm volatile("s_waitcnt vmcnt(0)" ::: "memory");
    __syncthreads();
    if (threadIdx.x == 0) {
        unsigned* bar = b.bar;
        __builtin_amdgcn_s_waitcnt(0);
        unsigned nloc = b.st[0], nx = b.st[1];
        if (nloc == 0u) { xcd_barrier_complete(bar, b.x, nloc, nx); b.st[0] = nloc; b.st[1] = nx; }
        const unsigned old = xb_add(&bar[XB_XSUB(b.x)], 1u);
        const unsigned gen = old / nloc;
        if (old + 1u == (gen + 1u) * nloc) {
            __builtin_amdgcn_fence(__ATOMIC_RELEASE, "agent");
            asm volatile("s_waitcnt vmcnt(0)" ::: "memory");
            const unsigned og = xb_add(&bar[XB_TOP], 1u);
            const unsigned tg = og / nx;
            if (og + 1u == (tg + 1u) * nx) xb_add(&bar[XB_TOPGEN], 1u);
            else XB_SPIN(xb_ld(&bar[XB_TOPGEN]) == tg, bar);
            __builtin_amdgcn_fence(__ATOMIC_ACQUIRE, "agent");
            xb_add(&bar[XB_XGEN(b.x)], 1u);
            asm volatile("s_waitcnt vmcnt(0)" ::: "memory");
        } else {
            XB_SPIN(xb_ld(&bar[XB_XGEN(b.x)]) == gen, bar);
            __builtin_amdgcn_fence(__ATOMIC_ACQUIRE, "agent");
            asm volatile("s_waitcnt vmcnt(0)" ::: "memory");
        }
    }
    __syncthreads();
}

struct Args {
    const float* in[26];
    float* out;
    unsigned char* ws;
    int ph_lo, ph_hi;
};

template <int KS> DEVI int lds_byte(int r, int c) {
    int st = (r >> 4) * KS + (c >> 5), ob = (r & 15) * 64 + (c & 31) * 2;
    return st * 1024 + (ob ^ (((ob >> 9) & 1) << 5));
}
typedef __attribute__((ext_vector_type(16))) float f32x16;
typedef __attribute__((ext_vector_type(8))) int i32x8;
DEVI void f8_stage_rb(int wid, int lane, int i, int& R, int& CB) {
    R = wid * 16 + i * 128 + (lane >> 2);
    CB = (((lane & 3) ^ (R >> 2)) & 3) * 16;
}
DEVI int acc_row32(int wr, int m, int r, int lane) { return wr * 128 + m * 32 + (r & 3) + 8 * (r >> 2) + 4 * (lane >> 5); }
DEVI unsigned cvt4_fp8(float a, float b, float c, float d) {
    int r = 0;
    r = __builtin_amdgcn_cvt_pk_fp8_f32(a, b, r, false);
    r = __builtin_amdgcn_cvt_pk_fp8_f32(c, d, r, true);
    return (unsigned)r;
}
#define WAIT_VN(n) asm volatile("s_waitcnt vmcnt(" #n ")" ::: "memory")
DEVI void f8_stage(char* lds, const unsigned char* __restrict__ A, const unsigned (&aoff)[2], const unsigned char* __restrict__ B, const unsigned (&boffv)[2], int wid, int t) {
    char* sb = lds + (t & 3) * 32768 + wid * 1024;
#pragma unroll
    for (int i = 0; i < 2; ++i) {
        __builtin_amdgcn_global_load_lds((const unsigned*)(A + aoff[i] + t * 64), (LAS unsigned*)(sb + i * 8192), 16, 0, 0);
        __builtin_amdgcn_global_load_lds((const unsigned*)(B + boffv[i] + t * 64), (LAS unsigned*)(sb + 16384 + i * 8192), 16, 0, 0);
    }
}
DEVI void f8_prefetch(char* lds, const unsigned char* __restrict__ A, const unsigned (&aoff)[2], const unsigned char* __restrict__ B, const unsigned (&boffv)[2], int wid) {
    f8_stage(lds, A, aoff, B, boffv, wid, 0); f8_stage(lds, A, aoff, B, boffv, wid, 1); f8_stage(lds, A, aoff, B, boffv, wid, 2);
}
DEVI void q8_stage(char* lds, const unsigned char* __restrict__ A, const unsigned (&aoff)[2], const unsigned char* __restrict__ B, const unsigned (&boffv)[2], int wid, int t) {
    char* sb = lds + (t & 3) * 32768 + wid * 1024;
#pragma unroll
    for (int i = 0; i < 2; ++i) {
        __builtin_amdgcn_global_load_lds((const unsigned*)(A + aoff[i] + t * 64), (LAS unsigned*)(sb + i * 8192), 16, 0, 0);
        __builtin_amdgcn_global_load_lds((const unsigned*)(B + boffv[i] + t * 8192), (LAS unsigned*)(sb + 16384 + i * 8192), 16, 0, 0);
    }
}
DEVI void q8_prefetch(char* lds, const unsigned char* __restrict__ A, const unsigned (&aoff)[2], const unsigned char* __restrict__ B, const unsigned (&boffv)[2], int wid) {
    q8_stage(lds, A, aoff, B, boffv, wid, 0); q8_stage(lds, A, aoff, B, boffv, wid, 1); q8_stage(lds, A, aoff, B, boffv, wid, 2);
}
template <int NT, int SCALE_A, int SCALE_B, bool MOE1>
DEVI void f8_mainloop(char* lds, const unsigned char* __restrict__ A, const unsigned (&aoff)[2], const unsigned char* __restrict__ B, const unsigned (&boffv)[2],
                      int wid, int lane, f32x16 (&acc)[2][4]) {
    const int wr = wid >> 2, wc = wid & 3, l31 = lane & 31, hh = lane >> 5;
    const int xs = (l31 >> 2) & 3;
    const int p0 = ((2 * hh) ^ xs) << 4, p1 = ((2 * hh + 1) ^ xs) << 4;
    const int a_lo = (wr * 128 + l31) * 64 + p0, a_hi = (wr * 128 + l31) * 64 + p1;
    int b_rd[2];
#pragma unroll
    for (int nf = 0; nf < 2; ++nf) {
        const int ntile = MOE1 ? nf : (wc >> 1), nbase = MOE1 ? wc * 32 : (wc & 1) * 64 + nf * 32;
        b_rd[nf] = 16384 + ntile * 8192 + (8 * hh) * 512 + (nbase + l31) * 4;
    }
    auto ldfrag = [&](const char* sa, int lo, int hi) -> i32x8 {
        const i32x4 x = *(const i32x4*)(sa + lo), y = *(const i32x4*)(sa + hi);
        i32x8 r; r[0] = x[0]; r[1] = x[1]; r[2] = x[2]; r[3] = x[3]; r[4] = y[0]; r[5] = y[1]; r[6] = y[2]; r[7] = y[3];
        return r;
    };
    auto compute = [&](int t) {
        const char* sa = lds + (t & 3) * 32768;
        i32x8 fa[4], fb[2];
#pragma unroll
        for (int m = 0; m < 4; ++m) fa[m] = ldfrag(sa + m * 2048, a_lo, a_hi);
#pragma unroll
        for (int n = 0; n < 2; ++n)
#pragma unroll
            for (int j = 0; j < 8; ++j) fb[n][j] = *(const int*)(sa + b_rd[n] + j * 512);
#pragma unroll
        for (int m = 0; m < 4; ++m)
#pragma unroll
            for (int n = 0; n < 2; ++n)
                acc[n][m] = __builtin_amdgcn_mfma_scale_f32_32x32x64_f8f6f4(fb[n], fa[m], acc[n][m], 0, 0, 0, SCALE_B, 0, SCALE_A);
    };
    WAIT_V0(); __builtin_amdgcn_s_barrier();
#pragma unroll 1
    for (int t = 0; t < NT; ++t) {
        if (t + 3 < NT) q8_stage(lds, A, aoff, B, boffv, wid, t + 3);
        compute(t);
        if (t + 3 < NT) { WAIT_VN(8); } else if (t + 2 < NT) { WAIT_VN(4); } else { WAIT_V0(); }
        WAIT_L0(); __builtin_amdgcn_s_barrier();
    }
}
DEVI void touch4(const f32x4& v) { asm volatile("" :: "v"(v)); }
DEVI void touchf(float v) { asm volatile("" :: "v"(v)); }
DEVI void zero_acc32(f32x16 (&acc)[2][4]) {
#pragma unroll
    for (int n = 0; n < 2; ++n)
#pragma unroll
        for (int m = 0; m < 4; ++m)
#pragma unroll
            for (int r = 0; r < 16; ++r) acc[n][m][r] = 0.f;
}

DEVI void bf_stage_rb(int wid, int lane, int i, int& R, int& CB) {
    R = wid * 16 + i * 128 + (lane >> 2);
    CB = (((lane & 3) ^ (R >> 1)) & 3) * 16;
}
template <int NT>
DEVI void bf_mainloop(char* lds, const unsigned char* __restrict__ A, const unsigned (&aoff)[2], const unsigned char* __restrict__ B, const unsigned (&boffv)[2],
                      int wid, int lane, f32x4 (&acc)[4][8]) {
    const int wr = wid >> 2, wc = wid & 3, l15 = lane & 15, q = lane >> 4;
    const int cp = (q ^ ((l15 >> 1) & 3)) << 4;
    const int t_rd = (wr * 128 + l15) * 64 + cp;
    const int w_rd = 16384 + (wc * 64 + l15) * 64 + cp;
    auto compute = [&](int t) {
        const char* sa = lds + (t & 3) * 32768;
        bf16x8 tf[8], wf[4];
#pragma unroll
        for (int nt = 0; nt < 4; ++nt) wf[nt] = *(const bf16x8*)(sa + w_rd + nt * 1024);
#pragma unroll
        for (int mt = 0; mt < 8; ++mt) tf[mt] = *(const bf16x8*)(sa + t_rd + mt * 1024);
#pragma unroll
        for (int mt = 0; mt < 8; ++mt)
#pragma unroll
            for (int nt = 0; nt < 4; ++nt)
                acc[nt][mt] = __builtin_amdgcn_mfma_f32_16x16x32_bf16(wf[nt], tf[mt], acc[nt][mt], 0, 0, 0);
    };
    WAIT_V0(); __builtin_amdgcn_s_barrier();
#pragma unroll 1
    for (int t = 0; t < NT; ++t) {
        if (t + 3 < NT) f8_stage(lds, A, aoff, B, boffv, wid, t + 3);
        compute(t);
        if (t + 3 < NT) { WAIT_VN(8); } else if (t + 2 < NT) { WAIT_VN(4); } else { WAIT_V0(); }
        WAIT_L0(); __builtin_amdgcn_s_barrier();
    }
}
DEVI void zero_acc16(f32x4 (&acc)[4][8]) {
#pragma unroll
    for (int nt = 0; nt < 4; ++nt)
#pragma unroll
        for (int mt = 0; mt < 8; ++mt) acc[nt][mt] = f32x4{0.f, 0.f, 0.f, 0.f};
}
DEVI void bf_offsets(unsigned (&off)[2], int wid, int lane, int row0, int ld) {
#pragma unroll
    for (int i = 0; i < 2; ++i) { int R, CB; bf_stage_rb(wid, lane, i, R, CB); off[i] = ((unsigned)(row0 + R) * ld) * 2u + CB; }
}

DEVI void dense_convert(const Args& a, char* lds, int tid, int wid, int lane) {
    constexpr int RS = 132;
    unsigned* L = (unsigned*)lds;
    const int kq = tid >> 5, nq = tid & 31;
    auto tile = [&](int tl, const float*& src, int& ld, int& ldo, u16*& dst) {
        if (tl < 512) { const int kt = tl & 15, nt = tl >> 4; const int c0 = (nt < 24) ? nt * 128 : 3088 + (nt - 24) * 128;
            src = a.in[2] + (size_t)(kt * 128) * PW + c0; ld = PW; ldo = D; dst = (u16*)(a.ws + WS_WINT) + (size_t)(nt * 128) * D + kt * 128; }
        else if (tl < 576) { const int t2 = tl - 512, kt = t2 & 7, nt = t2 >> 3;
            src = a.in[14] + (size_t)(kt * 128) * SW + nt * 128; ld = SW; ldo = SW; dst = (u16*)(a.ws + WS_GLUT) + (size_t)(nt * 128) * SW + kt * 128; }
        else { const int t2 = tl - 576, kt = t2 & 15, nt = t2 >> 4;
            src = a.in[17] + (size_t)(kt * 128) * D + nt * 128; ld = D; ldo = D; dst = (u16*)(a.ws + WS_WOUTT) + (size_t)(nt * 128) * D + kt * 128; }
    };
    f32x4 v[2][4];
    auto issue = [&](int tl) {
        const float* src; int ld, ldo; u16* dst; tile(tl, src, ld, ldo, dst);
#pragma unroll
        for (int h = 0; h < 2; ++h)
#pragma unroll
            for (int r = 0; r < 4; ++r) v[h][r] = *(const f32x4*)(src + (size_t)(4 * (kq + 16 * h) + r) * ld + 4 * nq);
    };
    if ((int)blockIdx.x < 832) issue(blockIdx.x);
#pragma unroll 1
    for (int tl = blockIdx.x; tl < 832; tl += gridDim.x) {
        const float* src; int ld, ldo; u16* dst; tile(tl, src, ld, ldo, dst);
        __syncthreads();
#pragma unroll
        for (int h = 0; h < 2; ++h) {
            i32x4 d0, d1;
#pragma unroll
            for (int c = 0; c < 4; ++c) { d0[c] = (int)pack2(v[h][0][c], v[h][1][c]); d1[c] = (int)pack2(v[h][2][c], v[h][3][c]); }
            *(i32x4*)(L + (2 * (kq + 16 * h)) * RS + 4 * nq) = d0;
            *(i32x4*)(L + (2 * (kq + 16 * h) + 1) * RS + 4 * nq) = d1;
        }
        if (tl + (int)gridDim.x < 832) issue(tl + gridDim.x);
        __syncthreads();
        {
            const int part = wid & 3, n = (wid >> 2) * 64 + lane;
            unsigned o[16];
#pragma unroll
            for (int j = 0; j < 16; ++j) o[j] = L[(16 * part + j) * RS + n];
            uint4* dp = (uint4*)(dst + (size_t)n * ldo + 32 * part);
            dp[0] = make_uint4(o[0], o[1], o[2], o[3]); dp[1] = make_uint4(o[4], o[5], o[6], o[7]);
            dp[2] = make_uint4(o[8], o[9], o[10], o[11]); dp[3] = make_uint4(o[12], o[13], o[14], o[15]);
        }
    }
}

DEVI void convert_range(const Args& a, char* lds, int t_lo, int t_hi, int tid, int wid, int lane) {
    const float* w1 = a.in[21]; const float* w2 = a.in[23];
    unsigned char* W1Q = a.ws + WS_W1T; unsigned char* W2Q = a.ws + WS_W2T;
    { int lq = lane; asm volatile("" : "+v"(lq)); lane = lq; tid = wid * 64 + lq; }
    const int kq0 = tid >> 5, n4 = tid & 31;
    auto tile_src = [&](int tl, const float*& src, int& ld, unsigned char*& dst) {
        if (tl < 16384) { const int kt = tl & 15, nt = (tl >> 4) & 31, e = tl >> 9;
            src = w1 + (size_t)e * D * 4096 + (size_t)(kt * 128) * 4096 + nt * 128; ld = 4096;
            dst = W1Q + ((size_t)(e * 32 + nt) * 512 + kt * 32) * 512; }
        else { const int t2 = tl - 16384, kt = t2 & 15, nt = (t2 >> 4) & 15, e = t2 >> 8;
            src = w2 + (size_t)e * FF * D + (size_t)(kt * 128) * D + nt * 128; ld = D;
            dst = W2Q + ((size_t)(e * 16 + nt) * 512 + kt * 32) * 512; }
    };
    f32x4 va[2][4], vb[2][4];
    auto issue = [&](int tl, f32x4 (&v)[2][4]) {
        const float* src; int ld; unsigned char* dst; tile_src(tl, src, ld, dst);
#pragma unroll
        for (int h = 0; h < 2; ++h)
#pragma unroll
            for (int r = 0; r < 4; ++r) v[h][r] = __builtin_nontemporal_load((const f32x4*)(src + (size_t)(4 * (kq0 + 16 * h) + r) * ld + 4 * n4));
    };
    auto finish = [&](int tl, f32x4 (&v)[2][4], int tnext) {
        const float* src; int ld; unsigned char* dst; tile_src(tl, src, ld, dst);
        uint4 o[2];
#pragma unroll
        for (int h = 0; h < 2; ++h) {
            o[h].x = cvt4_fp8(v[h][0][0] * 256.f, v[h][1][0] * 256.f, v[h][2][0] * 256.f, v[h][3][0] * 256.f);
            o[h].y = cvt4_fp8(v[h][0][1] * 256.f, v[h][1][1] * 256.f, v[h][2][1] * 256.f, v[h][3][1] * 256.f);
            o[h].z = cvt4_fp8(v[h][0][2] * 256.f, v[h][1][2] * 256.f, v[h][2][2] * 256.f, v[h][3][2] * 256.f);
            o[h].w = cvt4_fp8(v[h][0][3] * 256.f, v[h][1][3] * 256.f, v[h][2][3] * 256.f, v[h][3][3] * 256.f);
        }
        if (tnext < t_hi) issue(tnext, v);
#pragma unroll
        for (int h = 0; h < 2; ++h) *(uint4*)(dst + ((size_t)(kq0 + 16 * h) * 128 + 4 * n4) * 4) = o[h];
    };
    if (t_lo < t_hi) issue(t_lo, va);
    if (t_lo + 1 < t_hi) issue(t_lo + 1, vb);
#pragma unroll 1
    for (int tl = t_lo; tl < t_hi; tl += 2) {
        finish(tl, va, tl + 2);
        if (tl + 1 < t_hi) finish(tl + 1, vb, tl + 3);
    }
}

DEVI void convert_pool(const Args& a, char* lds, int which, int p_lo, int p_hi, int tid, int wid, int lane) {
    int* cur = (int*)(a.ws + WS_CNT) + 64 + which;
    volatile int* bc = (volatile int*)(lds - LDS_BASE + 32);
#pragma unroll 1
    while (true) {
        __syncthreads();
        if (tid == 0) *bc = atomicAdd(cur, 4);
        __syncthreads();
        const int t = p_lo + *bc;
        if (t >= p_hi) break;
        convert_range(a, lds, t, min(t + 4, p_hi), tid, wid, lane);
    }
}

DEVI void phase0(const Args& a, char* lds, int tid, int wid, int lane) {
    const float* x = a.in[0]; const float* g1 = a.in[1]; const float* w_in = a.in[2];
    u16* HN = (u16*)(a.ws + WS_HN); float* GLR = (float*)(a.ws + WS_GLR);
    constexpr int RSB = 4096 + 16;
    char* Wb = lds;
    char* Hb = lds + 16 * RSB;
    float* red = (float*)(lds + 32 * RSB);
    for (int u = blockIdx.x; u < 256; u += gridDim.x) {
        __syncthreads();
        for (int k = 0; k < 4; ++k) {
            const int d = (tid + 512 * k + 8 * (int)blockIdx.x) & 2047;
            const f32x4* src = (const f32x4*)(w_in + (size_t)d * PW + 3072);
#pragma unroll
            for (int q = 0; q < 4; ++q) { f32x4 v = src[q];
#pragma unroll
                for (int c = 0; c < 4; ++c) *(u16*)(Wb + (q * 4 + c) * RSB + d * 2) = f2bf(v[c]); }
        }
        if (tid < 32) ((float*)(a.ws + WS_SSQ))[u * 32 + tid] = 0.f;
        if (u == 0 && tid < 32) { ((int*)(a.ws + WS_CNT))[tid] = 0; ((int*)(a.ws + WS_CNT))[64 + tid] = 0; }
#pragma unroll 1
        for (int ps = 0; ps < 2; ++ps) {
            const int tok0 = u * 32 + ps * 16;
            {
                const int tokA = tok0 + wid * 2, tokB = tokA + 1;
                f32x4 xa[8], xb[8];
                float ssa = 0.f, ssb = 0.f;
#pragma unroll
                for (int i = 0; i < 8; ++i) {
                    xa[i] = *(const f32x4*)(x + (size_t)tokA * D + 256 * i + 4 * lane);
                    xb[i] = *(const f32x4*)(x + (size_t)tokB * D + 256 * i + 4 * lane);
#pragma unroll
                    for (int c = 0; c < 4; ++c) { ssa += xa[i][c] * xa[i][c]; ssb += xb[i][c] * xb[i][c]; }
                }
                ssa = wave_sum(ssa); ssb = wave_sum(ssb);
                const float ra = rsqrtf(ssa * (1.0f / D) + EPS), rb = rsqrtf(ssb * (1.0f / D) + EPS);
#pragma unroll
                for (int i = 0; i < 8; ++i) {
                    const f32x4 g = *(const f32x4*)(g1 + 256 * i + 4 * lane);
                    uint2 pa, pb;
                    pa.x = pack2(xa[i][0] * ra * g[0], xa[i][1] * ra * g[1]); pa.y = pack2(xa[i][2] * ra * g[2], xa[i][3] * ra * g[3]);
                    pb.x = pack2(xb[i][0] * rb * g[0], xb[i][1] * rb * g[1]); pb.y = pack2(xb[i][2] * rb * g[2], xb[i][3] * rb * g[3]);
                    *(uint2*)(HN + (size_t)tokA * D + 256 * i + 4 * lane) = pa;
                    *(uint2*)(HN + (size_t)tokB * D + 256 * i + 4 * lane) = pb;
                    *(uint2*)(Hb + (wid * 2) * RSB + (256 * i + 4 * lane) * 2) = pa;
                    *(uint2*)(Hb + (wid * 2 + 1) * RSB + (256 * i + 4 * lane) * 2) = pb;
                }
            }
            __syncthreads();
            {
                const int l15 = lane & 15, q = lane >> 4;
                f32x4 acc = {0.f, 0.f, 0.f, 0.f};
#pragma unroll
                for (int ks = 0; ks < 8; ++ks) {
                    const int kb = (wid * 256 + ks * 32 + q * 8) * 2;
                    const bf16x8 av = *(const bf16x8*)(Hb + l15 * RSB + kb);
                    const bf16x8 bv = *(const bf16x8*)(Wb + l15 * RSB + kb);
                    acc = __builtin_amdgcn_mfma_f32_16x16x32_bf16(av, bv, acc, 0, 0, 0);
                }
#pragma unroll
                for (int j = 0; j < 4; ++j) red[(wid * 16 + 4 * q + j) * 16 + l15] = acc[j];
            }
            __syncthreads();
            if (tid < 256) {
                float sacc = 0.f;
#pragma unroll
                for (int w = 0; w < 8; ++w) sacc += red[w * 256 + tid];
                GLR[(size_t)(tok0 + (tid >> 4)) * 16 + (tid & 15)] = sacc;
            }
        }
    }
    const float* a_re = a.in[6]; const float* a_im = a.in[7]; const float* b_re = a.in[8]; const float* b_im = a.in[9];
    const float* c_re = a.in[10]; const float* c_im = a.in[11]; const float* lstep = a.in[13];
    u16* KT = (u16*)(a.ws + WS_S5K); u16* WE = (u16*)(a.ws + WS_S5WE); u16* VV = (u16*)(a.ws + WS_S5V); float* AL = (float*)(a.ws + WS_S5AL);
    float* Bre = (float*)lds;
    float* Bim = Bre + 1024;
    float* Cre = Bim + 1024;
    float* Cim = Cre + 1024;
    float* Pre = Cim + 1024;
    float* Pim = Pre + 65 * 64;
    for (int u = blockIdx.x; u < 256; u += gridDim.x) {
        const int g = u >> 2, q = u & 3;
        __syncthreads();
        const float delta = __expf(lstep[g]);
        if (tid < 64) {
            const int p = tid;
            const float ar = a_re[g * 64 + p], ai = a_im[g * 64 + p];
            const float ea = expf(ar * delta);
            float sn, cs; sincosf(ai * delta, &sn, &cs);
            const float xr = ea * cs - 1.0f, xi = ea * sn;
            const float den = 1.0f / (ar * ar + ai * ai);
            const float cr = (xr * ar + xi * ai) * den, ci = (xi * ar - xr * ai) * den;
#pragma unroll
            for (int m = 0; m < 16; ++m) {
                const float br = b_re[(g * 64 + p) * 16 + m], bi = b_im[(g * 64 + p) * 16 + m];
                Bre[p * 16 + m] = cr * br - ci * bi;
                Bim[p * 16 + m] = cr * bi + ci * br;
            }
        }
        for (int i = tid; i < 1024; i += 512) { Cre[i] = c_re[g * 1024 + i]; Cim[i] = c_im[g * 1024 + i]; }
        for (int i = tid; i < 65 * 64; i += 512) {
            const int tau = i >> 6, p = i & 63;
            const float ar = a_re[g * 64 + p], ai = a_im[g * 64 + p];
            const float e = expf((float)tau * ar * delta);
            float sn, cs; sincosf((float)tau * (ai * delta), &sn, &cs);
            Pre[i] = e * cs; Pim[i] = e * sn;
        }
        __syncthreads();
        if (q == 0 && tid < 64) { AL[(g * 64 + tid) * 2] = Pre[64 * 64 + tid]; AL[(g * 64 + tid) * 2 + 1] = Pim[64 * 64 + tid]; }
        if (tid < 256) {
            const int tau = q * 16 + (tid >> 4), n = tid & 15;
            float acc[16];
#pragma unroll
            for (int m = 0; m < 16; ++m) acc[m] = 0.f;
#pragma unroll 2
            for (int p = 0; p < 64; ++p) {
                const float cr = Cre[n * 64 + p], ci = Cim[n * 64 + p], pr = Pre[tau * 64 + p], pi = Pim[tau * 64 + p];
                const float xr = cr * pr - ci * pi, xi = cr * pi + ci * pr;
#pragma unroll
                for (int m4 = 0; m4 < 4; ++m4) {
                    const f32x4 br = *(const f32x4*)(Bre + p * 16 + m4 * 4), bi = *(const f32x4*)(Bim + p * 16 + m4 * 4);
#pragma unroll
                    for (int c = 0; c < 4; ++c) acc[m4 * 4 + c] += xr * br[c] - xi * bi[c];
                }
            }
            uint4 o0, o1;
            o0.x = pack2(acc[0], acc[1]); o0.y = pack2(acc[2], acc[3]); o0.z = pack2(acc[4], acc[5]); o0.w = pack2(acc[6], acc[7]);
            o1.x = pack2(acc[8], acc[9]); o1.y = pack2(acc[10], acc[11]); o1.z = pack2(acc[12], acc[13]); o1.w = pack2(acc[14], acc[15]);
            uint4* dst = (uint4*)(KT + ((size_t)(g * 64 + tau) * 16 + n) * 16);
            dst[0] = o0; dst[1] = o1;
        }
        {
            const int p = tid >> 3;
#pragma unroll
            for (int ss = 0; ss < 2; ++ss) {
                const int s = q * 16 + (tid & 7) * 2 + ss;
                const float pr = Pre[(63 - s) * 64 + p], pi = Pim[(63 - s) * 64 + p];
                float vr[16], vi[16];
#pragma unroll
                for (int m = 0; m < 16; ++m) { const float br = Bre[p * 16 + m], bi = Bim[p * 16 + m]; vr[m] = pr * br - pi * bi; vi[m] = pr * bi + pi * br; }
                uint4 r0, r1, i0, i1;
                r0.x = pack2(vr[0], vr[1]); r0.y = pack2(vr[2], vr[3]); r0.z = pack2(vr[4], vr[5]); r0.w = pack2(vr[6], vr[7]);
                r1.x = pack2(vr[8], vr[9]); r1.y = pack2(vr[10], vr[11]); r1.z = pack2(vr[12], vr[13]); r1.w = pack2(vr[14], vr[15]);
                i0.x = pack2(vi[0], vi[1]); i0.y = pack2(vi[2], vi[3]); i0.z = pack2(vi[4], vi[5]); i0.w = pack2(vi[6], vi[7]);
                i1.x = pack2(vi[8], vi[9]); i1.y = pack2(vi[10], vi[11]); i1.z = pack2(vi[12], vi[13]); i1.w = pack2(vi[14], vi[15]);
                uint4* dr = (uint4*)(WE + ((size_t)(g * 128 + 2 * p) * 1024 + s * 16));
                uint4* di = (uint4*)(WE + ((size_t)(g * 128 + 2 * p + 1) * 1024 + s * 16));
                dr[0] = r0; dr[1] = r1; di[0] = i0; di[1] = i1;
            }
        }
        {
            const int tau = q * 16 + (tid >> 5), n = (tid >> 1) & 15, ph = tid & 1;
            unsigned* dst = (unsigned*)(VV + ((size_t)(g * 1024 + tau * 16 + n) * 128 + ph * 64));
#pragma unroll 4
            for (int pp = 0; pp < 32; ++pp) {
                const int p = ph * 32 + pp;
                const float cr = Cre[n * 64 + p], ci = Cim[n * 64 + p], pr = Pre[(tau + 1) * 64 + p], pi = Pim[(tau + 1) * 64 + p];
                dst[pp] = pack2(cr * pr - ci * pi, -(cr * pi + ci * pr));
            }
        }
    }
    __syncthreads();
    dense_convert(a, lds, tid, wid, lane);
}


namespace pg8 {
#define PG8_LAS __attribute__((address_space(3)))
constexpr int BM = 256, BK = 64, HALF = 128, HTB = HALF * BK * 2, NXCD = 8, WGM = 8;
DEVI int lds_byte(int r, int c) { const int st = (r >> 4) * 2 + (c >> 5), rr = r & 15, cc = c & 31, ob = rr * 64 + cc * 2; return st * 1024 + (ob ^ (((ob >> 9) & 1) << 5)); }
DEVI void stage_rc(int b, int& R, int& C) { const int st = b / 1024, sb = b % 1024, swz = sb ^ (((sb >> 9) & 1) << 5); R = (st >> 1) * 16 + swz / 64; C = (st & 1) * 32 + (swz % 64) / 2; }
DEVI int perm32(int rho) { const int n = rho >> 4, i = rho & 15; return 8 * (i >> 2) + 4 * n + (i & 3); }
struct Unit { int pm, pn, kofs, cont; };
struct Gemm { const void* A; const void* Bt; int ld, K; };
struct StaticOrder {
    int nM, nN, nwg, G, c;
    DEVI void init(int M, int N, int G_, int c_) { nM = M / BM; nN = N / BM; nwg = nM * nN; G = G_; c = c_; }
    DEVI bool tile(int i, Unit& u) const {
        const long L = (long)i * G + c; if (L >= nwg) return false;
        int wgid = (int)L; { const int q = nwg / NXCD, r = nwg % NXCD, xcd = wgid % NXCD, off = wgid / NXCD; wgid = (xcd < r ? xcd * (q + 1) : r * (q + 1) + (xcd - r) * q) + off; }
        const int nig = WGM * nN, gid = wgid / nig, fm = gid * WGM, gsz = (nM - fm) < WGM ? (nM - fm) : WGM;
        u.pm = fm + ((wgid % nig) % gsz); u.pn = (wgid % nig) / gsz; return true;
    }
    int i0 = 0, i1 = 1 << 30;
    DEVI bool next(int i, Unit& u) const { u.kofs = 0; u.cont = 0; return (i0 + i < i1) && tile(i0 + i, u); }
};
struct SplitKOrder : StaticOrder {
    int khalf;
    DEVI bool next(int i, Unit& u) const { if (i >= 2) return false; u.kofs = i == 0 ? khalf : 0; u.cont = i; return tile(0, u); }
};

template <class Epi, class Sched>
DEVI void gemm_phase(PG8_LAS unsigned char* lds, const Gemm g, const Sched& S, const Epi& E) {
    const int tid = threadIdx.x, wid = __builtin_amdgcn_readfirstlane(tid >> 6), lane = tid & 63, wr = wid >> 2, wc = wid & 3, fr = lane & 15, fq = lane >> 4;
    const int ld = g.ld, nt = g.K / BK;
    unsigned voffA[2], voffB[2];
#pragma unroll
    for (int i = 0; i < 2; ++i) { int R, C; stage_rc(tid * 16 + i * 8192, R, C); const int Rb = Epi::PERM ? ((R & ~31) + perm32(R & 31)) : R;
        voffA[i] = (unsigned)(R * ld + C) * 2u; voffB[i] = (unsigned)(Rb * ld + C) * 2u; }
    const size_t kstep = (size_t)(BK * 2);
    const size_t hstep = (size_t)HALF * ld * 2;
    const size_t tstep = 2 * hstep;
    const unsigned ldsw = (unsigned)wid * 1024u;
    const int aoff = lds_byte(wr * 64 + fr, fq * 8), boff = lds_byte(wc * 32 + fr, fq * 8);
#define PG8_SA(b, h) (((b) * 2 + (h)) * HTB)
#define PG8_SB(b, h) ((4 + (b) * 2 + (h)) * HTB)
#define PG8_STAGE(bufoff, gbase, voff) do { _Pragma("unroll") for (int _i = 0; _i < 2; ++_i) \
        __builtin_amdgcn_global_load_lds((const unsigned*)((const char*)(gbase) + (voff)[_i]), (PG8_LAS unsigned*)(lds + (bufoff) + ldsw + _i * 8192), 16, 0, 0); } while (0)
#define PG8_LDA(dst, b, h) do { _Pragma("unroll") for (int m = 0; m < 4; ++m) _Pragma("unroll") for (int k = 0; k < 2; ++k) dst[m][k] = *(const PG8_LAS bf16x8*)(lds + PG8_SA(b, h) + aoff + m * 2048 + k * 1024); } while (0)
#define PG8_LDB(dst, b, h) do { _Pragma("unroll") for (int n = 0; n < 2; ++n) _Pragma("unroll") for (int k = 0; k < 2; ++k) dst[n][k] = *(const PG8_LAS bf16x8*)(lds + PG8_SB(b, h) + boff + n * 2048 + k * 1024); } while (0)
#define PG8_MMA(ai, bj, At, Bt) do { __builtin_amdgcn_s_setprio(1); _Pragma("unroll") for (int m = 0; m < 4; ++m) _Pragma("unroll") for (int n = 0; n < 2; ++n) _Pragma("unroll") for (int k = 0; k < 2; ++k) \
        acc[ai][bj][m][n] = __builtin_amdgcn_mfma_f32_16x16x32_bf16(Bt[n][k], At[m][k], acc[ai][bj][m][n], 0, 0, 0); __builtin_amdgcn_s_setprio(0); } while (0)
#define PG8_WAIT_V(n) asm volatile("s_waitcnt vmcnt(" #n ")" ::: "memory")
#define PG8_WAIT_L(n) asm volatile("s_waitcnt lgkmcnt(" #n ")" ::: "memory")
#define PG8_BAR __builtin_amdgcn_s_barrier()
#define PG8_SCHED __builtin_amdgcn_sched_barrier(0)
#define PG8_ZERO() do { _Pragma("unroll") for (int a_ = 0; a_ < 2; ++a_) _Pragma("unroll") for (int b_ = 0; b_ < 2; ++b_) _Pragma("unroll") for (int m_ = 0; m_ < 4; ++m_) _Pragma("unroll") for (int n_ = 0; n_ < 2; ++n_) \
        acc[a_][b_][m_][n_] = (f32x4){0.f, 0.f, 0.f, 0.f}; } while (0)
    Unit cur, nxt; int ui = 0;
    if (!S.next(0, cur)) return;
    f32x4 acc[2][2][4][2];
    PG8_ZERO();
    bf16x8 At[4][2], B0[2][2], B1[2][2];
    const char* cA = (const char*)g.A + (size_t)cur.pm * tstep + cur.kofs; const char* cB = (const char*)g.Bt + (size_t)cur.pn * tstep + cur.kofs;
    PG8_STAGE(PG8_SB(0, 0), cB, voffB); PG8_STAGE(PG8_SA(0, 0), cA, voffA); PG8_STAGE(PG8_SB(0, 1), cB + hstep, voffB); PG8_STAGE(PG8_SA(0, 1), cA + hstep, voffA);
    if (wr == 1) PG8_BAR;
    PG8_WAIT_V(4); PG8_BAR;
    PG8_STAGE(PG8_SB(1, 0), cB + kstep, voffB); PG8_STAGE(PG8_SA(1, 0), cA + kstep, voffA); PG8_STAGE(PG8_SB(1, 1), cB + hstep + kstep, voffB);
    PG8_WAIT_V(6); PG8_BAR;
    for (;;) {
        const bool has_next = S.next(ui + 1, nxt);
        const char* nA = has_next ? (const char*)g.A + (size_t)nxt.pm * tstep + nxt.kofs : cA; const char* nB = has_next ? (const char*)g.Bt + (size_t)nxt.pn * tstep + nxt.kofs : cB;
        for (int t = 0; t < nt; t += 2) {
            const bool last = (t == nt - 2);
            const char* a1 = cA + (size_t)(t + 1) * kstep;
            const char* a2 = last ? nA : cA + (size_t)(t + 2) * kstep; const char* b2 = last ? nB : cB + (size_t)(t + 2) * kstep;
            const char* a3 = a2 + kstep; const char* b3 = b2 + kstep;
            PG8_LDB(B0, 0, 0); PG8_SCHED; PG8_LDA(At, 0, 0); PG8_STAGE(PG8_SA(1, 1), a1 + hstep, voffA);
            PG8_WAIT_L(8); PG8_BAR; PG8_WAIT_L(0); PG8_MMA(0, 0, At, B0); PG8_BAR; PG8_SCHED;
            PG8_LDB(B1, 0, 1); PG8_STAGE(PG8_SB(0, 0), b2, voffB);
            PG8_BAR; PG8_WAIT_L(0); PG8_MMA(0, 1, At, B1); PG8_BAR;
            PG8_LDA(At, 0, 1); PG8_STAGE(PG8_SA(0, 0), a2, voffA);
            PG8_BAR; PG8_WAIT_L(0); PG8_MMA(1, 0, At, B0); PG8_BAR; PG8_SCHED;
            PG8_STAGE(PG8_SB(0, 1), b2 + hstep, voffB);
            PG8_WAIT_V(6); PG8_BAR; PG8_MMA(1, 1, At, B1); PG8_BAR;
            PG8_LDB(B0, 1, 0); PG8_SCHED; PG8_LDA(At, 1, 0); PG8_STAGE(PG8_SA(0, 1), a2 + hstep, voffA);
            PG8_WAIT_L(8); PG8_BAR; PG8_WAIT_L(0); PG8_MMA(0, 0, At, B0); PG8_BAR; PG8_SCHED;
            PG8_LDB(B1, 1, 1); PG8_STAGE(PG8_SB(1, 0), b3, voffB);
            PG8_BAR; PG8_WAIT_L(0); PG8_MMA(0, 1, At, B1); PG8_BAR;
            PG8_LDA(At, 1, 1); PG8_STAGE(PG8_SA(1, 0), a3, voffA);
            PG8_BAR; PG8_WAIT_L(0); PG8_MMA(1, 0, At, B0); PG8_BAR; PG8_SCHED;
            PG8_STAGE(PG8_SB(1, 1), b3 + hstep, voffB);
            PG8_WAIT_V(6); PG8_BAR; PG8_MMA(1, 1, At, B1); PG8_BAR;
        }
        E(acc, cur, wr, wc, fr, fq);
        if (!has_next) break;
        if (!nxt.cont) PG8_ZERO();
        cur = nxt; cA = nA; cB = nB; ++ui;
    }
    PG8_WAIT_V(0);
    if (wr == 0) PG8_BAR;
    PG8_BAR;
#undef PG8_SA
#undef PG8_SB
#undef PG8_STAGE
#undef PG8_LDA
#undef PG8_LDB
#undef PG8_MMA
#undef PG8_WAIT_V
#undef PG8_WAIT_L
#undef PG8_BAR
#undef PG8_SCHED
#undef PG8_ZERO
}
}

struct EpiProj {
    static constexpr bool PERM = true;
    u16* out;
    DEVI void operator()(f32x4 (&acc)[2][2][4][2], const pg8::Unit& u, int wr, int wc, int fr, int fq) const {
        const float sc = (u.pn < 2) ? 0.08838834764831845f : 1.0f;
        const int row0 = u.pm * 256 + wr * 64 + fr, col0 = u.pn * 256 + wc * 32 + 8 * fq;
#pragma unroll
        for (int ai = 0; ai < 2; ++ai)
#pragma unroll
            for (int m = 0; m < 4; ++m) {
                u16* rowp = out + (size_t)(row0 + ai * 128 + m * 16) * PJ + col0;
#pragma unroll
                for (int bj = 0; bj < 2; ++bj) {
                    const f32x4 v0 = acc[ai][bj][m][0], v1 = acc[ai][bj][m][1];
                    uint4 w; w.x = pack2(v0[0] * sc, v0[1] * sc); w.y = pack2(v0[2] * sc, v0[3] * sc); w.z = pack2(v1[0] * sc, v1[1] * sc); w.w = pack2(v1[2] * sc, v1[3] * sc);
                    *(uint4*)(rowp + bj * 128) = w;
                }
            }
    }
};
struct EpiGlu {
    static constexpr bool PERM = true;
    const u16* Z; u16* MIX; float* SSQ; const float* gbias; const float* sng;
    DEVI void operator()(f32x4 (&acc)[2][2][4][2], const pg8::Unit& u, int wr, int wc, int fr, int fq) const {
        const int row0 = u.pm * 256 + wr * 64 + fr, col0 = u.pn * 256 + wc * 32 + 8 * fq;
#pragma unroll
        for (int ai = 0; ai < 2; ++ai)
#pragma unroll
            for (int m = 0; m < 4; ++m) {
                const int row = row0 + ai * 128 + m * 16;
                float sq = 0.f;
#pragma unroll
                for (int bj = 0; bj < 2; ++bj) {
                    const int c = col0 + bj * 128;
                    const uint4 zv = *(const uint4*)(Z + (size_t)row * SW + c);
                    const unsigned zw[4] = {zv.x, zv.y, zv.z, zv.w};
                    unsigned ow[4];
#pragma unroll
                    for (int n = 0; n < 2; ++n) {
                        const f32x4 gb = *(const f32x4*)(gbias + c + 4 * n), sg = *(const f32x4*)(sng + c + 4 * n);
                        const f32x4 v = acc[ai][bj][m][n];
                        const float y0 = bflo(zw[2 * n]) * sigmoidf_(v[0] + gb[0]), y1 = bfhi(zw[2 * n]) * sigmoidf_(v[1] + gb[1]);
                        const float y2 = bflo(zw[2 * n + 1]) * sigmoidf_(v[2] + gb[2]), y3 = bfhi(zw[2 * n + 1]) * sigmoidf_(v[3] + gb[3]);
                        sq += y0 * y0 + y1 * y1 + y2 * y2 + y3 * y3;
                        ow[2 * n] = pack2(y0 * sg[0], y1 * sg[1]); ow[2 * n + 1] = pack2(y2 * sg[2], y3 * sg[3]);
                    }
                    uint4 w; w.x = ow[0]; w.y = ow[1]; w.z = ow[2]; w.w = ow[3];
                    *(uint4*)(MIX + (size_t)row * D + 1024 + c) = w;
                }
                sq += __shfl_xor(sq, 16); sq += __shfl_xor(sq, 32);
                if (fq == 0) atomicAdd(&SSQ[row], sq);
            }
    }
};
struct EpiOut {
    static constexpr bool PERM = false;
    const float* x; float* H1; const float* SSQ;
    DEVI void operator()(f32x4 (&acc)[2][2][4][2], const pg8::Unit& u, int wr, int wc, int fr, int fq) const {
        const int row0 = u.pm * 256 + wr * 64 + fr, col0 = u.pn * 256 + wc * 32 + 4 * fq;
        if (u.cont == 0) {
#pragma unroll
            for (int ai = 0; ai < 2; ++ai)
#pragma unroll
                for (int m = 0; m < 4; ++m) {
                    const float rs = rsqrtf(SSQ[row0 + ai * 128 + m * 16] * (1.0f / SW) + EPS);
#pragma unroll
                    for (int bj = 0; bj < 2; ++bj)
#pragma unroll
                        for (int n = 0; n < 2; ++n) acc[ai][bj][m][n] *= rs;
                }
        } else {
#pragma unroll
            for (int ai = 0; ai < 2; ++ai)
#pragma unroll
                for (int m = 0; m < 4; ++m) {
                    const size_t base = (size_t)(row0 + ai * 128 + m * 16) * D + col0;
#pragma unroll
                    for (int bj = 0; bj < 2; ++bj)
#pragma unroll
                        for (int n = 0; n < 2; ++n) {
                            const f32x4 xv = *(const f32x4*)(x + base + bj * 128 + n * 16);
                            *(f32x4*)(H1 + base + bj * 128 + n * 16) = xv + acc[ai][bj][m][n];
                        }
                }
        }
    }
};

DEVI void phase1(const Args& a, char* lds, int tid, int wid, int lane) {
    extern __shared__ __attribute__((aligned(16))) char smem_pg8[];
    const int cpos = blockIdx.x % 3, c_lo = blockIdx.x * 24, c_hi = c_lo + 24;
#pragma unroll 1
    for (int part = 0; part < 2; ++part) {
        if (part == cpos) convert_range(a, lds, c_lo, c_hi, tid, wid, lane);
        pg8::Gemm g; g.A = a.ws + WS_HN; g.Bt = a.ws + WS_WINT; g.ld = D; g.K = D;
        pg8::StaticOrder S; S.init(T, PJ, (int)gridDim.x, (int)blockIdx.x);
        if (cpos == 1) { S.i0 = part; S.i1 = part + 1; } else if (part == 1) S.i1 = 0;
        EpiProj E; E.out = (u16*)(a.ws + WS_PROJ);
        pg8::gemm_phase(( PG8_LAS unsigned char*)(smem_pg8 + 1024), g, S, E);
    }
    if (cpos == 2) convert_range(a, lds, c_lo, c_hi, tid, wid, lane);
    convert_pool(a, lds, 0, 6144, 8192, tid, wid, lane);
}

DEVI void gla_gate(const Args& a, int n, int h, int tid, float* glr, float* tot, float (&b)[16], float& blast) {
    const float* GLR = (const float*)(a.ws + WS_GLR);
    const float* W2 = a.in[3]; const float* gb = a.in[4];
    for (int i = tid; i < 1024; i += 512) glr[i] = GLR[(size_t)n * 64 * 16 + i];
    const int ch = tid & 127, tq = tid >> 7;
    float w[16];
#pragma unroll
    for (int r = 0; r < 16; ++r) w[r] = W2[r * 512 + h * 128 + ch];
    const float bias = gb[h * 128 + ch];
    __syncthreads();
    float run = 0.f;
#pragma unroll
    for (int tt = 0; tt < 16; ++tt) {
        const int t = tq * 16 + tt;
        float s = bias;
#pragma unroll
        for (int r4 = 0; r4 < 4; ++r4) {
            const f32x4 gv = *(const f32x4*)(glr + t * 16 + r4 * 4);
            s += gv[0] * w[r4 * 4] + gv[1] * w[r4 * 4 + 1] + gv[2] * w[r4 * 4 + 2] + gv[3] * w[r4 * 4 + 3];
        }
        run += logsigmoid_(s) * (1.0f / 16.0f);
        b[tt] = run;
    }
    tot[tq * 128 + ch] = run;
    __syncthreads();
    float pre = 0.f;
#pragma unroll
    for (int k = 0; k < 4; ++k) { const float v = tot[k * 128 + ch]; if (k < tq) pre += v; }
    blast = tot[ch] + tot[128 + ch] + tot[256 + ch] + tot[384 + ch];
#pragma unroll
    for (int tt = 0; tt < 16; ++tt) b[tt] += pre;
}
DEVI void gla_stage_vT(const u16* PROJ, int t0, int vcol0, char* img, int tid) {
    if (tid < 256) {
        const int tb = tid >> 5, jb = tid & 31;
        unsigned R[8][4];
#pragma unroll
        for (int tt = 0; tt < 8; ++tt) {
            const uint4 v = *(const uint4*)(PROJ + (size_t)(t0 + tb * 8 + tt) * PJ + vcol0 + jb * 8);
            R[tt][0] = v.x; R[tt][1] = v.y; R[tt][2] = v.z; R[tt][3] = v.w;
        }
#pragma unroll
        for (int jj = 0; jj < 8; ++jj) {
            unsigned o[4];
#pragma unroll
            for (int d = 0; d < 4; ++d) {
                const unsigned lo = R[2 * d][jj >> 1], hi = R[2 * d + 1][jj >> 1];
                o[d] = (jj & 1) ? ((lo >> 16) | (hi & 0xffff0000u)) : ((lo & 0xffffu) | (hi << 16));
            }
            *(uint4*)(img + lds_byte<2>(jb * 8 + jj, tb * 8)) = make_uint4(o[0], o[1], o[2], o[3]);
        }
    }
}

constexpr int USTR = 2048 + 16;
DEVI void s5_fill_U(const u16* PROJ, int g, int cb, char* U, int tid) {
    for (int k = 0; k < 4; ++k) {
        const int idx = tid + 512 * k, c = idx >> 6, s = idx & 63;
        const uint4* src = (const uint4*)(PROJ + (size_t)((cb * 32 + c) * 64 + s) * PJ + 3072 + g * 16);
        uint4* dst = (uint4*)(U + c * USTR + s * 32);
        dst[0] = src[0]; dst[1] = src[1];
    }
}
DEVI void phase2(const Args& a, char* lds, int tid, int wid, int lane) {
    const u16* PROJ = (const u16*)(a.ws + WS_PROJ);
#pragma unroll 1
    for (int u = blockIdx.x; u < 768; u += gridDim.x) {
        { int lq = lane; asm volatile("" : "+v"(lq)); lane = lq; tid = wid * 64 + lq; }
        const int fr = lane & 15, fq = lane >> 4;
        __syncthreads();
        if (u < 256) {
            const int g = u >> 2, cb = u & 3;
            s5_fill_U(PROJ, g, cb, lds, tid);
            __syncthreads();
            const u16* WE = (const u16*)(a.ws + WS_S5WE) + (size_t)(g * 128 + wid * 16 + fr) * 1024 + fq * 8;
            f32x4 acc0 = {0.f, 0.f, 0.f, 0.f}, acc1 = {0.f, 0.f, 0.f, 0.f};
#pragma unroll 8
            for (int ks = 0; ks < 32; ++ks) {
                const bf16x8 bf = *(const bf16x8*)(WE + ks * 32);
                const bf16x8 a0 = *(const bf16x8*)(lds + fr * USTR + (ks * 32 + fq * 8) * 2);
                const bf16x8 a1 = *(const bf16x8*)(lds + (16 + fr) * USTR + (ks * 32 + fq * 8) * 2);
                acc0 = __builtin_amdgcn_mfma_f32_16x16x32_bf16(a0, bf, acc0, 0, 0, 0);
                acc1 = __builtin_amdgcn_mfma_f32_16x16x32_bf16(a1, bf, acc1, 0, 0, 0);
            }
            float* E = (float*)(a.ws + WS_S5E);
#pragma unroll
            for (int j = 0; j < 4; ++j) {
                E[(size_t)(g * 128 + cb * 32 + fq * 4 + j) * 128 + wid * 16 + fr] = acc0[j];
                E[(size_t)(g * 128 + cb * 32 + 16 + fq * 4 + j) * 128 + wid * 16 + fr] = acc1[j];
            }
        } else {
            const int uu = u - 256, n = uu >> 2, h = uu & 3, t0 = n * 64;
            char* vT = lds;
            char* kT = lds + 32768;
            float* glr = (float*)(lds + 49152);
            float* tot = glr + 1024;
            float b[16], blast;
            gla_gate(a, n, h, tid, glr, tot, b, blast);
            const int ch = tid & 127, tq = tid >> 7;
            {
                unsigned pk[8];
#pragma unroll
                for (int tt = 0; tt < 16; tt += 2) {
                    const float k0 = bf2f(PROJ[(size_t)(t0 + tq * 16 + tt) * PJ + 512 + h * 128 + ch]);
                    const float k1 = bf2f(PROJ[(size_t)(t0 + tq * 16 + tt + 1) * PJ + 512 + h * 128 + ch]);
                    pk[tt >> 1] = pack2(k0 * __expf(blast - b[tt]), k1 * __expf(blast - b[tt + 1]));
                }
                *(uint4*)(kT + lds_byte<2>(ch, tq * 16)) = make_uint4(pk[0], pk[1], pk[2], pk[3]);
                *(uint4*)(kT + lds_byte<2>(ch, tq * 16 + 8)) = make_uint4(pk[4], pk[5], pk[6], pk[7]);
                if (tq == 3) ((float*)(a.ws + WS_DEC))[(size_t)(n * 4 + h) * 128 + ch] = __expf(blast);
            }
            gla_stage_vT(PROJ, t0, 1024 + h * 256, vT, tid);
            __syncthreads();
            const int wr = wid >> 1, wc = wid & 1;
            f32x4 acc[4][4];
#pragma unroll
            for (int m = 0; m < 4; ++m)
#pragma unroll
                for (int nn = 0; nn < 4; ++nn) acc[m][nn] = f32x4{0.f, 0.f, 0.f, 0.f};
#pragma unroll
            for (int ks = 0; ks < 2; ++ks) {
                bf16x8 Af[4], Bf[4];
#pragma unroll
                for (int m = 0; m < 4; ++m) Af[m] = *(const bf16x8*)(vT + lds_byte<2>(wr * 64 + m * 16 + fr, ks * 32 + fq * 8));
#pragma unroll
                for (int nn = 0; nn < 4; ++nn) Bf[nn] = *(const bf16x8*)(kT + lds_byte<2>(wc * 64 + nn * 16 + fr, ks * 32 + fq * 8));
#pragma unroll
                for (int m = 0; m < 4; ++m)
#pragma unroll
                    for (int nn = 0; nn < 4; ++nn) acc[m][nn] = __builtin_amdgcn_mfma_f32_16x16x32_bf16(Af[m], Bf[nn], acc[m][nn], 0, 0, 0);
            }
            float* KV = (float*)(a.ws + WS_KV) + (size_t)(n * 4 + h) * (HV * HK);
#pragma unroll
            for (int m = 0; m < 4; ++m)
#pragma unroll
                for (int nn = 0; nn < 4; ++nn)
#pragma unroll
                    for (int j = 0; j < 4; ++j)
                        KV[(size_t)(wr * 64 + m * 16 + fq * 4 + j) * 128 + wc * 64 + nn * 16 + fr] = acc[m][nn][j];
        }
    }
}

DEVI void phase3(const Args& a, int tid) {
    const float* KV = (const float*)(a.ws + WS_KV); u16* ST = (u16*)(a.ws + WS_ST); const float* DEC = (const float*)(a.ws + WS_DEC);
    for (int e = blockIdx.x * 512 + tid; e < NH * HV * HK; e += gridDim.x * 512) {
        const int h = e >> 15, rem = e & 32767, i = e & 127;
        float S = 0.f;
#pragma unroll 1
        for (int n0 = 0; n0 < NCH; n0 += 16) {
            float kv[16], dc[16];
#pragma unroll
            for (int k = 0; k < 16; ++k) { kv[k] = KV[(size_t)((n0 + k) * 4 + h) * 32768 + rem]; dc[k] = DEC[(size_t)((n0 + k) * 4 + h) * 128 + i]; }
#pragma unroll
            for (int k = 0; k < 16; ++k) { ST[(size_t)((n0 + k) * 4 + h) * 32768 + rem] = f2bf(S); S = dc[k] * S + kv[k]; }
        }
    }
    const float* E = (const float*)(a.ws + WS_S5E); const float* AL = (const float*)(a.ws + WS_S5AL); unsigned* HP = (unsigned*)(a.ws + WS_S5H);
    for (int e = blockIdx.x * 512 + tid; e < NG * SP; e += gridDim.x * 512) {
        const int g = e >> 6, p = e & 63;
        const float ar = AL[e * 2], ai = AL[e * 2 + 1];
        float hr = 0.f, hi = 0.f;
#pragma unroll 1
        for (int c0 = 0; c0 < 128; c0 += 16) {
            float2 ev[16];
#pragma unroll
            for (int k = 0; k < 16; ++k) ev[k] = *(const float2*)(E + (size_t)(g * 128 + c0 + k) * 128 + 2 * p);
#pragma unroll
            for (int k = 0; k < 16; ++k) {
                HP[(size_t)(g * 128 + c0 + k) * 64 + p] = pack2(hr, hi);
                const float nr = ar * hr - ai * hi + ev[k].x, ni = ar * hi + ai * hr + ev[k].y;
                hr = nr; hi = ni;
            }
        }
    }
}

DEVI void phase4(const Args& a, char* lds, int tid, int wid, int lane) {
    const u16* PROJ = (const u16*)(a.ws + WS_PROJ);
    u16* MIX = (u16*)(a.ws + WS_MIX);
#pragma unroll 1
    for (int u = blockIdx.x; u < 768; u += gridDim.x) {
        { int lq = lane; asm volatile("" : "+v"(lq)); lane = lq; tid = wid * 64 + lq; }
        const int fr = lane & 15, fq = lane >> 4;
        __syncthreads();
        if (u < 256) {
            const int g = u >> 2, cb = u & 3;
            char* U = lds; char* KTl = lds + 32 * USTR;
            s5_fill_U(PROJ, g, cb, U, tid);
            {
                const uint4* src = (const uint4*)((const u16*)(a.ws + WS_S5K) + (size_t)g * 16384);
                uint4* dst = (uint4*)KTl;
                for (int k = 0; k < 4; ++k) dst[tid + 512 * k] = src[tid + 512 * k];
            }
            __syncthreads();
            f32x4 acc[8][2];
#pragma unroll
            for (int tt = 0; tt < 8; ++tt) { acc[tt][0] = f32x4{0.f, 0.f, 0.f, 0.f}; acc[tt][1] = f32x4{0.f, 0.f, 0.f, 0.f}; }
            const int sl = fq >> 1, m0 = (fq & 1) * 8;
            const char* kbase = KTl + ((wid - sl) * 256 + fr * 16 + m0) * 2;
#pragma unroll 1
            for (int j = 0; j < 32; ++j) {
                const bf16x8 a0 = *(const bf16x8*)(U + fr * USTR + (j * 32 + fq * 8) * 2);
                const bf16x8 a1 = *(const bf16x8*)(U + (16 + fr) * USTR + (j * 32 + fq * 8) * 2);
                const char* kb = kbase - j * 1024;
#pragma unroll
                for (int tt = 0; tt < 8; ++tt) {
                    const int t = wid + 8 * tt;
                    if (t >= 2 * j) {
                        bf16x8 bf = *(const bf16x8*)(kb + tt * 4096);
                        if (t == 2 * j && sl == 1) bf = bf16x8{0, 0, 0, 0, 0, 0, 0, 0};
                        acc[tt][0] = __builtin_amdgcn_mfma_f32_16x16x32_bf16(a0, bf, acc[tt][0], 0, 0, 0);
                        acc[tt][1] = __builtin_amdgcn_mfma_f32_16x16x32_bf16(a1, bf, acc[tt][1], 0, 0, 0);
                    }
                }
            }
            const u16* HP = (const u16*)(a.ws + WS_S5H); const u16* VV = (const u16*)(a.ws + WS_S5V);
#pragma unroll 1
            for (int kp = 0; kp < 2; ++kp) {
                bf16x8 a0[2], a1[2], bfv[2][8];
#pragma unroll
                for (int k2 = 0; k2 < 2; ++k2) {
                    const int ks = kp * 2 + k2;
                    a0[k2] = *(const bf16x8*)(HP + (size_t)(g * 128 + cb * 32 + fr) * 128 + ks * 32 + fq * 8);
                    a1[k2] = *(const bf16x8*)(HP + (size_t)(g * 128 + cb * 32 + 16 + fr) * 128 + ks * 32 + fq * 8);
#pragma unroll
                    for (int tt = 0; tt < 8; ++tt)
                        bfv[k2][tt] = *(const bf16x8*)(VV + (size_t)(g * 1024 + (wid + 8 * tt) * 16 + fr) * 128 + ks * 32 + fq * 8);
                }
#pragma unroll
                for (int k2 = 0; k2 < 2; ++k2)
#pragma unroll
                    for (int tt = 0; tt < 8; ++tt) {
                        acc[tt][0] = __builtin_amdgcn_mfma_f32_16x16x32_bf16(a0[k2], bfv[k2][tt], acc[tt][0], 0, 0, 0);
                        acc[tt][1] = __builtin_amdgcn_mfma_f32_16x16x32_bf16(a1[k2], bfv[k2][tt], acc[tt][1], 0, 0, 0);
                    }
            }
            const float dsk = a.in[12][g * 16 + fr];
            u16* Z = (u16*)(a.ws + WS_Z);
#pragma unroll
            for (int tt = 0; tt < 8; ++tt) {
                const int t = wid + 8 * tt;
#pragma unroll
                for (int mf = 0; mf < 2; ++mf)
#pragma unroll
                    for (int j = 0; j < 4; ++j) {
                        const int cl = mf * 16 + fq * 4 + j;
                        const float uv = bf2f(*(const u16*)(U + cl * USTR + (t * 16 + fr) * 2));
                        const float y = acc[tt][mf][j] + dsk * uv;
                        Z[(size_t)((cb * 32 + cl) * 64 + t) * SW + g * 16 + fr] = f2bf(gelu_tanh(y));
                    }
            }
        } else {
            const int uu = u - 256, n = uu >> 2, h = uu & 3, t0 = n * 64;
            char* vT = lds;
            char* qI = lds + 32768;
            char* kI = lds + 49152;
            char* pI = lds + 65536;
            float* glr = (float*)(lds + 73728);
            float* tot = glr + 1024;
            float* rss = tot + 512;
            char* sT = lds + 81920;
            {
                const u16* STg = (const u16*)(a.ws + WS_ST) + (size_t)(n * 4 + h) * (HV * HK);
#pragma unroll
                for (int p = 0; p < 8; ++p) {
                    const int row = p * 32 + wid * 4 + (lane >> 4), chunk = ((lane & 15) ^ row) & 15;
                    __builtin_amdgcn_global_load_lds((const unsigned*)(STg + (size_t)row * 128 + chunk * 8), (LAS unsigned*)(sT + p * 8192 + wid * 1024), 16, 0, 0);
                }
            }
            float b[16], blast;
            gla_gate(a, n, h, tid, glr, tot, b, blast);
            const int ch = tid & 127, tq = tid >> 7;
            {
                const int qb0 = (tq * 4 + (ch >> 5)) * 1024 + (ch & 31) * 2, qb1 = qb0 ^ 32;
                const u16* src = PROJ + (size_t)(t0 + tq * 16) * PJ + h * 128 + ch;
#pragma unroll
                for (int tt = 0; tt < 16; ++tt) {
                    const float qv = bf2f(src[(size_t)tt * PJ]);
                    const float kv = bf2f(src[(size_t)tt * PJ + 512]);
                    const int off = (tt < 8 ? qb0 : qb1) + tt * 64;
                    *(u16*)(qI + off) = f2bf(qv * __expf(b[tt]));
                    *(u16*)(kI + off) = f2bf(kv * __expf(-b[tt]));
                }
            }
            gla_stage_vT(PROJ, t0, 1024 + h * 256, vT, tid);
            __syncthreads();
            {
                const int mf = wid & 3, nb = (wid >> 2) * 2;
                f32x4 s0 = {0.f, 0.f, 0.f, 0.f}, s1 = {0.f, 0.f, 0.f, 0.f};
#pragma unroll
                for (int ks = 0; ks < 4; ++ks) {
                    const bf16x8 af = *(const bf16x8*)(qI + lds_byte<4>(mf * 16 + fr, ks * 32 + fq * 8));
                    const bf16x8 b0 = *(const bf16x8*)(kI + lds_byte<4>(nb * 16 + fr, ks * 32 + fq * 8));
                    const bf16x8 b1 = *(const bf16x8*)(kI + lds_byte<4>((nb + 1) * 16 + fr, ks * 32 + fq * 8));
                    s0 = __builtin_amdgcn_mfma_f32_16x16x32_bf16(af, b0, s0, 0, 0, 0);
                    s1 = __builtin_amdgcn_mfma_f32_16x16x32_bf16(af, b1, s1, 0, 0, 0);
                }
#pragma unroll
                for (int j = 0; j < 4; ++j) {
                    const int t = mf * 16 + fq * 4 + j, sA = nb * 16 + fr, sB = sA + 16;
                    *(u16*)(pI + lds_byte<2>(t, sA)) = f2bf(sA <= t ? s0[j] : 0.f);
                    *(u16*)(pI + lds_byte<2>(t, sB)) = f2bf(sB <= t ? s1[j] : 0.f);
                }
            }
            __syncthreads();
            const int mf = wid & 3, nh = wid >> 2;
            f32x4 acc[8];
#pragma unroll
            for (int nn = 0; nn < 8; ++nn) acc[nn] = f32x4{0.f, 0.f, 0.f, 0.f};
#pragma unroll
            for (int ks = 0; ks < 2; ++ks) {
                const bf16x8 af = *(const bf16x8*)(pI + lds_byte<2>(mf * 16 + fr, ks * 32 + fq * 8));
#pragma unroll
                for (int nn = 0; nn < 8; ++nn) {
                    const bf16x8 bf = *(const bf16x8*)(vT + lds_byte<2>(nh * 128 + nn * 16 + fr, ks * 32 + fq * 8));
                    acc[nn] = __builtin_amdgcn_mfma_f32_16x16x32_bf16(af, bf, acc[nn], 0, 0, 0);
                }
            }
#pragma unroll
            for (int ks = 0; ks < 4; ++ks) {
                const bf16x8 af = *(const bf16x8*)(qI + lds_byte<4>(mf * 16 + fr, ks * 32 + fq * 8));
#pragma unroll
                for (int nn = 0; nn < 8; ++nn) {
                    const bf16x8 bf = *(const bf16x8*)(sT + (nh * 128 + nn * 16 + fr) * 256 + ((((ks * 4 + fq) ^ fr) & 15) << 4));
                    acc[nn] = __builtin_amdgcn_mfma_f32_16x16x32_bf16(af, bf, acc[nn], 0, 0, 0);
                }
            }
            u16 rraw[4][8];
#pragma unroll
            for (int j = 0; j < 4; ++j)
#pragma unroll
                for (int nn = 0; nn < 8; ++nn) rraw[j][nn] = PROJ[(size_t)(t0 + mf * 16 + fq * 4 + j) * PJ + 2048 + h * 256 + nh * 128 + nn * 16 + fr];
            float ss[4];
#pragma unroll
            for (int j = 0; j < 4; ++j) {
                float s = 0.f;
#pragma unroll
                for (int nn = 0; nn < 8; ++nn) s += acc[nn][j] * acc[nn][j];
                ss[j] = sum16(s);
            }
            if (fr == 0) {
#pragma unroll
                for (int j = 0; j < 4; ++j) rss[nh * 64 + mf * 16 + fq * 4 + j] = ss[j];
            }
            __syncthreads();
            const float* gn = a.in[5];
#pragma unroll
            for (int j = 0; j < 4; ++j) {
                const int t = mf * 16 + fq * 4 + j;
                const float rstd = rsqrtf((rss[t] + rss[64 + t]) * (1.0f / 256.0f) + EPS);
#pragma unroll
                for (int nn = 0; nn < 8; ++nn) {
                    const int jc = nh * 128 + nn * 16 + fr;
                    const float rv = bf2f(rraw[j][nn]);
                    const float o = acc[nn][j] * rstd * gn[jc] * (rv * sigmoidf_(rv));
                    MIX[(size_t)(t0 + t) * D + h * 256 + jc] = f2bf(o);
                }
            }
        }
    }
}

DEVI void phase5(const Args& a, char* lds, int tid, int wid, int lane) {
    extern __shared__ __attribute__((aligned(16))) char smem_pg8[];
    if (blockIdx.x >= 128) {
        const int c_lo = 8192 + (blockIdx.x - 128) * 22;
        convert_range(a, lds, c_lo, c_lo + 22, tid, wid, lane);
    } else {
        pg8::Gemm g; g.A = a.ws + WS_Z; g.Bt = a.ws + WS_GLUT; g.ld = SW; g.K = SW;
        pg8::StaticOrder S; S.init(T, SW, 128, (int)blockIdx.x);
        EpiGlu E; E.Z = (const u16*)(a.ws + WS_Z); E.MIX = (u16*)(a.ws + WS_MIX); E.SSQ = (float*)(a.ws + WS_SSQ); E.gbias = a.in[15]; E.sng = a.in[16];
        pg8::gemm_phase((PG8_LAS unsigned char*)(smem_pg8 + 1024), g, S, E);
        const int c_lo = 11008 + blockIdx.x * 6; convert_range(a, lds, c_lo, c_lo + 6, tid, wid, lane);
    }
    convert_pool(a, lds, 1, 11776, 13312, tid, wid, lane);
}

DEVI void phase6(const Args& a, char* lds, int tid, int wid, int lane) {
    extern __shared__ __attribute__((aligned(16))) char smem_pg8[];
    const int c6_lo = 13312 + blockIdx.x * 8, c6_hi = c6_lo + 8;
    if ((blockIdx.x >> 3) & 1) convert_range(a, lds, c6_lo, c6_hi, tid, wid, lane);
    if (blockIdx.x < 256) {
        pg8::Gemm g; g.A = a.ws + WS_MIX; g.Bt = a.ws + WS_WOUTT; g.ld = D; g.K = 1024;
        pg8::SplitKOrder S; S.init(T, D, 256, (int)blockIdx.x); S.khalf = 2048;
        EpiOut E; E.x = a.in[0]; E.H1 = (float*)(a.ws + WS_H1); E.SSQ = (const float*)(a.ws + WS_SSQ);
        pg8::gemm_phase((PG8_LAS unsigned char*)(smem_pg8 + 1024), g, S, E);
    }
    if (!((blockIdx.x >> 3) & 1)) convert_range(a, lds, c6_lo, c6_hi, tid, wid, lane);
    convert_pool(a, lds, 2, 15360, 16384, tid, wid, lane);
}

DEVI void phase7(const Args& a, char* lds, int tid, int wid, int lane) {
    const float* H1 = (const float*)(a.ws + WS_H1); unsigned char* HN8 = a.ws + WS_HN2;
    const float* g2 = a.in[18]; const float* rw = a.in[19]; const float* rb = a.in[20];
    int* CNT = (int*)(a.ws + WS_CNT); int* LTOK = (int*)(a.ws + WS_LTOK); float* LGATE = (float*)(a.ws + WS_LGATE); int* TSLOT = (int*)(a.ws + WS_TSLOT);
    float* hn = (float*)lds;
    float* red = hn + 8 * 2048;
    float* lg = red + 8 * 8 * 32;
    for (int u = blockIdx.x; u < 256; u += gridDim.x) {
#pragma unroll 1
        for (int ps = 0; ps < 4; ++ps) {
            const int tok0 = u * 32 + ps * 8;
            { int lq = lane; asm volatile("" : "+v"(lq)); lane = lq; tid = wid * 64 + lq; }
            __syncthreads();
            {
                const int tl = wid, tok = tok0 + tl;
                f32x4 xv[8]; float ss = 0.f;
#pragma unroll
                for (int i = 0; i < 8; ++i) { xv[i] = *(const f32x4*)(H1 + (size_t)tok * D + 256 * i + 4 * lane);
#pragma unroll
                    for (int c = 0; c < 4; ++c) ss += xv[i][c] * xv[i][c]; }
                ss = wave_sum(ss);
                const float r = rsqrtf(ss * (1.0f / D) + EPS);
#pragma unroll
                for (int i = 0; i < 8; ++i) {
                    const f32x4 g = *(const f32x4*)(g2 + 256 * i + 4 * lane);
                    f32x4 o;
#pragma unroll
                    for (int c = 0; c < 4; ++c) o[c] = xv[i][c] * r * g[c];
                    *(f32x4*)(hn + tl * 2048 + 256 * i + 4 * lane) = o;
                }
            }
            __syncthreads();
            {
                const int e = tid & 31, dsl = tid >> 5;
                float acc[8];
#pragma unroll
                for (int k = 0; k < 8; ++k) acc[k] = 0.f;
#pragma unroll 1
                for (int d16 = 0; d16 < 8; ++d16) {
                    float w[16];
#pragma unroll
                    for (int q = 0; q < 16; ++q) w[q] = rw[(dsl * 128 + d16 * 16 + q) * 32 + e];
#pragma unroll
                    for (int q4 = 0; q4 < 4; ++q4) {
                        const int d = dsl * 128 + d16 * 16 + q4 * 4;
#pragma unroll
                        for (int k = 0; k < 8; ++k) {
                            const f32x4 hv = *(const f32x4*)(hn + k * 2048 + d);
                            acc[k] += hv[0] * w[q4 * 4] + hv[1] * w[q4 * 4 + 1] + hv[2] * w[q4 * 4 + 2] + hv[3] * w[q4 * 4 + 3];
                        }
                    }
                }
#pragma unroll
                for (int k = 0; k < 8; ++k) { acc[k] += __shfl_xor(acc[k], 32); }
                if (lane < 32) {
#pragma unroll
                    for (int k = 0; k < 8; ++k) red[(wid * 8 + k) * 32 + e] = acc[k];
                }
            }
            __syncthreads();
            if (tid < 256) {
                const int k = tid >> 5, e = tid & 31;
                float s = rb[e];
#pragma unroll
                for (int w = 0; w < 8; ++w) s += red[(w * 8 + k) * 32 + e];
                lg[k * 32 + e] = s;
            }
            __syncthreads();
            {
                const int tok = tok0 + wid, e = lane & 31;
                float x = lg[wid * 32 + e];
                float v[4]; int id[4];
#pragma unroll
                for (int j = 0; j < 4; ++j) {
                    float bv = x; int bi = e;
#pragma unroll
                    for (int o = 16; o >= 1; o >>= 1) {
                        const float ov = __shfl_xor(bv, o); const int oi = __shfl_xor(bi, o);
                        if (ov > bv || (ov == bv && oi < bi)) { bv = ov; bi = oi; }
                    }
                    v[j] = bv; id[j] = bi;
                    if (e == bi) x = -3.0e38f;
                }
                float ex[4], sum = 0.f;
#pragma unroll
                for (int j = 0; j < 4; ++j) { ex[j] = __expf(v[j] - v[0]); sum += ex[j]; }
                const float inv = 1.0f / sum;
                int ri = 0;
                if (lane < 4) {
                    const int myid = lane == 0 ? id[0] : lane == 1 ? id[1] : lane == 2 ? id[2] : id[3];
                    const float myg = (lane == 0 ? ex[0] : lane == 1 ? ex[1] : lane == 2 ? ex[2] : ex[3]) * inv;
                    const int slot = atomicAdd(&CNT[myid], 1);
                    ri = myid * CAP + slot;
                    LTOK[ri] = tok;
                    LGATE[ri] = myg;
                    TSLOT[tok * 4 + lane] = ri;
                }
                {
                    unsigned char* XG = a.ws + WS_XG;
                    const int r0 = __builtin_amdgcn_readlane(ri, 0), r1 = __builtin_amdgcn_readlane(ri, 1), r2 = __builtin_amdgcn_readlane(ri, 2), r3 = __builtin_amdgcn_readlane(ri, 3);
#pragma unroll
                    for (int i = 0; i < 8; ++i) {
                        const f32x4 o = *(const f32x4*)(hn + wid * 2048 + 256 * i + 4 * lane);
                        const unsigned pk = cvt4_fp8(o[0] * 16.f, o[1] * 16.f, o[2] * 16.f, o[3] * 16.f);
                        const size_t co = 256 * i + 4 * lane;
                        *(unsigned*)(XG + (size_t)r0 * D + co) = pk; *(unsigned*)(XG + (size_t)r1 * D + co) = pk;
                        *(unsigned*)(XG + (size_t)r2 * D + co) = pk; *(unsigned*)(XG + (size_t)r3 * D + co) = pk;
                    }
                }
            }
        }
    }
}

struct MoeTab { int cnt[32]; int off[33]; int ord[32]; int xe[4]; int xub[5]; };
DEVI void moe_tables(const Args& a, MoeTab* tb, int tid, int ntn) {
    __syncthreads();
    if (tid < 32) tb->cnt[tid] = ((const int*)(a.ws + WS_CNT))[tid];
    __syncthreads();
    if (tid < 32) {
        const int me = (tb->cnt[tid] + 255) >> 8;
        int rank = 0, o = 0;
        for (int k = 0; k < 32; ++k) {
            const int c = tb->cnt[k], mk = (c + 255) >> 8;
            rank += (mk > me || (mk == me && k < tid)) ? 1 : 0;
            o += (k < tid) ? c : 0;
        }
        tb->ord[rank] = tid; tb->off[tid] = o;
        if (tid == 31) tb->off[32] = o + tb->cnt[31];
    }
    __syncthreads();
    if (tid == 0) {
        const int xcd = blockIdx.x & 7;
        int ub = 0;
        for (int r = 0; r < 4; ++r) {
            const int e = tb->ord[r * 8 + ((r & 1) ? 7 - xcd : xcd)];
            tb->xe[r] = e; tb->xub[r] = ub;
            ub += ((tb->cnt[e] + 255) >> 8) * ntn;
        }
        tb->xub[4] = ub;
    }
    __syncthreads();
}

struct MoeUnit { int e, nt, r0, rows, grow0, cnt; };
DEVI MoeUnit moe_decode(const MoeTab* tb, int u) {
    int k = 0;
    for (int q = 1; q < 4; ++q) if (u >= tb->xub[q]) k = q;
    MoeUnit d; d.e = tb->xe[k];
    d.cnt = tb->cnt[d.e];
    const int mte = (d.cnt + 255) >> 8, ul = u - tb->xub[k];
    d.nt = ul / mte; const int mi = ul - d.nt * mte;
    d.r0 = mi * 256; d.rows = min(256, d.cnt - d.r0); d.grow0 = tb->off[d.e] + d.r0;
    return d;
}

struct MoeUnit;
namespace pg8 {
struct MU { const char* A; const char* B0; const char* B1; int e, nt, r0, rows, grow0, cnt; };
template <int SCALE_A, int SCALE_B, class Epi, class Sched>
DEVI void f8_gemm_phase(PG8_LAS unsigned char* lds, const Sched& S, const Epi& E) {
    const int tid = threadIdx.x, wid = __builtin_amdgcn_readfirstlane(tid >> 6), lane = tid & 63, wr = wid >> 2, wc = wid & 3, fr = lane & 15, fq = lane >> 4;
    constexpr int nt = 16;
    unsigned voffA[2], voffB[2];
#pragma unroll
    for (int i = 0; i < 2; ++i) { int R, C; stage_rc(tid * 16 + i * 8192, R, C); voffA[i] = (unsigned)(R * 1024 + C) * 2u;
        const int L = wid * 1024 + i * 8192 + lane * 16, q = L >> 9, p0 = (lane & 31) * 4, pu = (p0 - 16 * ((q >> 2) & 3)) & 127;
        voffB[i] = (unsigned)(q * 512 + ((pu & ~31) + perm32(pu & 31)) * 4); }
    const size_t kstep = 128, bstep = 16384, hstep = (size_t)HALF * 2048;
    const unsigned ldsw = (unsigned)wid * 1024u;
    const int aoff = lds_byte(wr * 64 + fr, fq * 8);
    int boffn[2];
#pragma unroll
    for (int n = 0; n < 2; ++n) boffn[n] = (4 * fq) * 512 + ((wc * 32 + 16 * n + fr + 16 * fq) & 127) * 4;
#define PG8_SA(b, h) (((b) * 2 + (h)) * HTB)
#define PG8_SB(b, h) ((4 + (b) * 2 + (h)) * HTB)
#define PG8_STAGE(bufoff, gbase, voff) do { _Pragma("unroll") for (int _i = 0; _i < 2; ++_i) \
        __builtin_amdgcn_global_load_lds((const unsigned*)((const char*)(gbase) + (voff)[_i]), (PG8_LAS unsigned*)(lds + (bufoff) + ldsw + _i * 8192), 16, 0, 0); } while (0)
#define PG8_LDA(dst, b, h) do { _Pragma("unroll") for (int m = 0; m < 4; ++m) { const i32x4 _x = *(const PG8_LAS i32x4*)(lds + PG8_SA(b, h) + aoff + m * 2048), _y = *(const PG8_LAS i32x4*)(lds + PG8_SA(b, h) + aoff + m * 2048 + 1024); \
        dst[m][0] = _x[0]; dst[m][1] = _x[1]; dst[m][2] = _x[2]; dst[m][3] = _x[3]; dst[m][4] = _y[0]; dst[m][5] = _y[1]; dst[m][6] = _y[2]; dst[m][7] = _y[3]; } } while (0)
#define PG8_LDB(dst, b, h) do { _Pragma("unroll") for (int n = 0; n < 2; ++n) _Pragma("unroll") for (int d = 0; d < 8; ++d) dst[n][d] = *(const PG8_LAS int*)(lds + PG8_SB(b, h) + boffn[n] + (d & 3) * 512 + (d >> 2) * 8192); } while (0)
#define PG8_MMA(ai, bj, At, Bt) do { __builtin_amdgcn_s_setprio(1); _Pragma("unroll") for (int m = 0; m < 4; ++m) _Pragma("unroll") for (int n = 0; n < 2; ++n) \
        acc[ai][bj][m][n] = __builtin_amdgcn_mfma_scale_f32_16x16x128_f8f6f4(Bt[n], At[m], acc[ai][bj][m][n], 0, 0, 0, SCALE_B, 0, SCALE_A); __builtin_amdgcn_s_setprio(0); } while (0)
#define PG8_WAIT_V(n) asm volatile("s_waitcnt vmcnt(" #n ")" ::: "memory")
#define PG8_WAIT_L(n) asm volatile("s_waitcnt lgkmcnt(" #n ")" ::: "memory")
#define PG8_BAR __builtin_amdgcn_s_barrier()
#define PG8_SCHED __builtin_amdgcn_sched_barrier(0)
#define PG8_ZERO() do { _Pragma("unroll") for (int a_ = 0; a_ < 2; ++a_) _Pragma("unroll") for (int b_ = 0; b_ < 2; ++b_) _Pragma("unroll") for (int m_ = 0; m_ < 4; ++m_) _Pragma("unroll") for (int n_ = 0; n_ < 2; ++n_) \
        acc[a_][b_][m_][n_] = (f32x4){0.f, 0.f, 0.f, 0.f}; } while (0)
    MU cur, nxt; int ui = 0;
    if (!S.next(0, cur)) return;
    f32x4 acc[2][2][4][2];
    PG8_ZERO();
    i32x8 At[4], B0[2], B1[2];
    const char* cA = cur.A; const char* cB0 = cur.B0; const char* cB1 = cur.B1;
    PG8_STAGE(PG8_SB(0, 0), cB0, voffB); PG8_STAGE(PG8_SA(0, 0), cA, voffA); PG8_STAGE(PG8_SB(0, 1), cB1, voffB); PG8_STAGE(PG8_SA(0, 1), cA + hstep, voffA);
    if (wr == 1) PG8_BAR;
    PG8_WAIT_V(4); PG8_BAR;
    PG8_STAGE(PG8_SB(1, 0), cB0 + bstep, voffB); PG8_STAGE(PG8_SA(1, 0), cA + kstep, voffA); PG8_STAGE(PG8_SB(1, 1), cB1 + bstep, voffB);
    PG8_WAIT_V(6); PG8_BAR;
    for (;;) {
        const bool has_next = S.next(ui + 1, nxt);
        const char* nA = has_next ? nxt.A : cA; const char* nB0 = has_next ? nxt.B0 : cB0; const char* nB1 = has_next ? nxt.B1 : cB1;
#pragma unroll 1
        for (int t = 0; t < nt; t += 2) {
            const bool last = (t == nt - 2);
            const char* a1 = cA + (size_t)(t + 1) * kstep;
            const char* a2 = last ? nA : cA + (size_t)(t + 2) * kstep;
            const char* b20 = last ? nB0 : cB0 + (size_t)(t + 2) * bstep; const char* b21 = last ? nB1 : cB1 + (size_t)(t + 2) * bstep;
            const char* a3 = a2 + kstep; const char* b30 = b20 + bstep; const char* b31 = b21 + bstep;
            PG8_LDB(B0, 0, 0); PG8_SCHED; PG8_LDA(At, 0, 0); PG8_STAGE(PG8_SA(1, 1), a1 + hstep, voffA);
            PG8_WAIT_L(8); PG8_BAR; PG8_WAIT_L(0); PG8_MMA(0, 0, At, B0); PG8_BAR; PG8_SCHED;
            PG8_LDB(B1, 0, 1); PG8_STAGE(PG8_SB(0, 0), b20, voffB);
            PG8_BAR; PG8_WAIT_L(0); PG8_MMA(0, 1, At, B1); PG8_BAR;
            PG8_LDA(At, 0, 1); PG8_STAGE(PG8_SA(0, 0), a2, voffA);
            PG8_BAR; PG8_WAIT_L(0); PG8_MMA(1, 0, At, B0); PG8_BAR; PG8_SCHED;
            PG8_STAGE(PG8_SB(0, 1), b21, voffB);
            PG8_WAIT_V(6); PG8_BAR; PG8_MMA(1, 1, At, B1); PG8_BAR;
            PG8_LDB(B0, 1, 0); PG8_SCHED; PG8_LDA(At, 1, 0); PG8_STAGE(PG8_SA(0, 1), a2 + hstep, voffA);
            PG8_WAIT_L(8); PG8_BAR; PG8_WAIT_L(0); PG8_MMA(0, 0, At, B0); PG8_BAR; PG8_SCHED;
            PG8_LDB(B1, 1, 1); PG8_STAGE(PG8_SB(1, 0), b30, voffB);
            PG8_BAR; PG8_WAIT_L(0); PG8_MMA(0, 1, At, B1); PG8_BAR;
            PG8_LDA(At, 1, 1); PG8_STAGE(PG8_SA(1, 0), a3, voffA);
            PG8_BAR; PG8_WAIT_L(0); PG8_MMA(1, 0, At, B0); PG8_BAR; PG8_SCHED;
            PG8_STAGE(PG8_SB(1, 1), b31, voffB);
            PG8_WAIT_V(6); PG8_BAR; PG8_MMA(1, 1, At, B1); PG8_BAR;
        }
        E(acc, cur, wr, wc, fr, fq);
        if (!has_next) break;
        PG8_ZERO();
        cur = nxt; cA = nA; cB0 = nB0; cB1 = nB1; ++ui;
    }
    PG8_WAIT_V(0);
    if (wr == 0) PG8_BAR;
    PG8_BAR;
#undef PG8_SA
#undef PG8_SB
#undef PG8_STAGE
#undef PG8_LDA
#undef PG8_LDB
#undef PG8_MMA
#undef PG8_WAIT_V
#undef PG8_WAIT_L
#undef PG8_BAR
#undef PG8_SCHED
#undef PG8_ZERO
}
}

struct MoeSched {
    const MoeTab* tb; int nun, nper, u0; const char* Ab; const char* Wb; bool first;
    DEVI bool next(int i, pg8::MU& m) const {
        const int u = u0 + i * nper; if (u >= nun) return false;
        const MoeUnit d = moe_decode(tb, u);
        m.e = __builtin_amdgcn_readfirstlane(d.e); m.nt = __builtin_amdgcn_readfirstlane(d.nt); m.r0 = __builtin_amdgcn_readfirstlane(d.r0);
        m.rows = __builtin_amdgcn_readfirstlane(d.rows); m.grow0 = __builtin_amdgcn_readfirstlane(d.grow0); m.cnt = __builtin_amdgcn_readfirstlane(d.cnt);
        if (first) { m.A = Ab + ((size_t)m.e * CAP + m.r0) * D;
            m.B0 = Wb + (size_t)((m.e * 32 + m.nt) * 512) * 512; m.B1 = m.B0 + (size_t)(16 * 512) * 512; }
        else { m.A = Ab + (size_t)m.grow0 * FF;
            m.B0 = Wb + (size_t)((m.e * 16 + m.nt * 2) * 512) * 512; m.B1 = m.B0 + (size_t)512 * 512; }
        return true;
    }
};
struct EpiMoe1 {
    unsigned char* ACT; const float* b1;
    DEVI void operator()(f32x4 (&acc)[2][2][4][2], const pg8::MU& u, int wr, int wc, int fr, int fq) const {
        const float* bb = b1 + (size_t)u.e * 4096 + u.nt * 128 + wc * 32 + 8 * fq;
        f32x4 bg[2], bl[2];
#pragma unroll
        for (int n = 0; n < 2; ++n) { bg[n] = *(const f32x4*)(bb + 4 * n); bl[n] = *(const f32x4*)(bb + 2048 + 4 * n); }
#pragma unroll
        for (int ai = 0; ai < 2; ++ai)
#pragma unroll
            for (int m = 0; m < 4; ++m) {
                const int row = ai * 128 + wr * 64 + m * 16 + fr;
                const int orow = (row < u.rows) ? u.grow0 + row : T * 4 + row;
                unsigned w[2];
#pragma unroll
                for (int n = 0; n < 2; ++n) {
                    float av[4];
#pragma unroll
                    for (int i = 0; i < 4; ++i) {
                        const float gl = fminf(acc[ai][0][m][n][i] + bg[n][i], 7.0f);
                        const float ln = fminf(fmaxf(acc[ai][1][m][n][i] + bl[n][i], -7.0f), 7.0f);
                        av[i] = gl * sigmoidf_(1.702f * gl) * (ln + 1.0f) * 4.0f;
                    }
                    w[n] = cvt4_fp8(av[0], av[1], av[2], av[3]);
                }
                uint2 pk; pk.x = w[0]; pk.y = w[1];
                *(uint2*)(ACT + (size_t)orow * FF + u.nt * 128 + wc * 32 + 8 * fq) = pk;
            }
    }
};
struct EpiMoe2 {
    u16* Y; const float* b2; const float* LGATE;
    DEVI void operator()(f32x4 (&acc)[2][2][4][2], const pg8::MU& u, int wr, int wc, int fr, int fq) const {
        const float* bb = b2 + (size_t)u.e * D + u.nt * 256 + wc * 32 + 8 * fq;
        f32x4 bv[2][2];
#pragma unroll
        for (int bj = 0; bj < 2; ++bj)
#pragma unroll
            for (int n = 0; n < 2; ++n) bv[bj][n] = *(const f32x4*)(bb + bj * 128 + 4 * n);
#pragma unroll
        for (int ai = 0; ai < 2; ++ai)
#pragma unroll
            for (int m = 0; m < 4; ++m) {
                const int row = ai * 128 + wr * 64 + m * 16 + fr;
                const float gt = LGATE[u.e * CAP + u.r0 + min(row, u.rows - 1)];
                const int orow = (row < u.rows) ? u.grow0 + row : T * 4 + row;
                u16* dst = Y + (size_t)orow * D + u.nt * 256 + wc * 32 + 8 * fq;
#pragma unroll
                for (int bj = 0; bj < 2; ++bj) {
                    const f32x4 v0 = acc[ai][bj][m][0] + bv[bj][0], v1 = acc[ai][bj][m][1] + bv[bj][1];
                    uint4 pk; pk.x = pack2(v0[0] * gt, v0[1] * gt); pk.y = pack2(v0[2] * gt, v0[3] * gt); pk.z = pack2(v1[0] * gt, v1[1] * gt); pk.w = pack2(v1[2] * gt, v1[3] * gt);
                    *(uint4*)(dst + bj * 128) = pk;
                }
            }
    }
};
DEVI void phase8(const Args& a, char* lds, MoeTab* tb, int tid, int wid, int lane) {
    extern __shared__ __attribute__((aligned(16))) char smem_pg8[];
    moe_tables(a, tb, tid, 16);
    const int nun = tb->xub[4], nper = gridDim.x >> 3;
    const int u = blockIdx.x >> 3;
    const int c_lo = 16384 + blockIdx.x * 24, c_hi = c_lo + 24;
    const int nb = u < nun ? (nun - u + nper - 1) / nper : 0;
    const int kc = (u * (nb + 1)) / nper;
#pragma unroll 1
    for (int part = 0; part < 2; ++part) {
        const int ulo = part == 0 ? u : u + kc * nper, uhi = part == 0 ? min(nun, u + kc * nper) : nun;
        if (ulo < uhi) {
            MoeSched S; S.tb = tb; S.nun = uhi; S.nper = nper; S.u0 = ulo; S.Ab = (const char*)(a.ws + WS_XG); S.Wb = (const char*)(a.ws + WS_W1T); S.first = true;
            EpiMoe1 E; E.ACT = a.ws + WS_ACT; E.b1 = a.in[22];
            pg8::f8_gemm_phase<0x7b7b7b7b, 0x77777777>((PG8_LAS unsigned char*)(smem_pg8 + 1024), S, E);
        }
        if (part == 0) convert_range(a, lds, c_lo, c_hi, tid, wid, lane);
    }
    convert_pool(a, lds, 3, 22528, 24576, tid, wid, lane);
}

DEVI void phase9(const Args& a, char* lds, MoeTab* tb, int tid, int wid, int lane) {
    extern __shared__ __attribute__((aligned(16))) char smem_pg8[];
    moe_tables(a, tb, tid, 8);
    const int nun = tb->xub[4], nper = gridDim.x >> 3;
    const int u = blockIdx.x >> 3;
    if (u >= nun) return;
    MoeSched S; S.tb = tb; S.nun = nun; S.nper = nper; S.u0 = u; S.Ab = (const char*)(a.ws + WS_ACT); S.Wb = (const char*)(a.ws + WS_W2T); S.first = false;
    EpiMoe2 E; E.Y = (u16*)(a.ws + WS_Y); E.b2 = a.in[24]; E.LGATE = (const float*)(a.ws + WS_LGATE);
    pg8::f8_gemm_phase<0x7d7d7d7d, 0x77777777>((PG8_LAS unsigned char*)(smem_pg8 + 1024), S, E);
}

DEVI void phase10(const Args& a, MoeTab* tb, int tid, int wid, int lane) {
    const float* H1 = (const float*)(a.ws + WS_H1); const u16* Y = (const u16*)(a.ws + WS_Y); const int* TSLOT = (const int*)(a.ws + WS_TSLOT);
    const float* fg = a.in[25];
    moe_tables(a, tb, tid, 8);
    for (int tok = blockIdx.x * 8 + wid; tok < T; tok += gridDim.x * 8) {
        int rowi[4];
#pragma unroll
        for (int j = 0; j < 4; ++j) { const int ts = TSLOT[tok * 4 + j]; rowi[j] = tb->off[ts >> 13] + (ts & (CAP - 1)); }
        f32x4 hv[8]; float ss = 0.f;
#pragma unroll
        for (int i = 0; i < 8; ++i) {
            hv[i] = *(const f32x4*)(H1 + (size_t)tok * D + 256 * i + 4 * lane);
#pragma unroll
            for (int j = 0; j < 4; ++j) {
                const uint2 yv = *(const uint2*)(Y + (size_t)rowi[j] * D + 256 * i + 4 * lane);
                hv[i][0] += bflo(yv.x); hv[i][1] += bfhi(yv.x); hv[i][2] += bflo(yv.y); hv[i][3] += bfhi(yv.y);
            }
#pragma unroll
            for (int c = 0; c < 4; ++c) ss += hv[i][c] * hv[i][c];
        }
        ss = wave_sum(ss);
        const float r = rsqrtf(ss * (1.0f / D) + EPS);
#pragma unroll
        for (int i = 0; i < 8; ++i) {
            const f32x4 g = *(const f32x4*)(fg + 256 * i + 4 * lane);
            f32x4 o;
#pragma unroll
            for (int c = 0; c < 4; ++c) o[c] = hv[i][c] * r * g[c];
            *(f32x4*)(a.out + (size_t)tok * D + 256 * i + 4 * lane) = o;
        }
    }
}

constexpr int NPHASE = 11;
__global__ void __launch_bounds__(512, 2) mega_fwd(Args a) {
    extern __shared__ __attribute__((aligned(1024))) char smem[];
    const int wid_s = __builtin_amdgcn_readfirstlane((int)threadIdx.x >> 6);
    if (threadIdx.x == 0) *(uint4*)smem = make_uint4(0u, 0u, 0u, 0u);
    __syncthreads();
    XcdBarrier bar = xcd_barrier_post((unsigned*)(a.ws + WS_BAR), (volatile LAS unsigned*)smem);
    char* lds = smem + LDS_BASE;
    MoeTab* tb = (MoeTab*)(smem + 64);
#ifndef REP_MASK
#define REP_MASK 0
#endif
#define PHASE(k, call) if (a.ph_lo <= (k) && (k) < a.ph_hi) { if (a.ph_lo < (k)) xcd_barrier(bar); \
        int lane = (int)__builtin_amdgcn_mbcnt_hi(~0u, __builtin_amdgcn_mbcnt_lo(~0u, 0u)); asm volatile("" : "+v"(lane)); \
        const int wid = wid_s, tid = wid_s * 64 + lane; \
        call; if ((REP_MASK >> (k)) & 1) { __syncthreads(); call; } }
    PHASE(0, phase0(a, lds, tid, wid, lane))
    PHASE(1, phase1(a, lds, tid, wid, lane))
    PHASE(2, phase2(a, lds, tid, wid, lane))
    PHASE(3, phase3(a, tid))
    PHASE(4, phase4(a, lds, tid, wid, lane))
    PHASE(5, phase5(a, lds, tid, wid, lane))
    PHASE(6, phase6(a, lds, tid, wid, lane))
    PHASE(7, phase7(a, lds, tid, wid, lane))
    PHASE(8, phase8(a, lds, tb, tid, wid, lane))
    PHASE(9, phase9(a, lds, tb, tid, wid, lane))
    PHASE(10, phase10(a, tb, tid, wid, lane))
#undef PHASE
}

extern "C" void kernel_launch(void* const* d_in, const int* in_sizes, int n_in, void* d_out, int out_size, void* d_ws, size_t ws_size, hipStream_t stream) {
    static int grid = 0;
    if (grid == 0) {
        if (n_in != 26 || out_size != T * D || ws_size < WS_END) { fprintf(stderr, "kernel_launch: unexpected shapes (n_in %d out %d ws %zu need %zu)\n", n_in, out_size, ws_size, (size_t)WS_END); grid = -1; return; }
        int dev = 0, cus = 0, per_cu = 0;
        if (hipGetDevice(&dev) != hipSuccess || hipDeviceGetAttribute(&cus, hipDeviceAttributeMultiprocessorCount, dev) != hipSuccess) { grid = -1; return; }
        if (hipFuncSetAttribute((const void*)mega_fwd, hipFuncAttributeMaxDynamicSharedMemorySize, LDS_BYTES) != hipSuccess) { fprintf(stderr, "kernel_launch: hipFuncSetAttribute failed\n"); grid = -1; return; }
        if (hipOccupancyMaxActiveBlocksPerMultiprocessor(&per_cu, (const void*)mega_fwd, 512, LDS_BYTES) != hipSuccess || per_cu < 1)
            fprintf(stderr, "kernel_launch: occupancy query reports %d blocks per CU\n", per_cu);
        (void)hipGetLastError();
        grid = cus;
    }
    if (grid < 0) return;
    Args a{};
    for (int i = 0; i < 26; ++i) a.in[i] = (const float*)d_in[i];
    a.out = (float*)d_out; a.ws = (unsigned char*)d_ws;
#if N_LAUNCH_SPLIT
    for (int k = 0; k < NPHASE; ++k) {
        (void)hipMemsetAsync((char*)d_ws + WS_BAR, 0, XCD_BAR_WORDS * sizeof(unsigned), stream);
        a.ph_lo = k; a.ph_hi = k + 1;
        hipLaunchKernelGGL(mega_fwd, dim3(grid), dim3(512), LDS_BYTES, stream, a);
    }
#else
    (void)hipMemsetAsync((char*)d_ws + WS_BAR, 0, XCD_BAR_WORDS * sizeof(unsigned), stream);
    a.ph_lo = 0; a.ph_hi = NPHASE;
    hipLaunchKernelGGL(mega_fwd, dim3(grid), dim3(512), LDS_BYTES, stream, a);
#endif
}
```

```cpp
#include <hip/hip_runtime.h>
#include <hip/hip_bf16.h>
#include <stdint.h>
#include <stdio.h>

#ifndef N_LAUNCH_SPLIT
#define N_LAUNCH_SPLIT 0
#endif

#define DEVI __device__ __forceinline__
typedef __attribute__((ext_vector_type(8))) short bf16x8;
typedef __attribute__((ext_vector_type(4))) float f32x4;
typedef __attribute__((ext_vector_type(4))) int i32x4;
typedef __attribute__((ext_vector_type(2))) float f2v;
typedef __attribute__((ext_vector_type(2))) __bf16 b2v;
typedef unsigned short u16;

constexpr int T = 8192, D = 2048, PW = 4112;
constexpr int NH = 4, HK = 128, HV = 256, CH = 64, NCH = 128, RANK = 16;
constexpr int SW = 1024, SG = 16, NG = 64, SP = 64;
constexpr int NE = 32, FF = 2048, CAP = 8192;
constexpr int PJ = 4096;
constexpr float EPS = 1e-6f;

constexpr size_t WS_BAR   = 0;
constexpr size_t WS_CNT   = 32768;
constexpr size_t WS_SSQ   = 65536;
constexpr size_t WS_GLR   = WS_SSQ + 65536;
constexpr size_t WS_DEC   = WS_GLR + (size_t)T * 16 * 4;
constexpr size_t WS_S5AL  = WS_DEC + (size_t)NCH * NH * HK * 4;
constexpr size_t WS_TSLOT = WS_S5AL + 65536;
constexpr size_t WS_LTOK  = WS_TSLOT + (size_t)T * 4 * 4;
constexpr size_t WS_LGATE = WS_LTOK + (size_t)NE * CAP * 4;
constexpr size_t WS_S5K   = WS_LGATE + (size_t)NE * CAP * 4;
constexpr size_t WS_S5WE  = WS_S5K + (size_t)NG * 64 * 256 * 2;
constexpr size_t WS_S5V   = WS_S5WE + (size_t)NG * 128 * 1024 * 2;
constexpr size_t WS_S5E   = WS_S5V + (size_t)NG * 1024 * 128 * 2;
constexpr size_t WS_S5H   = WS_S5E + (size_t)NG * 128 * 128 * 4;
constexpr size_t WS_HN    = WS_S5H + (size_t)NG * 128 * 128 * 2;
constexpr size_t WS_PROJ  = WS_HN + (size_t)T * D * 2;
constexpr size_t WS_KV    = WS_PROJ + (size_t)T * PJ * 2;
constexpr size_t WS_ST    = WS_KV + (size_t)NCH * NH * HV * HK * 4;
constexpr size_t WS_Z     = WS_ST + (size_t)NCH * NH * HV * HK * 2;
constexpr size_t WS_MIX   = WS_Z + (size_t)T * SW * 2;
constexpr size_t WS_H1    = WS_MIX + (size_t)T * D * 2;
constexpr size_t WS_HN2   = WS_H1 + (size_t)T * D * 4;
constexpr size_t WS_ACT   = WS_HN2 + (size_t)T * D * 2;
constexpr size_t WS_Y     = WS_ACT + (size_t)(T * 4 + 256) * FF * 2;
constexpr size_t WS_W1T   = WS_Y + (size_t)(T * 4 + 256) * D * 2;
constexpr size_t WS_W2T   = WS_W1T + (size_t)NE * 4096 * D;
constexpr size_t WS_WINT  = WS_W2T + (size_t)NE * D * FF;
constexpr size_t WS_GLUT  = WS_WINT + (size_t)PJ * D * 2;
constexpr size_t WS_WOUTT = WS_GLUT + (size_t)SW * SW * 2;
constexpr size_t WS_XG    = WS_WOUTT + (size_t)D * D * 2;
constexpr size_t WS_END   = WS_XG + (size_t)NE * 8192 * D;

constexpr int LDS_BYTES = 163840;
constexpr int LDS_CONV = 131072;
constexpr int LDS_BASE = 1024;

DEVI unsigned pack2(float a, float b) { f2v v = {a, b}; b2v r = __builtin_convertvector(v, b2v); return __builtin_bit_cast(unsigned, r); }
DEVI u16 f2bf(float a) { __bf16 r = (__bf16)a; return __builtin_bit_cast(u16, r); }
DEVI float bf2f(u16 h) { return __uint_as_float(((unsigned)h) << 16); }
DEVI float bflo(unsigned w) { return __uint_as_float(w << 16); }
DEVI float bfhi(unsigned w) { return __uint_as_float(w & 0xffff0000u); }
DEVI float wave_sum(float v) {
#pragma unroll
    for (int o = 32; o >= 1; o >>= 1) v += __shfl_xor(v, o);
    return v;
}
DEVI float sum16(float v) {
#pragma unroll
    for (int o = 8; o >= 1; o >>= 1) v += __shfl_xor(v, o);
    return v;
}
DEVI float sigmoidf_(float x) { return __builtin_amdgcn_rcpf(1.0f + __expf(-x)); }
DEVI float logsigmoid_(float x) { return fminf(x, 0.0f) - __logf(1.0f + __expf(-fabsf(x))); }
DEVI float gelu_tanh(float x) {
    const float a = 0.7978845608028654f * (x + 0.044715f * x * x * x);
    return x * __builtin_amdgcn_rcpf(1.0f + __expf(-2.0f * a));
}

#define WAIT_V0() asm volatile("s_waitcnt vmcnt(0)" ::: "memory")
#define WAIT_L0() asm volatile("s_waitcnt lgkmcnt(0)" ::: "memory")

#define XB_TMO      128
#define XB_XCNT(j)  (256  + 64 * (j))
#define XB_XSUB(j)  (1280 + 64 * (j))
#define XB_XGEN(j)  (2304 + 64 * (j))
#define XB_TOP      3328
#define XB_TOPGEN   3392
#define XCD_BAR_WORDS 3456
#define XB_SPIN_CAP (1u << 20)
#define LAS __attribute__((address_space(3)))

DEVI unsigned xb_ld(unsigned* p)              { return __hip_atomic_load(p, __ATOMIC_RELAXED, __HIP_MEMORY_SCOPE_AGENT); }
DEVI unsigned xb_add(unsigned* p, unsigned v) { return __hip_atomic_fetch_add(p, v, __ATOMIC_RELAXED, __HIP_MEMORY_SCOPE_AGENT); }
DEVI unsigned xb_xcc_id() { return (unsigned)__builtin_amdgcn_s_getreg((3 << 11) | 20) & 0xFu; }
#define XB_SPIN(cond, bar) do { unsigned _sp = 0; while (cond) { __builtin_amdgcn_s_sleep(1); \
    if ((++_sp & 255u) == 0u) { if (xb_ld(&(bar)[XB_TMO])) break; if (_sp > XB_SPIN_CAP) { atomicAdd(&(bar)[XB_TMO], 1u); break; } } } } while (0)

struct XcdBarrier { unsigned* bar; unsigned x; volatile LAS unsigned* st; };

DEVI XcdBarrier xcd_barrier_post(unsigned* bar, volatile LAS unsigned* st) {
    XcdBarrier b; b.bar = bar; b.x = xb_xcc_id(); b.st = st;
    if (threadIdx.x == 0) (void)xb_add(&bar[XB_XCNT(b.x)], 1u);
    return b;
}
DEVI void xcd_barrier_complete(unsigned* bar, unsigned x, unsigned& nloc, unsigned& nx) {
    const unsigned G = gridDim.x * gridDim.y * gridDim.z;
    unsigned sum, cnt, mine, sp = 0u;
    for (;;) {
        sum = 0u; cnt = 0u; mine = 0u;
#pragma unroll
        for (unsigned j = 0; j < 16; ++j) { const unsigned c = xb_ld(&bar[XB_XCNT(j)]); sum += c; cnt += (c > 0u) ? 1u : 0u; mine = (j == x) ? c : mine; }
        if (sum == G) break;
        __builtin_amdgcn_s_sleep(1);
        if ((++sp & 255u) == 0u) { if (xb_ld(&bar[XB_TMO])) break; if (sp > XB_SPIN_CAP) { atomicAdd(&bar[XB_TMO], 1u); break; } }
    }
    nloc = mine > 0u ? mine : 1u; nx = cnt > 0u ? cnt : 1u;
}
DEVI void xcd_barrier(const XcdBarrier& b) {
    asm volatile("s_waitcnt vmcnt(0)" ::: "memory");
    __syncthreads();
    if (threadIdx.x == 0) {
        unsigned* bar = b.bar;
        __builtin_amdgcn_s_waitcnt(0);
        unsigned nloc = b.st[0], nx = b.st[1];
        if (nloc == 0u) { xcd_barrier_complete(bar, b.x, nloc, nx); b.st[0] = nloc; b.st[1] = nx; }
        const unsigned old = xb_add(&bar[XB_XSUB(b.x)], 1u);
        const unsigned gen = old / nloc;
        if (old + 1u == (gen + 1u) * nloc) {
            __builtin_amdgcn_fence(__ATOMIC_RELEASE, "agent");
            asm volatile("s_waitcnt vmcnt(0)" ::: "memory");
            const unsigned og = xb_add(&bar[XB_TOP], 1u);
            const unsigned tg = og / nx;
            if (og + 1u == (tg + 1u) * nx) xb_add(&bar[XB_TOPGEN], 1u);
            else XB_SPIN(xb_ld(&bar[XB_TOPGEN]) == tg, bar);
            __builtin_amdgcn_fence(__ATOMIC_ACQUIRE, "agent");
            xb_add(&bar[XB_XGEN(b.x)], 1u);
            asm volatile("s_waitcnt vmcnt(0)" ::: "memory");
        } else {
            XB_SPIN(xb_ld(&bar[XB_XGEN(b.x)]) == gen, bar);
            __builtin_amdgcn_fence(__ATOMIC_ACQUIRE, "agent");
            asm volatile("s_waitcnt vmcnt(0)" ::: "memory");
        }
    }
    __syncthreads();
}

struct Args {
    const float* in[26];
    float* out;
    unsigned char* ws;
    int ph_lo, ph_hi;
};

template <int KS> DEVI int lds_byte(int r, int c) {
    int st = (r >> 4) * KS + (c >> 5), ob = (r & 15) * 64 + (c & 31) * 2;
    return st * 1024 + (ob ^ (((ob >> 9) & 1) << 5));
}
typedef __attribute__((ext_vector_type(16))) float f32x16;
typedef __attribute__((ext_vector_type(8))) int i32x8;
DEVI void f8_stage_rb(int wid, int lane, int i, int& R, int& CB) {
    R = wid * 16 + i * 128 + (lane >> 2);
    CB = (((lane & 3) ^ (R >> 2)) & 3) * 16;
}
DEVI int acc_row32(int wr, int m, int r, int lane) { return wr * 128 + m * 32 + (r & 3) + 8 * (r >> 2) + 4 * (lane >> 5); }
DEVI unsigned cvt4_fp8(float a, float b, float c, float d) {
    int r = 0;
    r = __builtin_amdgcn_cvt_pk_fp8_f32(a, b, r, false);
    r = __builtin_amdgcn_cvt_pk_fp8_f32(c, d, r, true);
    return (unsigned)r;
}
#define WAIT_VN(n) asm volatile("s_waitcnt vmcnt(" #n ")" ::: "memory")
DEVI void f8_stage(char* lds, const unsigned char* __restrict__ A, const unsigned (&aoff)[2], const unsigned char* __restrict__ B, const unsigned (&boffv)[2], int wid, int t) {
    char* sb = lds + (t & 3) * 32768 + wid * 1024;
#pragma unroll
    for (int i = 0; i < 2; ++i) {
        __builtin_amdgcn_global_load_lds((const unsigned*)(A + aoff[i] + t * 64), (LAS unsigned*)(sb + i * 8192), 16, 0, 0);
        __builtin_amdgcn_global_load_lds((const unsigned*)(B + boffv[i] + t * 64), (LAS unsigned*)(sb + 16384 + i * 8192), 16, 0, 0);
    }
}
DEVI void f8_prefetch(char* lds, const unsigned char* __restrict__ A, const unsigned (&aoff)[2], const unsigned char* __restrict__ B, const unsigned (&boffv)[2], int wid) {
    f8_stage(lds, A, aoff, B, boffv, wid, 0); f8_stage(lds, A, aoff, B, boffv, wid, 1); f8_stage(lds, A, aoff, B, boffv, wid, 2);
}
DEVI void q8_stage(char* lds, const unsigned char* __restrict__ A, const unsigned (&aoff)[2], const unsigned char* __restrict__ B, const unsigned (&boffv)[2], int wid, int t) {
    char* sb = lds + (t & 3) * 32768 + wid * 1024;
#pragma unroll
    for (int i = 0; i < 2; ++i) {
        __builtin_amdgcn_global_load_lds((const unsigned*)(A + aoff[i] + t * 64), (LAS unsigned*)(sb + i * 8192), 16, 0, 0);
        __builtin_amdgcn_global_load_lds((const unsigned*)(B + boffv[i] + t * 8192), (LAS unsigned*)(sb + 16384 + i * 8192), 16, 0, 0);
    }
}
DEVI void q8_prefetch(char* lds, const unsigned char* __restrict__ A, const unsigned (&aoff)[2], const unsigned char* __restrict__ B, const unsigned (&boffv)[2], int wid) {
    q8_stage(lds, A, aoff, B, boffv, wid, 0); q8_stage(lds, A, aoff, B, boffv, wid, 1); q8_stage(lds, A, aoff, B, boffv, wid, 2);
}
template <int NT, int SCALE_A, int SCALE_B, bool MOE1>
DEVI void f8_mainloop(char* lds, const unsigned char* __restrict__ A, const unsigned (&aoff)[2], const unsigned char* __restrict__ B, const unsigned (&boffv)[2],
                      int wid, int lane, f32x16 (&acc)[2][4]) {
    const int wr = wid >> 2, wc = wid & 3, l31 = lane & 31, hh = lane >> 5;
    const int xs = (l31 >> 2) & 3;
    const int p0 = ((2 * hh) ^ xs) << 4, p1 = ((2 * hh + 1) ^ xs) << 4;
    const int a_lo = (wr * 128 + l31) * 64 + p0, a_hi = (wr * 128 + l31) * 64 + p1;
    int b_rd[2];
#pragma unroll
    for (int nf = 0; nf < 2; ++nf) {
        const int ntile = MOE1 ? nf : (wc >> 1), nbase = MOE1 ? wc * 32 : (wc & 1) * 64 + nf * 32;
        b_rd[nf] = 16384 + ntile * 8192 + (8 * hh) * 512 + (nbase + l31) * 4;
    }
    auto ldfrag = [&](const char* sa, int lo, int hi) -> i32x8 {
        const i32x4 x = *(const i32x4*)(sa + lo), y = *(const i32x4*)(sa + hi);
        i32x8 r; r[0] = x[0]; r[1] = x[1]; r[2] = x[2]; r[3] = x[3]; r[4] = y[0]; r[5] = y[1]; r[6] = y[2]; r[7] = y[3];
        return r;
    };
    auto compute = [&](int t) {
        const char* sa = lds + (t & 3) * 32768;
        i32x8 fa[4], fb[2];
#pragma unroll
        for (int m = 0; m < 4; ++m) fa[m] = ldfrag(sa + m * 2048, a_lo, a_hi);
#pragma unroll
        for (int n = 0; n < 2; ++n)
#pragma unroll
            for (int j = 0; j < 8; ++j) fb[n][j] = *(const int*)(sa + b_rd[n] + j * 512);
#pragma unroll
        for (int m = 0; m < 4; ++m)
#pragma unroll
            for (int n = 0; n < 2; ++n)
                acc[n][m] = __builtin_amdgcn_mfma_scale_f32_32x32x64_f8f6f4(fb[n], fa[m], acc[n][m], 0, 0, 0, SCALE_B, 0, SCALE_A);
    };
    WAIT_V0(); __builtin_amdgcn_s_barrier();
#pragma unroll 1
    for (int t = 0; t < NT; ++t) {
        if (t + 3 < NT) q8_stage(lds, A, aoff, B, boffv, wid, t + 3);
        compute(t);
        if (t + 3 < NT) { WAIT_VN(8); } else if (t + 2 < NT) { WAIT_VN(4); } else { WAIT_V0(); }
        WAIT_L0(); __builtin_amdgcn_s_barrier();
    }
}
DEVI void touch4(const f32x4& v) { asm volatile("" :: "v"(v)); }
DEVI void touchf(float v) { asm volatile("" :: "v"(v)); }
DEVI void zero_acc32(f32x16 (&acc)[2][4]) {
#pragma unroll
    for (int n = 0; n < 2; ++n)
#pragma unroll
        for (int m = 0; m < 4; ++m)
#pragma unroll
            for (int r = 0; r < 16; ++r) acc[n][m][r] = 0.f;
}

DEVI void bf_stage_rb(int wid, int lane, int i, int& R, int& CB) {
    R = wid * 16 + i * 128 + (lane >> 2);
    CB = (((lane & 3) ^ (R >> 1)) & 3) * 16;
}
template <int NT>
DEVI void bf_mainloop(char* lds, const unsigned char* __restrict__ A, const unsigned (&aoff)[2], const unsigned char* __restrict__ B, const unsigned (&boffv)[2],
                      int wid, int lane, f32x4 (&acc)[4][8]) {
    const int wr = wid >> 2, wc = wid & 3, l15 = lane & 15, q = lane >> 4;
    const int cp = (q ^ ((l15 >> 1) & 3)) << 4;
    const int t_rd = (wr * 128 + l15) * 64 + cp;
    const int w_rd = 16384 + (wc * 64 + l15) * 64 + cp;
    auto compute = [&](int t) {
        const char* sa = lds + (t & 3) * 32768;
        bf16x8 tf[8], wf[4];
#pragma unroll
        for (int nt = 0; nt < 4; ++nt) wf[nt] = *(const bf16x8*)(sa + w_rd + nt * 1024);
#pragma unroll
        for (int mt = 0; mt < 8; ++mt) tf[mt] = *(const bf16x8*)(sa + t_rd + mt * 1024);
#pragma unroll
        for (int mt = 0; mt < 8; ++mt)
#pragma unroll
            for (int nt = 0; nt < 4; ++nt)
                acc[nt][mt] = __builtin_amdgcn_mfma_f32_16x16x32_bf16(wf[nt], tf[mt], acc[nt][mt], 0, 0, 0);
    };
    WAIT_V0(); __builtin_amdgcn_s_barrier();
#pragma unroll 1
    for (int t = 0; t < NT; ++t) {
        if (t + 3 < NT) f8_stage(lds, A, aoff, B, boffv, wid, t + 3);
        compute(t);
        if (t + 3 < NT) { WAIT_VN(8); } else if (t + 2 < NT) { WAIT_VN(4); } else { WAIT_V0(); }
        WAIT_L0(); __builtin_amdgcn_s_barrier();
    }
}
DEVI void zero_acc16(f32x4 (&acc)[4][8]) {
#pragma unroll
    for (int nt = 0; nt < 4; ++nt)
#pragma unroll
        for (int mt = 0; mt < 8; ++mt) acc[nt][mt] = f32x4{0.f, 0.f, 0.f, 0.f};
}
DEVI void bf_offsets(unsigned (&off)[2], int wid, int lane, int row0, int ld) {
#pragma unroll
    for (int i = 0; i < 2; ++i) { int R, CB; bf_stage_rb(wid, lane, i, R, CB); off[i] = ((unsigned)(row0 + R) * ld) * 2u + CB; }
}

DEVI void dense_convert(const Args& a, char* lds, int tid, int wid, int lane) {
    constexpr int RS = 132;
    unsigned* L = (unsigned*)lds;
    const int kq = tid >> 5, nq = tid & 31;
    auto tile = [&](int tl, const float*& src, int& ld, int& ldo, u16*& dst) {
        if (tl < 512) { const int kt = tl & 15, nt = tl >> 4; const int c0 = (nt < 24) ? nt * 128 : 3088 + (nt - 24) * 128;
            src = a.in[2] + (size_t)(kt * 128) * PW + c0; ld = PW; ldo = D; dst = (u16*)(a.ws + WS_WINT) + (size_t)(nt * 128) * D + kt * 128; }
        else if (tl < 576) { const int t2 = tl - 512, kt = t2 & 7, nt = t2 >> 3;
            src = a.in[14] + (size_t)(kt * 128) * SW + nt * 128; ld = SW; ldo = SW; dst = (u16*)(a.ws + WS_GLUT) + (size_t)(nt * 128) * SW + kt * 128; }
        else { const int t2 = tl - 576, kt = t2 & 15, nt = t2 >> 4;
            src = a.in[17] + (size_t)(kt * 128) * D + nt * 128; ld = D; ldo = D; dst = (u16*)(a.ws + WS_WOUTT) + (size_t)(nt * 128) * D + kt * 128; }
    };
    f32x4 v[2][4];
    auto issue = [&](int tl) {
        const float* src; int ld, ldo; u16* dst; tile(tl, src, ld, ldo, dst);
#pragma unroll
        for (int h = 0; h < 2; ++h)
#pragma unroll
            for (int r = 0; r < 4; ++r) v[h][r] = *(const f32x4*)(src + (size_t)(4 * (kq + 16 * h) + r) * ld + 4 * nq);
    };
    if ((int)blockIdx.x < 832) issue(blockIdx.x);
#pragma unroll 1
    for (int tl = blockIdx.x; tl < 832; tl += gridDim.x) {
        const float* src; int ld, ldo; u16* dst; tile(tl, src, ld, ldo, dst);
        __syncthreads();
#pragma unroll
        for (int h = 0; h < 2; ++h) {
            i32x4 d0, d1;
#pragma unroll
            for (int c = 0; c < 4; ++c) { d0[c] = (int)pack2(v[h][0][c], v[h][1][c]); d1[c] = (int)pack2(v[h][2][c], v[h][3][c]); }
            *(i32x4*)(L + (2 * (kq + 16 * h)) * RS + 4 * nq) = d0;
            *(i32x4*)(L + (2 * (kq + 16 * h) + 1) * RS + 4 * nq) = d1;
        }
        if (tl + (int)gridDim.x < 832) issue(tl + gridDim.x);
        __syncthreads();
        {
            const int part = wid & 3, n = (wid >> 2) * 64 + lane;
            unsigned o[16];
#pragma unroll
            for (int j = 0; j < 16; ++j) o[j] = L[(16 * part + j) * RS + n];
            uint4* dp = (uint4*)(dst + (size_t)n * ldo + 32 * part);
            dp[0] = make_uint4(o[0], o[1], o[2], o[3]); dp[1] = make_uint4(o[4], o[5], o[6], o[7]);
            dp[2] = make_uint4(o[8], o[9], o[10], o[11]); dp[3] = make_uint4(o[12], o[13], o[14], o[15]);
        }
    }
}

DEVI void convert_range(const Args& a, char* lds, int t_lo, int t_hi, int tid, int wid, int lane) {
    const float* w1 = a.in[21]; const float* w2 = a.in[23];
    unsigned char* W1Q = a.ws + WS_W1T; unsigned char* W2Q = a.ws + WS_W2T;
    { int lq = lane; asm volatile("" : "+v"(lq)); lane = lq; tid = wid * 64 + lq; }
    const int kq0 = tid >> 5, n4 = tid & 31;
    auto tile_src = [&](int tl, const float*& src, int& ld, unsigned char*& dst) {
        if (tl < 16384) { const int kt = tl & 15, nt = (tl >> 4) & 31, e = tl >> 9;
            src = w1 + (size_t)e * D * 4096 + (size_t)(kt * 128) * 4096 + nt * 128; ld = 4096;
            dst = W1Q + ((size_t)(e * 32 + nt) * 512 + kt * 32) * 512; }
        else { const int t2 = tl - 16384, kt = t2 & 15, nt = (t2 >> 4) & 15, e = t2 >> 8;
            src = w2 + (size_t)e * FF * D + (size_t)(kt * 128) * D + nt * 128; ld = D;
            dst = W2Q + ((size_t)(e * 16 + nt) * 512 + kt * 32) * 512; }
    };
    f32x4 va[2][4], vb[2][4];
    auto issue = [&](int tl, f32x4 (&v)[2][4]) {
        const float* src; int ld; unsigned char* dst; tile_src(tl, src, ld, dst);
#pragma unroll
        for (int h = 0; h < 2; ++h)
#pragma unroll
            for (int r = 0; r < 4; ++r) v[h][r] = __builtin_nontemporal_load((const f32x4*)(src + (size_t)(4 * (kq0 + 16 * h) + r) * ld + 4 * n4));
    };
    auto finish = [&](int tl, f32x4 (&v)[2][4], int tnext) {
        const float* src; int ld; unsigned char* dst; tile_src(tl, src, ld, dst);
        uint4 o[2];
#pragma unroll
        for (int h = 0; h < 2; ++h) {
            o[h].x = cvt4_fp8(v[h][0][0] * 256.f, v[h][1][0] * 256.f, v[h][2][0] * 256.f, v[h][3][0] * 256.f);
            o[h].y = cvt4_fp8(v[h][0][1] * 256.f, v[h][1][1] * 256.f, v[h][2][1] * 256.f, v[h][3][1] * 256.f);
            o[h].z = cvt4_fp8(v[h][0][2] * 256.f, v[h][1][2] * 256.f, v[h][2][2] * 256.f, v[h][3][2] * 256.f);
            o[h].w = cvt4_fp8(v[h][0][3] * 256.f, v[h][1][3] * 256.f, v[h][2][3] * 256.f, v[h][3][3] * 256.f);
        }
        if (tnext < t_hi) issue(tnext, v);
#pragma unroll
        for (int h = 0; h < 2; ++h) *(uint4*)(dst + ((size_t)(kq0 + 16 * h) * 128 + 4 * n4) * 4) = o[h];
    };
    if (t_lo < t_hi) issue(t_lo, va);
    if (t_lo + 1 < t_hi) issue(t_lo + 1, vb);
#pragma unroll 1
    for (int tl = t_lo; tl < t_hi; tl += 2) {
        finish(tl, va, tl + 2);
        if (tl + 1 < t_hi) finish(tl + 1, vb, tl + 3);
    }
}

DEVI void convert_pool(const Args& a, char* lds, int which, int p_lo, int p_hi, int tid, int wid, int lane) {
    int* cur = (int*)(a.ws + WS_CNT) + 64 + which;
    volatile int* bc = (volatile int*)(lds - LDS_BASE + 32);
#pragma unroll 1
    while (true) {
        __syncthreads();
        if (tid == 0) *bc = atomicAdd(cur, 4);
        __syncthreads();
        const int t = p_lo + *bc;
        if (t >= p_hi) break;
        convert_range(a, lds, t, min(t + 4, p_hi), tid, wid, lane);
    }
}

DEVI void phase0(const Args& a, char* lds, int tid, int wid, int lane) {
    const float* x = a.in[0]; const float* g1 = a.in[1]; const float* w_in = a.in[2];
    u16* HN = (u16*)(a.ws + WS_HN); float* GLR = (float*)(a.ws + WS_GLR);
    constexpr int RSB = 4096 + 16;
    char* Wb = lds;
    char* Hb = lds + 16 * RSB;
    float* red = (float*)(lds + 32 * RSB);
    for (int u = blockIdx.x; u < 256; u += gridDim.x) {
        __syncthreads();
        for (int k = 0; k < 4; ++k) {
            const int d = (tid + 512 * k + 8 * (int)blockIdx.x) & 2047;
            const f32x4* src = (const f32x4*)(w_in + (size_t)d * PW + 3072);
#pragma unroll
            for (int q = 0; q < 4; ++q) { f32x4 v = src[q];
#pragma unroll
                for (int c = 0; c < 4; ++c) *(u16*)(Wb + (q * 4 + c) * RSB + d * 2) = f2bf(v[c]); }
        }
        if (tid < 32) ((float*)(a.ws + WS_SSQ))[u * 32 + tid] = 0.f;
        if (u == 0 && tid < 32) { ((int*)(a.ws + WS_CNT))[tid] = 0; ((int*)(a.ws + WS_CNT))[64 + tid] = 0; }
#pragma unroll 1
        for (int ps = 0; ps < 2; ++ps) {
            const int tok0 = u * 32 + ps * 16;
            {
                const int tokA = tok0 + wid * 2, tokB = tokA + 1;
                f32x4 xa[8], xb[8];
                float ssa = 0.f, ssb = 0.f;
#pragma unroll
                for (int i = 0; i < 8; ++i) {
                    xa[i] = *(const f32x4*)(x + (size_t)tokA * D + 256 * i + 4 * lane);
                    xb[i] = *(const f32x4*)(x + (size_t)tokB * D + 256 * i + 4 * lane);
#pragma unroll
                    for (int c = 0; c < 4; ++c) { ssa += xa[i][c] * xa[i][c]; ssb += xb[i][c] * xb[i][c]; }
                }
                ssa = wave_sum(ssa); ssb = wave_sum(ssb);
                const float ra = rsqrtf(ssa * (1.0f / D) + EPS), rb = rsqrtf(ssb * (1.0f / D) + EPS);
#pragma unroll
                for (int i = 0; i < 8; ++i) {
                    const f32x4 g = *(const f32x4*)(g1 + 256 * i + 4 * lane);
                    uint2 pa, pb;
                    pa.x = pack2(xa[i][0] * ra * g[0], xa[i][1] * ra * g[1]); pa.y = pack2(xa[i][2] * ra * g[2], xa[i][3] * ra * g[3]);
                    pb.x = pack2(xb[i][0] * rb * g[0], xb[i][1] * rb * g[1]); pb.y = pack2(xb[i][2] * rb * g[2], xb[i][3] * rb * g[3]);
                    *(uint2*)(HN + (size_t)tokA * D + 256 * i + 4 * lane) = pa;
                    *(uint2*)(HN + (size_t)tokB * D + 256 * i + 4 * lane) = pb;
                    *(uint2*)(Hb + (wid * 2) * RSB + (256 * i + 4 * lane) * 2) = pa;
                    *(uint2*)(Hb + (wid * 2 + 1) * RSB + (256 * i + 4 * lane) * 2) = pb;
                }
            }
            __syncthreads();
            {
                const int l15 = lane & 15, q = lane >> 4;
                f32x4 acc = {0.f, 0.f, 0.f, 0.f};
#pragma unroll
                for (int ks = 0; ks < 8; ++ks) {
                    const int kb = (wid * 256 + ks * 32 + q * 8) * 2;
                    const bf16x8 av = *(const bf16x8*)(Hb + l15 * RSB + kb);
                    const bf16x8 bv = *(const bf16x8*)(Wb + l15 * RSB + kb);
                    acc = __builtin_amdgcn_mfma_f32_16x16x32_bf16(av, bv, acc, 0, 0, 0);
                }
#pragma unroll
                for (int j = 0; j < 4; ++j) red[(wid * 16 + 4 * q + j) * 16 + l15] = acc[j];
            }
            __syncthreads();
            if (tid < 256) {
                float sacc = 0.f;
#pragma unroll
                for (int w = 0; w < 8; ++w) sacc += red[w * 256 + tid];
                GLR[(size_t)(tok0 + (tid >> 4)) * 16 + (tid & 15)] = sacc;
            }
        }
    }
    const float* a_re = a.in[6]; const float* a_im = a.in[7]; const float* b_re = a.in[8]; const float* b_im = a.in[9];
    const float* c_re = a.in[10]; const float* c_im = a.in[11]; const float* lstep = a.in[13];
    u16* KT = (u16*)(a.ws + WS_S5K); u16* WE = (u16*)(a.ws + WS_S5WE); u16* VV = (u16*)(a.ws + WS_S5V); float* AL = (float*)(a.ws + WS_S5AL);
    float* Bre = (float*)lds;
    float* Bim = Bre + 1024;
    float* Cre = Bim + 1024;
    float* Cim = Cre + 1024;
    float* Pre = Cim + 1024;
    float* Pim = Pre + 65 * 64;
    for (int u = blockIdx.x; u < 256; u += gridDim.x) {
        const int g = u >> 2, q = u & 3;
        __syncthreads();
        const float delta = __expf(lstep[g]);
        if (tid < 64) {
            const int p = tid;
            const float ar = a_re[g * 64 + p], ai = a_im[g * 64 + p];
            const float ea = expf(ar * delta);
            float sn, cs; sincosf(ai * delta, &sn, &cs);
            const float xr = ea * cs - 1.0f, xi = ea * sn;
            const float den = 1.0f / (ar * ar + ai * ai);
            const float cr = (xr * ar + xi * ai) * den, ci = (xi * ar - xr * ai) * den;
#pragma unroll
            for (int m = 0; m < 16; ++m) {
                const float br = b_re[(g * 64 + p) * 16 + m], bi = b_im[(g * 64 + p) * 16 + m];
                Bre[p * 16 + m] = cr * br - ci * bi;
                Bim[p * 16 + m] = cr * bi + ci * br;
            }
        }
        for (int i = tid; i < 1024; i += 512) { Cre[i] = c_re[g * 1024 + i]; Cim[i] = c_im[g * 1024 + i]; }
        for (int i = tid; i < 65 * 64; i += 512) {
            const int tau = i >> 6, p = i & 63;
            const float ar = a_re[g * 64 + p], ai = a_im[g * 64 + p];
            const float e = expf((float)tau * ar * delta);
            float sn, cs; sincosf((float)tau * (ai * delta), &sn, &cs);
            Pre[i] = e * cs; Pim[i] = e * sn;
        }
        __syncthreads();
        if (q == 0 && tid < 64) { AL[(g * 64 + tid) * 2] = Pre[64 * 64 + tid]; AL[(g * 64 + tid) * 2 + 1] = Pim[64 * 64 + tid]; }
        if (tid < 256) {
            const int tau = q * 16 + (tid >> 4), n = tid & 15;
            float acc[16];
#pragma unroll
            for (int m = 0; m < 16; ++m) acc[m] = 0.f;
#pragma unroll 2
            for (int p = 0; p < 64; ++p) {
                const float cr = Cre[n * 64 + p], ci = Cim[n * 64 + p], pr = Pre[tau * 64 + p], pi = Pim[tau * 64 + p];
                const float xr = cr * pr - ci * pi, xi = cr * pi + ci * pr;
#pragma unroll
                for (int m4 = 0; m4 < 4; ++m4) {
                    const f32x4 br = *(const f32x4*)(Bre + p * 16 + m4 * 4), bi = *(const f32x4*)(Bim + p * 16 + m4 * 4);
#pragma unroll
                    for (int c = 0; c < 4; ++c) acc[m4 * 4 + c] += xr * br[c] - xi * bi[c];
                }
            }
            uint4 o0, o1;
            o0.x = pack2(acc[0], acc[1]); o0.y = pack2(acc[2], acc[3]); o0.z = pack2(acc[4], acc[5]); o0.w = pack2(acc[6], acc[7]);
            o1.x = pack2(acc[8], acc[9]); o1.y = pack2(acc[10], acc[11]); o1.z = pack2(acc[12], acc[13]); o1.w = pack2(acc[14], acc[15]);
            uint4* dst = (uint4*)(KT + ((size_t)(g * 64 + tau) * 16 + n) * 16);
            dst[0] = o0; dst[1] = o1;
        }
        {
            const int p = tid >> 3;
#pragma unroll
            for (int ss = 0; ss < 2; ++ss) {
                const int s = q * 16 + (tid & 7) * 2 + ss;
                const float pr = Pre[(63 - s) * 64 + p], pi = Pim[(63 - s) * 64 + p];
                float vr[16], vi[16];
#pragma unroll
                for (int m = 0; m < 16; ++m) { const float br = Bre[p * 16 + m], bi = Bim[p * 16 + m]; vr[m] = pr * br - pi * bi; vi[m] = pr * bi + pi * br; }
                uint4 r0, r1, i0, i1;
                r0.x = pack2(vr[0], vr[1]); r0.y = pack2(vr[2], vr[3]); r0.z = pack2(vr[4], vr[5]); r0.w = pack2(vr[6], vr[7]);
                r1.x = pack2(vr[8], vr[9]); r1.y = pack2(vr[10], vr[11]); r1.z = pack2(vr[12], vr[13]); r1.w = pack2(vr[14], vr[15]);
                i0.x = pack2(vi[0], vi[1]); i0.y = pack2(vi[2], vi[3]); i0.z = pack2(vi[4], vi[5]); i0.w = pack2(vi[6], vi[7]);
                i1.x = pack2(vi[8], vi[9]); i1.y = pack2(vi[10], vi[11]); i1.z = pack2(vi[12], vi[13]); i1.w = pack2(vi[14], vi[15]);
                uint4* dr = (uint4*)(WE + ((size_t)(g * 128 + 2 * p) * 1024 + s * 16));
                uint4* di = (uint4*)(WE + ((size_t)(g * 128 + 2 * p + 1) * 1024 + s * 16));
                dr[0] = r0; dr[1] = r1; di[0] = i0; di[1] = i1;
            }
        }
        {
            const int tau = q * 16 + (tid >> 5), n = (tid >> 1) & 15, ph = tid & 1;
            unsigned* dst = (unsigned*)(VV + ((size_t)(g * 1024 + tau * 16 + n) * 128 + ph * 64));
#pragma unroll 4
            for (int pp = 0; pp < 32; ++pp) {
                const int p = ph * 32 + pp;
                const float cr = Cre[n * 64 + p], ci = Cim[n * 64 + p], pr = Pre[(tau + 1) * 64 + p], pi = Pim[(tau + 1) * 64 + p];
                dst[pp] = pack2(cr * pr - ci * pi, -(cr * pi + ci * pr));
            }
        }
    }
    __syncthreads();
    dense_convert(a, lds, tid, wid, lane);
}


namespace pg8 {
#define PG8_LAS __attribute__((address_space(3)))
constexpr int BM = 256, BK = 64, HALF = 128, HTB = HALF * BK * 2, NXCD = 8, WGM = 8;
DEVI int lds_byte(int r, int c) { const int st = (r >> 4) * 2 + (c >> 5), rr = r & 15, cc = c & 31, ob = rr * 64 + cc * 2; return st * 1024 + (ob ^ (((ob >> 9) & 1) << 5)); }
DEVI void stage_rc(int b, int& R, int& C) { const int st = b / 1024, sb = b % 1024, swz = sb ^ (((sb >> 9) & 1) << 5); R = (st >> 1) * 16 + swz / 64; C = (st & 1) * 32 + (swz % 64) / 2; }
DEVI int perm32(int rho) { const int n = rho >> 4, i = rho & 15; return 8 * (i >> 2) + 4 * n + (i & 3); }
struct Unit { int pm, pn, kofs, cont; };
struct Gemm { const void* A; const void* Bt; int ld, K; };
struct StaticOrder {
    int nM, nN, nwg, G, c;
    DEVI void init(int M, int N, int G_, int c_) { nM = M / BM; nN = N / BM; nwg = nM * nN; G = G_; c = c_; }
    DEVI bool tile(int i, Unit& u) const {
        const long L = (long)i * G + c; if (L >= nwg) return false;
        int wgid = (int)L; { const int q = nwg / NXCD, r = nwg % NXCD, xcd = wgid % NXCD, off = wgid / NXCD; wgid = (xcd < r ? xcd * (q + 1) : r * (q + 1) + (xcd - r) * q) + off; }
        const int nig = WGM * nN, gid = wgid / nig, fm = gid * WGM, gsz = (nM - fm) < WGM ? (nM - fm) : WGM;
        u.pm = fm + ((wgid % nig) % gsz); u.pn = (wgid % nig) / gsz; return true;
    }
    int i0 = 0, i1 = 1 << 30;
    DEVI bool next(int i, Unit& u) const { u.kofs = 0; u.cont = 0; return (i0 + i < i1) && tile(i0 + i, u); }
};
struct SplitKOrder : StaticOrder {
    int khalf;
    DEVI bool next(int i, Unit& u) const { if (i >= 2) return false; u.kofs = i == 0 ? khalf : 0; u.cont = i; return tile(0, u); }
};

template <class Epi, class Sched>
DEVI void gemm_phase(PG8_LAS unsigned char* lds, const Gemm g, const Sched& S, const Epi& E) {
    const int tid = threadIdx.x, wid = __builtin_amdgcn_readfirstlane(tid >> 6), lane = tid & 63, wr = wid >> 2, wc = wid & 3, fr = lane & 15, fq = lane >> 4;
    const int ld = g.ld, nt = g.K / BK;
    unsigned voffA[2], voffB[2];
#pragma unroll
    for (int i = 0; i < 2; ++i) { int R, C; stage_rc(tid * 16 + i * 8192, R, C); const int Rb = Epi::PERM ? ((R & ~31) + perm32(R & 31)) : R;
        voffA[i] = (unsigned)(R * ld + C) * 2u; voffB[i] = (unsigned)(Rb * ld + C) * 2u; }
    const size_t kstep = (size_t)(BK * 2);
    const size_t hstep = (size_t)HALF * ld * 2;
    const size_t tstep = 2 * hstep;
    const unsigned ldsw = (unsigned)wid * 1024u;
    const int aoff = lds_byte(wr * 64 + fr, fq * 8), boff = lds_byte(wc * 32 + fr, fq * 8);
#define PG8_SA(b, h) (((b) * 2 + (h)) * HTB)
#define PG8_SB(b, h) ((4 + (b) * 2 + (h)) * HTB)
#define PG8_STAGE(bufoff, gbase, voff) do { _Pragma("unroll") for (int _i = 0; _i < 2; ++_i) \
        __builtin_amdgcn_global_load_lds((const unsigned*)((const char*)(gbase) + (voff)[_i]), (PG8_LAS unsigned*)(lds + (bufoff) + ldsw + _i * 8192), 16, 0, 0); } while (0)
#define PG8_LDA(dst, b, h) do { _Pragma("unroll") for (int m = 0; m < 4; ++m) _Pragma("unroll") for (int k = 0; k < 2; ++k) dst[m][k] = *(const PG8_LAS bf16x8*)(lds + PG8_SA(b, h) + aoff + m * 2048 + k * 1024); } while (0)
#define PG8_LDB(dst, b, h) do { _Pragma("unroll") for (int n = 0; n < 2; ++n) _Pragma("unroll") for (int k = 0; k < 2; ++k) dst[n][k] = *(const PG8_LAS bf16x8*)(lds + PG8_SB(b, h) + boff + n * 2048 + k * 1024); } while (0)
#define PG8_MMA(ai, bj, At, Bt) do { __builtin_amdgcn_s_setprio(1); _Pragma("unroll") for (int m = 0; m < 4; ++m) _Pragma("unroll") for (int n = 0; n < 2; ++n) _Pragma("unroll") for (int k = 0; k < 2; ++k) \
        acc[ai][bj][m][n] = __builtin_amdgcn_mfma_f32_16x16x32_bf16(Bt[n][k], At[m][k], acc[ai][bj][m][n], 0, 0, 0); __builtin_amdgcn_s_setprio(0); } while (0)
#define PG8_WAIT_V(n) asm volatile("s_waitcnt vmcnt(" #n ")" ::: "memory")
#define PG8_WAIT_L(n) asm volatile("s_waitcnt lgkmcnt(" #n ")" ::: "memory")
#define PG8_BAR __builtin_amdgcn_s_barrier()
#define PG8_SCHED __builtin_amdgcn_sched_barrier(0)
#define PG8_ZERO() do { _Pragma("unroll") for (int a_ = 0; a_ < 2; ++a_) _Pragma("unroll") for (int b_ = 0; b_ < 2; ++b_) _Pragma("unroll") for (int m_ = 0; m_ < 4; ++m_) _Pragma("unroll") for (int n_ = 0; n_ < 2; ++n_) \
        acc[a_][b_][m_][n_] = (f32x4){0.f, 0.f, 0.f, 0.f}; } while (0)
    Unit cur, nxt; int ui = 0;
    if (!S.next(0, cur)) return;
    f32x4 acc[2][2][4][2];
    PG8_ZERO();
    bf16x8 At[4][2], B0[2][2], B1[2][2];
    const char* cA = (const char*)g.A + (size_t)cur.pm * tstep + cur.kofs; const char* cB = (const char*)g.Bt + (size_t)cur.pn * tstep + cur.kofs;
    PG8_STAGE(PG8_SB(0, 0), cB, voffB); PG8_STAGE(PG8_SA(0, 0), cA, voffA); PG8_STAGE(PG8_SB(0, 1), cB + hstep, voffB); PG8_STAGE(PG8_SA(0, 1), cA + hstep, voffA);
    if (wr == 1) PG8_BAR;
    PG8_WAIT_V(4); PG8_BAR;
    PG8_STAGE(PG8_SB(1, 0), cB + kstep, voffB); PG8_STAGE(PG8_SA(1, 0), cA + kstep, voffA); PG8_STAGE(PG8_SB(1, 1), cB + hstep + kstep, voffB);
    PG8_WAIT_V(6); PG8_BAR;
    for (;;) {
        const bool has_next = S.next(ui + 1, nxt);
        const char* nA = has_next ? (const char*)g.A + (size_t)nxt.pm * tstep + nxt.kofs : cA; const char* nB = has_next ? (const char*)g.Bt + (size_t)nxt.pn * tstep + nxt.kofs : cB;
        for (int t = 0; t < nt; t += 2) {
            const bool last = (t == nt - 2);
            const char* a1 = cA + (size_t)(t + 1) * kstep;
            const char* a2 = last ? nA : cA + (size_t)(t + 2) * kstep; const char* b2 = last ? nB : cB + (size_t)(t + 2) * kstep;
            const char* a3 = a2 + kstep; const char* b3 = b2 + kstep;
            PG8_LDB(B0, 0, 0); PG8_SCHED; PG8_LDA(At, 0, 0); PG8_STAGE(PG8_SA(1, 1), a1 + hstep, voffA);
            PG8_WAIT_L(8); PG8_BAR; PG8_WAIT_L(0); PG8_MMA(0, 0, At, B0); PG8_BAR; PG8_SCHED;
            PG8_LDB(B1, 0, 1); PG8_STAGE(PG8_SB(0, 0), b2, voffB);
            PG8_BAR; PG8_WAIT_L(0); PG8_MMA(0, 1, At, B1); PG8_BAR;
            PG8_LDA(At, 0, 1); PG8_STAGE(PG8_SA(0, 0), a2, voffA);
            PG8_BAR; PG8_WAIT_L(0); PG8_MMA(1, 0, At, B0); PG8_BAR; PG8_SCHED;
            PG8_STAGE(PG8_SB(0, 1), b2 + hstep, voffB);
            PG8_WAIT_V(6); PG8_BAR; PG8_MMA(1, 1, At, B1); PG8_BAR;
            PG8_LDB(B0, 1, 0); PG8_SCHED; PG8_LDA(At, 1, 0); PG8_STAGE(PG8_SA(0, 1), a2 + hstep, voffA);
            PG8_WAIT_L(8); PG8_BAR; PG8_WAIT_L(0); PG8_MMA(0, 0, At, B0); PG8_BAR; PG8_SCHED;
            PG8_LDB(B1, 1, 1); PG8_STAGE(PG8_SB(1, 0), b3, voffB);
            PG8_BAR; PG8_WAIT_L(0); PG8_MMA(0, 1, At, B1); PG8_BAR;
            PG8_LDA(At, 1, 1); PG8_STAGE(PG8_SA(1, 0), a3, voffA);
            PG8_BAR; PG8_WAIT_L(0); PG8_MMA(1, 0, At, B0); PG8_BAR; PG8_SCHED;
            PG8_STAGE(PG8_SB(1, 1), b3 + hstep, voffB);
            PG8_WAIT_V(6); PG8_BAR; PG8_MMA(1, 1, At, B1); PG8_BAR;
        }
        E(acc, cur, wr, wc, fr, fq);
        if (!has_next) break;
        if (!nxt.cont) PG8_ZERO();
        cur = nxt; cA = nA; cB = nB; ++ui;
    }
    PG8_WAIT_V(0);
    if (wr == 0) PG8_BAR;
    PG8_BAR;
#undef PG8_SA
#undef PG8_SB
#undef PG8_STAGE
#undef PG8_LDA
#undef PG8_LDB
#undef PG8_MMA
#undef PG8_WAIT_V
#undef PG8_WAIT_L
#undef PG8_BAR
#undef PG8_SCHED
#undef PG8_ZERO
}
}

struct EpiProj {
    static constexpr bool PERM = true;
    u16* out;
    DEVI void operator()(f32x4 (&acc)[2][2][4][2], const pg8::Unit& u, int wr, int wc, int fr, int fq) const {
        const float sc = (u.pn < 2) ? 0.08838834764831845f : 1.0f;
        const int row0 = u.pm * 256 + wr * 64 + fr, col0 = u.pn * 256 + wc * 32 + 8 * fq;
#pragma unroll
        for (int ai = 0; ai < 2; ++ai)
#pragma unroll
            for (int m = 0; m < 4; ++m) {
                u16* rowp = out + (size_t)(row0 + ai * 128 + m * 16) * PJ + col0;
#pragma unroll
                for (int bj = 0; bj < 2; ++bj) {
                    const f32x4 v0 = acc[ai][bj][m][0], v1 = acc[ai][bj][m][1];
                    uint4 w; w.x = pack2(v0[0] * sc, v0[1] * sc); w.y = pack2(v0[2] * sc, v0[3] * sc); w.z = pack2(v1[0] * sc, v1[1] * sc); w.w = pack2(v1[2] * sc, v1[3] * sc);
                    *(uint4*)(rowp + bj * 128) = w;
                }
            }
    }
};
struct EpiGlu {
    static constexpr bool PERM = true;
    const u16* Z; u16* MIX; float* SSQ; const float* gbias; const float* sng;
    DEVI void operator()(f32x4 (&acc)[2][2][4][2], const pg8::Unit& u, int wr, int wc, int fr, int fq) const {
        const int row0 = u.pm * 256 + wr * 64 + fr, col0 = u.pn * 256 + wc * 32 + 8 * fq;
#pragma unroll
        for (int ai = 0; ai < 2; ++ai)
#pragma unroll
            for (int m = 0; m < 4; ++m) {
                const int row = row0 + ai * 128 + m * 16;
                float sq = 0.f;
#pragma unroll
                for (int bj = 0; bj < 2; ++bj) {
                    const int c = col0 + bj * 128;
                    const uint4 zv = *(const uint4*)(Z + (size_t)row * SW + c);
                    const unsigned zw[4] = {zv.x, zv.y, zv.z, zv.w};
                    unsigned ow[4];
#pragma unroll
                    for (int n = 0; n < 2; ++n) {
                        const f32x4 gb = *(const f32x4*)(gbias + c + 4 * n), sg = *(const f32x4*)(sng + c + 4 * n);
                        const f32x4 v = acc[ai][bj][m][n];
                        const float y0 = bflo(zw[2 * n]) * sigmoidf_(v[0] + gb[0]), y1 = bfhi(zw[2 * n]) * sigmoidf_(v[1] + gb[1]);
                        const float y2 = bflo(zw[2 * n + 1]) * sigmoidf_(v[2] + gb[2]), y3 = bfhi(zw[2 * n + 1]) * sigmoidf_(v[3] + gb[3]);
                        sq += y0 * y0 + y1 * y1 + y2 * y2 + y3 * y3;
                        ow[2 * n] = pack2(y0 * sg[0], y1 * sg[1]); ow[2 * n + 1] = pack2(y2 * sg[2], y3 * sg[3]);
                    }
                    uint4 w; w.x = ow[0]; w.y = ow[1]; w.z = ow[2]; w.w = ow[3];
                    *(uint4*)(MIX + (size_t)row * D + 1024 + c) = w;
                }
                sq += __shfl_xor(sq, 16); sq += __shfl_xor(sq, 32);
                if (fq == 0) atomicAdd(&SSQ[row], sq);
            }
    }
};
struct EpiOut {
    static constexpr bool PERM = false;
    const float* x; float* H1; const float* SSQ;
    DEVI void operator()(f32x4 (&acc)[2][2][4][2], const pg8::Unit& u, int wr, int wc, int fr, int fq) const {
        const int row0 = u.pm * 256 + wr * 64 + fr, col0 = u.pn * 256 + wc * 32 + 4 * fq;
        if (u.cont == 0) {
#pragma unroll
            for (int ai = 0; ai < 2; ++ai)
#pragma unroll
                for (int m = 0; m < 4; ++m) {
                    const float rs = rsqrtf(SSQ[row0 + ai * 128 + m * 16] * (1.0f / SW) + EPS);
#pragma unroll
                    for (int bj = 0; bj < 2; ++bj)
#pragma unroll
                        for (int n = 0; n < 2; ++n) acc[ai][bj][m][n] *= rs;
                }
        } else {
#pragma unroll
            for (int ai = 0; ai < 2; ++ai)
#pragma unroll
                for (int m = 0; m < 4; ++m) {
                    const size_t base = (size_t)(row0 + ai * 128 + m * 16) * D + col0;
#pragma unroll
                    for (int bj = 0; bj < 2; ++bj)
#pragma unroll
                        for (int n = 0; n < 2; ++n) {
                            const f32x4 xv = *(const f32x4*)(x + base + bj * 128 + n * 16);
                            *(f32x4*)(H1 + base + bj * 128 + n * 16) = xv + acc[ai][bj][m][n];
                        }
                }
        }
    }
};

DEVI void phase1(const Args& a, char* lds, int tid, int wid, int lane) {
    extern __shared__ __attribute__((aligned(16))) char smem_pg8[];
    const int cpos = blockIdx.x % 3, c_lo = blockIdx.x * 24, c_hi = c_lo + 24;
#pragma unroll 1
    for (int part = 0; part < 2; ++part) {
        if (part == cpos) convert_range(a, lds, c_lo, c_hi, tid, wid, lane);
        pg8::Gemm g; g.A = a.ws + WS_HN; g.Bt = a.ws + WS_WINT; g.ld = D; g.K = D;
        pg8::StaticOrder S; S.init(T, PJ, (int)gridDim.x, (int)blockIdx.x);
        if (cpos == 1) { S.i0 = part; S.i1 = part + 1; } else if (part == 1) S.i1 = 0;
        EpiProj E; E.out = (u16*)(a.ws + WS_PROJ);
        pg8::gemm_phase(( PG8_LAS unsigned char*)(smem_pg8 + 1024), g, S, E);
    }
    if (cpos == 2) convert_range(a, lds, c_lo, c_hi, tid, wid, lane);
    convert_pool(a, lds, 0, 6144, 8192, tid, wid, lane);
}

DEVI void gla_gate(const Args& a, int n, int h, int tid, float* glr, float* tot, float (&b)[16], float& blast) {
    const float* GLR = (const float*)(a.ws + WS_GLR);
    const float* W2 = a.in[3]; const float* gb = a.in[4];
    for (int i = tid; i < 1024; i += 512) glr[i] = GLR[(size_t)n * 64 * 16 + i];
    const int ch = tid & 127, tq = tid >> 7;
    float w[16];
#pragma unroll
    for (int r = 0; r < 16; ++r) w[r] = W2[r * 512 + h * 128 + ch];
    const float bias = gb[h * 128 + ch];
    __syncthreads();
    float run = 0.f;
#pragma unroll
    for (int tt = 0; tt < 16; ++tt) {
        const int t = tq * 16 + tt;
        float s = bias;
#pragma unroll
        for (int r4 = 0; r4 < 4; ++r4) {
            const f32x4 gv = *(const f32x4*)(glr + t * 16 + r4 * 4);
            s += gv[0] * w[r4 * 4] + gv[1] * w[r4 * 4 + 1] + gv[2] * w[r4 * 4 + 2] + gv[3] * w[r4 * 4 + 3];
        }
        run += logsigmoid_(s) * (1.0f / 16.0f);
        b[tt] = run;
    }
    tot[tq * 128 + ch] = run;
    __syncthreads();
    float pre = 0.f;
#pragma unroll
    for (int k = 0; k < 4; ++k) { const float v = tot[k * 128 + ch]; if (k < tq) pre += v; }
    blast = tot[ch] + tot[128 + ch] + tot[256 + ch] + tot[384 + ch];
#pragma unroll
    for (int tt = 0; tt < 16; ++tt) b[tt] += pre;
}
DEVI void gla_stage_vT(const u16* PROJ, int t0, int vcol0, char* img, int tid) {
    if (tid < 256) {
        const int tb = tid >> 5, jb = tid & 31;
        unsigned R[8][4];
#pragma unroll
        for (int tt = 0; tt < 8; ++tt) {
            const uint4 v = *(const uint4*)(PROJ + (size_t)(t0 + tb * 8 + tt) * PJ + vcol0 + jb * 8);
            R[tt][0] = v.x; R[tt][1] = v.y; R[tt][2] = v.z; R[tt][3] = v.w;
        }
#pragma unroll
        for (int jj = 0; jj < 8; ++jj) {
            unsigned o[4];
#pragma unroll
            for (int d = 0; d < 4; ++d) {
                const unsigned lo = R[2 * d][jj >> 1], hi = R[2 * d + 1][jj >> 1];
                o[d] = (jj & 1) ? ((lo >> 16) | (hi & 0xffff0000u)) : ((lo & 0xffffu) | (hi << 16));
            }
            *(uint4*)(img + lds_byte<2>(jb * 8 + jj, tb * 8)) = make_uint4(o[0], o[1], o[2], o[3]);
        }
    }
}

constexpr int USTR = 2048 + 16;
DEVI void s5_fill_U(const u16* PROJ, int g, int cb, char* U, int tid) {
    for (int k = 0; k < 4; ++k) {
        const int idx = tid + 512 * k, c = idx >> 6, s = idx & 63;
        const uint4* src = (const uint4*)(PROJ + (size_t)((cb * 32 + c) * 64 + s) * PJ + 3072 + g * 16);
        uint4* dst = (uint4*)(U + c * USTR + s * 32);
        dst[0] = src[0]; dst[1] = src[1];
    }
}
DEVI void phase2(const Args& a, char* lds, int tid, int wid, int lane) {
    const u16* PROJ = (const u16*)(a.ws + WS_PROJ);
#pragma unroll 1
    for (int u = blockIdx.x; u < 768; u += gridDim.x) {
        { int lq = lane; asm volatile("" : "+v"(lq)); lane = lq; tid = wid * 64 + lq; }
        const int fr = lane & 15, fq = lane >> 4;
        __syncthreads();
        if (u < 256) {
            const int g = u >> 2, cb = u & 3;
            s5_fill_U(PROJ, g, cb, lds, tid);
            __syncthreads();
            const u16* WE = (const u16*)(a.ws + WS_S5WE) + (size_t)(g * 128 + wid * 16 + fr) * 1024 + fq * 8;
            f32x4 acc0 = {0.f, 0.f, 0.f, 0.f}, acc1 = {0.f, 0.f, 0.f, 0.f};
#pragma unroll 8
            for (int ks = 0; ks < 32; ++ks) {
                const bf16x8 bf = *(const bf16x8*)(WE + ks * 32);
                const bf16x8 a0 = *(const bf16x8*)(lds + fr * USTR + (ks * 32 + fq * 8) * 2);
                const bf16x8 a1 = *(const bf16x8*)(lds + (16 + fr) * USTR + (ks * 32 + fq * 8) * 2);
                acc0 = __builtin_amdgcn_mfma_f32_16x16x32_bf16(a0, bf, acc0, 0, 0, 0);
                acc1 = __builtin_amdgcn_mfma_f32_16x16x32_bf16(a1, bf, acc1, 0, 0, 0);
            }
            float* E = (float*)(a.ws + WS_S5E);
#pragma unroll
            for (int j = 0; j < 4; ++j) {
                E[(size_t)(g * 128 + cb * 32 + fq * 4 + j) * 128 + wid * 16 + fr] = acc0[j];
                E[(size_t)(g * 128 + cb * 32 + 16 + fq * 4 + j) * 128 + wid * 16 + fr] = acc1[j];
            }
        } else {
            const int uu = u - 256, n = uu >> 2, h = uu & 3, t0 = n * 64;
            char* vT = lds;
            char* kT = lds + 32768;
            float* glr = (float*)(lds + 49152);
            float* tot = glr + 1024;
            float b[16], blast;
            gla_gate(a, n, h, tid, glr, tot, b, blast);
            const int ch = tid & 127, tq = tid >> 7;
            {
                unsigned pk[8];
#pragma unroll
                for (int tt = 0; tt < 16; tt += 2) {
                    const float k0 = bf2f(PROJ[(size_t)(t0 + tq * 16 + tt) * PJ + 512 + h * 128 + ch]);
                    const float k1 = bf2f(PROJ[(size_t)(t0 + tq * 16 + tt + 1) * PJ + 512 + h * 128 + ch]);
                    pk[tt >> 1] = pack2(k0 * __expf(blast - b[tt]), k1 * __expf(blast - b[tt + 1]));
                }
                *(uint4*)(kT + lds_byte<2>(ch, tq * 16)) = make_uint4(pk[0], pk[1], pk[2], pk[3]);
                *(uint4*)(kT + lds_byte<2>(ch, tq * 16 + 8)) = make_uint4(pk[4], pk[5], pk[6], pk[7]);
                if (tq == 3) ((float*)(a.ws + WS_DEC))[(size_t)(n * 4 + h) * 128 + ch] = __expf(blast);
            }
            gla_stage_vT(PROJ, t0, 1024 + h * 256, vT, tid);
            __syncthreads();
            const int wr = wid >> 1, wc = wid & 1;
            f32x4 acc[4][4];
#pragma unroll
            for (int m = 0; m < 4; ++m)
#pragma unroll
                for (int nn = 0; nn < 4; ++nn) acc[m][nn] = f32x4{0.f, 0.f, 0.f, 0.f};
#pragma unroll
            for (int ks = 0; ks < 2; ++ks) {
                bf16x8 Af[4], Bf[4];
#pragma unroll
                for (int m = 0; m < 4; ++m) Af[m] = *(const bf16x8*)(vT + lds_byte<2>(wr * 64 + m * 16 + fr, ks * 32 + fq * 8));
#pragma unroll
                for (int nn = 0; nn < 4; ++nn) Bf[nn] = *(const bf16x8*)(kT + lds_byte<2>(wc * 64 + nn * 16 + fr, ks * 32 + fq * 8));
#pragma unroll
                for (int m = 0; m < 4; ++m)
#pragma unroll
                    for (int nn = 0; nn < 4; ++nn) acc[m][nn] = __builtin_amdgcn_mfma_f32_16x16x32_bf16(Af[m], Bf[nn], acc[m][nn], 0, 0, 0);
            }
            float* KV = (float*)(a.ws + WS_KV) + (size_t)(n * 4 + h) * (HV * HK);
#pragma unroll
            for (int m = 0; m < 4; ++m)
#pragma unroll
                for (int nn = 0; nn < 4; ++nn)
#pragma unroll
                    for (int j = 0; j < 4; ++j)
                        KV[(size_t)(wr * 64 + m * 16 + fq * 4 + j) * 128 + wc * 64 + nn * 16 + fr] = acc[m][nn][j];
        }
    }
}

DEVI void phase3(const Args& a, int tid) {
    const float* KV = (const float*)(a.ws + WS_KV); u16* ST = (u16*)(a.ws + WS_ST); const float* DEC = (const float*)(a.ws + WS_DEC);
    for (int e = blockIdx.x * 512 + tid; e < NH * HV * HK; e += gridDim.x * 512) {
        const int h = e >> 15, rem = e & 32767, i = e & 127;
        float S = 0.f;
#pragma unroll 1
        for (int n0 = 0; n0 < NCH; n0 += 16) {
            float kv[16], dc[16];
#pragma unroll
            for (int k = 0; k < 16; ++k) { kv[k] = KV[(size_t)((n0 + k) * 4 + h) * 32768 + rem]; dc[k] = DEC[(size_t)((n0 + k) * 4 + h) * 128 + i]; }
#pragma unroll
            for (int k = 0; k < 16; ++k) { ST[(size_t)((n0 + k) * 4 + h) * 32768 + rem] = f2bf(S); S = dc[k] * S + kv[k]; }
        }
    }
    const float* E = (const float*)(a.ws + WS_S5E); const float* AL = (const float*)(a.ws + WS_S5AL); unsigned* HP = (unsigned*)(a.ws + WS_S5H);
    for (int e = blockIdx.x * 512 + tid; e < NG * SP; e += gridDim.x * 512) {
        const int g = e >> 6, p = e & 63;
        const float ar = AL[e * 2], ai = AL[e * 2 + 1];
        float hr = 0.f, hi = 0.f;
#pragma unroll 1
        for (int c0 = 0; c0 < 128; c0 += 16) {
            float2 ev[16];
#pragma unroll
            for (int k = 0; k < 16; ++k) ev[k] = *(const float2*)(E + (size_t)(g * 128 + c0 + k) * 128 + 2 * p);
#pragma unroll
            for (int k = 0; k < 16; ++k) {
                HP[(size_t)(g * 128 + c0 + k) * 64 + p] = pack2(hr, hi);
                const float nr = ar * hr - ai * hi + ev[k].x, ni = ar * hi + ai * hr + ev[k].y;
                hr = nr; hi = ni;
            }
        }
    }
}

DEVI void phase4(const Args& a, char* lds, int tid, int wid, int lane) {
    const u16* PROJ = (const u16*)(a.ws + WS_PROJ);
    u16* MIX = (u16*)(a.ws + WS_MIX);
#pragma unroll 1
    for (int u = blockIdx.x; u < 768; u += gridDim.x) {
        { int lq = lane; asm volatile("" : "+v"(lq)); lane = lq; tid = wid * 64 + lq; }
        const int fr = lane & 15, fq = lane >> 4;
        __syncthreads();
        if (u < 256) {
            const int g = u >> 2, cb = u & 3;
            char* U = lds; char* KTl = lds + 32 * USTR;
            s5_fill_U(PROJ, g, cb, U, tid);
            {
                const uint4* src = (const uint4*)((const u16*)(a.ws + WS_S5K) + (size_t)g * 16384);
                uint4* dst = (uint4*)KTl;
                for (int k = 0; k < 4; ++k) dst[tid + 512 * k] = src[tid + 512 * k];
            }
            __syncthreads();
            f32x4 acc[8][2];
#pragma unroll
            for (int tt = 0; tt < 8; ++tt) { acc[tt][0] = f32x4{0.f, 0.f, 0.f, 0.f}; acc[tt][1] = f32x4{0.f, 0.f, 0.f, 0.f}; }
            const int sl = fq >> 1, m0 = (fq & 1) * 8;
            const char* kbase = KTl + ((wid - sl) * 256 + fr * 16 + m0) * 2;
#pragma unroll 1
            for (int j = 0; j < 32; ++j) {
                const bf16x8 a0 = *(const bf16x8*)(U + fr * USTR + (j * 32 + fq * 8) * 2);
                const bf16x8 a1 = *(const bf16x8*)(U + (16 + fr) * USTR + (j * 32 + fq * 8) * 2);
                const char* kb = kbase - j * 1024;
#pragma unroll
                for (int tt = 0; tt < 8; ++tt) {
                    const int t = wid + 8 * tt;
                    if (t >= 2 * j) {
                        bf16x8 bf = *(const bf16x8*)(kb + tt * 4096);
                        if (t == 2 * j && sl == 1) bf = bf16x8{0, 0, 0, 0, 0, 0, 0, 0};
                        acc[tt][0] = __builtin_amdgcn_mfma_f32_16x16x32_bf16(a0, bf, acc[tt][0], 0, 0, 0);
                        acc[tt][1] = __builtin_amdgcn_mfma_f32_16x16x32_bf16(a1, bf, acc[tt][1], 0, 0, 0);
                    }
                }
            }
            const u16* HP = (const u16*)(a.ws + WS_S5H); const u16* VV = (const u16*)(a.ws + WS_S5V);
#pragma unroll 1
            for (int kp = 0; kp < 2; ++kp) {
                bf16x8 a0[2], a1[2], bfv[2][8];
#pragma unroll
                for (int k2 = 0; k2 < 2; ++k2) {
                    const int ks = kp * 2 + k2;
                    a0[k2] = *(const bf16x8*)(HP + (size_t)(g * 128 + cb * 32 + fr) * 128 + ks * 32 + fq * 8);
                    a1[k2] = *(const bf16x8*)(HP + (size_t)(g * 128 + cb * 32 + 16 + fr) * 128 + ks * 32 + fq * 8);
#pragma unroll
                    for (int tt = 0; tt < 8; ++tt)
                        bfv[k2][tt] = *(const bf16x8*)(VV + (size_t)(g * 1024 + (wid + 8 * tt) * 16 + fr) * 128 + ks * 32 + fq * 8);
                }
#pragma unroll
                for (int k2 = 0; k2 < 2; ++k2)
#pragma unroll
                    for (int tt = 0; tt < 8; ++tt) {
                        acc[tt][0] = __builtin_amdgcn_mfma_f32_16x16x32_bf16(a0[k2], bfv[k2][tt], acc[tt][0], 0, 0, 0);
                        acc[tt][1] = __builtin_amdgcn_mfma_f32_16x16x32_bf16(a1[k2], bfv[k2][tt], acc[tt][1], 0, 0, 0);
                    }
            }
            const float dsk = a.in[12][g * 16 + fr];
            u16* Z = (u16*)(a.ws + WS_Z);
#pragma unroll
            for (int tt = 0; tt < 8; ++tt) {
                const int t = wid + 8 * tt;
#pragma unroll
                for (int mf = 0; mf < 2; ++mf)
#pragma unroll
                    for (int j = 0; j < 4; ++j) {
                        const int cl = mf * 16 + fq * 4 + j;
                        const float uv = bf2f(*(const u16*)(U + cl * USTR + (t * 16 + fr) * 2));
                        const float y = acc[tt][mf][j] + dsk * uv;
                        Z[(size_t)((cb * 32 + cl) * 64 + t) * SW + g * 16 + fr] = f2bf(gelu_tanh(y));
                    }
            }
        } else {
            const int uu = u - 256, n = uu >> 2, h = uu & 3, t0 = n * 64;
            char* vT = lds;
            char* qI = lds + 32768;
            char* kI = lds + 49152;
            char* pI = lds + 65536;
            float* glr = (float*)(lds + 73728);
            float* tot = glr + 1024;
            float* rss = tot + 512;
            char* sT = lds + 81920;
            {
                const u16* STg = (const u16*)(a.ws + WS_ST) + (size_t)(n * 4 + h) * (HV * HK);
#pragma unroll
                for (int p = 0; p < 8; ++p) {
                    const int row = p * 32 + wid * 4 + (lane >> 4), chunk = ((lane & 15) ^ row) & 15;
                    __builtin_amdgcn_global_load_lds((const unsigned*)(STg + (size_t)row * 128 + chunk * 8), (LAS unsigned*)(sT + p * 8192 + wid * 1024), 16, 0, 0);
                }
            }
            float b[16], blast;
            gla_gate(a, n, h, tid, glr, tot, b, blast);
            const int ch = tid & 127, tq = tid >> 7;
            {
                const int qb0 = (tq * 4 + (ch >> 5)) * 1024 + (ch & 31) * 2, qb1 = qb0 ^ 32;
                const u16* src = PROJ + (size_t)(t0 + tq * 16) * PJ + h * 128 + ch;
#pragma unroll
                for (int tt = 0; tt < 16; ++tt) {
                    const float qv = bf2f(src[(size_t)tt * PJ]);
                    const float kv = bf2f(src[(size_t)tt * PJ + 512]);
                    const int off = (tt < 8 ? qb0 : qb1) + tt * 64;
                    *(u16*)(qI + off) = f2bf(qv * __expf(b[tt]));
                    *(u16*)(kI + off) = f2bf(kv * __expf(-b[tt]));
                }
            }
            gla_stage_vT(PROJ, t0, 1024 + h * 256, vT, tid);
            __syncthreads();
            {
                const int mf = wid & 3, nb = (wid >> 2) * 2;
                f32x4 s0 = {0.f, 0.f, 0.f, 0.f}, s1 = {0.f, 0.f, 0.f, 0.f};
#pragma unroll
                for (int ks = 0; ks < 4; ++ks) {
                    const bf16x8 af = *(const bf16x8*)(qI + lds_byte<4>(mf * 16 + fr, ks * 32 + fq * 8));
                    const bf16x8 b0 = *(const bf16x8*)(kI + lds_byte<4>(nb * 16 + fr, ks * 32 + fq * 8));
                    const bf16x8 b1 = *(const bf16x8*)(kI + lds_byte<4>((nb + 1) * 16 + fr, ks * 32 + fq * 8));
                    s0 = __builtin_amdgcn_mfma_f32_16x16x32_bf16(af, b0, s0, 0, 0, 0);
                    s1 = __builtin_amdgcn_mfma_f32_16x16x32_bf16(af, b1, s1, 0, 0, 0);
                }
#pragma unroll
                for (int j = 0; j < 4; ++j) {
                    const int t = mf * 16 + fq * 4 + j, sA = nb * 16 + fr, sB = sA + 16;
                    *(u16*)(pI + lds_byte<2>(t, sA)) = f2bf(sA <= t ? s0[j] : 0.f);
                    *(u16*)(pI + lds_byte<2>(t, sB)) = f2bf(sB <= t ? s1[j] : 0.f);
                }
            }
            __syncthreads();
            const int mf = wid & 3, nh = wid >> 2;
            f32x4 acc[8];
#pragma unroll
            for (int nn = 0; nn < 8; ++nn) acc[nn] = f32x4{0.f, 0.f, 0.f, 0.f};
#pragma unroll
            for (int ks = 0; ks < 2; ++ks) {
                const bf16x8 af = *(const bf16x8*)(pI + lds_byte<2>(mf * 16 + fr, ks * 32 + fq * 8));
#pragma unroll
                for (int nn = 0; nn < 8; ++nn) {
                    const bf16x8 bf = *(const bf16x8*)(vT + lds_byte<2>(nh * 128 + nn * 16 + fr, ks * 32 + fq * 8));
                    acc[nn] = __builtin_amdgcn_mfma_f32_16x16x32_bf16(af, bf, acc[nn], 0, 0, 0);
                }
            }
#pragma unroll
            for (int ks = 0; ks < 4; ++ks) {
                const bf16x8 af = *(const bf16x8*)(qI + lds_byte<4>(mf * 16 + fr, ks * 32 + fq * 8));
#pragma unroll
                for (int nn = 0; nn < 8; ++nn) {
                    const bf16x8 bf = *(const bf16x8*)(sT + (nh * 128 + nn * 16 + fr) * 256 + ((((ks * 4 + fq) ^ fr) & 15) << 4));
                    acc[nn] = __builtin_amdgcn_mfma_f32_16x16x32_bf16(af, bf, acc[nn], 0, 0, 0);
                }
            }
            u16 rraw[4][8];
#pragma unroll
            for (int j = 0; j < 4; ++j)
#pragma unroll
                for (int nn = 0; nn < 8; ++nn) rraw[j][nn] = PROJ[(size_t)(t0 + mf * 16 + fq * 4 + j) * PJ + 2048 + h * 256 + nh * 128 + nn * 16 + fr];
            float ss[4];
#pragma unroll
            for (int j = 0; j < 4; ++j) {
                float s = 0.f;
#pragma unroll
                for (int nn = 0; nn < 8; ++nn) s += acc[nn][j] * acc[nn][j];
                ss[j] = sum16(s);
            }
            if (fr == 0) {
#pragma unroll
                for (int j = 0; j < 4; ++j) rss[nh * 64 + mf * 16 + fq * 4 + j] = ss[j];
            }
            __syncthreads();
            const float* gn = a.in[5];
#pragma unroll
            for (int j = 0; j < 4; ++j) {
                const int t = mf * 16 + fq * 4 + j;
                const float rstd = rsqrtf((rss[t] + rss[64 + t]) * (1.0f / 256.0f) + EPS);
#pragma unroll
                for (int nn = 0; nn < 8; ++nn) {
                    const int jc = nh * 128 + nn * 16 + fr;
                    const float rv = bf2f(rraw[j][nn]);
                    const float o = acc[nn][j] * rstd * gn[jc] * (rv * sigmoidf_(rv));
                    MIX[(size_t)(t0 + t) * D + h * 256 + jc] = f2bf(o);
                }
            }
        }
    }
}

DEVI void phase5(const Args& a, char* lds, int tid, int wid, int lane) {
    extern __shared__ __attribute__((aligned(16))) char smem_pg8[];
    if (blockIdx.x >= 128) {
        const int c_lo = 8192 + (blockIdx.x - 128) * 22;
        convert_range(a, lds, c_lo, c_lo + 22, tid, wid, lane);
    } else {
        pg8::Gemm g; g.A = a.ws + WS_Z; g.Bt = a.ws + WS_GLUT; g.ld = SW; g.K = SW;
        pg8::StaticOrder S; S.init(T, SW, 128, (int)blockIdx.x);
        EpiGlu E; E.Z = (const u16*)(a.ws + WS_Z); E.MIX = (u16*)(a.ws + WS_MIX); E.SSQ = (float*)(a.ws + WS_SSQ); E.gbias = a.in[15]; E.sng = a.in[16];
        pg8::gemm_phase((PG8_LAS unsigned char*)(smem_pg8 + 1024), g, S, E);
        const int c_lo = 11008 + blockIdx.x * 6; convert_range(a, lds, c_lo, c_lo + 6, tid, wid, lane);
    }
    convert_pool(a, lds, 1, 11776, 13312, tid, wid, lane);
}

DEVI void phase6(const Args& a, char* lds, int tid, int wid, int lane) {
    extern __shared__ __attribute__((aligned(16))) char smem_pg8[];
    const int c6_lo = 13312 + blockIdx.x * 8, c6_hi = c6_lo + 8;
    if ((blockIdx.x >> 3) & 1) convert_range(a, lds, c6_lo, c6_hi, tid, wid, lane);
    if (blockIdx.x < 256) {
        pg8::Gemm g; g.A = a.ws + WS_MIX; g.Bt = a.ws + WS_WOUTT; g.ld = D; g.K = 1024;
        pg8::SplitKOrder S; S.init(T, D, 256, (int)blockIdx.x); S.khalf = 2048;
        EpiOut E; E.x = a.in[0]; E.H1 = (float*)(a.ws + WS_H1); E.SSQ = (const float*)(a.ws + WS_SSQ);
        pg8::gemm_phase((PG8_LAS unsigned char*)(smem_pg8 + 1024), g, S, E);
    }
    if (!((blockIdx.x >> 3) & 1)) convert_range(a, lds, c6_lo, c6_hi, tid, wid, lane);
    convert_pool(a, lds, 2, 15360, 16384, tid, wid, lane);
}

DEVI void phase7(const Args& a, char* lds, int tid, int wid, int lane) {
    const float* H1 = (const float*)(a.ws + WS_H1); unsigned char* HN8 = a.ws + WS_HN2;
    const float* g2 = a.in[18]; const float* rw = a.in[19]; const float* rb = a.in[20];
    int* CNT = (int*)(a.ws + WS_CNT); int* LTOK = (int*)(a.ws + WS_LTOK); float* LGATE = (float*)(a.ws + WS_LGATE); int* TSLOT = (int*)(a.ws + WS_TSLOT);
    float* hn = (float*)lds;
    float* red = hn + 8 * 2048;
    float* lg = red + 8 * 8 * 32;
    for (int u = blockIdx.x; u < 256; u += gridDim.x) {
#pragma unroll 1
        for (int ps = 0; ps < 4; ++ps) {
            const int tok0 = u * 32 + ps * 8;
            { int lq = lane; asm volatile("" : "+v"(lq)); lane = lq; tid = wid * 64 + lq; }
            __syncthreads();
            {
                const int tl = wid, tok = tok0 + tl;
                f32x4 xv[8]; float ss = 0.f;
#pragma unroll
                for (int i = 0; i < 8; ++i) { xv[i] = *(const f32x4*)(H1 + (size_t)tok * D + 256 * i + 4 * lane);
#pragma unroll
                    for (int c = 0; c < 4; ++c) ss += xv[i][c] * xv[i][c]; }
                ss = wave_sum(ss);
                const float r = rsqrtf(ss * (1.0f / D) + EPS);
#pragma unroll
                for (int i = 0; i < 8; ++i) {
                    const f32x4 g = *(const f32x4*)(g2 + 256 * i + 4 * lane);
                    f32x4 o;
#pragma unroll
                    for (int c = 0; c < 4; ++c) o[c] = xv[i][c] * r * g[c];
                    *(f32x4*)(hn + tl * 2048 + 256 * i + 4 * lane) = o;
                }
            }
            __syncthreads();
            {
                const int e = tid & 31, dsl = tid >> 5;
                float acc[8];
#pragma unroll
                for (int k = 0; k < 8; ++k) acc[k] = 0.f;
#pragma unroll 1
                for (int d16 = 0; d16 < 8; ++d16) {
                    float w[16];
#pragma unroll
                    for (int q = 0; q < 16; ++q) w[q] = rw[(dsl * 128 + d16 * 16 + q) * 32 + e];
#pragma unroll
                    for (int q4 = 0; q4 < 4; ++q4) {
                        const int d = dsl * 128 + d16 * 16 + q4 * 4;
#pragma unroll
                        for (int k = 0; k < 8; ++k) {
                            const f32x4 hv = *(const f32x4*)(hn + k * 2048 + d);
                            acc[k] += hv[0] * w[q4 * 4] + hv[1] * w[q4 * 4 + 1] + hv[2] * w[q4 * 4 + 2] + hv[3] * w[q4 * 4 + 3];
                        }
                    }
                }
#pragma unroll
                for (int k = 0; k < 8; ++k) { acc[k] += __shfl_xor(acc[k], 32); }
                if (lane < 32) {
#pragma unroll
                    for (int k = 0; k < 8; ++k) red[(wid * 8 + k) * 32 + e] = acc[k];
                }
            }
            __syncthreads();
            if (tid < 256) {
                const int k = tid >> 5, e = tid & 31;
                float s = rb[e];
#pragma unroll
                for (int w = 0; w < 8; ++w) s += red[(w * 8 + k) * 32 + e];
                lg[k * 32 + e] = s;
            }
            __syncthreads();
            {
                const int tok = tok0 + wid, e = lane & 31;
                float x = lg[wid * 32 + e];
                float v[4]; int id[4];
#pragma unroll
                for (int j = 0; j < 4; ++j) {
                    float bv = x; int bi = e;
#pragma unroll
                    for (int o = 16; o >= 1; o >>= 1) {
                        const float ov = __shfl_xor(bv, o); const int oi = __shfl_xor(bi, o);
                        if (ov > bv || (ov == bv && oi < bi)) { bv = ov; bi = oi; }
                    }
                    v[j] = bv; id[j] = bi;
                    if (e == bi) x = -3.0e38f;
                }
                float ex[4], sum = 0.f;
#pragma unroll
                for (int j = 0; j < 4; ++j) { ex[j] = __expf(v[j] - v[0]); sum += ex[j]; }
                const float inv = 1.0f / sum;
                int ri = 0;
                if (lane < 4) {
                    const int myid = lane == 0 ? id[0] : lane == 1 ? id[1] : lane == 2 ? id[2] : id[3];
                    const float myg = (lane == 0 ? ex[0] : lane == 1 ? ex[1] : lane == 2 ? ex[2] : ex[3]) * inv;
                    const int slot = atomicAdd(&CNT[myid], 1);
                    ri = myid * CAP + slot;
                    LTOK[ri] = tok;
                    LGATE[ri] = myg;
                    TSLOT[tok * 4 + lane] = ri;
                }
                {
                    unsigned char* XG = a.ws + WS_XG;
                    const int r0 = __builtin_amdgcn_readlane(ri, 0), r1 = __builtin_amdgcn_readlane(ri, 1), r2 = __builtin_amdgcn_readlane(ri, 2), r3 = __builtin_amdgcn_readlane(ri, 3);
#pragma unroll
                    for (int i = 0; i < 8; ++i) {
                        const f32x4 o = *(const f32x4*)(hn + wid * 2048 + 256 * i + 4 * lane);
                        const unsigned pk = cvt4_fp8(o[0] * 16.f, o[1] * 16.f, o[2] * 16.f, o[3] * 16.f);
                        const size_t co = 256 * i + 4 * lane;
                        *(unsigned*)(XG + (size_t)r0 * D + co) = pk; *(unsigned*)(XG + (size_t)r1 * D + co) = pk;
                        *(unsigned*)(XG + (size_t)r2 * D + co) = pk; *(unsigned*)(XG + (size_t)r3 * D + co) = pk;
                    }
                }
            }
        }
    }
}

struct MoeTab { int cnt[32]; int off[33]; int ord[32]; int xe[4]; int xub[5]; };
DEVI void moe_tables(const Args& a, MoeTab* tb, int tid, int ntn) {
    __syncthreads();
    if (tid < 32) tb->cnt[tid] = ((const int*)(a.ws + WS_CNT))[tid];
    __syncthreads();
    if (tid < 32) {
        const int me = (tb->cnt[tid] + 255) >> 8;
        int rank = 0, o = 0;
        for (int k = 0; k < 32; ++k) {
            const int c = tb->cnt[k], mk = (c + 255) >> 8;
            rank += (mk > me || (mk == me && k < tid)) ? 1 : 0;
            o += (k < tid) ? c : 0;
        }
        tb->ord[rank] = tid; tb->off[tid] = o;
        if (tid == 31) tb->off[32] = o + tb->cnt[31];
    }
    __syncthreads();
    if (tid == 0) {
        const int xcd = blockIdx.x & 7;
        int ub = 0;
        for (int r = 0; r < 4; ++r) {
            const int e = tb->ord[r * 8 + ((r & 1) ? 7 - xcd : xcd)];
            tb->xe[r] = e; tb->xub[r] = ub;
            ub += ((tb->cnt[e] + 255) >> 8) * ntn;
        }
        tb->xub[4] = ub;
    }
    __syncthreads();
}

struct MoeUnit { int e, nt, r0, rows, grow0, cnt; };
DEVI MoeUnit moe_decode(const MoeTab* tb, int u) {
    int k = 0;
    for (int q = 1; q < 4; ++q) if (u >= tb->xub[q]) k = q;
    MoeUnit d; d.e = tb->xe[k];
    d.cnt = tb->cnt[d.e];
    const int mte = (d.cnt + 255) >> 8, ul = u - tb->xub[k];
    d.nt = ul / mte; const int mi = ul - d.nt * mte;
    d.r0 = mi * 256; d.rows = min(256, d.cnt - d.r0); d.grow0 = tb->off[d.e] + d.r0;
    return d;
}

struct MoeUnit;
namespace pg8 {
struct MU { const char* A; const char* B0; const char* B1; int e, nt, r0, rows, grow0, cnt; };
template <int SCALE_A, int SCALE_B, class Epi, class Sched>
DEVI void f8_gemm_phase(PG8_LAS unsigned char* lds, const Sched& S, const Epi& E) {
    const int tid = threadIdx.x, wid = __builtin_amdgcn_readfirstlane(tid >> 6), lane = tid & 63, wr = wid >> 2, wc = wid & 3, fr = lane & 15, fq = lane >> 4;
    constexpr int nt = 16;
    unsigned voffA[2], voffB[2];
#pragma unroll
    for (int i = 0; i < 2; ++i) { int R, C; stage_rc(tid * 16 + i * 8192, R, C); voffA[i] = (unsigned)(R * 1024 + C) * 2u;
        const int L = wid * 1024 + i * 8192 + lane * 16, q = L >> 9, p0 = (lane & 31) * 4, pu = (p0 - 16 * ((q >> 2) & 3)) & 127;
        voffB[i] = (unsigned)(q * 512 + ((pu & ~31) + perm32(pu & 31)) * 4); }
    const size_t kstep = 128, bstep = 16384, hstep = (size_t)HALF * 2048;
    const unsigned ldsw = (unsigned)wid * 1024u;
    const int aoff = lds_byte(wr * 64 + fr, fq * 8);
    int boffn[2];
#pragma unroll
    for (int n = 0; n < 2; ++n) boffn[n] = (4 * fq) * 512 + ((wc * 32 + 16 * n + fr + 16 * fq) & 127) * 4;
#define PG8_SA(b, h) (((b) * 2 + (h)) * HTB)
#define PG8_SB(b, h) ((4 + (b) * 2 + (h)) * HTB)
#define PG8_STAGE(bufoff, gbase, voff) do { _Pragma("unroll") for (int _i = 0; _i < 2; ++_i) \
        __builtin_amdgcn_global_load_lds((const unsigned*)((const char*)(gbase) + (voff)[_i]), (PG8_LAS unsigned*)(lds + (bufoff) + ldsw + _i * 8192), 16, 0, 0); } while (0)
#define PG8_LDA(dst, b, h) do { _Pragma("unroll") for (int m = 0; m < 4; ++m) { const i32x4 _x = *(const PG8_LAS i32x4*)(lds + PG8_SA(b, h) + aoff + m * 2048), _y = *(const PG8_LAS i32x4*)(lds + PG8_SA(b, h) + aoff + m * 2048 + 1024); \
        dst[m][0] = _x[0]; dst[m][1] = _x[1]; dst[m][2] = _x[2]; dst[m][3] = _x[3]; dst[m][4] = _y[0]; dst[m][5] = _y[1]; dst[m][6] = _y[2]; dst[m][7] = _y[3]; } } while (0)
#define PG8_LDB(dst, b, h) do { _Pragma("unroll") for (int n = 0; n < 2; ++n) _Pragma("unroll") for (int d = 0; d < 8; ++d) dst[n][d] = *(const PG8_LAS int*)(lds + PG8_SB(b, h) + boffn[n] + (d & 3) * 512 + (d >> 2) * 8192); } while (0)
#define PG8_MMA(ai, bj, At, Bt) do { __builtin_amdgcn_s_setprio(1); _Pragma("unroll") for (int m = 0; m < 4; ++m) _Pragma("unroll") for (int n = 0; n < 2; ++n) \
        acc[ai][bj][m][n] = __builtin_amdgcn_mfma_scale_f32_16x16x128_f8f6f4(Bt[n], At[m], acc[ai][bj][m][n], 0, 0, 0, SCALE_B, 0, SCALE_A); __builtin_amdgcn_s_setprio(0); } while (0)
#define PG8_WAIT_V(n) asm volatile("s_waitcnt vmcnt(" #n ")" ::: "memory")
#define PG8_WAIT_L(n) asm volatile("s_waitcnt lgkmcnt(" #n ")" ::: "memory")
#define PG8_BAR __builtin_amdgcn_s_barrier()
#define PG8_SCHED __builtin_amdgcn_sched_barrier(0)
#define PG8_ZERO() do { _Pragma("unroll") for (int a_ = 0; a_ < 2; ++a_) _Pragma("unroll") for (int b_ = 0; b_ < 2; ++b_) _Pragma("unroll") for (int m_ = 0; m_ < 4; ++m_) _Pragma("unroll") for (int n_ = 0; n_ < 2; ++n_) \
        acc[a_][b_][m_][n_] = (f32x4){0.f, 0.f, 0.f, 0.f}; } while (0)
    MU cur, nxt; int ui = 0;
    if (!S.next(0, cur)) return;
    f32x4 acc[2][2][4][2];
    i32x8 At[4], B0[2], B1[2];
    PG8_LAS unsigned char* side = lds + 8 * HTB;
    int sc = 0; E.prefetch(cur, side, wid, lane);
    const char* cA = cur.A; const char* cB0 = cur.B0; const char* cB1 = cur.B1;
    PG8_STAGE(PG8_SB(0, 0), cB0, voffB); PG8_STAGE(PG8_SA(0, 0), cA, voffA); PG8_STAGE(PG8_SB(0, 1), cB1, voffB); PG8_STAGE(PG8_SA(0, 1), cA + hstep, voffA);
    if (wr == 1) PG8_BAR;
    PG8_WAIT_V(4); PG8_BAR;
    E.init(acc, side, wc, fq); PG8_WAIT_L(0);
    PG8_STAGE(PG8_SB(1, 0), cB0 + bstep, voffB); PG8_STAGE(PG8_SA(1, 0), cA + kstep, voffA); PG8_STAGE(PG8_SB(1, 1), cB1 + bstep, voffB);
    PG8_WAIT_V(6); PG8_BAR;
    for (;;) {
        const bool has_next = S.next(ui + 1, nxt);
        const int sn = sc == 2 ? 0 : sc + 1;
        if (has_next) { int lz = lane; asm volatile("" : "+v"(lz)); E.prefetch(nxt, side + sn * 2048, wid, lz); }
        const char* nA = has_next ? nxt.A : cA; const char* nB0 = has_next ? nxt.B0 : cB0; const char* nB1 = has_next ? nxt.B1 : cB1;
#pragma unroll 1
        for (int t = 0; t < nt; t += 2) {
            const bool last = (t == nt - 2);
            const char* a1 = cA + (size_t)(t + 1) * kstep;
            const char* a2 = last ? nA : cA + (size_t)(t + 2) * kstep;
            const char* b20 = last ? nB0 : cB0 + (size_t)(t + 2) * bstep; const char* b21 = last ? nB1 : cB1 + (size_t)(t + 2) * bstep;
            const char* a3 = a2 + kstep; const char* b30 = b20 + bstep; const char* b31 = b21 + bstep;
            PG8_LDB(B0, 0, 0); PG8_SCHED; PG8_LDA(At, 0, 0); PG8_STAGE(PG8_SA(1, 1), a1 + hstep, voffA);
            PG8_WAIT_L(8); PG8_BAR; PG8_WAIT_L(0); PG8_MMA(0, 0, At, B0); PG8_BAR; PG8_SCHED;
            PG8_LDB(B1, 0, 1); PG8_STAGE(PG8_SB(0, 0), b20, voffB);
            PG8_BAR; PG8_WAIT_L(0); PG8_MMA(0, 1, At, B1); PG8_BAR;
            PG8_LDA(At, 0, 1); PG8_STAGE(PG8_SA(0, 0), a2, voffA);
            PG8_BAR; PG8_WAIT_L(0); PG8_MMA(1, 0, At, B0); PG8_BAR; PG8_SCHED;
            PG8_STAGE(PG8_SB(0, 1), b21, voffB);
            PG8_WAIT_V(6); PG8_BAR; PG8_MMA(1, 1, At, B1); PG8_BAR;
            PG8_LDB(B0, 1, 0); PG8_SCHED; PG8_LDA(At, 1, 0); PG8_STAGE(PG8_SA(0, 1), a2 + hstep, voffA);
            PG8_WAIT_L(8); PG8_BAR; PG8_WAIT_L(0); PG8_MMA(0, 0, At, B0); PG8_BAR; PG8_SCHED;
            PG8_LDB(B1, 1, 1); PG8_STAGE(PG8_SB(1, 0), b30, voffB);
            PG8_BAR; PG8_WAIT_L(0); PG8_MMA(0, 1, At, B1); PG8_BAR;
            PG8_LDA(At, 1, 1); PG8_STAGE(PG8_SA(1, 0), a3, voffA);
            PG8_BAR; PG8_WAIT_L(0); PG8_MMA(1, 0, At, B0); PG8_BAR; PG8_SCHED;
            PG8_STAGE(PG8_SB(1, 1), b31, voffB);
            PG8_WAIT_V(6); PG8_BAR; PG8_MMA(1, 1, At, B1); PG8_BAR;
        }
        int lz = lane; asm volatile("" : "+v"(lz));
        E(acc, cur, side + sc * 2048, wr, wc, lz & 15, lz >> 4);
        if (!has_next) break;
        E.init(acc, side + sn * 2048, wc, lz >> 4); PG8_WAIT_L(0);
        sc = sn; cur = nxt; cA = nA; cB0 = nB0; cB1 = nB1; ++ui;
    }
    PG8_WAIT_V(0);
    if (wr == 0) PG8_BAR;
    PG8_BAR;
#undef PG8_SA
#undef PG8_SB
#undef PG8_STAGE
#undef PG8_LDA
#undef PG8_LDB
#undef PG8_MMA
#undef PG8_WAIT_V
#undef PG8_WAIT_L
#undef PG8_BAR
#undef PG8_SCHED
#undef PG8_ZERO
}
}

struct MoeSched {
    const MoeTab* tb; int nun, nper, u0; const char* Ab; const char* Wb; bool first;
    DEVI bool next(int i, pg8::MU& m) const {
        const int u = u0 + i * nper; if (u >= nun) return false;
        const MoeUnit d = moe_decode(tb, u);
        m.e = __builtin_amdgcn_readfirstlane(d.e); m.nt = __builtin_amdgcn_readfirstlane(d.nt); m.r0 = __builtin_amdgcn_readfirstlane(d.r0);
        m.rows = __builtin_amdgcn_readfirstlane(d.rows); m.grow0 = __builtin_amdgcn_readfirstlane(d.grow0); m.cnt = __builtin_amdgcn_readfirstlane(d.cnt);
        if (first) { m.A = Ab + ((size_t)m.e * CAP + m.r0) * D;
            m.B0 = Wb + (size_t)((m.e * 32 + m.nt) * 512) * 512; m.B1 = m.B0 + (size_t)(16 * 512) * 512; }
        else { m.A = Ab + (size_t)m.grow0 * FF;
            m.B0 = Wb + (size_t)((m.e * 16 + m.nt * 2) * 512) * 512; m.B1 = m.B0 + (size_t)512 * 512; }
        return true;
    }
};
typedef float f32x2 __attribute__((ext_vector_type(2)));
struct EpiMoe1 {
    unsigned char* ACT; const float* b1;
    DEVI void prefetch(const pg8::MU& u, PG8_LAS unsigned char* side, int wid, int lane) const {
        if (wid == 0) __builtin_amdgcn_global_load_lds((const unsigned*)(b1 + (size_t)u.e * 4096 + u.nt * 128 + (lane >> 5) * 2048 + 4 * (lane & 31)), (PG8_LAS unsigned*)side, 16, 0, 0);
    }
    DEVI void init(f32x4 (&acc)[2][2][4][2], PG8_LAS unsigned char* side, int wc, int fq) const {
#pragma unroll
        for (int bj = 0; bj < 2; ++bj)
#pragma unroll
            for (int n = 0; n < 2; ++n) { const f32x4 b = *(const PG8_LAS f32x4*)(side + bj * 512 + (wc * 32 + 8 * fq + 4 * n) * 4);
#pragma unroll
                for (int ai = 0; ai < 2; ++ai)
#pragma unroll
                    for (int m = 0; m < 4; ++m) acc[ai][bj][m][n] = b; }
    }
    DEVI void operator()(f32x4 (&acc)[2][2][4][2], const pg8::MU& u, PG8_LAS unsigned char* side, int wr, int wc, int fr, int fq) const {
#pragma unroll
        for (int ai = 0; ai < 2; ++ai)
#pragma unroll
            for (int m = 0; m < 4; ++m) {
                const int row = ai * 128 + wr * 64 + m * 16 + fr;
                const int orow = (row < u.rows) ? u.grow0 + row : T * 4 + row;
                unsigned w[2];
#pragma unroll
                for (int n = 0; n < 2; ++n) {
                    const f32x4 g4 = acc[ai][0][m][n], l4 = acc[ai][1][m][n];
                    f32x2 av[2];
#pragma unroll
                    for (int h = 0; h < 2; ++h) {
                        f32x2 gl, ln;
                        gl.x = fminf(g4[2 * h], 7.0f); gl.y = fminf(g4[2 * h + 1], 7.0f);
                        ln.x = __builtin_amdgcn_fmed3f(l4[2 * h], -7.0f, 7.0f); ln.y = __builtin_amdgcn_fmed3f(l4[2 * h + 1], -7.0f, 7.0f);
                        const f32x2 ea = gl * (-1.702f * 1.4426950408889634f);
                        f32x2 e; e.x = __builtin_amdgcn_exp2f(ea.x); e.y = __builtin_amdgcn_exp2f(ea.y);
                        const f32x2 d = e + 1.0f;
                        f32x2 r; r.x = __builtin_amdgcn_rcpf(d.x); r.y = __builtin_amdgcn_rcpf(d.y);
                        av[h] = (gl * r) * (ln * 4.0f + 4.0f);
                    }
                    w[n] = cvt4_fp8(av[0].x, av[0].y, av[1].x, av[1].y);
                }
                uint2 pk; pk.x = w[0]; pk.y = w[1];
                *(uint2*)(ACT + (size_t)orow * FF + u.nt * 128 + wc * 32 + 8 * fq) = pk;
            }
    }
};
struct EpiMoe2 {
    u16* Y; const float* b2; const float* LGATE;
    DEVI void prefetch(const pg8::MU& u, PG8_LAS unsigned char* side, int wid, int lane) const {
        if (wid == 0) __builtin_amdgcn_global_load_lds((const unsigned*)(b2 + (size_t)u.e * D + u.nt * 256 + 4 * lane), (PG8_LAS unsigned*)side, 16, 0, 0);
        if (wid == 1) __builtin_amdgcn_global_load_lds((const unsigned*)(LGATE + (size_t)u.e * CAP + u.r0 + 4 * lane), (PG8_LAS unsigned*)(side + 1024), 16, 0, 0);
    }
    DEVI void init(f32x4 (&acc)[2][2][4][2], PG8_LAS unsigned char* side, int wc, int fq) const {
#pragma unroll
        for (int bj = 0; bj < 2; ++bj)
#pragma unroll
            for (int n = 0; n < 2; ++n) { const f32x4 b = *(const PG8_LAS f32x4*)(side + (bj * 128 + wc * 32 + 8 * fq + 4 * n) * 4);
#pragma unroll
                for (int ai = 0; ai < 2; ++ai)
#pragma unroll
                    for (int m = 0; m < 4; ++m) acc[ai][bj][m][n] = b; }
    }
    DEVI void operator()(f32x4 (&acc)[2][2][4][2], const pg8::MU& u, PG8_LAS unsigned char* side, int wr, int wc, int fr, int fq) const {
#pragma unroll
        for (int ai = 0; ai < 2; ++ai)
#pragma unroll
            for (int m = 0; m < 4; ++m) {
                const int row = ai * 128 + wr * 64 + m * 16 + fr;
                const float gt = *(const PG8_LAS float*)(side + 1024 + row * 4);
                const int orow = (row < u.rows) ? u.grow0 + row : T * 4 + row;
                u16* dst = Y + (size_t)orow * D + u.nt * 256 + wc * 32 + 8 * fq;
#pragma unroll
                for (int bj = 0; bj < 2; ++bj) {
                    const f32x4 v0 = acc[ai][bj][m][0] * gt, v1 = acc[ai][bj][m][1] * gt;
                    uint4 pk; pk.x = pack2(v0[0], v0[1]); pk.y = pack2(v0[2], v0[3]); pk.z = pack2(v1[0], v1[1]); pk.w = pack2(v1[2], v1[3]);
                    *(uint4*)(dst + bj * 128) = pk;
                }
            }
    }
};
DEVI void phase8(const Args& a, char* lds, MoeTab* tb, int tid, int wid, int lane) {
    extern __shared__ __attribute__((aligned(16))) char smem_pg8[];
    moe_tables(a, tb, tid, 16);
    const int nun = tb->xub[4], nper = gridDim.x >> 3;
    const int u = blockIdx.x >> 3;
    const int c_lo = 16384 + blockIdx.x * 24, c_hi = c_lo + 24;
    const int nb = u < nun ? (nun - u + nper - 1) / nper : 0;
    const int kc = (u * (nb + 1)) / nper;
#pragma unroll 1
    for (int part = 0; part < 2; ++part) {
        const int ulo = part == 0 ? u : u + kc * nper, uhi = part == 0 ? min(nun, u + kc * nper) : nun;
        if (ulo < uhi) {
            MoeSched S; S.tb = tb; S.nun = uhi; S.nper = nper; S.u0 = ulo; S.Ab = (const char*)(a.ws + WS_XG); S.Wb = (const char*)(a.ws + WS_W1T); S.first = true;
            EpiMoe1 E; E.ACT = a.ws + WS_ACT; E.b1 = a.in[22];
            pg8::f8_gemm_phase<0x7b7b7b7b, 0x77777777>((PG8_LAS unsigned char*)(smem_pg8 + 1024), S, E);
        }
        if (part == 0) convert_range(a, lds, c_lo, c_hi, tid, wid, lane);
    }
    convert_pool(a, lds, 3, 22528, 24576, tid, wid, lane);
}

DEVI void phase9(const Args& a, char* lds, MoeTab* tb, int tid, int wid, int lane) {
    extern __shared__ __attribute__((aligned(16))) char smem_pg8[];
    moe_tables(a, tb, tid, 8);
    const int nun = tb->xub[4], nper = gridDim.x >> 3;
    const int u = blockIdx.x >> 3;
    if (u >= nun) return;
    MoeSched S; S.tb = tb; S.nun = nun; S.nper = nper; S.u0 = u; S.Ab = (const char*)(a.ws + WS_ACT); S.Wb = (const char*)(a.ws + WS_W2T); S.first = false;
    EpiMoe2 E; E.Y = (u16*)(a.ws + WS_Y); E.b2 = a.in[24]; E.LGATE = (const float*)(a.ws + WS_LGATE);
    pg8::f8_gemm_phase<0x7d7d7d7d, 0x77777777>((PG8_LAS unsigned char*)(smem_pg8 + 1024), S, E);
}

DEVI void phase10(const Args& a, MoeTab* tb, int tid, int wid, int lane) {
    const float* H1 = (const float*)(a.ws + WS_H1); const u16* Y = (const u16*)(a.ws + WS_Y); const int* TSLOT = (const int*)(a.ws + WS_TSLOT);
    const float* fg = a.in[25];
    moe_tables(a, tb, tid, 8);
    for (int tok = blockIdx.x * 8 + wid; tok < T; tok += gridDim.x * 8) {
        int rowi[4];
#pragma unroll
        for (int j = 0; j < 4; ++j) { const int ts = TSLOT[tok * 4 + j]; rowi[j] = tb->off[ts >> 13] + (ts & (CAP - 1)); }
        f32x4 hv[8]; float ss = 0.f;
#pragma unroll
        for (int i = 0; i < 8; ++i) {
            hv[i] = *(const f32x4*)(H1 + (size_t)tok * D + 256 * i + 4 * lane);
#pragma unroll
            for (int j = 0; j < 4; ++j) {
                const uint2 yv = *(const uint2*)(Y + (size_t)rowi[j] * D + 256 * i + 4 * lane);
                hv[i][0] += bflo(yv.x); hv[i][1] += bfhi(yv.x); hv[i][2] += bflo(yv.y); hv[i][3] += bfhi(yv.y);
            }
#pragma unroll
            for (int c = 0; c < 4; ++c) ss += hv[i][c] * hv[i][c];
        }
        ss = wave_sum(ss);
        const float r = rsqrtf(ss * (1.0f / D) + EPS);
#pragma unroll
        for (int i = 0; i < 8; ++i) {
            const f32x4 g = *(const f32x4*)(fg + 256 * i + 4 * lane);
            f32x4 o;
#pragma unroll
            for (int c = 0; c < 4; ++c) o[c] = hv[i][c] * r * g[c];
            *(f32x4*)(a.out + (size_t)tok * D + 256 * i + 4 * lane) = o;
        }
    }
}

constexpr int NPHASE = 11;
__global__ void __launch_bounds__(512, 2) mega_fwd(Args a) {
    extern __shared__ __attribute__((aligned(1024))) char smem[];
    const int wid_s = __builtin_amdgcn_readfirstlane((int)threadIdx.x >> 6);
    if (threadIdx.x == 0) *(uint4*)smem = make_uint4(0u, 0u, 0u, 0u);
    __syncthreads();
    XcdBarrier bar = xcd_barrier_post((unsigned*)(a.ws + WS_BAR), (volatile LAS unsigned*)smem);
    char* lds = smem + LDS_BASE;
    MoeTab* tb = (MoeTab*)(smem + 64);
#ifndef REP_MASK
#define REP_MASK 0
#endif
#define PHASE(k, call) if (a.ph_lo <= (k) && (k) < a.ph_hi) { if (a.ph_lo < (k)) xcd_barrier(bar); \
        int lane = (int)__builtin_amdgcn_mbcnt_hi(~0u, __builtin_amdgcn_mbcnt_lo(~0u, 0u)); asm volatile("" : "+v"(lane)); \
        const int wid = wid_s, tid = wid_s * 64 + lane; \
        call; if ((REP_MASK >> (k)) & 1) { __syncthreads(); call; } }
    PHASE(0, phase0(a, lds, tid, wid, lane))
    PHASE(1, phase1(a, lds, tid, wid, lane))
    PHASE(2, phase2(a, lds, tid, wid, lane))
    PHASE(3, phase3(a, tid))
    PHASE(4, phase4(a, lds, tid, wid, lane))
    PHASE(5, phase5(a, lds, tid, wid, lane))
    PHASE(6, phase6(a, lds, tid, wid, lane))
    PHASE(7, phase7(a, lds, tid, wid, lane))
    PHASE(8, phase8(a, lds, tb, tid, wid, lane))
    PHASE(9, phase9(a, lds, tb, tid, wid, lane))
    PHASE(10, phase10(a, tb, tid, wid, lane))
#undef PHASE
}

extern "C" void kernel_launch(void* const* d_in, const int* in_sizes, int n_in, void* d_out, int out_size, void* d_ws, size_t ws_size, hipStream_t stream) {
    static int grid = 0;
    if (grid == 0) {
        if (n_in != 26 || out_size != T * D || ws_size < WS_END) { fprintf(stderr, "kernel_launch: unexpected shapes (n_in %d out %d ws %zu need %zu)\n", n_in, out_size, ws_size, (size_t)WS_END); grid = -1; return; }
        int dev = 0, cus = 0, per_cu = 0;
        if (hipGetDevice(&dev) != hipSuccess || hipDeviceGetAttribute(&cus, hipDeviceAttributeMultiprocessorCount, dev) != hipSuccess) { grid = -1; return; }
        if (hipFuncSetAttribute((const void*)mega_fwd, hipFuncAttributeMaxDynamicSharedMemorySize, LDS_BYTES) != hipSuccess) { fprintf(stderr, "kernel_launch: hipFuncSetAttribute failed\n"); grid = -1; return; }
        if (hipOccupancyMaxActiveBlocksPerMultiprocessor(&per_cu, (const void*)mega_fwd, 512, LDS_BYTES) != hipSuccess || per_cu < 1)
            fprintf(stderr, "kernel_launch: occupancy query reports %d blocks per CU\n", per_cu);
        (void)hipGetLastError();
        grid = cus;
    }
    if (grid < 0) return;
    Args a{};
    for (int i = 0; i < 26; ++i) a.in[i] = (const float*)d_in[i];
    a.out = (float*)d_out; a.ws = (unsigned char*)d_ws;
#if N_LAUNCH_SPLIT
    for (int k = 0; k < NPHASE; ++k) {
        (void)hipMemsetAsync((char*)d_ws + WS_BAR, 0, XCD_BAR_WORDS * sizeof(unsigned), stream);
        a.ph_lo = k; a.ph_hi = k + 1;
        hipLaunchKernelGGL(mega_fwd, dim3(grid), dim3(512), LDS_BYTES, stream, a);
    }
#else
    (void)hipMemsetAsync((char*)d_ws + WS_BAR, 0, XCD_BAR_WORDS * sizeof(unsigned), stream);
    a.ph_lo = 0; a.ph_hi = NPHASE;
    hipLaunchKernelGGL(mega_fwd, dim3(grid), dim3(512), LDS_BYTES, stream, a);
#endif
}
```

```cpp
#include <hip/hip_runtime.h>
#include <hip/hip_bf16.h>
#include <stdint.h>
#include <stdio.h>

#ifndef N_LAUNCH_SPLIT
#define N_LAUNCH_SPLIT 0
#endif

#define DEVI __device__ __forceinline__
typedef __attribute__((ext_vector_type(8))) short bf16x8;
typedef __attribute__((ext_vector_type(4))) float f32x4;
typedef __attribute__((ext_vector_type(4))) int i32x4;
typedef __attribute__((ext_vector_type(2))) float f2v;
typedef __attribute__((ext_vector_type(2))) __bf16 b2v;
typedef unsigned short u16;

constexpr int T = 8192, D = 2048, PW = 4112;
constexpr int NH = 4, HK = 128, HV = 256, CH = 64, NCH = 128, RANK = 16;
constexpr int SW = 1024, SG = 16, NG = 64, SP = 64;
constexpr int NE = 32, FF = 2048, CAP = 8192;
constexpr int PJ = 4096;
constexpr float EPS = 1e-6f;

constexpr size_t WS_BAR   = 0;
constexpr size_t WS_CNT   = 32768;
constexpr size_t WS_SSQ   = 65536;
constexpr size_t WS_GLR   = WS_SSQ + 65536;
constexpr size_t WS_DEC   = WS_GLR + (size_t)T * 16 * 4;
constexpr size_t WS_S5AL  = WS_DEC + (size_t)NCH * NH * HK * 4;
constexpr size_t WS_TSLOT = WS_S5AL + 65536;
constexpr size_t WS_LTOK  = WS_TSLOT + (size_t)T * 4 * 4;
constexpr size_t WS_LGATE = WS_LTOK + (size_t)NE * CAP * 4;
constexpr size_t WS_S5K   = WS_LGATE + (size_t)NE * CAP * 4;
constexpr size_t WS_S5WE  = WS_S5K + (size_t)NG * 64 * 256 * 2;
constexpr size_t WS_S5V   = WS_S5WE + (size_t)NG * 128 * 1024 * 2;
constexpr size_t WS_S5E   = WS_S5V + (size_t)NG * 1024 * 128 * 2;
constexpr size_t WS_S5H   = WS_S5E + (size_t)NG * 128 * 128 * 4;
constexpr size_t WS_HN    = WS_S5H + (size_t)NG * 128 * 128 * 2;
constexpr size_t WS_PROJ  = WS_HN + (size_t)T * D * 2;
constexpr size_t WS_KV    = WS_PROJ + (size_t)T * PJ * 2;
constexpr size_t WS_ST    = WS_KV + (size_t)NCH * NH * HV * HK * 4;
constexpr size_t WS_Z     = WS_ST + (size_t)NCH * NH * HV * HK * 2;
constexpr size_t WS_MIX   = WS_Z + (size_t)T * SW * 2;
constexpr size_t WS_H1    = WS_MIX + (size_t)T * D * 2;
constexpr size_t WS_HN2   = WS_H1 + (size_t)T * D * 4;
constexpr size_t WS_ACT   = WS_HN2 + (size_t)T * D * 2;
constexpr size_t WS_Y     = WS_ACT + (size_t)(T * 4 + 256) * FF * 2;
constexpr size_t WS_W1T   = WS_Y + (size_t)(T * 4 + 256) * D * 2;
constexpr size_t WS_W2T   = WS_W1T + (size_t)NE * 4096 * D;
constexpr size_t WS_WINT  = WS_W2T + (size_t)NE * D * FF;
constexpr size_t WS_GLUT  = WS_WINT + (size_t)PJ * D * 2;
constexpr size_t WS_WOUTT = WS_GLUT + (size_t)SW * SW * 2;
constexpr size_t WS_XG    = WS_WOUTT + (size_t)D * D * 2;
constexpr size_t WS_END   = WS_XG + (size_t)NE * 8192 * D;

constexpr int LDS_BYTES = 163840;
constexpr int LDS_CONV = 131072;
constexpr int LDS_BASE = 1024;

DEVI unsigned pack2(float a, float b) { f2v v = {a, b}; b2v r = __builtin_convertvector(v, b2v); return __builtin_bit_cast(unsigned, r); }
DEVI u16 f2bf(float a) { __bf16 r = (__bf16)a; return __builtin_bit_cast(u16, r); }
DEVI float bf2f(u16 h) { return __uint_as_float(((unsigned)h) << 16); }
DEVI float bflo(unsigned w) { return __uint_as_float(w << 16); }
DEVI float bfhi(unsigned w) { return __uint_as_float(w & 0xffff0000u); }
DEVI float wave_sum(float v) {
#pragma unroll
    for (int o = 32; o >= 1; o >>= 1) v += __shfl_xor(v, o);
    return v;
}
DEVI float sum16(float v) {
#pragma unroll
    for (int o = 8; o >= 1; o >>= 1) v += __shfl_xor(v, o);
    return v;
}
DEVI float sigmoidf_(float x) { return __builtin_amdgcn_rcpf(1.0f + __expf(-x)); }
DEVI float logsigmoid_(float x) { return fminf(x, 0.0f) - __logf(1.0f + __expf(-fabsf(x))); }
DEVI float gelu_tanh(float x) {
    const float a = 0.7978845608028654f * (x + 0.044715f * x * x * x);
    return x * __builtin_amdgcn_rcpf(1.0f + __expf(-2.0f * a));
}

#define WAIT_V0() asm volatile("s_waitcnt vmcnt(0)" ::: "memory")
#define WAIT_L0() asm volatile("s_waitcnt lgkmcnt(0)" ::: "memory")

#define XB_TMO      128
#define XB_XCNT(j)  (256  + 64 * (j))
#define XB_XSUB(j)  (1280 + 64 * (j))
#define XB_XGEN(j)  (2304 + 64 * (j))
#define XB_TOP      3328
#define XB_TOPGEN   3392
#define XCD_BAR_WORDS 3456
#define XB_SPIN_CAP (1u << 20)
#define LAS __attribute__((address_space(3)))

DEVI unsigned xb_ld(unsigned* p)              { return __hip_atomic_load(p, __ATOMIC_RELAXED, __HIP_MEMORY_SCOPE_AGENT); }
DEVI unsigned xb_add(unsigned* p, unsigned v) { return __hip_atomic_fetch_add(p, v, __ATOMIC_RELAXED, __HIP_MEMORY_SCOPE_AGENT); }
DEVI unsigned xb_xcc_id() { return (unsigned)__builtin_amdgcn_s_getreg((3 << 11) | 20) & 0xFu; }
#define XB_SPIN(cond, bar) do { unsigned _sp = 0; while (cond) { __builtin_amdgcn_s_sleep(1); \
    if ((++_sp & 255u) == 0u) { if (xb_ld(&(bar)[XB_TMO])) break; if (_sp > XB_SPIN_CAP) { atomicAdd(&(bar)[XB_TMO], 1u); break; } } } } while (0)

struct XcdBarrier { unsigned* bar; unsigned x; volatile LAS unsigned* st; };

DEVI XcdBarrier xcd_barrier_post(unsigned* bar, volatile LAS unsigned* st) {
    XcdBarrier b; b.bar = bar; b.x = xb_xcc_id(); b.st = st;
    if (threadIdx.x == 0) (void)xb_add(&bar[XB_XCNT(b.x)], 1u);
    return b;
}
DEVI void xcd_barrier_complete(unsigned* bar, unsigned x, unsigned& nloc, unsigned& nx) {
    const unsigned G = gridDim.x * gridDim.y * gridDim.z;
    unsigned sum, cnt, mine, sp = 0u;
    for (;;) {
        sum = 0u; cnt = 0u; mine = 0u;
#pragma unroll
        for (unsigned j = 0; j < 16; ++j) { const unsigned c = xb_ld(&bar[XB_XCNT(j)]); sum += c; cnt += (c > 0u) ? 1u : 0u; mine = (j == x) ? c : mine; }
        if (sum == G) break;
        __builtin_amdgcn_s_sleep(1);
        if ((++sp & 255u) == 0u) { if (xb_ld(&bar[XB_TMO])) break; if (sp > XB_SPIN_CAP) { atomicAdd(&bar[XB_TMO], 1u); break; } }
    }
    nloc = mine > 0u ? mine : 1u; nx = cnt > 0u ? cnt : 1u;
}
DEVI void xcd_barrier(const XcdBarrier& b) {
    asm volatile("s_waitcnt vmcnt(0)" ::: "memory");
    __syncthreads();
    if (threadIdx.x == 0) {
        unsigned* bar = b.bar;
        __builtin_amdgcn_s_waitcnt(0);
        unsigned nloc = b.st[0], nx = b.st[1];
        if (nloc == 0u) { xcd_barrier_complete(bar, b.x, nloc, nx); b.st[0] = nloc; b.st[1] = nx; }
        const unsigned old = xb_add(&bar[XB_XSUB(b.x)], 1u);
        const unsigned gen = old / nloc;
        if (old + 1u == (gen + 1u) * nloc) {
            __builtin_amdgcn_fence(__ATOMIC_RELEASE, "agent");
            asm volatile("s_waitcnt vmcnt(0)" ::: "memory");
            const unsigned og = xb_add(&bar[XB_TOP], 1u);
            const unsigned tg = og / nx;
            if (og + 1u == (tg + 1u) * nx) xb_add(&bar[XB_TOPGEN], 1u);
            else XB_SPIN(xb_ld(&bar[XB_TOPGEN]) == tg, bar);
            __builtin_amdgcn_fence(__ATOMIC_ACQUIRE, "agent");
            xb_add(&bar[XB_XGEN(b.x)], 1u);
            asm volatile("s_waitcnt vmcnt(0)" ::: "memory");
        } else {
            XB_SPIN(xb_ld(&bar[XB_XGEN(b.x)]) == gen, bar);
            __builtin_amdgcn_fence(__ATOMIC_ACQUIRE, "agent");
            asm volatile("s_waitcnt vmcnt(0)" ::: "memory");
        }
    }
    __syncthreads();
}

struct Args {
    const float* in[26];
    float* out;
    unsigned char* ws;
    int ph_lo, ph_hi;
};

template <int KS> DEVI int lds_byte(int r, int c) {
    int st = (r >> 4) * KS + (c >> 5), ob = (r & 15) * 64 + (c & 31) * 2;
    return st * 1024 + (ob ^ (((ob >> 9) & 1) << 5));
}
typedef __attribute__((ext_vector_type(16))) float f32x16;
typedef __attribute__((ext_vector_type(8))) int i32x8;
DEVI void f8_stage_rb(int wid, int lane, int i, int& R, int& CB) {
    R = wid * 16 + i * 128 + (lane >> 2);
    CB = (((lane & 3) ^ (R >> 2)) & 3) * 16;
}
DEVI int acc_row32(int wr, int m, int r, int lane) { return wr * 128 + m * 32 + (r & 3) + 8 * (r >> 2) + 4 * (lane >> 5); }
DEVI unsigned cvt4_fp8(float a, float b, float c, float d) {
    int r = 0;
    r = __builtin_amdgcn_cvt_pk_fp8_f32(a, b, r, false);
    r = __builtin_amdgcn_cvt_pk_fp8_f32(c, d, r, true);
    return (unsigned)r;
}
#define WAIT_VN(n) asm volatile("s_waitcnt vmcnt(" #n ")" ::: "memory")
DEVI void f8_stage(char* lds, const unsigned char* __restrict__ A, const unsigned (&aoff)[2], const unsigned char* __restrict__ B, const unsigned (&boffv)[2], int wid, int t) {
    char* sb = lds + (t & 3) * 32768 + wid * 1024;
#pragma unroll
    for (int i = 0; i < 2; ++i) {
        __builtin_amdgcn_global_load_lds((const unsigned*)(A + aoff[i] + t * 64), (LAS unsigned*)(sb + i * 8192), 16, 0, 0);
        __builtin_amdgcn_global_load_lds((const unsigned*)(B + boffv[i] + t * 64), (LAS unsigned*)(sb + 16384 + i * 8192), 16, 0, 0);
    }
}
DEVI void f8_prefetch(char* lds, const unsigned char* __restrict__ A, const unsigned (&aoff)[2], const unsigned char* __restrict__ B, const unsigned (&boffv)[2], int wid) {
    f8_stage(lds, A, aoff, B, boffv, wid, 0); f8_stage(lds, A, aoff, B, boffv, wid, 1); f8_stage(lds, A, aoff, B, boffv, wid, 2);
}
DEVI void q8_stage(char* lds, const unsigned char* __restrict__ A, const unsigned (&aoff)[2], const unsigned char* __restrict__ B, const unsigned (&boffv)[2], int wid, int t) {
    char* sb = lds + (t & 3) * 32768 + wid * 1024;
#pragma unroll
    for (int i = 0; i < 2; ++i) {
        __builtin_amdgcn_global_load_lds((const unsigned*)(A + aoff[i] + t * 64), (LAS unsigned*)(sb + i * 8192), 16, 0, 0);
        __builtin_amdgcn_global_load_lds((const unsigned*)(B + boffv[i] + t * 8192), (LAS unsigned*)(sb + 16384 + i * 8192), 16, 0, 0);
    }
}
DEVI void q8_prefetch(char* lds, const unsigned char* __restrict__ A, const unsigned (&aoff)[2], const unsigned char* __restrict__ B, const unsigned (&boffv)[2], int wid) {
    q8_stage(lds, A, aoff, B, boffv, wid, 0); q8_stage(lds, A, aoff, B, boffv, wid, 1); q8_stage(lds, A, aoff, B, boffv, wid, 2);
}
template <int NT, int SCALE_A, int SCALE_B, bool MOE1>
DEVI void f8_mainloop(char* lds, const unsigned char* __restrict__ A, const unsigned (&aoff)[2], const unsigned char* __restrict__ B, const unsigned (&boffv)[2],
                      int wid, int lane, f32x16 (&acc)[2][4]) {
    const int wr = wid >> 2, wc = wid & 3, l31 = lane & 31, hh = lane >> 5;
    const int xs = (l31 >> 2) & 3;
    const int p0 = ((2 * hh) ^ xs) << 4, p1 = ((2 * hh + 1) ^ xs) << 4;
    const int a_lo = (wr * 128 + l31) * 64 + p0, a_hi = (wr * 128 + l31) * 64 + p1;
    int b_rd[2];
#pragma unroll
    for (int nf = 0; nf < 2; ++nf) {
        const int ntile = MOE1 ? nf : (wc >> 1), nbase = MOE1 ? wc * 32 : (wc & 1) * 64 + nf * 32;
        b_rd[nf] = 16384 + ntile * 8192 + (8 * hh) * 512 + (nbase + l31) * 4;
    }
    auto ldfrag = [&](const char* sa, int lo, int hi) -> i32x8 {
        const i32x4 x = *(const i32x4*)(sa + lo), y = *(const i32x4*)(sa + hi);
        i32x8 r; r[0] = x[0]; r[1] = x[1]; r[2] = x[2]; r[3] = x[3]; r[4] = y[0]; r[5] = y[1]; r[6] = y[2]; r[7] = y[3];
        return r;
    };
    auto compute = [&](int t) {
        const char* sa = lds + (t & 3) * 32768;
        i32x8 fa[4], fb[2];
#pragma unroll
        for (int m = 0; m < 4; ++m) fa[m] = ldfrag(sa + m * 2048, a_lo, a_hi);
#pragma unroll
        for (int n = 0; n < 2; ++n)
#pragma unroll
            for (int j = 0; j < 8; ++j) fb[n][j] = *(const int*)(sa + b_rd[n] + j * 512);
#pragma unroll
        for (int m = 0; m < 4; ++m)
#pragma unroll
            for (int n = 0; n < 2; ++n)
                acc[n][m] = __builtin_amdgcn_mfma_scale_f32_32x32x64_f8f6f4(fb[n], fa[m], acc[n][m], 0, 0, 0, SCALE_B, 0, SCALE_A);
    };
    WAIT_V0(); __builtin_amdgcn_s_barrier();
#pragma unroll 1
    for (int t = 0; t < NT; ++t) {
        if (t + 3 < NT) q8_stage(lds, A, aoff, B, boffv, wid, t + 3);
        compute(t);
        if (t + 3 < NT) { WAIT_VN(8); } else if (t + 2 < NT) { WAIT_VN(4); } else { WAIT_V0(); }
        WAIT_L0(); __builtin_amdgcn_s_barrier();
    }
}
DEVI void touch4(const f32x4& v) { asm volatile("" :: "v"(v)); }
DEVI void touchf(float v) { asm volatile("" :: "v"(v)); }
DEVI void zero_acc32(f32x16 (&acc)[2][4]) {
#pragma unroll
    for (int n = 0; n < 2; ++n)
#pragma unroll
        for (int m = 0; m < 4; ++m)
#pragma unroll
            for (int r = 0; r < 16; ++r) acc[n][m][r] = 0.f;
}

DEVI void bf_stage_rb(int wid, int lane, int i, int& R, int& CB) {
    R = wid * 16 + i * 128 + (lane >> 2);
    CB = (((lane & 3) ^ (R >> 1)) & 3) * 16;
}
template <int NT>
DEVI void bf_mainloop(char* lds, const unsigned char* __restrict__ A, const unsigned (&aoff)[2], const unsigned char* __restrict__ B, const unsigned (&boffv)[2],
                      int wid, int lane, f32x4 (&acc)[4][8]) {
    const int wr = wid >> 2, wc = wid & 3, l15 = lane & 15, q = lane >> 4;
    const int cp = (q ^ ((l15 >> 1) & 3)) << 4;
    const int t_rd = (wr * 128 + l15) * 64 + cp;
    const int w_rd = 16384 + (wc * 64 + l15) * 64 + cp;
    auto compute = [&](int t) {
        const char* sa = lds + (t & 3) * 32768;
        bf16x8 tf[8], wf[4];
#pragma unroll
        for (int nt = 0; nt < 4; ++nt) wf[nt] = *(const bf16x8*)(sa + w_rd + nt * 1024);
#pragma unroll
        for (int mt = 0; mt < 8; ++mt) tf[mt] = *(const bf16x8*)(sa + t_rd + mt * 1024);
#pragma unroll
        for (int mt = 0; mt < 8; ++mt)
#pragma unroll
            for (int nt = 0; nt < 4; ++nt)
                acc[nt][mt] = __builtin_amdgcn_mfma_f32_16x16x32_bf16(wf[nt], tf[mt], acc[nt][mt], 0, 0, 0);
    };
    WAIT_V0(); __builtin_amdgcn_s_barrier();
#pragma unroll 1
    for (int t = 0; t < NT; ++t) {
        if (t + 3 < NT) f8_stage(lds, A, aoff, B, boffv, wid, t + 3);
        compute(t);
        if (t + 3 < NT) { WAIT_VN(8); } else if (t + 2 < NT) { WAIT_VN(4); } else { WAIT_V0(); }
        WAIT_L0(); __builtin_amdgcn_s_barrier();
    }
}
DEVI void zero_acc16(f32x4 (&acc)[4][8]) {
#pragma unroll
    for (int nt = 0; nt < 4; ++nt)
#pragma unroll
        for (int mt = 0; mt < 8; ++mt) acc[nt][mt] = f32x4{0.f, 0.f, 0.f, 0.f};
}
DEVI void bf_offsets(unsigned (&off)[2], int wid, int lane, int row0, int ld) {
#pragma unroll
    for (int i = 0; i < 2; ++i) { int R, CB; bf_stage_rb(wid, lane, i, R, CB); off[i] = ((unsigned)(row0 + R) * ld) * 2u + CB; }
}

DEVI void dense_convert(const Args& a, char* lds, int tid, int wid, int lane) {
    constexpr int RS = 132;
    unsigned* L = (unsigned*)lds;
    const int kq = tid >> 5, nq = tid & 31;
    auto tile = [&](int tl, const float*& src, int& ld, int& ldo, u16*& dst) {
        if (tl < 512) { const int kt = tl & 15, nt = tl >> 4; const int c0 = (nt < 24) ? nt * 128 : 3088 + (nt - 24) * 128;
            src = a.in[2] + (size_t)(kt * 128) * PW + c0; ld = PW; ldo = D; dst = (u16*)(a.ws + WS_WINT) + (size_t)(nt * 128) * D + kt * 128; }
        else if (tl < 576) { const int t2 = tl - 512, kt = t2 & 7, nt = t2 >> 3;
            src = a.in[14] + (size_t)(kt * 128) * SW + nt * 128; ld = SW; ldo = SW; dst = (u16*)(a.ws + WS_GLUT) + (size_t)(nt * 128) * SW + kt * 128; }
        else { const int t2 = tl - 576, kt = t2 & 15, nt = t2 >> 4;
            src = a.in[17] + (size_t)(kt * 128) * D + nt * 128; ld = D; ldo = D; dst = (u16*)(a.ws + WS_WOUTT) + (size_t)(nt * 128) * D + kt * 128; }
    };
    f32x4 v[2][4];
    auto issue = [&](int tl) {
        const float* src; int ld, ldo; u16* dst; tile(tl, src, ld, ldo, dst);
#pragma unroll
        for (int h = 0; h < 2; ++h)
#pragma unroll
            for (int r = 0; r < 4; ++r) v[h][r] = *(const f32x4*)(src + (size_t)(4 * (kq + 16 * h) + r) * ld + 4 * nq);
    };
    if ((int)blockIdx.x < 832) issue(blockIdx.x);
#pragma unroll 1
    for (int tl = blockIdx.x; tl < 832; tl += gridDim.x) {
        const float* src; int ld, ldo; u16* dst; tile(tl, src, ld, ldo, dst);
        __syncthreads();
#pragma unroll
        for (int h = 0; h < 2; ++h) {
            i32x4 d0, d1;
#pragma unroll
            for (int c = 0; c < 4; ++c) { d0[c] = (int)pack2(v[h][0][c], v[h][1][c]); d1[c] = (int)pack2(v[h][2][c], v[h][3][c]); }
            *(i32x4*)(L + (2 * (kq + 16 * h)) * RS + 4 * nq) = d0;
            *(i32x4*)(L + (2 * (kq + 16 * h) + 1) * RS + 4 * nq) = d1;
        }
        if (tl + (int)gridDim.x < 832) issue(tl + gridDim.x);
        __syncthreads();
        {
            const int part = wid & 3, n = (wid >> 2) * 64 + lane;
            unsigned o[16];
#pragma unroll
            for (int j = 0; j < 16; ++j) o[j] = L[(16 * part + j) * RS + n];
            uint4* dp = (uint4*)(dst + (size_t)n * ldo + 32 * part);
            dp[0] = make_uint4(o[0], o[1], o[2], o[3]); dp[1] = make_uint4(o[4], o[5], o[6], o[7]);
            dp[2] = make_uint4(o[8], o[9], o[10], o[11]); dp[3] = make_uint4(o[12], o[13], o[14], o[15]);
        }
    }
}

DEVI void convert_range(const Args& a, char* lds, int t_lo, int t_hi, int tid, int wid, int lane) {
    const float* w1 = a.in[21]; const float* w2 = a.in[23];
    unsigned char* W1Q = a.ws + WS_W1T; unsigned char* W2Q = a.ws + WS_W2T;
    { int lq = lane; asm volatile("" : "+v"(lq)); lane = lq; tid = wid * 64 + lq; }
    const int kq0 = tid >> 5, n4 = tid & 31;
    auto tile_src = [&](int tl, const float*& src, int& ld, unsigned char*& dst) {
        if (tl < 16384) { const int kt = tl & 15, nt = (tl >> 4) & 31, e = tl >> 9;
            src = w1 + (size_t)e * D * 4096 + (size_t)(kt * 128) * 4096 + nt * 128; ld = 4096;
            dst = W1Q + ((size_t)(e * 32 + nt) * 512 + kt * 32) * 512; }
        else { const int t2 = tl - 16384, kt = t2 & 15, nt = (t2 >> 4) & 15, e = t2 >> 8;
            src = w2 + (size_t)e * FF * D + (size_t)(kt * 128) * D + nt * 128; ld = D;
            dst = W2Q + ((size_t)(e * 16 + nt) * 512 + kt * 32) * 512; }
    };
    f32x4 va[2][4], vb[2][4];
    auto issue = [&](int tl, f32x4 (&v)[2][4]) {
        const float* src; int ld; unsigned char* dst; tile_src(tl, src, ld, dst);
#pragma unroll
        for (int h = 0; h < 2; ++h)
#pragma unroll
            for (int r = 0; r < 4; ++r) v[h][r] = __builtin_nontemporal_load((const f32x4*)(src + (size_t)(4 * (kq0 + 16 * h) + r) * ld + 4 * n4));
    };
    auto finish = [&](int tl, f32x4 (&v)[2][4], int tnext) {
        const float* src; int ld; unsigned char* dst; tile_src(tl, src, ld, dst);
        uint4 o[2];
#pragma unroll
        for (int h = 0; h < 2; ++h) {
            o[h].x = cvt4_fp8(v[h][0][0] * 256.f, v[h][1][0] * 256.f, v[h][2][0] * 256.f, v[h][3][0] * 256.f);
            o[h].y = cvt4_fp8(v[h][0][1] * 256.f, v[h][1][1] * 256.f, v[h][2][1] * 256.f, v[h][3][1] * 256.f);
            o[h].z = cvt4_fp8(v[h][0][2] * 256.f, v[h][1][2] * 256.f, v[h][2][2] * 256.f, v[h][3][2] * 256.f);
            o[h].w = cvt4_fp8(v[h][0][3] * 256.f, v[h][1][3] * 256.f, v[h][2][3] * 256.f, v[h][3][3] * 256.f);
        }
        if (tnext < t_hi) issue(tnext, v);
#pragma unroll
        for (int h = 0; h < 2; ++h) *(uint4*)(dst + ((size_t)(kq0 + 16 * h) * 128 + 4 * n4) * 4) = o[h];
    };
    if (t_lo < t_hi) issue(t_lo, va);
    if (t_lo + 1 < t_hi) issue(t_lo + 1, vb);
#pragma unroll 1
    for (int tl = t_lo; tl < t_hi; tl += 2) {
        finish(tl, va, tl + 2);
        if (tl + 1 < t_hi) finish(tl + 1, vb, tl + 3);
    }
}

DEVI void convert_pool(const Args& a, char* lds, int which, int p_lo, int p_hi, int tid, int wid, int lane) {
    int* cur = (int*)(a.ws + WS_CNT) + 64 + which;
    volatile int* bc = (volatile int*)(lds - LDS_BASE + 32);
#pragma unroll 1
    while (true) {
        __syncthreads();
        if (tid == 0) *bc = atomicAdd(cur, 4);
        __syncthreads();
        const int t = p_lo + *bc;
        if (t >= p_hi) break;
        convert_range(a, lds, t, min(t + 4, p_hi), tid, wid, lane);
    }
}

DEVI void phase0(const Args& a, char* lds, int tid, int wid, int lane) {
    const float* x = a.in[0]; const float* g1 = a.in[1]; const float* w_in = a.in[2];
    u16* HN = (u16*)(a.ws + WS_HN); float* GLR = (float*)(a.ws + WS_GLR);
    constexpr int RSB = 4096 + 16;
    char* Wb = lds;
    char* Hb = lds + 16 * RSB;
    float* red = (float*)(lds + 32 * RSB);
    for (int u = blockIdx.x; u < 256; u += gridDim.x) {
        __syncthreads();
        for (int k = 0; k < 4; ++k) {
            const int d = (tid + 512 * k + 8 * (int)blockIdx.x) & 2047;
            const f32x4* src = (const f32x4*)(w_in + (size_t)d * PW + 3072);
#pragma unroll
            for (int q = 0; q < 4; ++q) { f32x4 v = src[q];
#pragma unroll
                for (int c = 0; c < 4; ++c) *(u16*)(Wb + (q * 4 + c) * RSB + d * 2) = f2bf(v[c]); }
        }
        if (tid < 32) ((float*)(a.ws + WS_SSQ))[u * 32 + tid] = 0.f;
        if (u == 0 && tid < 32) { ((int*)(a.ws + WS_CNT))[tid] = 0; ((int*)(a.ws + WS_CNT))[64 + tid] = 0; }
#pragma unroll 1
        for (int ps = 0; ps < 2; ++ps) {
            const int tok0 = u * 32 + ps * 16;
            {
                const int tokA = tok0 + wid * 2, tokB = tokA + 1;
                f32x4 xa[8], xb[8];
                float ssa = 0.f, ssb = 0.f;
#pragma unroll
                for (int i = 0; i < 8; ++i) {
                    xa[i] = *(const f32x4*)(x + (size_t)tokA * D + 256 * i + 4 * lane);
                    xb[i] = *(const f32x4*)(x + (size_t)tokB * D + 256 * i + 4 * lane);
#pragma unroll
                    for (int c = 0; c < 4; ++c) { ssa += xa[i][c] * xa[i][c]; ssb += xb[i][c] * xb[i][c]; }
                }
                ssa = wave_sum(ssa); ssb = wave_sum(ssb);
                const float ra = rsqrtf(ssa * (1.0f / D) + EPS), rb = rsqrtf(ssb * (1.0f / D) + EPS);
#pragma unroll
                for (int i = 0; i < 8; ++i) {
                    const f32x4 g = *(const f32x4*)(g1 + 256 * i + 4 * lane);
                    uint2 pa, pb;
                    pa.x = pack2(xa[i][0] * ra * g[0], xa[i][1] * ra * g[1]); pa.y = pack2(xa[i][2] * ra * g[2], xa[i][3] * ra * g[3]);
                    pb.x = pack2(xb[i][0] * rb * g[0], xb[i][1] * rb * g[1]); pb.y = pack2(xb[i][2] * rb * g[2], xb[i][3] * rb * g[3]);
                    *(uint2*)(HN + (size_t)tokA * D + 256 * i + 4 * lane) = pa;
                    *(uint2*)(HN + (size_t)tokB * D + 256 * i + 4 * lane) = pb;
                    *(uint2*)(Hb + (wid * 2) * RSB + (256 * i + 4 * lane) * 2) = pa;
                    *(uint2*)(Hb + (wid * 2 + 1) * RSB + (256 * i + 4 * lane) * 2) = pb;
                }
            }
            __syncthreads();
            {
                const int l15 = lane & 15, q = lane >> 4;
                f32x4 acc = {0.f, 0.f, 0.f, 0.f};
#pragma unroll
                for (int ks = 0; ks < 8; ++ks) {
                    const int kb = (wid * 256 + ks * 32 + q * 8) * 2;
                    const bf16x8 av = *(const bf16x8*)(Hb + l15 * RSB + kb);
                    const bf16x8 bv = *(const bf16x8*)(Wb + l15 * RSB + kb);
                    acc = __builtin_amdgcn_mfma_f32_16x16x32_bf16(av, bv, acc, 0, 0, 0);
                }
#pragma unroll
                for (int j = 0; j < 4; ++j) red[(wid * 16 + 4 * q + j) * 16 + l15] = acc[j];
            }
            __syncthreads();
            if (tid < 256) {
                float sacc = 0.f;
#pragma unroll
                for (int w = 0; w < 8; ++w) sacc += red[w * 256 + tid];
                GLR[(size_t)(tok0 + (tid >> 4)) * 16 + (tid & 15)] = sacc;
            }
        }
    }
    const float* a_re = a.in[6]; const float* a_im = a.in[7]; const float* b_re = a.in[8]; const float* b_im = a.in[9];
    const float* c_re = a.in[10]; const float* c_im = a.in[11]; const float* lstep = a.in[13];
    u16* KT = (u16*)(a.ws + WS_S5K); u16* WE = (u16*)(a.ws + WS_S5WE); u16* VV = (u16*)(a.ws + WS_S5V); float* AL = (float*)(a.ws + WS_S5AL);
    float* Bre = (float*)lds;
    float* Bim = Bre + 1024;
    float* Cre = Bim + 1024;
    float* Cim = Cre + 1024;
    float* Pre = Cim + 1024;
    float* Pim = Pre + 65 * 64;
    for (int u = blockIdx.x; u < 256; u += gridDim.x) {
        const int g = u >> 2, q = u & 3;
        __syncthreads();
        const float delta = __expf(lstep[g]);
        if (tid < 64) {
            const int p = tid;
            const float ar = a_re[g * 64 + p], ai = a_im[g * 64 + p];
            const float ea = expf(ar * delta);
            float sn, cs; sincosf(ai * delta, &sn, &cs);
            const float xr = ea * cs - 1.0f, xi = ea * sn;
            const float den = 1.0f / (ar * ar + ai * ai);
            const float cr = (xr * ar + xi * ai) * den, ci = (xi * ar - xr * ai) * den;
#pragma unroll
            for (int m = 0; m < 16; ++m) {
                const float br = b_re[(g * 64 + p) * 16 + m], bi = b_im[(g * 64 + p) * 16 + m];
                Bre[p * 16 + m] = cr * br - ci * bi;
                Bim[p * 16 + m] = cr * bi + ci * br;
            }
        }
        for (int i = tid; i < 1024; i += 512) { Cre[i] = c_re[g * 1024 + i]; Cim[i] = c_im[g * 1024 + i]; }
        for (int i = tid; i < 65 * 64; i += 512) {
            const int tau = i >> 6, p = i & 63;
            const float ar = a_re[g * 64 + p], ai = a_im[g * 64 + p];
            const float e = expf((float)tau * ar * delta);
            float sn, cs; sincosf((float)tau * (ai * delta), &sn, &cs);
            Pre[i] = e * cs; Pim[i] = e * sn;
        }
        __syncthreads();
        if (q == 0 && tid < 64) { AL[(g * 64 + tid) * 2] = Pre[64 * 64 + tid]; AL[(g * 64 + tid) * 2 + 1] = Pim[64 * 64 + tid]; }
        if (tid < 256) {
            const int tau = q * 16 + (tid >> 4), n = tid & 15;
            float acc[16];
#pragma unroll
            for (int m = 0; m < 16; ++m) acc[m] = 0.f;
#pragma unroll 2
            for (int p = 0; p < 64; ++p) {
                const float cr = Cre[n * 64 + p], ci = Cim[n * 64 + p], pr = Pre[tau * 64 + p], pi = Pim[tau * 64 + p];
                const float xr = cr * pr - ci * pi, xi = cr * pi + ci * pr;
#pragma unroll
                for (int m4 = 0; m4 < 4; ++m4) {
                    const f32x4 br = *(const f32x4*)(Bre + p * 16 + m4 * 4), bi = *(const f32x4*)(Bim + p * 16 + m4 * 4);
#pragma unroll
                    for (int c = 0; c < 4; ++c) acc[m4 * 4 + c] += xr * br[c] - xi * bi[c];
                }
            }
            uint4 o0, o1;
            o0.x = pack2(acc[0], acc[1]); o0.y = pack2(acc[2], acc[3]); o0.z = pack2(acc[4], acc[5]); o0.w = pack2(acc[6], acc[7]);
            o1.x = pack2(acc[8], acc[9]); o1.y = pack2(acc[10], acc[11]); o1.z = pack2(acc[12], acc[13]); o1.w = pack2(acc[14], acc[15]);
            uint4* dst = (uint4*)(KT + ((size_t)(g * 64 + tau) * 16 + n) * 16);
            dst[0] = o0; dst[1] = o1;
        }
        {
            const int p = tid >> 3;
#pragma unroll
            for (int ss = 0; ss < 2; ++ss) {
                const int s = q * 16 + (tid & 7) * 2 + ss;
                const float pr = Pre[(63 - s) * 64 + p], pi = Pim[(63 - s) * 64 + p];
                float vr[16], vi[16];
#pragma unroll
                for (int m = 0; m < 16; ++m) { const float br = Bre[p * 16 + m], bi = Bim[p * 16 + m]; vr[m] = pr * br - pi * bi; vi[m] = pr * bi + pi * br; }
                uint4 r0, r1, i0, i1;
                r0.x = pack2(vr[0], vr[1]); r0.y = pack2(vr[2], vr[3]); r0.z = pack2(vr[4], vr[5]); r0.w = pack2(vr[6], vr[7]);
                r1.x = pack2(vr[8], vr[9]); r1.y = pack2(vr[10], vr[11]); r1.z = pack2(vr[12], vr[13]); r1.w = pack2(vr[14], vr[15]);
                i0.x = pack2(vi[0], vi[1]); i0.y = pack2(vi[2], vi[3]); i0.z = pack2(vi[4], vi[5]); i0.w = pack2(vi[6], vi[7]);
                i1.x = pack2(vi[8], vi[9]); i1.y = pack2(vi[10], vi[11]); i1.z = pack2(vi[12], vi[13]); i1.w = pack2(vi[14], vi[15]);
                uint4* dr = (uint4*)(WE + ((size_t)(g * 128 + 2 * p) * 1024 + s * 16));
                uint4* di = (uint4*)(WE + ((size_t)(g * 128 + 2 * p + 1) * 1024 + s * 16));
                dr[0] = r0; dr[1] = r1; di[0] = i0; di[1] = i1;
            }
        }
        {
            const int tau = q * 16 + (tid >> 5), n = (tid >> 1) & 15, ph = tid & 1;
            unsigned* dst = (unsigned*)(VV + ((size_t)(g * 1024 + tau * 16 + n) * 128 + ph * 64));
#pragma unroll 4
            for (int pp = 0; pp < 32; ++pp) {
                const int p = ph * 32 + pp;
                const float cr = Cre[n * 64 + p], ci = Cim[n * 64 + p], pr = Pre[(tau + 1) * 64 + p], pi = Pim[(tau + 1) * 64 + p];
                dst[pp] = pack2(cr * pr - ci * pi, -(cr * pi + ci * pr));
            }
        }
    }
    __syncthreads();
    dense_convert(a, lds, tid, wid, lane);
}


namespace pg8 {
#define PG8_LAS __attribute__((address_space(3)))
constexpr int BM = 256, BK = 64, HALF = 128, HTB = HALF * BK * 2, NXCD = 8, WGM = 8;
DEVI int lds_byte(int r, int c) { const int st = (r >> 4) * 2 + (c >> 5), rr = r & 15, cc = c & 31, ob = rr * 64 + cc * 2; return st * 1024 + (ob ^ (((ob >> 9) & 1) << 5)); }
DEVI void stage_rc(int b, int& R, int& C) { const int st = b / 1024, sb = b % 1024, swz = sb ^ (((sb >> 9) & 1) << 5); R = (st >> 1) * 16 + swz / 64; C = (st & 1) * 32 + (swz % 64) / 2; }
DEVI int perm32(int rho) { const int n = rho >> 4, i = rho & 15; return 8 * (i >> 2) + 4 * n + (i & 3); }
struct Unit { int pm, pn, kofs, cont; };
struct Gemm { const void* A; const void* Bt; int ld, K; };
struct StaticOrder {
    int nM, nN, nwg, G, c;
    DEVI void init(int M, int N, int G_, int c_) { nM = M / BM; nN = N / BM; nwg = nM * nN; G = G_; c = c_; }
    DEVI bool tile(int i, Unit& u) const {
        const long L = (long)i * G + c; if (L >= nwg) return false;
        int wgid = (int)L; { const int q = nwg / NXCD, r = nwg % NXCD, xcd = wgid % NXCD, off = wgid / NXCD; wgid = (xcd < r ? xcd * (q + 1) : r * (q + 1) + (xcd - r) * q) + off; }
        const int nig = WGM * nN, gid = wgid / nig, fm = gid * WGM, gsz = (nM - fm) < WGM ? (nM - fm) : WGM;
        u.pm = fm + ((wgid % nig) % gsz); u.pn = (wgid % nig) / gsz; return true;
    }
    int i0 = 0, i1 = 1 << 30;
    DEVI bool next(int i, Unit& u) const { u.kofs = 0; u.cont = 0; return (i0 + i < i1) && tile(i0 + i, u); }
};
struct SplitKOrder : StaticOrder {
    int khalf;
    DEVI bool next(int i, Unit& u) const { if (i >= 2) return false; u.kofs = i == 0 ? khalf : 0; u.cont = i; return tile(0, u); }
};

template <class Epi, class Sched>
DEVI void gemm_phase(PG8_LAS unsigned char* lds, const Gemm g, const Sched& S, const Epi& E) {
    const int tid = threadIdx.x, wid = __builtin_amdgcn_readfirstlane(tid >> 6), lane = tid & 63, wr = wid >> 2, wc = wid & 3, fr = lane & 15, fq = lane >> 4;
    const int ld = g.ld, nt = g.K / BK;
    unsigned voffA[2], voffB[2];
#pragma unroll
    for (int i = 0; i < 2; ++i) { int R, C; stage_rc(tid * 16 + i * 8192, R, C); const int Rb = Epi::PERM ? ((R & ~31) + perm32(R & 31)) : R;
        voffA[i] = (unsigned)(R * ld + C) * 2u; voffB[i] = (unsigned)(Rb * ld + C) * 2u; }
    const size_t kstep = (size_t)(BK * 2);
    const size_t hstep = (size_t)HALF * ld * 2;
    const size_t tstep = 2 * hstep;
    const unsigned ldsw = (unsigned)wid * 1024u;
    const int aoff = lds_byte(wr * 64 + fr, fq * 8), boff = lds_byte(wc * 32 + fr, fq * 8);
#define PG8_SA(b, h) (((b) * 2 + (h)) * HTB)
#define PG8_SB(b, h) ((4 + (b) * 2 + (h)) * HTB)
#define PG8_STAGE(bufoff, gbase, voff) do { _Pragma("unroll") for (int _i = 0; _i < 2; ++_i) \
        __builtin_amdgcn_global_load_lds((const unsigned*)((const char*)(gbase) + (voff)[_i]), (PG8_LAS unsigned*)(lds + (bufoff) + ldsw + _i * 8192), 16, 0, 0); } while (0)
#define PG8_LDA(dst, b, h) do { _Pragma("unroll") for (int m = 0; m < 4; ++m) _Pragma("unroll") for (int k = 0; k < 2; ++k) dst[m][k] = *(const PG8_LAS bf16x8*)(lds + PG8_SA(b, h) + aoff + m * 2048 + k * 1024); } while (0)
#define PG8_LDB(dst, b, h) do { _Pragma("unroll") for (int n = 0; n < 2; ++n) _Pragma("unroll") for (int k = 0; k < 2; ++k) dst[n][k] = *(const PG8_LAS bf16x8*)(lds + PG8_SB(b, h) + boff + n * 2048 + k * 1024); } while (0)
#define PG8_MMA(ai, bj, At, Bt) do { __builtin_amdgcn_s_setprio(1); _Pragma("unroll") for (int m = 0; m < 4; ++m) _Pragma("unroll") for (int n = 0; n < 2; ++n) _Pragma("unroll") for (int k = 0; k < 2; ++k) \
        acc[ai][bj][m][n] = __builtin_amdgcn_mfma_f32_16x16x32_bf16(Bt[n][k], At[m][k], acc[ai][bj][m][n], 0, 0, 0); __builtin_amdgcn_s_setprio(0); } while (0)
#define PG8_WAIT_V(n) asm volatile("s_waitcnt vmcnt(" #n ")" ::: "memory")
#define PG8_WAIT_L(n) asm volatile("s_waitcnt lgkmcnt(" #n ")" ::: "memory")
#define PG8_BAR __builtin_amdgcn_s_barrier()
#define PG8_SCHED __builtin_amdgcn_sched_barrier(0)
#define PG8_ZERO() do { _Pragma("unroll") for (int a_ = 0; a_ < 2; ++a_) _Pragma("unroll") for (int b_ = 0; b_ < 2; ++b_) _Pragma("unroll") for (int m_ = 0; m_ < 4; ++m_) _Pragma("unroll") for (int n_ = 0; n_ < 2; ++n_) \
        acc[a_][b_][m_][n_] = (f32x4){0.f, 0.f, 0.f, 0.f}; } while (0)
    Unit cur, nxt; int ui = 0;
    if (!S.next(0, cur)) return;
    f32x4 acc[2][2][4][2];
    PG8_ZERO();
    bf16x8 At[4][2], B0[2][2], B1[2][2];
    const char* cA = (const char*)g.A + (size_t)cur.pm * tstep + cur.kofs; const char* cB = (const char*)g.Bt + (size_t)cur.pn * tstep + cur.kofs;
    PG8_STAGE(PG8_SB(0, 0), cB, voffB); PG8_STAGE(PG8_SA(0, 0), cA, voffA); PG8_STAGE(PG8_SB(0, 1), cB + hstep, voffB); PG8_STAGE(PG8_SA(0, 1), cA + hstep, voffA);
    if (wr == 1) PG8_BAR;
    PG8_WAIT_V(4); PG8_BAR;
    PG8_STAGE(PG8_SB(1, 0), cB + kstep, voffB); PG8_STAGE(PG8_SA(1, 0), cA + kstep, voffA); PG8_STAGE(PG8_SB(1, 1), cB + hstep + kstep, voffB);
    PG8_WAIT_V(6); PG8_BAR;
    for (;;) {
        const bool has_next = S.next(ui + 1, nxt);
        const char* nA = has_next ? (const char*)g.A + (size_t)nxt.pm * tstep + nxt.kofs : cA; const char* nB = has_next ? (const char*)g.Bt + (size_t)nxt.pn * tstep + nxt.kofs : cB;
        for (int t = 0; t < nt; t += 2) {
            const bool last = (t == nt - 2);
            const char* a1 = cA + (size_t)(t + 1) * kstep;
            const char* a2 = last ? nA : cA + (size_t)(t + 2) * kstep; const char* b2 = last ? nB : cB + (size_t)(t + 2) * kstep;
            const char* a3 = a2 + kstep; const char* b3 = b2 + kstep;
            PG8_LDB(B0, 0, 0); PG8_SCHED; PG8_LDA(At, 0, 0); PG8_STAGE(PG8_SA(1, 1), a1 + hstep, voffA);
            PG8_WAIT_L(8); PG8_BAR; PG8_WAIT_L(0); PG8_MMA(0, 0, At, B0); PG8_BAR; PG8_SCHED;
            PG8_LDB(B1, 0, 1); PG8_STAGE(PG8_SB(0, 0), b2, voffB);
            PG8_BAR; PG8_WAIT_L(0); PG8_MMA(0, 1, At, B1); PG8_BAR;
            PG8_LDA(At, 0, 1); PG8_STAGE(PG8_SA(0, 0), a2, voffA);
            PG8_BAR; PG8_WAIT_L(0); PG8_MMA(1, 0, At, B0); PG8_BAR; PG8_SCHED;
            PG8_STAGE(PG8_SB(0, 1), b2 + hstep, voffB);
            PG8_WAIT_V(6); PG8_BAR; PG8_MMA(1, 1, At, B1); PG8_BAR;
            PG8_LDB(B0, 1, 0); PG8_SCHED; PG8_LDA(At, 1, 0); PG8_STAGE(PG8_SA(0, 1), a2 + hstep, voffA);
            PG8_WAIT_L(8); PG8_BAR; PG8_WAIT_L(0); PG8_MMA(0, 0, At, B0); PG8_BAR; PG8_SCHED;
            PG8_LDB(B1, 1, 1); PG8_STAGE(PG8_SB(1, 0), b3, voffB);
            PG8_BAR; PG8_WAIT_L(0); PG8_MMA(0, 1, At, B1); PG8_BAR;
            PG8_LDA(At, 1, 1); PG8_STAGE(PG8_SA(1, 0), a3, voffA);
            PG8_BAR; PG8_WAIT_L(0); PG8_MMA(1, 0, At, B0); PG8_BAR; PG8_SCHED;
            PG8_STAGE(PG8_SB(1, 1), b3 + hstep, voffB);
            PG8_WAIT_V(6); PG8_BAR; PG8_MMA(1, 1, At, B1); PG8_BAR;
        }
        E(acc, cur, wr, wc, fr, fq);
        if (!has_next) break;
        if (!nxt.cont) PG8_ZERO();
        cur = nxt; cA = nA; cB = nB; ++ui;
    }
    PG8_WAIT_V(0);
    if (wr == 0) PG8_BAR;
    PG8_BAR;
#undef PG8_SA
#undef PG8_SB
#undef PG8_STAGE
#undef PG8_LDA
#undef PG8_LDB
#undef PG8_MMA
#undef PG8_WAIT_V
#undef PG8_WAIT_L
#undef PG8_BAR
#undef PG8_SCHED
#undef PG8_ZERO
}
}

struct EpiProj {
    static constexpr bool PERM = true;
    u16* out;
    DEVI void operator()(f32x4 (&acc)[2][2][4][2], const pg8::Unit& u, int wr, int wc, int fr, int fq) const {
        const float sc = (u.pn < 2) ? 0.08838834764831845f : 1.0f;
        const int row0 = u.pm * 256 + wr * 64 + fr, col0 = u.pn * 256 + wc * 32 + 8 * fq;
#pragma unroll
        for (int ai = 0; ai < 2; ++ai)
#pragma unroll
            for (int m = 0; m < 4; ++m) {
                u16* rowp = out + (size_t)(row0 + ai * 128 + m * 16) * PJ + col0;
#pragma unroll
                for (int bj = 0; bj < 2; ++bj) {
                    const f32x4 v0 = acc[ai][bj][m][0], v1 = acc[ai][bj][m][1];
                    uint4 w; w.x = pack2(v0[0] * sc, v0[1] * sc); w.y = pack2(v0[2] * sc, v0[3] * sc); w.z = pack2(v1[0] * sc, v1[1] * sc); w.w = pack2(v1[2] * sc, v1[3] * sc);
                    *(uint4*)(rowp + bj * 128) = w;
                }
            }
    }
};
struct EpiGlu {
    static constexpr bool PERM = true;
    const u16* Z; u16* MIX; float* SSQ; const float* gbias; const float* sng;
    DEVI void operator()(f32x4 (&acc)[2][2][4][2], const pg8::Unit& u, int wr, int wc, int fr, int fq) const {
        const int row0 = u.pm * 256 + wr * 64 + fr, col0 = u.pn * 256 + wc * 32 + 8 * fq;
#pragma unroll
        for (int ai = 0; ai < 2; ++ai)
#pragma unroll
            for (int m = 0; m < 4; ++m) {
                const int row = row0 + ai * 128 + m * 16;
                float sq = 0.f;
#pragma unroll
                for (int bj = 0; bj < 2; ++bj) {
                    const int c = col0 + bj * 128;
                    const uint4 zv = *(const uint4*)(Z + (size_t)row * SW + c);
                    const unsigned zw[4] = {zv.x, zv.y, zv.z, zv.w};
                    unsigned ow[4];
#pragma unroll
                    for (int n = 0; n < 2; ++n) {
                        const f32x4 gb = *(const f32x4*)(gbias + c + 4 * n), sg = *(const f32x4*)(sng + c + 4 * n);
                        const f32x4 v = acc[ai][bj][m][n];
                        const float y0 = bflo(zw[2 * n]) * sigmoidf_(v[0] + gb[0]), y1 = bfhi(zw[2 * n]) * sigmoidf_(v[1] + gb[1]);
                        const float y2 = bflo(zw[2 * n + 1]) * sigmoidf_(v[2] + gb[2]), y3 = bfhi(zw[2 * n + 1]) * sigmoidf_(v[3] + gb[3]);
                        sq += y0 * y0 + y1 * y1 + y2 * y2 + y3 * y3;
                        ow[2 * n] = pack2(y0 * sg[0], y1 * sg[1]); ow[2 * n + 1] = pack2(y2 * sg[2], y3 * sg[3]);
                    }
                    uint4 w; w.x = ow[0]; w.y = ow[1]; w.z = ow[2]; w.w = ow[3];
                    *(uint4*)(MIX + (size_t)row * D + 1024 + c) = w;
                }
                sq += __shfl_xor(sq, 16); sq += __shfl_xor(sq, 32);
                if (fq == 0) atomicAdd(&SSQ[row], sq);
            }
    }
};
struct EpiOut {
    static constexpr bool PERM = true;
    const float* x; u16* H1; const float* SSQ;
    DEVI void operator()(f32x4 (&acc)[2][2][4][2], const pg8::Unit& u, int wr, int wc, int fr, int fq) const {
        const int row0 = u.pm * 256 + wr * 64 + fr, col0 = u.pn * 256 + wc * 32 + 8 * fq;
        if (u.cont == 0) {
#pragma unroll
            for (int ai = 0; ai < 2; ++ai)
#pragma unroll
                for (int m = 0; m < 4; ++m) {
                    const float rs = rsqrtf(SSQ[row0 + ai * 128 + m * 16] * (1.0f / SW) + EPS);
#pragma unroll
                    for (int bj = 0; bj < 2; ++bj)
#pragma unroll
                        for (int n = 0; n < 2; ++n) acc[ai][bj][m][n] *= rs;
                }
        } else {
#pragma unroll
            for (int ai = 0; ai < 2; ++ai)
#pragma unroll
                for (int m = 0; m < 4; ++m) {
                    const size_t base = (size_t)(row0 + ai * 128 + m * 16) * D + col0;
#pragma unroll
                    for (int bj = 0; bj < 2; ++bj) {
                        const f32x4 v0 = *(const f32x4*)(x + base + bj * 128) + acc[ai][bj][m][0], v1 = *(const f32x4*)(x + base + bj * 128 + 4) + acc[ai][bj][m][1];
                        uint4 pk; pk.x = pack2(v0[0], v0[1]); pk.y = pack2(v0[2], v0[3]); pk.z = pack2(v1[0], v1[1]); pk.w = pack2(v1[2], v1[3]);
                        *(uint4*)(H1 + base + bj * 128) = pk;
                    }
                }
        }
    }
};

DEVI void phase1(const Args& a, char* lds, int tid, int wid, int lane) {
    extern __shared__ __attribute__((aligned(16))) char smem_pg8[];
    const int cpos = blockIdx.x % 3, c_lo = blockIdx.x * 30, c_hi = c_lo + 30;
#pragma unroll 1
    for (int part = 0; part < 2; ++part) {
        if (part == cpos) convert_range(a, lds, c_lo, c_hi, tid, wid, lane);
        pg8::Gemm g; g.A = a.ws + WS_HN; g.Bt = a.ws + WS_WINT; g.ld = D; g.K = D;
        pg8::StaticOrder S; S.init(T, PJ, (int)gridDim.x, (int)blockIdx.x);
        if (cpos == 1) { S.i0 = part; S.i1 = part + 1; } else if (part == 1) S.i1 = 0;
        EpiProj E; E.out = (u16*)(a.ws + WS_PROJ);
        pg8::gemm_phase(( PG8_LAS unsigned char*)(smem_pg8 + 1024), g, S, E);
    }
    if (cpos == 2) convert_range(a, lds, c_lo, c_hi, tid, wid, lane);
    convert_pool(a, lds, 0, 7680, 8192, tid, wid, lane);
}

DEVI void gla_gate(const Args& a, int n, int h, int tid, float* glr, float* tot, float (&b)[16], float& blast) {
    const float* GLR = (const float*)(a.ws + WS_GLR);
    const float* W2 = a.in[3]; const float* gb = a.in[4];
    for (int i = tid; i < 1024; i += 512) glr[i] = GLR[(size_t)n * 64 * 16 + i];
    const int ch = tid & 127, tq = tid >> 7;
    float w[16];
#pragma unroll
    for (int r = 0; r < 16; ++r) w[r] = W2[r * 512 + h * 128 + ch];
    const float bias = gb[h * 128 + ch];
    __syncthreads();
    float run = 0.f;
#pragma unroll
    for (int tt = 0; tt < 16; ++tt) {
        const int t = tq * 16 + tt;
        float s = bias;
#pragma unroll
        for (int r4 = 0; r4 < 4; ++r4) {
            const f32x4 gv = *(const f32x4*)(glr + t * 16 + r4 * 4);
            s += gv[0] * w[r4 * 4] + gv[1] * w[r4 * 4 + 1] + gv[2] * w[r4 * 4 + 2] + gv[3] * w[r4 * 4 + 3];
        }
        run += logsigmoid_(s) * (1.0f / 16.0f);
        b[tt] = run;
    }
    tot[tq * 128 + ch] = run;
    __syncthreads();
    float pre = 0.f;
#pragma unroll
    for (int k = 0; k < 4; ++k) { const float v = tot[k * 128 + ch]; if (k < tq) pre += v; }
    blast = tot[ch] + tot[128 + ch] + tot[256 + ch] + tot[384 + ch];
#pragma unroll
    for (int tt = 0; tt < 16; ++tt) b[tt] += pre;
}
DEVI void gla_stage_vT(const u16* PROJ, int t0, int vcol0, char* img, int tid) {
    if (tid < 256) {
        const int tb = tid >> 5, jb = tid & 31;
        unsigned R[8][4];
#pragma unroll
        for (int tt = 0; tt < 8; ++tt) {
            const uint4 v = *(const uint4*)(PROJ + (size_t)(t0 + tb * 8 + tt) * PJ + vcol0 + jb * 8);
            R[tt][0] = v.x; R[tt][1] = v.y; R[tt][2] = v.z; R[tt][3] = v.w;
        }
#pragma unroll
        for (int jj = 0; jj < 8; ++jj) {
            unsigned o[4];
#pragma unroll
            for (int d = 0; d < 4; ++d) {
                const unsigned lo = R[2 * d][jj >> 1], hi = R[2 * d + 1][jj >> 1];
                o[d] = (jj & 1) ? ((lo >> 16) | (hi & 0xffff0000u)) : ((lo & 0xffffu) | (hi << 16));
            }
            *(uint4*)(img + lds_byte<2>(jb * 8 + jj, tb * 8)) = make_uint4(o[0], o[1], o[2], o[3]);
        }
    }
}

constexpr int USTR = 2048 + 16;
DEVI void s5_fill_U(const u16* PROJ, int g, int cb, char* U, int tid) {
    for (int k = 0; k < 4; ++k) {
        const int idx = tid + 512 * k, c = idx >> 6, s = idx & 63;
        const uint4* src = (const uint4*)(PROJ + (size_t)((cb * 32 + c) * 64 + s) * PJ + 3072 + g * 16);
        uint4* dst = (uint4*)(U + c * USTR + s * 32);
        dst[0] = src[0]; dst[1] = src[1];
    }
}
DEVI void phase2(const Args& a, char* lds, int tid, int wid, int lane) {
    const u16* PROJ = (const u16*)(a.ws + WS_PROJ);
#pragma unroll 1
    for (int u = blockIdx.x; u < 768; u += gridDim.x) {
        { int lq = lane; asm volatile("" : "+v"(lq)); lane = lq; tid = wid * 64 + lq; }
        const int fr = lane & 15, fq = lane >> 4;
        __syncthreads();
        if (u < 256) {
            const int g = u >> 2, cb = u & 3;
            s5_fill_U(PROJ, g, cb, lds, tid);
            __syncthreads();
            const u16* WE = (const u16*)(a.ws + WS_S5WE) + (size_t)(g * 128 + wid * 16 + fr) * 1024 + fq * 8;
            f32x4 acc0 = {0.f, 0.f, 0.f, 0.f}, acc1 = {0.f, 0.f, 0.f, 0.f};
#pragma unroll 8
            for (int ks = 0; ks < 32; ++ks) {
                const bf16x8 bf = *(const bf16x8*)(WE + ks * 32);
                const bf16x8 a0 = *(const bf16x8*)(lds + fr * USTR + (ks * 32 + fq * 8) * 2);
                const bf16x8 a1 = *(const bf16x8*)(lds + (16 + fr) * USTR + (ks * 32 + fq * 8) * 2);
                acc0 = __builtin_amdgcn_mfma_f32_16x16x32_bf16(a0, bf, acc0, 0, 0, 0);
                acc1 = __builtin_amdgcn_mfma_f32_16x16x32_bf16(a1, bf, acc1, 0, 0, 0);
            }
            float* E = (float*)(a.ws + WS_S5E);
#pragma unroll
            for (int j = 0; j < 4; ++j) {
                E[(size_t)(g * 128 + cb * 32 + fq * 4 + j) * 128 + wid * 16 + fr] = acc0[j];
                E[(size_t)(g * 128 + cb * 32 + 16 + fq * 4 + j) * 128 + wid * 16 + fr] = acc1[j];
            }
        } else {
            const int uu = u - 256, n = uu >> 2, h = uu & 3, t0 = n * 64;
            char* vT = lds;
            char* kT = lds + 32768;
            float* glr = (float*)(lds + 49152);
            float* tot = glr + 1024;
            float b[16], blast;
            gla_gate(a, n, h, tid, glr, tot, b, blast);
            const int ch = tid & 127, tq = tid >> 7;
            {
                unsigned pk[8];
#pragma unroll
                for (int tt = 0; tt < 16; tt += 2) {
                    const float k0 = bf2f(PROJ[(size_t)(t0 + tq * 16 + tt) * PJ + 512 + h * 128 + ch]);
                    const float k1 = bf2f(PROJ[(size_t)(t0 + tq * 16 + tt + 1) * PJ + 512 + h * 128 + ch]);
                    pk[tt >> 1] = pack2(k0 * __expf(blast - b[tt]), k1 * __expf(blast - b[tt + 1]));
                }
                *(uint4*)(kT + lds_byte<2>(ch, tq * 16)) = make_uint4(pk[0], pk[1], pk[2], pk[3]);
                *(uint4*)(kT + lds_byte<2>(ch, tq * 16 + 8)) = make_uint4(pk[4], pk[5], pk[6], pk[7]);
                if (tq == 3) ((float*)(a.ws + WS_DEC))[(size_t)(n * 4 + h) * 128 + ch] = __expf(blast);
            }
            gla_stage_vT(PROJ, t0, 1024 + h * 256, vT, tid);
            __syncthreads();
            const int wr = wid >> 1, wc = wid & 1;
            f32x4 acc[4][4];
#pragma unroll
            for (int m = 0; m < 4; ++m)
#pragma unroll
                for (int nn = 0; nn < 4; ++nn) acc[m][nn] = f32x4{0.f, 0.f, 0.f, 0.f};
#pragma unroll
            for (int ks = 0; ks < 2; ++ks) {
                bf16x8 Af[4], Bf[4];
#pragma unroll
                for (int m = 0; m < 4; ++m) Af[m] = *(const bf16x8*)(vT + lds_byte<2>(wr * 64 + m * 16 + fr, ks * 32 + fq * 8));
#pragma unroll
                for (int nn = 0; nn < 4; ++nn) Bf[nn] = *(const bf16x8*)(kT + lds_byte<2>(wc * 64 + nn * 16 + fr, ks * 32 + fq * 8));
#pragma unroll
                for (int m = 0; m < 4; ++m)
#pragma unroll
                    for (int nn = 0; nn < 4; ++nn) acc[m][nn] = __builtin_amdgcn_mfma_f32_16x16x32_bf16(Af[m], Bf[nn], acc[m][nn], 0, 0, 0);
            }
            float* KV = (float*)(a.ws + WS_KV) + (size_t)(n * 4 + h) * (HV * HK);
#pragma unroll
            for (int m = 0; m < 4; ++m)
#pragma unroll
                for (int nn = 0; nn < 4; ++nn)
#pragma unroll
                    for (int j = 0; j < 4; ++j)
                        KV[(size_t)(wr * 64 + m * 16 + fq * 4 + j) * 128 + wc * 64 + nn * 16 + fr] = acc[m][nn][j];
        }
    }
}

DEVI void phase3(const Args& a, int tid) {
    const float* KV = (const float*)(a.ws + WS_KV); u16* ST = (u16*)(a.ws + WS_ST); const float* DEC = (const float*)(a.ws + WS_DEC);
    for (int e = blockIdx.x * 512 + tid; e < NH * HV * HK; e += gridDim.x * 512) {
        const int h = e >> 15, rem = e & 32767, i = e & 127;
        float S = 0.f;
#pragma unroll 1
        for (int n0 = 0; n0 < NCH; n0 += 16) {
            float kv[16], dc[16];
#pragma unroll
            for (int k = 0; k < 16; ++k) { kv[k] = KV[(size_t)((n0 + k) * 4 + h) * 32768 + rem]; dc[k] = DEC[(size_t)((n0 + k) * 4 + h) * 128 + i]; }
#pragma unroll
            for (int k = 0; k < 16; ++k) { ST[(size_t)((n0 + k) * 4 + h) * 32768 + rem] = f2bf(S); S = dc[k] * S + kv[k]; }
        }
    }
    const float* E = (const float*)(a.ws + WS_S5E); const float* AL = (const float*)(a.ws + WS_S5AL); unsigned* HP = (unsigned*)(a.ws + WS_S5H);
    for (int e = blockIdx.x * 512 + tid; e < NG * SP; e += gridDim.x * 512) {
        const int g = e >> 6, p = e & 63;
        const float ar = AL[e * 2], ai = AL[e * 2 + 1];
        float hr = 0.f, hi = 0.f;
#pragma unroll 1
        for (int c0 = 0; c0 < 128; c0 += 16) {
            float2 ev[16];
#pragma unroll
            for (int k = 0; k < 16; ++k) ev[k] = *(const float2*)(E + (size_t)(g * 128 + c0 + k) * 128 + 2 * p);
#pragma unroll
            for (int k = 0; k < 16; ++k) {
                HP[(size_t)(g * 128 + c0 + k) * 64 + p] = pack2(hr, hi);
                const float nr = ar * hr - ai * hi + ev[k].x, ni = ar * hi + ai * hr + ev[k].y;
                hr = nr; hi = ni;
            }
        }
    }
}

DEVI void phase4(const Args& a, char* lds, int tid, int wid, int lane) {
    const u16* PROJ = (const u16*)(a.ws + WS_PROJ);
    u16* MIX = (u16*)(a.ws + WS_MIX);
#pragma unroll 1
    for (int u = blockIdx.x; u < 768; u += gridDim.x) {
        { int lq = lane; asm volatile("" : "+v"(lq)); lane = lq; tid = wid * 64 + lq; }
        const int fr = lane & 15, fq = lane >> 4;
        __syncthreads();
        if (u < 256) {
            const int g = u >> 2, cb = u & 3;
            char* U = lds; char* KTl = lds + 32 * USTR;
            s5_fill_U(PROJ, g, cb, U, tid);
            {
                const uint4* src = (const uint4*)((const u16*)(a.ws + WS_S5K) + (size_t)g * 16384);
                uint4* dst = (uint4*)KTl;
                for (int k = 0; k < 4; ++k) dst[tid + 512 * k] = src[tid + 512 * k];
            }
            __syncthreads();
            f32x4 acc[8][2];
#pragma unroll
            for (int tt = 0; tt < 8; ++tt) { acc[tt][0] = f32x4{0.f, 0.f, 0.f, 0.f}; acc[tt][1] = f32x4{0.f, 0.f, 0.f, 0.f}; }
            const int sl = fq >> 1, m0 = (fq & 1) * 8;
            const char* kbase = KTl + ((wid - sl) * 256 + fr * 16 + m0) * 2;
#pragma unroll 1
            for (int j = 0; j < 32; ++j) {
                const bf16x8 a0 = *(const bf16x8*)(U + fr * USTR + (j * 32 + fq * 8) * 2);
                const bf16x8 a1 = *(const bf16x8*)(U + (16 + fr) * USTR + (j * 32 + fq * 8) * 2);
                const char* kb = kbase - j * 1024;
#pragma unroll
                for (int tt = 0; tt < 8; ++tt) {
                    const int t = wid + 8 * tt;
                    if (t >= 2 * j) {
                        bf16x8 bf = *(const bf16x8*)(kb + tt * 4096);
                        if (t == 2 * j && sl == 1) bf = bf16x8{0, 0, 0, 0, 0, 0, 0, 0};
                        acc[tt][0] = __builtin_amdgcn_mfma_f32_16x16x32_bf16(a0, bf, acc[tt][0], 0, 0, 0);
                        acc[tt][1] = __builtin_amdgcn_mfma_f32_16x16x32_bf16(a1, bf, acc[tt][1], 0, 0, 0);
                    }
                }
            }
            const u16* HP = (const u16*)(a.ws + WS_S5H); const u16* VV = (const u16*)(a.ws + WS_S5V);
#pragma unroll 1
            for (int kp = 0; kp < 2; ++kp) {
                bf16x8 a0[2], a1[2], bfv[2][8];
#pragma unroll
                for (int k2 = 0; k2 < 2; ++k2) {
                    const int ks = kp * 2 + k2;
                    a0[k2] = *(const bf16x8*)(HP + (size_t)(g * 128 + cb * 32 + fr) * 128 + ks * 32 + fq * 8);
                    a1[k2] = *(const bf16x8*)(HP + (size_t)(g * 128 + cb * 32 + 16 + fr) * 128 + ks * 32 + fq * 8);
#pragma unroll
                    for (int tt = 0; tt < 8; ++tt)
                        bfv[k2][tt] = *(const bf16x8*)(VV + (size_t)(g * 1024 + (wid + 8 * tt) * 16 + fr) * 128 + ks * 32 + fq * 8);
                }
#pragma unroll
                for (int k2 = 0; k2 < 2; ++k2)
#pragma unroll
                    for (int tt = 0; tt < 8; ++tt) {
                        acc[tt][0] = __builtin_amdgcn_mfma_f32_16x16x32_bf16(a0[k2], bfv[k2][tt], acc[tt][0], 0, 0, 0);
                        acc[tt][1] = __builtin_amdgcn_mfma_f32_16x16x32_bf16(a1[k2], bfv[k2][tt], acc[tt][1], 0, 0, 0);
                    }
            }
            const float dsk = a.in[12][g * 16 + fr];
            u16* Z = (u16*)(a.ws + WS_Z);
#pragma unroll
            for (int tt = 0; tt < 8; ++tt) {
                const int t = wid + 8 * tt;
#pragma unroll
                for (int mf = 0; mf < 2; ++mf)
#pragma unroll
                    for (int j = 0; j < 4; ++j) {
                        const int cl = mf * 16 + fq * 4 + j;
                        const float uv = bf2f(*(const u16*)(U + cl * USTR + (t * 16 + fr) * 2));
                        const float y = acc[tt][mf][j] + dsk * uv;
                        Z[(size_t)((cb * 32 + cl) * 64 + t) * SW + g * 16 + fr] = f2bf(gelu_tanh(y));
                    }
            }
        } else {
            const int uu = u - 256, n = uu >> 2, h = uu & 3, t0 = n * 64;
            char* vT = lds;
            char* qI = lds + 32768;
            char* kI = lds + 49152;
            char* pI = lds + 65536;
            float* glr = (float*)(lds + 73728);
            float* tot = glr + 1024;
            float* rss = tot + 512;
            char* sT = lds + 81920;
            {
                const u16* STg = (const u16*)(a.ws + WS_ST) + (size_t)(n * 4 + h) * (HV * HK);
#pragma unroll
                for (int p = 0; p < 8; ++p) {
                    const int row = p * 32 + wid * 4 + (lane >> 4), chunk = ((lane & 15) ^ row) & 15;
                    __builtin_amdgcn_global_load_lds((const unsigned*)(STg + (size_t)row * 128 + chunk * 8), (LAS unsigned*)(sT + p * 8192 + wid * 1024), 16, 0, 0);
                }
            }
            float b[16], blast;
            gla_gate(a, n, h, tid, glr, tot, b, blast);
            const int ch = tid & 127, tq = tid >> 7;
            {
                const int qb0 = (tq * 4 + (ch >> 5)) * 1024 + (ch & 31) * 2, qb1 = qb0 ^ 32;
                const u16* src = PROJ + (size_t)(t0 + tq * 16) * PJ + h * 128 + ch;
#pragma unroll
                for (int tt = 0; tt < 16; ++tt) {
                    const float qv = bf2f(src[(size_t)tt * PJ]);
                    const float kv = bf2f(src[(size_t)tt * PJ + 512]);
                    const int off = (tt < 8 ? qb0 : qb1) + tt * 64;
                    *(u16*)(qI + off) = f2bf(qv * __expf(b[tt]));
                    *(u16*)(kI + off) = f2bf(kv * __expf(-b[tt]));
                }
            }
            gla_stage_vT(PROJ, t0, 1024 + h * 256, vT, tid);
            __syncthreads();
            {
                const int mf = wid & 3, nb = (wid >> 2) * 2;
                f32x4 s0 = {0.f, 0.f, 0.f, 0.f}, s1 = {0.f, 0.f, 0.f, 0.f};
#pragma unroll
                for (int ks = 0; ks < 4; ++ks) {
                    const bf16x8 af = *(const bf16x8*)(qI + lds_byte<4>(mf * 16 + fr, ks * 32 + fq * 8));
                    const bf16x8 b0 = *(const bf16x8*)(kI + lds_byte<4>(nb * 16 + fr, ks * 32 + fq * 8));
                    const bf16x8 b1 = *(const bf16x8*)(kI + lds_byte<4>((nb + 1) * 16 + fr, ks * 32 + fq * 8));
                    s0 = __builtin_amdgcn_mfma_f32_16x16x32_bf16(af, b0, s0, 0, 0, 0);
                    s1 = __builtin_amdgcn_mfma_f32_16x16x32_bf16(af, b1, s1, 0, 0, 0);
                }
#pragma unroll
                for (int j = 0; j < 4; ++j) {
                    const int t = mf * 16 + fq * 4 + j, sA = nb * 16 + fr, sB = sA + 16;
                    *(u16*)(pI + lds_byte<2>(t, sA)) = f2bf(sA <= t ? s0[j] : 0.f);
                    *(u16*)(pI + lds_byte<2>(t, sB)) = f2bf(sB <= t ? s1[j] : 0.f);
                }
            }
            __syncthreads();
            const int mf = wid & 3, nh = wid >> 2;
            f32x4 acc[8];
#pragma unroll
            for (int nn = 0; nn < 8; ++nn) acc[nn] = f32x4{0.f, 0.f, 0.f, 0.f};
#pragma unroll
            for (int ks = 0; ks < 2; ++ks) {
                const bf16x8 af = *(const bf16x8*)(pI + lds_byte<2>(mf * 16 + fr, ks * 32 + fq * 8));
#pragma unroll
                for (int nn = 0; nn < 8; ++nn) {
                    const bf16x8 bf = *(const bf16x8*)(vT + lds_byte<2>(nh * 128 + nn * 16 + fr, ks * 32 + fq * 8));
                    acc[nn] = __builtin_amdgcn_mfma_f32_16x16x32_bf16(af, bf, acc[nn], 0, 0, 0);
                }
            }
#pragma unroll
            for (int ks = 0; ks < 4; ++ks) {
                const bf16x8 af = *(const bf16x8*)(qI + lds_byte<4>(mf * 16 + fr, ks * 32 + fq * 8));
#pragma unroll
                for (int nn = 0; nn < 8; ++nn) {
                    const bf16x8 bf = *(const bf16x8*)(sT + (nh * 128 + nn * 16 + fr) * 256 + ((((ks * 4 + fq) ^ fr) & 15) << 4));
                    acc[nn] = __builtin_amdgcn_mfma_f32_16x16x32_bf16(af, bf, acc[nn], 0, 0, 0);
                }
            }
            u16 rraw[4][8];
#pragma unroll
            for (int j = 0; j < 4; ++j)
#pragma unroll
                for (int nn = 0; nn < 8; ++nn) rraw[j][nn] = PROJ[(size_t)(t0 + mf * 16 + fq * 4 + j) * PJ + 2048 + h * 256 + nh * 128 + nn * 16 + fr];
            float ss[4];
#pragma unroll
            for (int j = 0; j < 4; ++j) {
                float s = 0.f;
#pragma unroll
                for (int nn = 0; nn < 8; ++nn) s += acc[nn][j] * acc[nn][j];
                ss[j] = sum16(s);
            }
            if (fr == 0) {
#pragma unroll
                for (int j = 0; j < 4; ++j) rss[nh * 64 + mf * 16 + fq * 4 + j] = ss[j];
            }
            __syncthreads();
            const float* gn = a.in[5];
#pragma unroll
            for (int j = 0; j < 4; ++j) {
                const int t = mf * 16 + fq * 4 + j;
                const float rstd = rsqrtf((rss[t] + rss[64 + t]) * (1.0f / 256.0f) + EPS);
#pragma unroll
                for (int nn = 0; nn < 8; ++nn) {
                    const int jc = nh * 128 + nn * 16 + fr;
                    const float rv = bf2f(rraw[j][nn]);
                    const float o = acc[nn][j] * rstd * gn[jc] * (rv * sigmoidf_(rv));
                    MIX[(size_t)(t0 + t) * D + h * 256 + jc] = f2bf(o);
                }
            }
        }
    }
}

DEVI void phase5(const Args& a, char* lds, int tid, int wid, int lane) {
    extern __shared__ __attribute__((aligned(16))) char smem_pg8[];
    if (blockIdx.x >= 128) {
        const int c_lo = 8192 + (blockIdx.x - 128) * 22;
        convert_range(a, lds, c_lo, c_lo + 22, tid, wid, lane);
    } else {
        pg8::Gemm g; g.A = a.ws + WS_Z; g.Bt = a.ws + WS_GLUT; g.ld = SW; g.K = SW;
        pg8::StaticOrder S; S.init(T, SW, 128, (int)blockIdx.x);
        EpiGlu E; E.Z = (const u16*)(a.ws + WS_Z); E.MIX = (u16*)(a.ws + WS_MIX); E.SSQ = (float*)(a.ws + WS_SSQ); E.gbias = a.in[15]; E.sng = a.in[16];
        pg8::gemm_phase((PG8_LAS unsigned char*)(smem_pg8 + 1024), g, S, E);
        const int c_lo = 11008 + blockIdx.x * 6; convert_range(a, lds, c_lo, c_lo + 6, tid, wid, lane);
    }
    convert_pool(a, lds, 1, 11776, 13312, tid, wid, lane);
}

DEVI void phase6(const Args& a, char* lds, int tid, int wid, int lane) {
    extern __shared__ __attribute__((aligned(16))) char smem_pg8[];
    const int c6_lo = 13312 + blockIdx.x * 11, c6_hi = c6_lo + 11;
    if ((blockIdx.x >> 3) & 1) convert_range(a, lds, c6_lo, c6_hi, tid, wid, lane);
    if (blockIdx.x < 256) {
        pg8::Gemm g; g.A = a.ws + WS_MIX; g.Bt = a.ws + WS_WOUTT; g.ld = D; g.K = 1024;
        pg8::SplitKOrder S; S.init(T, D, 256, (int)blockIdx.x); S.khalf = 2048;
        EpiOut E; E.x = a.in[0]; E.H1 = (u16*)(a.ws + WS_H1); E.SSQ = (const float*)(a.ws + WS_SSQ);
        pg8::gemm_phase((PG8_LAS unsigned char*)(smem_pg8 + 1024), g, S, E);
    }
    if (!((blockIdx.x >> 3) & 1)) convert_range(a, lds, c6_lo, c6_hi, tid, wid, lane);
    convert_pool(a, lds, 2, 16128, 16384, tid, wid, lane);
}

DEVI void phase7(const Args& a, char* lds, int tid, int wid, int lane) {
    const u16* H1 = (const u16*)(a.ws + WS_H1);
    const float* g2 = a.in[18]; const float* rw = a.in[19]; const float* rb = a.in[20];
    int* CNT = (int*)(a.ws + WS_CNT); int* LTOK = (int*)(a.ws + WS_LTOK); float* LGATE = (float*)(a.ws + WS_LGATE); int* TSLOT = (int*)(a.ws + WS_TSLOT);
    float* hn = (float*)lds;
    float* red = hn + 8 * 2048;
    float* lg = red + 8 * 8 * 32;
    for (int u = blockIdx.x; u < 256; u += gridDim.x) {
#pragma unroll 1
        for (int ps = 0; ps < 4; ++ps) {
            const int tok0 = u * 32 + ps * 8;
            { int lq = lane; asm volatile("" : "+v"(lq)); lane = lq; tid = wid * 64 + lq; }
            __syncthreads();
            {
                const int tl = wid, tok = tok0 + tl;
                f32x4 xv[8]; float ss = 0.f;
#pragma unroll
                for (int i = 0; i < 8; ++i) { const uint2 hv2 = *(const uint2*)(H1 + (size_t)tok * D + 256 * i + 4 * lane); xv[i] = f32x4{bflo(hv2.x), bfhi(hv2.x), bflo(hv2.y), bfhi(hv2.y)};
#pragma unroll
                    for (int c = 0; c < 4; ++c) ss += xv[i][c] * xv[i][c]; }
                ss = wave_sum(ss);
                const float r = rsqrtf(ss * (1.0f / D) + EPS);
#pragma unroll
                for (int i = 0; i < 8; ++i) {
                    const f32x4 g = *(const f32x4*)(g2 + 256 * i + 4 * lane);
                    f32x4 o;
#pragma unroll
                    for (int c = 0; c < 4; ++c) o[c] = xv[i][c] * r * g[c];
                    *(f32x4*)(hn + tl * 2048 + 256 * i + 4 * lane) = o;
                }
            }
            __syncthreads();
            {
                const int e = tid & 31, dsl = tid >> 5;
                float acc[8];
#pragma unroll
                for (int k = 0; k < 8; ++k) acc[k] = 0.f;
#pragma unroll 1
                for (int d16 = 0; d16 < 8; ++d16) {
                    float w[16];
#pragma unroll
                    for (int q = 0; q < 16; ++q) w[q] = rw[(dsl * 128 + d16 * 16 + q) * 32 + e];
#pragma unroll
                    for (int q4 = 0; q4 < 4; ++q4) {
                        const int d = dsl * 128 + d16 * 16 + q4 * 4;
#pragma unroll
                        for (int k = 0; k < 8; ++k) {
                            const f32x4 hv = *(const f32x4*)(hn + k * 2048 + d);
                            acc[k] += hv[0] * w[q4 * 4] + hv[1] * w[q4 * 4 + 1] + hv[2] * w[q4 * 4 + 2] + hv[3] * w[q4 * 4 + 3];
                        }
                    }
                }
#pragma unroll
                for (int k = 0; k < 8; ++k) { acc[k] += __shfl_xor(acc[k], 32); }
                if (lane < 32) {
#pragma unroll
                    for (int k = 0; k < 8; ++k) red[(wid * 8 + k) * 32 + e] = acc[k];
                }
            }
            __syncthreads();
            if (tid < 256) {
                const int k = tid >> 5, e = tid & 31;
                float s = rb[e];
#pragma unroll
                for (int w = 0; w < 8; ++w) s += red[(w * 8 + k) * 32 + e];
                lg[k * 32 + e] = s;
            }
            __syncthreads();
            {
                const int tok = tok0 + wid, e = lane & 31;
                float x = lg[wid * 32 + e];
                float v[4]; int id[4];
#pragma unroll
                for (int j = 0; j < 4; ++j) {
                    float bv = x; int bi = e;
#pragma unroll
                    for (int o = 16; o >= 1; o >>= 1) {
                        const float ov = __shfl_xor(bv, o); const int oi = __shfl_xor(bi, o);
                        if (ov > bv || (ov == bv && oi < bi)) { bv = ov; bi = oi; }
                    }
                    v[j] = bv; id[j] = bi;
                    if (e == bi) x = -3.0e38f;
                }
                float ex[4], sum = 0.f;
#pragma unroll
                for (int j = 0; j < 4; ++j) { ex[j] = __expf(v[j] - v[0]); sum += ex[j]; }
                const float inv = 1.0f / sum;
                int ri = 0;
                if (lane < 4) {
                    const int myid = lane == 0 ? id[0] : lane == 1 ? id[1] : lane == 2 ? id[2] : id[3];
                    const float myg = (lane == 0 ? ex[0] : lane == 1 ? ex[1] : lane == 2 ? ex[2] : ex[3]) * inv;
                    const int slot = atomicAdd(&CNT[myid], 1);
                    ri = myid * CAP + slot;
                    LTOK[ri] = tok;
                    LGATE[ri] = myg;
                    TSLOT[tok * 4 + lane] = ri;
                }
                {
                    unsigned char* XG = a.ws + WS_XG;
                    const int r0 = __builtin_amdgcn_readlane(ri, 0), r1 = __builtin_amdgcn_readlane(ri, 1), r2 = __builtin_amdgcn_readlane(ri, 2), r3 = __builtin_amdgcn_readlane(ri, 3);
#pragma unroll
                    for (int i = 0; i < 8; ++i) {
                        const f32x4 o = *(const f32x4*)(hn + wid * 2048 + 256 * i + 4 * lane);
                        const unsigned pk = cvt4_fp8(o[0] * 16.f, o[1] * 16.f, o[2] * 16.f, o[3] * 16.f);
                        const size_t co = 256 * i + 4 * lane;
                        *(unsigned*)(XG + (size_t)r0 * D + co) = pk; *(unsigned*)(XG + (size_t)r1 * D + co) = pk;
                        *(unsigned*)(XG + (size_t)r2 * D + co) = pk; *(unsigned*)(XG + (size_t)r3 * D + co) = pk;
                    }
                }
            }
        }
    }
}

struct MoeTab { int cnt[32]; int off[33]; int ord[32]; int xe[4]; int xub[5]; };
DEVI void moe_tables(const Args& a, MoeTab* tb, int tid, int ntn) {
    __syncthreads();
    if (tid < 32) tb->cnt[tid] = ((const int*)(a.ws + WS_CNT))[tid];
    __syncthreads();
    if (tid < 32) {
        const int me = (tb->cnt[tid] + 255) >> 8;
        int rank = 0, o = 0;
        for (int k = 0; k < 32; ++k) {
            const int c = tb->cnt[k], mk = (c + 255) >> 8;
            rank += (mk > me || (mk == me && k < tid)) ? 1 : 0;
            o += (k < tid) ? c : 0;
        }
        tb->ord[rank] = tid; tb->off[tid] = o;
        if (tid == 31) tb->off[32] = o + tb->cnt[31];
    }
    __syncthreads();
    if (tid == 0) {
        const int xcd = blockIdx.x & 7;
        int ub = 0;
        for (int r = 0; r < 4; ++r) {
            const int e = tb->ord[r * 8 + ((r & 1) ? 7 - xcd : xcd)];
            tb->xe[r] = e; tb->xub[r] = ub;
            ub += ((tb->cnt[e] + 255) >> 8) * ntn;
        }
        tb->xub[4] = ub;
    }
    __syncthreads();
}

struct MoeUnit { int e, nt, r0, rows, grow0, cnt; };
DEVI MoeUnit moe_decode(const MoeTab* tb, int u) {
    int k = 0;
    for (int q = 1; q < 4; ++q) if (u >= tb->xub[q]) k = q;
    MoeUnit d; d.e = tb->xe[k];
    d.cnt = tb->cnt[d.e];
    const int mte = (d.cnt + 255) >> 8, ul = u - tb->xub[k];
    d.nt = ul / mte; const int mi = ul - d.nt * mte;
    d.r0 = mi * 256; d.rows = min(256, d.cnt - d.r0); d.grow0 = tb->off[d.e] + d.r0;
    return d;
}

struct MoeUnit;
namespace pg8 {
struct MU { const char* A; const char* B0; const char* B1; int e, nt, r0, rows, grow0, cnt; };
template <int SCALE_A, int SCALE_B, class Epi, class Sched>
DEVI void f8_gemm_phase(PG8_LAS unsigned char* lds, const Sched& S, const Epi& E) {
    const int tid = threadIdx.x, wid = __builtin_amdgcn_readfirstlane(tid >> 6), lane = tid & 63, wr = wid >> 2, wc = wid & 3, fr = lane & 15, fq = lane >> 4;
    constexpr int nt = 16;
    unsigned voffA[2], voffB[2];
#pragma unroll
    for (int i = 0; i < 2; ++i) { int R, C; stage_rc(tid * 16 + i * 8192, R, C); voffA[i] = (unsigned)(R * 1024 + C) * 2u;
        const int L = wid * 1024 + i * 8192 + lane * 16, q = L >> 9, p0 = (lane & 31) * 4, pu = (p0 - 16 * ((q >> 2) & 3)) & 127;
        voffB[i] = (unsigned)(q * 512 + ((pu & ~31) + perm32(pu & 31)) * 4); }
    const size_t kstep = 128, bstep = 16384, hstep = (size_t)HALF * 2048;
    const unsigned ldsw = (unsigned)wid * 1024u;
    const int aoff = lds_byte(wr * 64 + fr, fq * 8);
    int boffn[2];
#pragma unroll
    for (int n = 0; n < 2; ++n) boffn[n] = (4 * fq) * 512 + ((wc * 32 + 16 * n + fr + 16 * fq) & 127) * 4;
#define PG8_SA(b, h) (((b) * 2 + (h)) * HTB)
#define PG8_SB(b, h) ((4 + (b) * 2 + (h)) * HTB)
#define PG8_STAGE(bufoff, gbase, voff) do { _Pragma("unroll") for (int _i = 0; _i < 2; ++_i) \
        __builtin_amdgcn_global_load_lds((const unsigned*)((const char*)(gbase) + (voff)[_i]), (PG8_LAS unsigned*)(lds + (bufoff) + ldsw + _i * 8192), 16, 0, 0); } while (0)
#define PG8_LDA(dst, b, h) do { _Pragma("unroll") for (int m = 0; m < 4; ++m) { const i32x4 _x = *(const PG8_LAS i32x4*)(lds + PG8_SA(b, h) + aoff + m * 2048), _y = *(const PG8_LAS i32x4*)(lds + PG8_SA(b, h) + aoff + m * 2048 + 1024); \
        dst[m][0] = _x[0]; dst[m][1] = _x[1]; dst[m][2] = _x[2]; dst[m][3] = _x[3]; dst[m][4] = _y[0]; dst[m][5] = _y[1]; dst[m][6] = _y[2]; dst[m][7] = _y[3]; } } while (0)
#define PG8_LDB(dst, b, h) do { _Pragma("unroll") for (int n = 0; n < 2; ++n) _Pragma("unroll") for (int d = 0; d < 8; ++d) dst[n][d] = *(const PG8_LAS int*)(lds + PG8_SB(b, h) + boffn[n] + (d & 3) * 512 + (d >> 2) * 8192); } while (0)
#define PG8_MMA(ai, bj, At, Bt) do { __builtin_amdgcn_s_setprio(1); _Pragma("unroll") for (int m = 0; m < 4; ++m) _Pragma("unroll") for (int n = 0; n < 2; ++n) \
        acc[ai][bj][m][n] = __builtin_amdgcn_mfma_scale_f32_16x16x128_f8f6f4(Bt[n], At[m], acc[ai][bj][m][n], 0, 0, 0, SCALE_B, 0, SCALE_A); __builtin_amdgcn_s_setprio(0); } while (0)
#define PG8_WAIT_V(n) asm volatile("s_waitcnt vmcnt(" #n ")" ::: "memory")
#define PG8_WAIT_L(n) asm volatile("s_waitcnt lgkmcnt(" #n ")" ::: "memory")
#define PG8_BAR __builtin_amdgcn_s_barrier()
#define PG8_SCHED __builtin_amdgcn_sched_barrier(0)
#define PG8_ZERO() do { _Pragma("unroll") for (int a_ = 0; a_ < 2; ++a_) _Pragma("unroll") for (int b_ = 0; b_ < 2; ++b_) _Pragma("unroll") for (int m_ = 0; m_ < 4; ++m_) _Pragma("unroll") for (int n_ = 0; n_ < 2; ++n_) \
        acc[a_][b_][m_][n_] = (f32x4){0.f, 0.f, 0.f, 0.f}; } while (0)
    MU cur, nxt; int ui = 0;
    if (!S.next(0, cur)) return;
    f32x4 acc[2][2][4][2];
    i32x8 At[4], B0[2], B1[2];
    PG8_LAS unsigned char* side = lds + 8 * HTB;
    int sc = 0; E.prefetch(cur, side, wid, lane);
    const char* cA = cur.A; const char* cB0 = cur.B0; const char* cB1 = cur.B1;
    PG8_STAGE(PG8_SB(0, 0), cB0, voffB); PG8_STAGE(PG8_SA(0, 0), cA, voffA); PG8_STAGE(PG8_SB(0, 1), cB1, voffB); PG8_STAGE(PG8_SA(0, 1), cA + hstep, voffA);
    if (wr == 1) PG8_BAR;
    PG8_WAIT_V(4); PG8_BAR;
    E.init(acc, side, wc, fq); PG8_WAIT_L(0);
    PG8_STAGE(PG8_SB(1, 0), cB0 + bstep, voffB); PG8_STAGE(PG8_SA(1, 0), cA + kstep, voffA); PG8_STAGE(PG8_SB(1, 1), cB1 + bstep, voffB);
    PG8_WAIT_V(6); PG8_BAR;
    for (;;) {
        const bool has_next = S.next(ui + 1, nxt);
        const int sn = sc == 2 ? 0 : sc + 1;
        if (has_next) { int lz = lane; asm volatile("" : "+v"(lz)); E.prefetch(nxt, side + sn * 2048, wid, lz); }
        const char* nA = has_next ? nxt.A : cA; const char* nB0 = has_next ? nxt.B0 : cB0; const char* nB1 = has_next ? nxt.B1 : cB1;
#pragma unroll 1
        for (int t = 0; t < nt; t += 2) {
            const bool last = (t == nt - 2);
            const char* a1 = cA + (size_t)(t + 1) * kstep;
            const char* a2 = last ? nA : cA + (size_t)(t + 2) * kstep;
            const char* b20 = last ? nB0 : cB0 + (size_t)(t + 2) * bstep; const char* b21 = last ? nB1 : cB1 + (size_t)(t + 2) * bstep;
            const char* a3 = a2 + kstep; const char* b30 = b20 + bstep; const char* b31 = b21 + bstep;
            PG8_LDB(B0, 0, 0); PG8_SCHED; PG8_LDA(At, 0, 0); PG8_STAGE(PG8_SA(1, 1), a1 + hstep, voffA);
            PG8_WAIT_L(8); PG8_BAR; PG8_WAIT_L(0); PG8_MMA(0, 0, At, B0); PG8_BAR; PG8_SCHED;
            PG8_LDB(B1, 0, 1); PG8_STAGE(PG8_SB(0, 0), b20, voffB);
            PG8_BAR; PG8_WAIT_L(0); PG8_MMA(0, 1, At, B1); PG8_BAR;
            PG8_LDA(At, 0, 1); PG8_STAGE(PG8_SA(0, 0), a2, voffA);
            PG8_BAR; PG8_WAIT_L(0); PG8_MMA(1, 0, At, B0); PG8_BAR; PG8_SCHED;
            PG8_STAGE(PG8_SB(0, 1), b21, voffB);
            PG8_WAIT_V(6); PG8_BAR; PG8_MMA(1, 1, At, B1); PG8_BAR;
            PG8_LDB(B0, 1, 0); PG8_SCHED; PG8_LDA(At, 1, 0); PG8_STAGE(PG8_SA(0, 1), a2 + hstep, voffA);
            PG8_WAIT_L(8); PG8_BAR; PG8_WAIT_L(0); PG8_MMA(0, 0, At, B0); PG8_BAR; PG8_SCHED;
            PG8_LDB(B1, 1, 1); PG8_STAGE(PG8_SB(1, 0), b30, voffB);
            PG8_BAR; PG8_WAIT_L(0); PG8_MMA(0, 1, At, B1); PG8_BAR;
            PG8_LDA(At, 1, 1); PG8_STAGE(PG8_SA(1, 0), a3, voffA);
            PG8_BAR; PG8_WAIT_L(0); PG8_MMA(1, 0, At, B0); PG8_BAR; PG8_SCHED;
            PG8_STAGE(PG8_SB(1, 1), b31, voffB);
            PG8_WAIT_V(6); PG8_BAR; PG8_MMA(1, 1, At, B1); PG8_BAR;
        }
        int lz = lane; asm volatile("" : "+v"(lz));
        E(acc, cur, side + sc * 2048, wr, wc, lz & 15, lz >> 4);
        if (!has_next) break;
        E.init(acc, side + sn * 2048, wc, lz >> 4); PG8_WAIT_L(0);
        sc = sn; cur = nxt; cA = nA; cB0 = nB0; cB1 = nB1; ++ui;
    }
    PG8_WAIT_V(0);
    if (wr == 0) PG8_BAR;
    PG8_BAR;
#undef PG8_SA
#undef PG8_SB
#undef PG8_STAGE
#undef PG8_LDA
#undef PG8_LDB
#undef PG8_MMA
#undef PG8_WAIT_V
#undef PG8_WAIT_L
#undef PG8_BAR
#undef PG8_SCHED
#undef PG8_ZERO
}
}

struct MoeSched {
    const MoeTab* tb; int nun, nper, u0; const char* Ab; const char* Wb; bool first;
    DEVI bool next(int i, pg8::MU& m) const {
        const int u = u0 + i * nper; if (u >= nun) return false;
        const MoeUnit d = moe_decode(tb, u);
        m.e = __builtin_amdgcn_readfirstlane(d.e); m.nt = __builtin_amdgcn_readfirstlane(d.nt); m.r0 = __builtin_amdgcn_readfirstlane(d.r0);
        m.rows = __builtin_amdgcn_readfirstlane(d.rows); m.grow0 = __builtin_amdgcn_readfirstlane(d.grow0); m.cnt = __builtin_amdgcn_readfirstlane(d.cnt);
        if (first) { m.A = Ab + ((size_t)m.e * CAP + m.r0) * D;
            m.B0 = Wb + (size_t)((m.e * 32 + m.nt) * 512) * 512; m.B1 = m.B0 + (size_t)(16 * 512) * 512; }
        else { m.A = Ab + (size_t)m.grow0 * FF;
            m.B0 = Wb + (size_t)((m.e * 16 + m.nt * 2) * 512) * 512; m.B1 = m.B0 + (size_t)512 * 512; }
        return true;
    }
};
typedef float f32x2 __attribute__((ext_vector_type(2)));
struct EpiMoe1 {
    unsigned char* ACT; const float* b1;
    DEVI void prefetch(const pg8::MU& u, PG8_LAS unsigned char* side, int wid, int lane) const {
        if (wid == 0) __builtin_amdgcn_global_load_lds((const unsigned*)(b1 + (size_t)u.e * 4096 + u.nt * 128 + (lane >> 5) * 2048 + 4 * (lane & 31)), (PG8_LAS unsigned*)side, 16, 0, 0);
    }
    DEVI void init(f32x4 (&acc)[2][2][4][2], PG8_LAS unsigned char* side, int wc, int fq) const {
#pragma unroll
        for (int bj = 0; bj < 2; ++bj)
#pragma unroll
            for (int n = 0; n < 2; ++n) { const f32x4 b = *(const PG8_LAS f32x4*)(side + bj * 512 + (wc * 32 + 8 * fq + 4 * n) * 4);
#pragma unroll
                for (int ai = 0; ai < 2; ++ai)
#pragma unroll
                    for (int m = 0; m < 4; ++m) acc[ai][bj][m][n] = b; }
    }
    DEVI void operator()(f32x4 (&acc)[2][2][4][2], const pg8::MU& u, PG8_LAS unsigned char* side, int wr, int wc, int fr, int fq) const {
#pragma unroll
        for (int ai = 0; ai < 2; ++ai)
#pragma unroll
            for (int m = 0; m < 4; ++m) {
                const int row = ai * 128 + wr * 64 + m * 16 + fr;
                const int orow = (row < u.rows) ? u.grow0 + row : T * 4 + row;
                unsigned w[2];
#pragma unroll
                for (int n = 0; n < 2; ++n) {
                    const f32x4 g4 = acc[ai][0][m][n], l4 = acc[ai][1][m][n];
                    f32x2 av[2];
#pragma unroll
                    for (int h = 0; h < 2; ++h) {
                        f32x2 gl, ln;
                        gl.x = __builtin_amdgcn_fmed3f(g4[2 * h], -3.0e38f, 7.0f); gl.y = __builtin_amdgcn_fmed3f(g4[2 * h + 1], -3.0e38f, 7.0f);
                        ln.x = __builtin_amdgcn_fmed3f(l4[2 * h], -7.0f, 7.0f); ln.y = __builtin_amdgcn_fmed3f(l4[2 * h + 1], -7.0f, 7.0f);
                        const f32x2 ea = gl * (-1.702f * 1.4426950408889634f);
                        f32x2 e; e.x = __builtin_amdgcn_exp2f(ea.x); e.y = __builtin_amdgcn_exp2f(ea.y);
                        const f32x2 d = e + 1.0f;
                        f32x2 r; r.x = __builtin_amdgcn_rcpf(d.x); r.y = __builtin_amdgcn_rcpf(d.y);
                        av[h] = (gl * r) * (ln * 4.0f + 4.0f);
                    }
                    w[n] = cvt4_fp8(av[0].x, av[0].y, av[1].x, av[1].y);
                }
                uint2 pk; pk.x = w[0]; pk.y = w[1];
                *(uint2*)(ACT + (size_t)orow * FF + u.nt * 128 + wc * 32 + 8 * fq) = pk;
            }
    }
};
struct EpiMoe2 {
    u16* Y; const float* b2; const float* LGATE;
    DEVI void prefetch(const pg8::MU& u, PG8_LAS unsigned char* side, int wid, int lane) const {
        if (wid == 0) __builtin_amdgcn_global_load_lds((const unsigned*)(b2 + (size_t)u.e * D + u.nt * 256 + 4 * lane), (PG8_LAS unsigned*)side, 16, 0, 0);
        if (wid == 1) __builtin_amdgcn_global_load_lds((const unsigned*)(LGATE + (size_t)u.e * CAP + u.r0 + 4 * lane), (PG8_LAS unsigned*)(side + 1024), 16, 0, 0);
    }
    DEVI void init(f32x4 (&acc)[2][2][4][2], PG8_LAS unsigned char* side, int wc, int fq) const {
#pragma unroll
        for (int bj = 0; bj < 2; ++bj)
#pragma unroll
            for (int n = 0; n < 2; ++n) { const f32x4 b = *(const PG8_LAS f32x4*)(side + (bj * 128 + wc * 32 + 8 * fq + 4 * n) * 4);
#pragma unroll
                for (int ai = 0; ai < 2; ++ai)
#pragma unroll
                    for (int m = 0; m < 4; ++m) acc[ai][bj][m][n] = b; }
    }
    DEVI void operator()(f32x4 (&acc)[2][2][4][2], const pg8::MU& u, PG8_LAS unsigned char* side, int wr, int wc, int fr, int fq) const {
#pragma unroll
        for (int ai = 0; ai < 2; ++ai)
#pragma unroll
            for (int m = 0; m < 4; ++m) {
                const int row = ai * 128 + wr * 64 + m * 16 + fr;
                const float gt = *(const PG8_LAS float*)(side + 1024 + row * 4);
                const int orow = (row < u.rows) ? u.grow0 + row : T * 4 + row;
                u16* dst = Y + (size_t)orow * D + u.nt * 256 + wc * 32 + 8 * fq;
#pragma unroll
                for (int bj = 0; bj < 2; ++bj) {
                    const f32x4 v0 = acc[ai][bj][m][0] * gt, v1 = acc[ai][bj][m][1] * gt;
                    uint4 pk; pk.x = pack2(v0[0], v0[1]); pk.y = pack2(v0[2], v0[3]); pk.z = pack2(v1[0], v1[1]); pk.w = pack2(v1[2], v1[3]);
                    *(uint4*)(dst + bj * 128) = pk;
                }
            }
    }
};
DEVI void phase8(const Args& a, char* lds, MoeTab* tb, int tid, int wid, int lane) {
    extern __shared__ __attribute__((aligned(16))) char smem_pg8[];
    moe_tables(a, tb, tid, 16);
    const int nun = tb->xub[4], nper = gridDim.x >> 3;
    const int u = blockIdx.x >> 3;
    const int c_lo = 16384 + blockIdx.x * 28, c_hi = c_lo + 28;
    const int nb = u < nun ? (nun - u + nper - 1) / nper : 0;
    const int kc = (u * (nb + 1)) / nper;
#pragma unroll 1
    for (int part = 0; part < 2; ++part) {
        const int ulo = part == 0 ? u : u + kc * nper, uhi = part == 0 ? min(nun, u + kc * nper) : nun;
        if (ulo < uhi) {
            MoeSched S; S.tb = tb; S.nun = uhi; S.nper = nper; S.u0 = ulo; S.Ab = (const char*)(a.ws + WS_XG); S.Wb = (const char*)(a.ws + WS_W1T); S.first = true;
            EpiMoe1 E; E.ACT = a.ws + WS_ACT; E.b1 = a.in[22];
            pg8::f8_gemm_phase<0x7b7b7b7b, 0x77777777>((PG8_LAS unsigned char*)(smem_pg8 + 1024), S, E);
        }
        if (part == 0) convert_range(a, lds, c_lo, c_hi, tid, wid, lane);
    }
    convert_pool(a, lds, 3, 23552, 24576, tid, wid, lane);
}

DEVI void phase9(const Args& a, char* lds, MoeTab* tb, int tid, int wid, int lane) {
    extern __shared__ __attribute__((aligned(16))) char smem_pg8[];
    moe_tables(a, tb, tid, 8);
    const int nun = tb->xub[4], nper = gridDim.x >> 3;
    const int u = blockIdx.x >> 3;
    if (u >= nun) return;
    MoeSched S; S.tb = tb; S.nun = nun; S.nper = nper; S.u0 = u; S.Ab = (const char*)(a.ws + WS_ACT); S.Wb = (const char*)(a.ws + WS_W2T); S.first = false;
    EpiMoe2 E; E.Y = (u16*)(a.ws + WS_Y); E.b2 = a.in[24]; E.LGATE = (const float*)(a.ws + WS_LGATE);
    pg8::f8_gemm_phase<0x7d7d7d7d, 0x77777777>((PG8_LAS unsigned char*)(smem_pg8 + 1024), S, E);
}

DEVI void phase10(const Args& a, MoeTab* tb, int tid, int wid, int lane) {
    const u16* H1 = (const u16*)(a.ws + WS_H1); const u16* Y = (const u16*)(a.ws + WS_Y); const int* TSLOT = (const int*)(a.ws + WS_TSLOT);
    const float* fg = a.in[25];
    moe_tables(a, tb, tid, 8);
    for (int tok = blockIdx.x * 8 + wid; tok < T; tok += gridDim.x * 8) {
        int rowi[4];
#pragma unroll
        for (int j = 0; j < 4; ++j) { const int ts = TSLOT[tok * 4 + j]; rowi[j] = tb->off[ts >> 13] + (ts & (CAP - 1)); }
        f32x4 hv[8]; float ss = 0.f;
#pragma unroll
        for (int i = 0; i < 8; ++i) {
            { const uint2 h2 = *(const uint2*)(H1 + (size_t)tok * D + 256 * i + 4 * lane); hv[i] = f32x4{bflo(h2.x), bfhi(h2.x), bflo(h2.y), bfhi(h2.y)}; }
#pragma unroll
            for (int j = 0; j < 4; ++j) {
                const uint2 yv = *(const uint2*)(Y + (size_t)rowi[j] * D + 256 * i + 4 * lane);
                hv[i][0] += bflo(yv.x); hv[i][1] += bfhi(yv.x); hv[i][2] += bflo(yv.y); hv[i][3] += bfhi(yv.y);
            }
#pragma unroll
            for (int c = 0; c < 4; ++c) ss += hv[i][c] * hv[i][c];
        }
        ss = wave_sum(ss);
        const float r = rsqrtf(ss * (1.0f / D) + EPS);
#pragma unroll
        for (int i = 0; i < 8; ++i) {
            const f32x4 g = *(const f32x4*)(fg + 256 * i + 4 * lane);
            f32x4 o;
#pragma unroll
            for (int c = 0; c < 4; ++c) o[c] = hv[i][c] * r * g[c];
            *(f32x4*)(a.out + (size_t)tok * D + 256 * i + 4 * lane) = o;
        }
    }
}

DEVI void warm_code(unsigned long long pc, unsigned dlo, unsigned dhi, unsigned len, int wid_s) {
    if (wid_s != 7 || len > 131072u) return;
    const unsigned long long base = (pc + (((unsigned long long)dhi << 32) | dlo)) & ~127ull;
    const unsigned nl = (len + 255u) >> 7;
    for (unsigned i = blockIdx.x >> 3; i < nl; i += gridDim.x >> 3) {
        unsigned t; asm volatile("s_load_dword %0, %1, 0x0" : "=s"(t) : "s"(base + (unsigned long long)i * 128ull));
    }
    asm volatile("s_waitcnt lgkmcnt(0)" ::: "memory");
}
constexpr int NPHASE = 11;
__global__ void __launch_bounds__(512, 2) mega_fwd(Args a) {
    extern __shared__ __attribute__((aligned(1024))) char smem[];
    const int wid_s = __builtin_amdgcn_readfirstlane((int)threadIdx.x >> 6);
    if (threadIdx.x == 0) *(uint4*)smem = make_uint4(0u, 0u, 0u, 0u);
    __syncthreads();
    XcdBarrier bar = xcd_barrier_post((unsigned*)(a.ws + WS_BAR), (volatile LAS unsigned*)smem);
    char* lds = smem + LDS_BASE;
    MoeTab* tb = (MoeTab*)(smem + 64);
#ifndef REP_MASK
#define REP_MASK 0
#endif
#define PHASE(k, k1, call) if (a.ph_lo <= (k) && (k) < a.ph_hi) { if (a.ph_lo < (k)) { \
        unsigned long long pc_; unsigned dlo_, dhi_, len_; \
        asm volatile("s_getpc_b64 %0\n.Lmkw" #k ":\n\ts_mov_b32 %1, (.Lmkph" #k "-.Lmkw" #k ")&4294967295\n\ts_mov_b32 %2, (.Lmkph" #k "-.Lmkw" #k ")>>32\n\ts_mov_b32 %3, (.Lmkph" #k1 "-.Lmkph" #k ")&4294967295" \
                     : "=s"(pc_), "=s"(dlo_), "=s"(dhi_), "=s"(len_)); \
        warm_code(pc_, dlo_, dhi_, len_, wid_s); xcd_barrier(bar); } \
        asm volatile(".Lmkph" #k ":"); \
        int lane = (int)__builtin_amdgcn_mbcnt_hi(~0u, __builtin_amdgcn_mbcnt_lo(~0u, 0u)); asm volatile("" : "+v"(lane)); \
        const int wid = wid_s, tid = wid_s * 64 + lane; \
        call; if ((REP_MASK >> (k)) & 1) { __syncthreads(); call; } }
    PHASE(0, 1, phase0(a, lds, tid, wid, lane))
    PHASE(1, 2, phase1(a, lds, tid, wid, lane))
    PHASE(2, 3, phase2(a, lds, tid, wid, lane))
    PHASE(3, 4, phase3(a, tid))
    PHASE(4, 5, phase4(a, lds, tid, wid, lane))
    PHASE(5, 6, phase5(a, lds, tid, wid, lane))
    PHASE(6, 7, phase6(a, lds, tid, wid, lane))
    PHASE(7, 8, phase7(a, lds, tid, wid, lane))
    PHASE(8, 9, phase8(a, lds, tb, tid, wid, lane))
    PHASE(9, 10, phase9(a, lds, tb, tid, wid, lane))
    PHASE(10, 11, phase10(a, tb, tid, wid, lane))
    asm volatile(".Lmkph11:");
#undef PHASE
}

extern "C" void kernel_launch(void* const* d_in, const int* in_sizes, int n_in, void* d_out, int out_size, void* d_ws, size_t ws_size, hipStream_t stream) {
    static int grid = 0;
    if (grid == 0) {
        if (n_in != 26 || out_size != T * D || ws_size < WS_END) { fprintf(stderr, "kernel_launch: unexpected shapes (n_in %d out %d ws %zu need %zu)\n", n_in, out_size, ws_size, (size_t)WS_END); grid = -1; return; }
        int dev = 0, cus = 0, per_cu = 0;
        if (hipGetDevice(&dev) != hipSuccess || hipDeviceGetAttribute(&cus, hipDeviceAttributeMultiprocessorCount, dev) != hipSuccess) { grid = -1; return; }
        if (hipFuncSetAttribute((const void*)mega_fwd, hipFuncAttributeMaxDynamicSharedMemorySize, LDS_BYTES) != hipSuccess) { fprintf(stderr, "kernel_launch: hipFuncSetAttribute failed\n"); grid = -1; return; }
        if (hipOccupancyMaxActiveBlocksPerMultiprocessor(&per_cu, (const void*)mega_fwd, 512, LDS_BYTES) != hipSuccess || per_cu < 1)
            fprintf(stderr, "kernel_launch: occupancy query reports %d blocks per CU\n", per_cu);
        (void)hipGetLastError();
        grid = cus;
    }
    if (grid < 0) return;
    Args a{};
    for (int i = 0; i < 26; ++i) a.in[i] = (const float*)d_in[i];
    a.out = (float*)d_out; a.ws = (unsigned char*)d_ws;
#if N_LAUNCH_SPLIT
    for (int k = 0; k < NPHASE; ++k) {
        (void)hipMemsetAsync((char*)d_ws + WS_BAR, 0, XCD_BAR_WORDS * sizeof(unsigned), stream);
        a.ph_lo = k; a.ph_hi = k + 1;
        hipLaunchKernelGGL(mega_fwd, dim3(grid), dim3(512), LDS_BYTES, stream, a);
    }
#else
    (void)hipMemsetAsync((char*)d_ws + WS_BAR, 0, XCD_BAR_WORDS * sizeof(unsigned), stream);
    a.ph_lo = 0; a.ph_hi = NPHASE;
    hipLaunchKernelGGL(mega_fwd, dim3(grid), dim3(512), LDS_BYTES, stream, a);
#endif
}
```

```cpp
#include <hip/hip_runtime.h>
#include <hip/hip_bf16.h>
#include <stdint.h>
#include <stdio.h>

#ifndef N_LAUNCH_SPLIT
#define N_LAUNCH_SPLIT 0
#endif

#define DEVI __device__ __forceinline__
typedef __attribute__((ext_vector_type(8))) short bf16x8;
typedef __attribute__((ext_vector_type(4))) float f32x4;
typedef __attribute__((ext_vector_type(4))) int i32x4;
typedef __attribute__((ext_vector_type(2))) float f2v;
typedef __attribute__((ext_vector_type(2))) __bf16 b2v;
typedef unsigned short u16;

constexpr int T = 8192, D = 2048, PW = 4112;
constexpr int NH = 4, HK = 128, HV = 256, CH = 64, NCH = 128, RANK = 16;
constexpr int SW = 1024, SG = 16, NG = 64, SP = 64;
constexpr int NE = 32, FF = 2048, CAP = 8192;
constexpr int PJ = 4096;
constexpr float EPS = 1e-6f;

constexpr size_t WS_BAR   = 0;
constexpr size_t WS_CNT   = 32768;
constexpr size_t WS_SSQ   = 65536;
constexpr size_t WS_GLR   = WS_SSQ + 65536;
constexpr size_t WS_DEC   = WS_GLR + (size_t)T * 16 * 4;
constexpr size_t WS_S5AL  = WS_DEC + (size_t)NCH * NH * HK * 4;
constexpr size_t WS_TSLOT = WS_S5AL + 65536;
constexpr size_t WS_LTOK  = WS_TSLOT + (size_t)T * 4 * 4;
constexpr size_t WS_LGATE = WS_LTOK + (size_t)NE * CAP * 4;
constexpr size_t WS_S5K   = WS_LGATE + (size_t)NE * CAP * 4;
constexpr size_t WS_S5WE  = WS_S5K + (size_t)NG * 64 * 256 * 2;
constexpr size_t WS_S5V   = WS_S5WE + (size_t)NG * 128 * 1024 * 2;
constexpr size_t WS_S5E   = WS_S5V + (size_t)NG * 1024 * 128 * 2;
constexpr size_t WS_S5H   = WS_S5E + (size_t)NG * 128 * 128 * 4;
constexpr size_t WS_HN    = WS_S5H + (size_t)NG * 128 * 128 * 2;
constexpr size_t WS_PROJ  = WS_HN + (size_t)T * D * 2;
constexpr size_t WS_KV    = WS_PROJ + (size_t)T * PJ * 2;
constexpr size_t WS_ST    = WS_KV + (size_t)NCH * NH * HV * HK * 4;
constexpr size_t WS_Z     = WS_ST + (size_t)NCH * NH * HV * HK * 2;
constexpr size_t WS_MIX   = WS_Z + (size_t)T * SW * 2;
constexpr size_t WS_H1    = WS_MIX + (size_t)T * D * 2;
constexpr size_t WS_HN2   = WS_H1 + (size_t)T * D * 4;
constexpr size_t WS_ACT   = WS_HN2 + (size_t)T * D * 2;
constexpr size_t WS_Y     = WS_ACT + (size_t)(T * 4 + 256) * FF * 2;
constexpr size_t WS_W1T   = WS_Y + (size_t)(T * 4 + 256) * D * 2;
constexpr size_t WS_W2T   = WS_W1T + (size_t)NE * 4096 * D;
constexpr size_t WS_WINT  = WS_W2T + (size_t)NE * D * FF;
constexpr size_t WS_GLUT  = WS_WINT + (size_t)PJ * D * 2;
constexpr size_t WS_WOUTT = WS_GLUT + (size_t)SW * SW * 2;
constexpr size_t WS_XG    = WS_WOUTT + (size_t)D * D * 2;
constexpr size_t WS_UG    = WS_XG + (size_t)NE * 8192 * D;
constexpr size_t WS_YSC   = WS_UG + (size_t)T * SW * 2;
constexpr size_t WS_END   = WS_YSC + (size_t)(T * 4 + 256) * 8 * 4;

constexpr int LDS_BYTES = 163840;
constexpr int LDS_CONV = 131072;
constexpr int LDS_BASE = 1024;

DEVI unsigned pack2(float a, float b) { f2v v = {a, b}; b2v r = __builtin_convertvector(v, b2v); return __builtin_bit_cast(unsigned, r); }
DEVI u16 f2bf(float a) { __bf16 r = (__bf16)a; return __builtin_bit_cast(u16, r); }
DEVI float bf2f(u16 h) { return __uint_as_float(((unsigned)h) << 16); }
DEVI float bflo(unsigned w) { return __uint_as_float(w << 16); }
DEVI float bfhi(unsigned w) { return __uint_as_float(w & 0xffff0000u); }
DEVI float wave_sum(float v) {
#pragma unroll
    for (int o = 32; o >= 1; o >>= 1) v += __shfl_xor(v, o);
    return v;
}
DEVI float sum16(float v) {
#pragma unroll
    for (int o = 8; o >= 1; o >>= 1) v += __shfl_xor(v, o);
    return v;
}
DEVI float sigmoidf_(float x) { return __builtin_amdgcn_rcpf(1.0f + __expf(-x)); }
DEVI float logsigmoid_(float x) { return fminf(x, 0.0f) - __logf(1.0f + __expf(-fabsf(x))); }
DEVI float gelu_tanh(float x) {
    const float a = 0.7978845608028654f * (x + 0.044715f * x * x * x);
    return x * __builtin_amdgcn_rcpf(1.0f + __expf(-2.0f * a));
}

#define WAIT_V0() asm volatile("s_waitcnt vmcnt(0)" ::: "memory")
#define WAIT_L0() asm volatile("s_waitcnt lgkmcnt(0)" ::: "memory")

#define XB_TMO      128
#define XB_XCNT(j)  (256  + 64 * (j))
#define XB_XSUB(j)  (1280 + 64 * (j))
#define XB_XGEN(j)  (2304 + 64 * (j))
#define XB_TOP      3328
#define XB_TOPGEN   3392
#define XCD_BAR_WORDS 3456
#define XB_SPIN_CAP (1u << 20)
#define LAS __attribute__((address_space(3)))

DEVI unsigned xb_ld(unsigned* p)              { return __hip_atomic_load(p, __ATOMIC_RELAXED, __HIP_MEMORY_SCOPE_AGENT); }
DEVI unsigned xb_add(unsigned* p, unsigned v) { return __hip_atomic_fetch_add(p, v, __ATOMIC_RELAXED, __HIP_MEMORY_SCOPE_AGENT); }
DEVI unsigned xb_xcc_id() { return (unsigned)__builtin_amdgcn_s_getreg((3 << 11) | 20) & 0xFu; }
#define XB_SPIN(cond, bar) do { unsigned _sp = 0; while (cond) { __builtin_amdgcn_s_sleep(1); \
    if ((++_sp & 255u) == 0u) { if (xb_ld(&(bar)[XB_TMO])) break; if (_sp > XB_SPIN_CAP) { atomicAdd(&(bar)[XB_TMO], 1u); break; } } } } while (0)

struct XcdBarrier { unsigned* bar; unsigned x; volatile LAS unsigned* st; };

DEVI XcdBarrier xcd_barrier_post(unsigned* bar, volatile LAS unsigned* st) {
    XcdBarrier b; b.bar = bar; b.x = xb_xcc_id(); b.st = st;
    if (threadIdx.x == 0) (void)xb_add(&bar[XB_XCNT(b.x)], 1u);
    return b;
}
DEVI void xcd_barrier_complete(unsigned* bar, unsigned x, unsigned& nloc, unsigned& nx) {
    const unsigned G = gridDim.x * gridDim.y * gridDim.z;
    unsigned sum, cnt, mine, sp = 0u;
    for (;;) {
        sum = 0u; cnt = 0u; mine = 0u;
#pragma unroll
        for (unsigned j = 0; j < 16; ++j) { const unsigned c = xb_ld(&bar[XB_XCNT(j)]); sum += c; cnt += (c > 0u) ? 1u : 0u; mine = (j == x) ? c : mine; }
        if (sum == G) break;
        __builtin_amdgcn_s_sleep(1);
        if ((++sp & 255u) == 0u) { if (xb_ld(&bar[XB_TMO])) break; if (sp > XB_SPIN_CAP) { atomicAdd(&bar[XB_TMO], 1u); break; } }
    }
    nloc = mine > 0u ? mine : 1u; nx = cnt > 0u ? cnt : 1u;
}
DEVI void xcd_barrier(const XcdBarrier& b) {
    asm volatile("s_waitcnt vmcnt(0)" ::: "memory");
    __syncthreads();
    if (threadIdx.x == 0) {
        unsigned* bar = b.bar;
        __builtin_amdgcn_s_waitcnt(0);
        unsigned nloc = b.st[0], nx = b.st[1];
        if (nloc == 0u) { xcd_barrier_complete(bar, b.x, nloc, nx); b.st[0] = nloc; b.st[1] = nx; }
        const unsigned old = xb_add(&bar[XB_XSUB(b.x)], 1u);
        const unsigned gen = old / nloc;
        if (old + 1u == (gen + 1u) * nloc) {
            __builtin_amdgcn_fence(__ATOMIC_RELEASE, "agent");
            asm volatile("s_waitcnt vmcnt(0)" ::: "memory");
            const unsigned og = xb_add(&bar[XB_TOP], 1u);
            const unsigned tg = og / nx;
            if (og + 1u == (tg + 1u) * nx) xb_add(&bar[XB_TOPGEN], 1u);
            else XB_SPIN(xb_ld(&bar[XB_TOPGEN]) == tg, bar);
            __builtin_amdgcn_fence(__ATOMIC_ACQUIRE, "agent");
            xb_add(&bar[XB_XGEN(b.x)], 1u);
            asm volatile("s_waitcnt vmcnt(0)" ::: "memory");
        } else {
            XB_SPIN(xb_ld(&bar[XB_XGEN(b.x)]) == gen, bar);
            __builtin_amdgcn_fence(__ATOMIC_ACQUIRE, "agent");
            asm volatile("s_waitcnt vmcnt(0)" ::: "memory");
        }
    }
    __syncthreads();
}

struct Args {
    const float* in[26];
    float* out;
    unsigned char* ws;
    int ph_lo, ph_hi;
};

template <int KS> DEVI int lds_byte(int r, int c) {
    int st = (r >> 4) * KS + (c >> 5), ob = (r & 15) * 64 + (c & 31) * 2;
    return st * 1024 + (ob ^ (((ob >> 9) & 1) << 5));
}
typedef __attribute__((ext_vector_type(16))) float f32x16;
typedef __attribute__((ext_vector_type(8))) int i32x8;
DEVI void f8_stage_rb(int wid, int lane, int i, int& R, int& CB) {
    R = wid * 16 + i * 128 + (lane >> 2);
    CB = (((lane & 3) ^ (R >> 2)) & 3) * 16;
}
DEVI int acc_row32(int wr, int m, int r, int lane) { return wr * 128 + m * 32 + (r & 3) + 8 * (r >> 2) + 4 * (lane >> 5); }
DEVI unsigned cvt4_fp8(float a, float b, float c, float d) {
    int r = 0;
    r = __builtin_amdgcn_cvt_pk_fp8_f32(a, b, r, false);
    r = __builtin_amdgcn_cvt_pk_fp8_f32(c, d, r, true);
    return (unsigned)r;
}
#define WAIT_VN(n) asm volatile("s_waitcnt vmcnt(" #n ")" ::: "memory")
DEVI void f8_stage(char* lds, const unsigned char* __restrict__ A, const unsigned (&aoff)[2], const unsigned char* __restrict__ B, const unsigned (&boffv)[2], int wid, int t) {
    char* sb = lds + (t & 3) * 32768 + wid * 1024;
#pragma unroll
    for (int i = 0; i < 2; ++i) {
        __builtin_amdgcn_global_load_lds((const unsigned*)(A + aoff[i] + t * 64), (LAS unsigned*)(sb + i * 8192), 16, 0, 0);
        __builtin_amdgcn_global_load_lds((const unsigned*)(B + boffv[i] + t * 64), (LAS unsigned*)(sb + 16384 + i * 8192), 16, 0, 0);
    }
}
DEVI void f8_prefetch(char* lds, const unsigned char* __restrict__ A, const unsigned (&aoff)[2], const unsigned char* __restrict__ B, const unsigned (&boffv)[2], int wid) {
    f8_stage(lds, A, aoff, B, boffv, wid, 0); f8_stage(lds, A, aoff, B, boffv, wid, 1); f8_stage(lds, A, aoff, B, boffv, wid, 2);
}
DEVI void q8_stage(char* lds, const unsigned char* __restrict__ A, const unsigned (&aoff)[2], const unsigned char* __restrict__ B, const unsigned (&boffv)[2], int wid, int t) {
    char* sb = lds + (t & 3) * 32768 + wid * 1024;
#pragma unroll
    for (int i = 0; i < 2; ++i) {
        __builtin_amdgcn_global_load_lds((const unsigned*)(A + aoff[i] + t * 64), (LAS unsigned*)(sb + i * 8192), 16, 0, 0);
        __builtin_amdgcn_global_load_lds((const unsigned*)(B + boffv[i] + t * 8192), (LAS unsigned*)(sb + 16384 + i * 8192), 16, 0, 0);
    }
}
DEVI void q8_prefetch(char* lds, const unsigned char* __restrict__ A, const unsigned (&aoff)[2], const unsigned char* __restrict__ B, const unsigned (&boffv)[2], int wid) {
    q8_stage(lds, A, aoff, B, boffv, wid, 0); q8_stage(lds, A, aoff, B, boffv, wid, 1); q8_stage(lds, A, aoff, B, boffv, wid, 2);
}
template <int NT, int SCALE_A, int SCALE_B, bool MOE1>
DEVI void f8_mainloop(char* lds, const unsigned char* __restrict__ A, const unsigned (&aoff)[2], const unsigned char* __restrict__ B, const unsigned (&boffv)[2],
                      int wid, int lane, f32x16 (&acc)[2][4]) {
    const int wr = wid >> 2, wc = wid & 3, l31 = lane & 31, hh = lane >> 5;
    const int xs = (l31 >> 2) & 3;
    const int p0 = ((2 * hh) ^ xs) << 4, p1 = ((2 * hh + 1) ^ xs) << 4;
    const int a_lo = (wr * 128 + l31) * 64 + p0, a_hi = (wr * 128 + l31) * 64 + p1;
    int b_rd[2];
#pragma unroll
    for (int nf = 0; nf < 2; ++nf) {
        const int ntile = MOE1 ? nf : (wc >> 1), nbase = MOE1 ? wc * 32 : (wc & 1) * 64 + nf * 32;
        b_rd[nf] = 16384 + ntile * 8192 + (8 * hh) * 512 + (nbase + l31) * 4;
    }
    auto ldfrag = [&](const char* sa, int lo, int hi) -> i32x8 {
        const i32x4 x = *(const i32x4*)(sa + lo), y = *(const i32x4*)(sa + hi);
        i32x8 r; r[0] = x[0]; r[1] = x[1]; r[2] = x[2]; r[3] = x[3]; r[4] = y[0]; r[5] = y[1]; r[6] = y[2]; r[7] = y[3];
        return r;
    };
    auto compute = [&](int t) {
        const char* sa = lds + (t & 3) * 32768;
        i32x8 fa[4], fb[2];
#pragma unroll
        for (int m = 0; m < 4; ++m) fa[m] = ldfrag(sa + m * 2048, a_lo, a_hi);
#pragma unroll
        for (int n = 0; n < 2; ++n)
#pragma unroll
            for (int j = 0; j < 8; ++j) fb[n][j] = *(const int*)(sa + b_rd[n] + j * 512);
#pragma unroll
        for (int m = 0; m < 4; ++m)
#pragma unroll
            for (int n = 0; n < 2; ++n)
                acc[n][m] = __builtin_amdgcn_mfma_scale_f32_32x32x64_f8f6f4(fb[n], fa[m], acc[n][m], 0, 0, 0, SCALE_B, 0, SCALE_A);
    };
    WAIT_V0(); __builtin_amdgcn_s_barrier();
#pragma unroll 1
    for (int t = 0; t < NT; ++t) {
        if (t + 3 < NT) q8_stage(lds, A, aoff, B, boffv, wid, t + 3);
        compute(t);
        if (t + 3 < NT) { WAIT_VN(8); } else if (t + 2 < NT) { WAIT_VN(4); } else { WAIT_V0(); }
        WAIT_L0(); __builtin_amdgcn_s_barrier();
    }
}
DEVI void touch4(const f32x4& v) { asm volatile("" :: "v"(v)); }
DEVI void touchf(float v) { asm volatile("" :: "v"(v)); }
DEVI void zero_acc32(f32x16 (&acc)[2][4]) {
#pragma unroll
    for (int n = 0; n < 2; ++n)
#pragma unroll
        for (int m = 0; m < 4; ++m)
#pragma unroll
            for (int r = 0; r < 16; ++r) acc[n][m][r] = 0.f;
}

DEVI void bf_stage_rb(int wid, int lane, int i, int& R, int& CB) {
    R = wid * 16 + i * 128 + (lane >> 2);
    CB = (((lane & 3) ^ (R >> 1)) & 3) * 16;
}
template <int NT>
DEVI void bf_mainloop(char* lds, const unsigned char* __restrict__ A, const unsigned (&aoff)[2], const unsigned char* __restrict__ B, const unsigned (&boffv)[2],
                      int wid, int lane, f32x4 (&acc)[4][8]) {
    const int wr = wid >> 2, wc = wid & 3, l15 = lane & 15, q = lane >> 4;
    const int cp = (q ^ ((l15 >> 1) & 3)) << 4;
    const int t_rd = (wr * 128 + l15) * 64 + cp;
    const int w_rd = 16384 + (wc * 64 + l15) * 64 + cp;
    auto compute = [&](int t) {
        const char* sa = lds + (t & 3) * 32768;
        bf16x8 tf[8], wf[4];
#pragma unroll
        for (int nt = 0; nt < 4; ++nt) wf[nt] = *(const bf16x8*)(sa + w_rd + nt * 1024);
#pragma unroll
        for (int mt = 0; mt < 8; ++mt) tf[mt] = *(const bf16x8*)(sa + t_rd + mt * 1024);
#pragma unroll
        for (int mt = 0; mt < 8; ++mt)
#pragma unroll
            for (int nt = 0; nt < 4; ++nt)
                acc[nt][mt] = __builtin_amdgcn_mfma_f32_16x16x32_bf16(wf[nt], tf[mt], acc[nt][mt], 0, 0, 0);
    };
    WAIT_V0(); __builtin_amdgcn_s_barrier();
#pragma unroll 1
    for (int t = 0; t < NT; ++t) {
        if (t + 3 < NT) f8_stage(lds, A, aoff, B, boffv, wid, t + 3);
        compute(t);
        if (t + 3 < NT) { WAIT_VN(8); } else if (t + 2 < NT) { WAIT_VN(4); } else { WAIT_V0(); }
        WAIT_L0(); __builtin_amdgcn_s_barrier();
    }
}
DEVI void zero_acc16(f32x4 (&acc)[4][8]) {
#pragma unroll
    for (int nt = 0; nt < 4; ++nt)
#pragma unroll
        for (int mt = 0; mt < 8; ++mt) acc[nt][mt] = f32x4{0.f, 0.f, 0.f, 0.f};
}
DEVI void bf_offsets(unsigned (&off)[2], int wid, int lane, int row0, int ld) {
#pragma unroll
    for (int i = 0; i < 2; ++i) { int R, CB; bf_stage_rb(wid, lane, i, R, CB); off[i] = ((unsigned)(row0 + R) * ld) * 2u + CB; }
}

DEVI void dense_convert(const Args& a, char* lds, int tid, int wid, int lane) {
    constexpr int RS = 132;
    unsigned* L = (unsigned*)lds;
    const int kq = tid >> 5, nq = tid & 31;
    auto tile = [&](int tl, const float*& src, int& ld, int& ldo, u16*& dst) {
        if (tl < 512) { const int kt = tl & 15, nt = tl >> 4; const int c0 = (nt < 24) ? nt * 128 : 3088 + (nt - 24) * 128;
            src = a.in[2] + (size_t)(kt * 128) * PW + c0; ld = PW; ldo = D; dst = (u16*)(a.ws + WS_WINT) + (size_t)(nt * 128) * D + kt * 128; }
        else if (tl < 576) { const int t2 = tl - 512, kt = t2 & 7, nt = t2 >> 3;
            src = a.in[14] + (size_t)(kt * 128) * SW + nt * 128; ld = SW; ldo = SW; dst = (u16*)(a.ws + WS_GLUT) + (size_t)(nt * 128) * SW + kt * 128; }
        else { const int t2 = tl - 576, kt = t2 & 15, nt = t2 >> 4;
            src = a.in[17] + (size_t)(kt * 128) * D + nt * 128; ld = D; ldo = D; dst = (u16*)(a.ws + WS_WOUTT) + (size_t)(nt * 128) * D + kt * 128; }
    };
    f32x4 v[2][4];
    auto issue = [&](int tl) {
        const float* src; int ld, ldo; u16* dst; tile(tl, src, ld, ldo, dst);
#pragma unroll
        for (int h = 0; h < 2; ++h)
#pragma unroll
            for (int r = 0; r < 4; ++r) v[h][r] = __builtin_nontemporal_load((const f32x4*)(src + (size_t)(4 * (kq + 16 * h) + r) * ld + 4 * nq));
    };
    if ((int)blockIdx.x < 832) issue(blockIdx.x);
#pragma unroll 1
    for (int tl = blockIdx.x; tl < 832; tl += gridDim.x) {
        const float* src; int ld, ldo; u16* dst; tile(tl, src, ld, ldo, dst);
        __syncthreads();
#pragma unroll
        for (int h = 0; h < 2; ++h) {
            i32x4 d0, d1;
#pragma unroll
            for (int c = 0; c < 4; ++c) { d0[c] = (int)pack2(v[h][0][c], v[h][1][c]); d1[c] = (int)pack2(v[h][2][c], v[h][3][c]); }
            *(i32x4*)(L + (2 * (kq + 16 * h)) * RS + 4 * nq) = d0;
            *(i32x4*)(L + (2 * (kq + 16 * h) + 1) * RS + 4 * nq) = d1;
        }
        if (tl + (int)gridDim.x < 832) issue(tl + gridDim.x);
        __syncthreads();
        {
            const int part = wid & 3, n = (wid >> 2) * 64 + lane;
            unsigned o[16];
#pragma unroll
            for (int j = 0; j < 16; ++j) o[j] = L[(16 * part + j) * RS + n];
            uint4* dp = (uint4*)(dst + (size_t)n * ldo + 32 * part);
            dp[0] = make_uint4(o[0], o[1], o[2], o[3]); dp[1] = make_uint4(o[4], o[5], o[6], o[7]);
            dp[2] = make_uint4(o[8], o[9], o[10], o[11]); dp[3] = make_uint4(o[12], o[13], o[14], o[15]);
        }
    }
}

DEVI void convert_range(const Args& a, char* lds, int t_lo, int t_hi, int tid, int wid, int lane) {
    const float* w1 = a.in[21]; const float* w2 = a.in[23];
    unsigned char* W1Q = a.ws + WS_W1T; unsigned char* W2Q = a.ws + WS_W2T;
    { int lq = lane; asm volatile("" : "+v"(lq)); lane = lq; tid = wid * 64 + lq; }
    const int kq0 = tid >> 5, n4 = tid & 31;
    auto tile_src = [&](int tl, const float*& src, int& ld, unsigned char*& dst) {
        if (tl < 16384) { const int kt = tl & 15, nt = (tl >> 4) & 31, e = tl >> 9;
            src = w1 + (size_t)e * D * 4096 + (size_t)(kt * 128) * 4096 + nt * 128; ld = 4096;
            dst = W1Q + ((size_t)(e * 32 + nt) * 512 + kt * 32) * 512; }
        else { const int t2 = tl - 16384, kt = t2 & 15, nt = (t2 >> 4) & 15, e = t2 >> 8;
            src = w2 + (size_t)e * FF * D + (size_t)(kt * 128) * D + nt * 128; ld = D;
            dst = W2Q + ((size_t)(e * 16 + nt) * 512 + kt * 32) * 512; }
    };
    f32x4 va[2][4], vb[2][4];
    auto issue = [&](int tl, f32x4 (&v)[2][4]) {
        const float* src; int ld; unsigned char* dst; tile_src(tl, src, ld, dst);
#pragma unroll
        for (int h = 0; h < 2; ++h)
#pragma unroll
            for (int r = 0; r < 4; ++r) v[h][r] = __builtin_nontemporal_load((const f32x4*)(src + (size_t)(4 * (kq0 + 16 * h) + r) * ld + 4 * n4));
    };
    auto finish = [&](int tl, f32x4 (&v)[2][4], int tnext) {
        const float* src; int ld; unsigned char* dst; tile_src(tl, src, ld, dst);
        uint4 o[2];
#pragma unroll
        for (int h = 0; h < 2; ++h) {
            o[h].x = cvt4_fp8(v[h][0][0] * 256.f, v[h][1][0] * 256.f, v[h][2][0] * 256.f, v[h][3][0] * 256.f);
            o[h].y = cvt4_fp8(v[h][0][1] * 256.f, v[h][1][1] * 256.f, v[h][2][1] * 256.f, v[h][3][1] * 256.f);
            o[h].z = cvt4_fp8(v[h][0][2] * 256.f, v[h][1][2] * 256.f, v[h][2][2] * 256.f, v[h][3][2] * 256.f);
            o[h].w = cvt4_fp8(v[h][0][3] * 256.f, v[h][1][3] * 256.f, v[h][2][3] * 256.f, v[h][3][3] * 256.f);
        }
        if (tnext < t_hi) issue(tnext, v);
#pragma unroll
        for (int h = 0; h < 2; ++h) { typedef unsigned u32x4v __attribute__((ext_vector_type(4))); const u32x4v ov = {o[h].x, o[h].y, o[h].z, o[h].w};
            __builtin_nontemporal_store(ov, (u32x4v*)(dst + ((size_t)(kq0 + 16 * h) * 128 + 4 * n4) * 4)); }
    };
    if (t_lo < t_hi) issue(t_lo, va);
    if (t_lo + 1 < t_hi) issue(t_lo + 1, vb);
#pragma unroll 1
    for (int tl = t_lo; tl < t_hi; tl += 2) {
        finish(tl, va, tl + 2);
        if (tl + 1 < t_hi) finish(tl + 1, vb, tl + 3);
    }
}

DEVI void convert_pool(const Args& a, char* lds, int which, int p_lo, int p_hi, int tid, int wid, int lane) {
    int* cur = (int*)(a.ws + WS_CNT) + 64 + which;
    volatile int* bc = (volatile int*)(lds - LDS_BASE + 32);
#pragma unroll 1
    while (true) {
        __syncthreads();
        if (tid == 0) *bc = atomicAdd(cur, 4);
        __syncthreads();
        const int t = p_lo + *bc;
        if (t >= p_hi) break;
        convert_range(a, lds, t, min(t + 4, p_hi), tid, wid, lane);
    }
}

DEVI void phase0(const Args& a, char* lds, int tid, int wid, int lane) {
    const float* x = a.in[0]; const float* g1 = a.in[1]; const float* w_in = a.in[2];
    u16* HN = (u16*)(a.ws + WS_HN); float* GLR = (float*)(a.ws + WS_GLR);
    constexpr int RSB = 4096 + 16;
    char* Wb = lds;
    char* Hb = lds + 16 * RSB;
    float* red = (float*)(lds + 32 * RSB);
    for (int u = blockIdx.x; u < 256; u += gridDim.x) {
        __syncthreads();
        for (int k = 0; k < 4; ++k) {
            const int d = (tid + 512 * k + 8 * (int)blockIdx.x) & 2047;
            const f32x4* src = (const f32x4*)(w_in + (size_t)d * PW + 3072);
#pragma unroll
            for (int q = 0; q < 4; ++q) { f32x4 v = src[q];
#pragma unroll
                for (int c = 0; c < 4; ++c) *(u16*)(Wb + (q * 4 + c) * RSB + d * 2) = f2bf(v[c]); }
        }
        if (tid < 32) ((float*)(a.ws + WS_SSQ))[u * 32 + tid] = 0.f;
        if (u == 0 && tid < 32) { ((int*)(a.ws + WS_CNT))[tid] = 0; ((int*)(a.ws + WS_CNT))[64 + tid] = 0; }
#pragma unroll 1
        for (int ps = 0; ps < 2; ++ps) {
            const int tok0 = u * 32 + ps * 16;
            {
                const int tokA = tok0 + wid * 2, tokB = tokA + 1;
                f32x4 xa[8], xb[8];
                float ssa = 0.f, ssb = 0.f;
#pragma unroll
                for (int i = 0; i < 8; ++i) {
                    xa[i] = __builtin_nontemporal_load((const f32x4*)(x + (size_t)tokA * D + 256 * i + 4 * lane));
                    xb[i] = __builtin_nontemporal_load((const f32x4*)(x + (size_t)tokB * D + 256 * i + 4 * lane));
#pragma unroll
                    for (int c = 0; c < 4; ++c) { ssa += xa[i][c] * xa[i][c]; ssb += xb[i][c] * xb[i][c]; }
                }
                ssa = wave_sum(ssa); ssb = wave_sum(ssb);
                const float ra = rsqrtf(ssa * (1.0f / D) + EPS), rb = rsqrtf(ssb * (1.0f / D) + EPS);
#pragma unroll
                for (int i = 0; i < 8; ++i) {
                    const f32x4 g = *(const f32x4*)(g1 + 256 * i + 4 * lane);
                    uint2 pa, pb;
                    pa.x = pack2(xa[i][0] * ra * g[0], xa[i][1] * ra * g[1]); pa.y = pack2(xa[i][2] * ra * g[2], xa[i][3] * ra * g[3]);
                    pb.x = pack2(xb[i][0] * rb * g[0], xb[i][1] * rb * g[1]); pb.y = pack2(xb[i][2] * rb * g[2], xb[i][3] * rb * g[3]);
                    *(uint2*)(HN + (size_t)tokA * D + 256 * i + 4 * lane) = pa;
                    *(uint2*)(HN + (size_t)tokB * D + 256 * i + 4 * lane) = pb;
                    *(uint2*)(Hb + (wid * 2) * RSB + (256 * i + 4 * lane) * 2) = pa;
                    *(uint2*)(Hb + (wid * 2 + 1) * RSB + (256 * i + 4 * lane) * 2) = pb;
                }
            }
            __syncthreads();
            {
                const int l15 = lane & 15, q = lane >> 4;
                f32x4 acc = {0.f, 0.f, 0.f, 0.f};
#pragma unroll
                for (int ks = 0; ks < 8; ++ks) {
                    const int kb = (wid * 256 + ks * 32 + q * 8) * 2;
                    const bf16x8 av = *(const bf16x8*)(Hb + l15 * RSB + kb);
                    const bf16x8 bv = *(const bf16x8*)(Wb + l15 * RSB + kb);
                    acc = __builtin_amdgcn_mfma_f32_16x16x32_bf16(av, bv, acc, 0, 0, 0);
                }
#pragma unroll
                for (int j = 0; j < 4; ++j) red[(wid * 16 + 4 * q + j) * 16 + l15] = acc[j];
            }
            __syncthreads();
            if (tid < 256) {
                float sacc = 0.f;
#pragma unroll
                for (int w = 0; w < 8; ++w) sacc += red[w * 256 + tid];
                GLR[(size_t)(tok0 + (tid >> 4)) * 16 + (tid & 15)] = sacc;
            }
        }
    }
    const float* a_re = a.in[6]; const float* a_im = a.in[7]; const float* b_re = a.in[8]; const float* b_im = a.in[9];
    const float* c_re = a.in[10]; const float* c_im = a.in[11]; const float* lstep = a.in[13];
    u16* KT = (u16*)(a.ws + WS_S5K); u16* WE = (u16*)(a.ws + WS_S5WE); u16* VV = (u16*)(a.ws + WS_S5V); float* AL = (float*)(a.ws + WS_S5AL);
    float* Bre = (float*)lds;
    float* Bim = Bre + 1024;
    float* Cre = Bim + 1024;
    float* Cim = Cre + 1024;
    float* Pre = Cim + 1024;
    float* Pim = Pre + 65 * 64;
    for (int u = blockIdx.x; u < 256; u += gridDim.x) {
        const int g = u >> 2, q = u & 3;
        __syncthreads();
        const float delta = __expf(lstep[g]);
        if (tid < 64) {
            const int p = tid;
            const float ar = a_re[g * 64 + p], ai = a_im[g * 64 + p];
            const float ea = expf(ar * delta);
            float sn, cs; sincosf(ai * delta, &sn, &cs);
            const float xr = ea * cs - 1.0f, xi = ea * sn;
            const float den = 1.0f / (ar * ar + ai * ai);
            const float cr = (xr * ar + xi * ai) * den, ci = (xi * ar - xr * ai) * den;
#pragma unroll
            for (int m = 0; m < 16; ++m) {
                const float br = b_re[(g * 64 + p) * 16 + m], bi = b_im[(g * 64 + p) * 16 + m];
                Bre[p * 16 + m] = cr * br - ci * bi;
                Bim[p * 16 + m] = cr * bi + ci * br;
            }
        }
        for (int i = tid; i < 1024; i += 512) { Cre[i] = c_re[g * 1024 + i]; Cim[i] = c_im[g * 1024 + i]; }
        for (int i = tid; i < 65 * 64; i += 512) {
            const int tau = i >> 6, p = i & 63;
            const float ar = a_re[g * 64 + p], ai = a_im[g * 64 + p];
            const float e = expf((float)tau * ar * delta);
            float sn, cs; sincosf((float)tau * (ai * delta), &sn, &cs);
            Pre[i] = e * cs; Pim[i] = e * sn;
        }
        __syncthreads();
        if (q == 0 && tid < 64) { AL[(g * 64 + tid) * 2] = Pre[64 * 64 + tid]; AL[(g * 64 + tid) * 2 + 1] = Pim[64 * 64 + tid]; }
        if (tid < 256) {
            const int tau = q * 16 + (tid >> 4), n = tid & 15;
            float acc[16];
#pragma unroll
            for (int m = 0; m < 16; ++m) acc[m] = 0.f;
#pragma unroll 2
            for (int p = 0; p < 64; ++p) {
                const float cr = Cre[n * 64 + p], ci = Cim[n * 64 + p], pr = Pre[tau * 64 + p], pi = Pim[tau * 64 + p];
                const float xr = cr * pr - ci * pi, xi = cr * pi + ci * pr;
#pragma unroll
                for (int m4 = 0; m4 < 4; ++m4) {
                    const f32x4 br = *(const f32x4*)(Bre + p * 16 + m4 * 4), bi = *(const f32x4*)(Bim + p * 16 + m4 * 4);
#pragma unroll
                    for (int c = 0; c < 4; ++c) acc[m4 * 4 + c] += xr * br[c] - xi * bi[c];
                }
            }
            uint4 o0, o1;
            o0.x = pack2(acc[0], acc[1]); o0.y = pack2(acc[2], acc[3]); o0.z = pack2(acc[4], acc[5]); o0.w = pack2(acc[6], acc[7]);
            o1.x = pack2(acc[8], acc[9]); o1.y = pack2(acc[10], acc[11]); o1.z = pack2(acc[12], acc[13]); o1.w = pack2(acc[14], acc[15]);
            uint4* dst = (uint4*)(KT + ((size_t)(g * 64 + tau) * 16 + n) * 16);
            dst[0] = o0; dst[1] = o1;
        }
        {
            const int p = tid >> 3;
#pragma unroll
            for (int ss = 0; ss < 2; ++ss) {
                const int s = q * 16 + (tid & 7) * 2 + ss;
                const float pr = Pre[(63 - s) * 64 + p], pi = Pim[(63 - s) * 64 + p];
                float vr[16], vi[16];
#pragma unroll
                for (int m = 0; m < 16; ++m) { const float br = Bre[p * 16 + m], bi = Bim[p * 16 + m]; vr[m] = pr * br - pi * bi; vi[m] = pr * bi + pi * br; }
                uint4 r0, r1, i0, i1;
                r0.x = pack2(vr[0], vr[1]); r0.y = pack2(vr[2], vr[3]); r0.z = pack2(vr[4], vr[5]); r0.w = pack2(vr[6], vr[7]);
                r1.x = pack2(vr[8], vr[9]); r1.y = pack2(vr[10], vr[11]); r1.z = pack2(vr[12], vr[13]); r1.w = pack2(vr[14], vr[15]);
                i0.x = pack2(vi[0], vi[1]); i0.y = pack2(vi[2], vi[3]); i0.z = pack2(vi[4], vi[5]); i0.w = pack2(vi[6], vi[7]);
                i1.x = pack2(vi[8], vi[9]); i1.y = pack2(vi[10], vi[11]); i1.z = pack2(vi[12], vi[13]); i1.w = pack2(vi[14], vi[15]);
                uint4* dr = (uint4*)(WE + ((size_t)(g * 128 + 2 * p) * 1024 + s * 16));
                uint4* di = (uint4*)(WE + ((size_t)(g * 128 + 2 * p + 1) * 1024 + s * 16));
                dr[0] = r0; dr[1] = r1; di[0] = i0; di[1] = i1;
            }
        }
        {
            const int tau = q * 16 + (tid >> 5), n = (tid >> 1) & 15, ph = tid & 1;
            unsigned* dst = (unsigned*)(VV + ((size_t)(g * 1024 + tau * 16 + n) * 128 + ph * 64));
#pragma unroll 4
            for (int pp = 0; pp < 32; ++pp) {
                const int p = ph * 32 + pp;
                const float cr = Cre[n * 64 + p], ci = Cim[n * 64 + p], pr = Pre[(tau + 1) * 64 + p], pi = Pim[(tau + 1) * 64 + p];
                dst[pp] = pack2(cr * pr - ci * pi, -(cr * pi + ci * pr));
            }
        }
    }
    __syncthreads();
    dense_convert(a, lds, tid, wid, lane);
}


namespace pg8 {
#define PG8_LAS __attribute__((address_space(3)))
constexpr int BM = 256, BK = 64, HALF = 128, HTB = HALF * BK * 2, NXCD = 8, WGM = 8;
DEVI int lds_byte(int r, int c) { const int st = (r >> 4) * 2 + (c >> 5), rr = r & 15, cc = c & 31, ob = rr * 64 + cc * 2; return st * 1024 + (ob ^ (((ob >> 9) & 1) << 5)); }
DEVI void stage_rc(int b, int& R, int& C) { const int st = b / 1024, sb = b % 1024, swz = sb ^ (((sb >> 9) & 1) << 5); R = (st >> 1) * 16 + swz / 64; C = (st & 1) * 32 + (swz % 64) / 2; }
DEVI int perm32(int rho) { const int n = rho >> 4, i = rho & 15; return 8 * (i >> 2) + 4 * n + (i & 3); }
struct Unit { int pm, pn, kofs, cont; };
struct Gemm { const void* A; const void* Bt; int ld, K; };
struct StaticOrder {
    int nM, nN, nwg, G, c;
    DEVI void init(int M, int N, int G_, int c_) { nM = M / BM; nN = N / BM; nwg = nM * nN; G = G_; c = c_; }
    DEVI bool tile(int i, Unit& u) const {
        const long L = (long)i * G + c; if (L >= nwg) return false;
        int wgid = (int)L; { const int q = nwg / NXCD, r = nwg % NXCD, xcd = wgid % NXCD, off = wgid / NXCD; wgid = (xcd < r ? xcd * (q + 1) : r * (q + 1) + (xcd - r) * q) + off; }
        const int nig = WGM * nN, gid = wgid / nig, fm = gid * WGM, gsz = (nM - fm) < WGM ? (nM - fm) : WGM;
        u.pm = fm + ((wgid % nig) % gsz); u.pn = (wgid % nig) / gsz; return true;
    }
    int i0 = 0, i1 = 1 << 30;
    DEVI bool next(int i, Unit& u) const { u.kofs = 0; u.cont = 0; return (i0 + i < i1) && tile(i0 + i, u); }
};
struct SplitKOrder : StaticOrder {
    int khalf;
    DEVI bool next(int i, Unit& u) const { if (i >= 2) return false; u.kofs = i == 0 ? khalf : 0; u.cont = i; return tile(0, u); }
};

template <class Epi, class Sched>
DEVI void gemm_phase(PG8_LAS unsigned char* lds, const Gemm g, const Sched& S, const Epi& E) {
    const int tid = threadIdx.x, wid = __builtin_amdgcn_readfirstlane(tid >> 6), lane = tid & 63, wr = wid >> 2, wc = wid & 3, fr = lane & 15, fq = lane >> 4;
    const int ld = g.ld, nt = g.K / BK;
    unsigned voffA[2], voffB[2];
#pragma unroll
    for (int i = 0; i < 2; ++i) { int R, C; stage_rc(tid * 16 + i * 8192, R, C); const int Rb = Epi::PERM ? ((R & ~31) + perm32(R & 31)) : R;
        voffA[i] = (unsigned)(R * ld + C) * 2u; voffB[i] = (unsigned)(Rb * ld + C) * 2u; }
    const size_t kstep = (size_t)(BK * 2);
    const size_t hstep = (size_t)HALF * ld * 2;
    const size_t tstep = 2 * hstep;
    const unsigned ldsw = (unsigned)wid * 1024u;
    const int aoff = lds_byte(wr * 64 + fr, fq * 8), boff = lds_byte(wc * 32 + fr, fq * 8);
#define PG8_SA(b, h) (((b) * 2 + (h)) * HTB)
#define PG8_SB(b, h) ((4 + (b) * 2 + (h)) * HTB)
#define PG8_STAGE(bufoff, gbase, voff) do { _Pragma("unroll") for (int _i = 0; _i < 2; ++_i) \
        __builtin_amdgcn_global_load_lds((const unsigned*)((const char*)(gbase) + (voff)[_i]), (PG8_LAS unsigned*)(lds + (bufoff) + ldsw + _i * 8192), 16, 0, 0); } while (0)
#define PG8_LDA(dst, b, h) do { _Pragma("unroll") for (int m = 0; m < 4; ++m) _Pragma("unroll") for (int k = 0; k < 2; ++k) dst[m][k] = *(const PG8_LAS bf16x8*)(lds + PG8_SA(b, h) + aoff + m * 2048 + k * 1024); } while (0)
#define PG8_LDB(dst, b, h) do { _Pragma("unroll") for (int n = 0; n < 2; ++n) _Pragma("unroll") for (int k = 0; k < 2; ++k) dst[n][k] = *(const PG8_LAS bf16x8*)(lds + PG8_SB(b, h) + boff + n * 2048 + k * 1024); } while (0)
#define PG8_MMA(ai, bj, At, Bt) do { __builtin_amdgcn_s_setprio(1); _Pragma("unroll") for (int m = 0; m < 4; ++m) _Pragma("unroll") for (int n = 0; n < 2; ++n) _Pragma("unroll") for (int k = 0; k < 2; ++k) \
        acc[ai][bj][m][n] = __builtin_amdgcn_mfma_f32_16x16x32_bf16(Bt[n][k], At[m][k], acc[ai][bj][m][n], 0, 0, 0); __builtin_amdgcn_s_setprio(0); } while (0)
#define PG8_WAIT_V(n) asm volatile("s_waitcnt vmcnt(" #n ")" ::: "memory")
#define PG8_WAIT_L(n) asm volatile("s_waitcnt lgkmcnt(" #n ")" ::: "memory")
#define PG8_BAR __builtin_amdgcn_s_barrier()
#define PG8_SCHED __builtin_amdgcn_sched_barrier(0)
#define PG8_ZERO() do { _Pragma("unroll") for (int a_ = 0; a_ < 2; ++a_) _Pragma("unroll") for (int b_ = 0; b_ < 2; ++b_) _Pragma("unroll") for (int m_ = 0; m_ < 4; ++m_) _Pragma("unroll") for (int n_ = 0; n_ < 2; ++n_) \
        acc[a_][b_][m_][n_] = (f32x4){0.f, 0.f, 0.f, 0.f}; } while (0)
    Unit cur, nxt; int ui = 0;
    if (!S.next(0, cur)) return;
    f32x4 acc[2][2][4][2];
    PG8_ZERO();
    bf16x8 At[4][2], B0[2][2], B1[2][2];
    const char* cA = (const char*)g.A + (size_t)cur.pm * tstep + cur.kofs; const char* cB = (const char*)g.Bt + (size_t)cur.pn * tstep + cur.kofs;
    PG8_STAGE(PG8_SB(0, 0), cB, voffB); PG8_STAGE(PG8_SA(0, 0), cA, voffA); PG8_STAGE(PG8_SB(0, 1), cB + hstep, voffB); PG8_STAGE(PG8_SA(0, 1), cA + hstep, voffA);
    if (wr == 1) PG8_BAR;
    PG8_WAIT_V(4); PG8_BAR;
    PG8_STAGE(PG8_SB(1, 0), cB + kstep, voffB); PG8_STAGE(PG8_SA(1, 0), cA + kstep, voffA); PG8_STAGE(PG8_SB(1, 1), cB + hstep + kstep, voffB);
    PG8_WAIT_V(6); PG8_BAR;
    for (;;) {
        const bool has_next = S.next(ui + 1, nxt);
        const char* nA = has_next ? (const char*)g.A + (size_t)nxt.pm * tstep + nxt.kofs : cA; const char* nB = has_next ? (const char*)g.Bt + (size_t)nxt.pn * tstep + nxt.kofs : cB;
        for (int t = 0; t < nt; t += 2) {
            const bool last = (t == nt - 2);
            const char* a1 = cA + (size_t)(t + 1) * kstep;
            const char* a2 = last ? nA : cA + (size_t)(t + 2) * kstep; const char* b2 = last ? nB : cB + (size_t)(t + 2) * kstep;
            const char* a3 = a2 + kstep; const char* b3 = b2 + kstep;
            PG8_LDB(B0, 0, 0); PG8_SCHED; PG8_LDA(At, 0, 0); PG8_STAGE(PG8_SA(1, 1), a1 + hstep, voffA);
            PG8_WAIT_L(8); PG8_BAR; PG8_WAIT_L(0); PG8_MMA(0, 0, At, B0); PG8_BAR; PG8_SCHED;
            PG8_LDB(B1, 0, 1); PG8_STAGE(PG8_SB(0, 0), b2, voffB);
            PG8_BAR; PG8_WAIT_L(0); PG8_MMA(0, 1, At, B1); PG8_BAR;
            PG8_LDA(At, 0, 1); PG8_STAGE(PG8_SA(0, 0), a2, voffA);
            PG8_BAR; PG8_WAIT_L(0); PG8_MMA(1, 0, At, B0); PG8_BAR; PG8_SCHED;
            PG8_STAGE(PG8_SB(0, 1), b2 + hstep, voffB);
            PG8_WAIT_V(6); PG8_BAR; PG8_MMA(1, 1, At, B1); PG8_BAR;
            PG8_LDB(B0, 1, 0); PG8_SCHED; PG8_LDA(At, 1, 0); PG8_STAGE(PG8_SA(0, 1), a2 + hstep, voffA);
            PG8_WAIT_L(8); PG8_BAR; PG8_WAIT_L(0); PG8_MMA(0, 0, At, B0); PG8_BAR; PG8_SCHED;
            PG8_LDB(B1, 1, 1); PG8_STAGE(PG8_SB(1, 0), b3, voffB);
            PG8_BAR; PG8_WAIT_L(0); PG8_MMA(0, 1, At, B1); PG8_BAR;
            PG8_LDA(At, 1, 1); PG8_STAGE(PG8_SA(1, 0), a3, voffA);
            PG8_BAR; PG8_WAIT_L(0); PG8_MMA(1, 0, At, B0); PG8_BAR; PG8_SCHED;
            PG8_STAGE(PG8_SB(1, 1), b3 + hstep, voffB);
            PG8_WAIT_V(6); PG8_BAR; PG8_MMA(1, 1, At, B1); PG8_BAR;
        }
        E(acc, cur, wr, wc, fr, fq);
        if (!has_next) break;
        if (!nxt.cont) PG8_ZERO();
        cur = nxt; cA = nA; cB = nB; ++ui;
    }
    PG8_WAIT_V(0);
    if (wr == 0) PG8_BAR;
    PG8_BAR;
#undef PG8_SA
#undef PG8_SB
#undef PG8_STAGE
#undef PG8_LDA
#undef PG8_LDB
#undef PG8_MMA
#undef PG8_WAIT_V
#undef PG8_WAIT_L
#undef PG8_BAR
#undef PG8_SCHED
#undef PG8_ZERO
}
}

struct EpiProj {
    static constexpr bool PERM = true;
    u16* out; u16* ug;
    DEVI void operator()(f32x4 (&acc)[2][2][4][2], const pg8::Unit& u, int wr, int wc, int fr, int fq) const {
        const float sc = (u.pn < 2) ? 0.08838834764831845f : 1.0f;
        const int row0 = u.pm * 256 + wr * 64 + fr, col0 = u.pn * 256 + wc * 32 + 8 * fq;
        const bool isu = u.pn >= 12;
#pragma unroll
        for (int ai = 0; ai < 2; ++ai)
#pragma unroll
            for (int m = 0; m < 4; ++m) {
                const int row = row0 + ai * 128 + m * 16;
#pragma unroll
                for (int bj = 0; bj < 2; ++bj) {
                    const f32x4 v0 = acc[ai][bj][m][0], v1 = acc[ai][bj][m][1];
                    uint4 w; w.x = pack2(v0[0] * sc, v0[1] * sc); w.y = pack2(v0[2] * sc, v0[3] * sc); w.z = pack2(v1[0] * sc, v1[1] * sc); w.w = pack2(v1[2] * sc, v1[3] * sc);
                    const int c = col0 + bj * 128;
                    u16* dst = isu ? ug + ((size_t)((c - 3072) >> 4) * T + row) * 16 + (c & 8) : out + (size_t)row * PJ + c;
                    *(uint4*)dst = w;
                }
            }
    }
};
struct EpiGlu {
    static constexpr bool PERM = true;
    const u16* Z; u16* MIX; float* SSQ; const float* gbias; const float* sng;
    DEVI void operator()(f32x4 (&acc)[2][2][4][2], const pg8::Unit& u, int wr, int wc, int fr, int fq) const {
        const int row0 = u.pm * 256 + wr * 64 + fr, col0 = u.pn * 256 + wc * 32 + 8 * fq;
#pragma unroll
        for (int ai = 0; ai < 2; ++ai)
#pragma unroll
            for (int m = 0; m < 4; ++m) {
                const int row = row0 + ai * 128 + m * 16;
                float sq = 0.f;
#pragma unroll
                for (int bj = 0; bj < 2; ++bj) {
                    const int c = col0 + bj * 128;
                    typedef unsigned u32x4z __attribute__((ext_vector_type(4)));
                    const u32x4z zv = __builtin_nontemporal_load((const u32x4z*)(Z + (size_t)row * SW + c));
                    const unsigned zw[4] = {zv.x, zv.y, zv.z, zv.w};
                    unsigned ow[4];
#pragma unroll
                    for (int n = 0; n < 2; ++n) {
                        const f32x4 gb = *(const f32x4*)(gbias + c + 4 * n), sg = *(const f32x4*)(sng + c + 4 * n);
                        const f32x4 v = acc[ai][bj][m][n];
                        const float y0 = bflo(zw[2 * n]) * sigmoidf_(v[0] + gb[0]), y1 = bfhi(zw[2 * n]) * sigmoidf_(v[1] + gb[1]);
                        const float y2 = bflo(zw[2 * n + 1]) * sigmoidf_(v[2] + gb[2]), y3 = bfhi(zw[2 * n + 1]) * sigmoidf_(v[3] + gb[3]);
                        sq += y0 * y0 + y1 * y1 + y2 * y2 + y3 * y3;
                        ow[2 * n] = pack2(y0 * sg[0], y1 * sg[1]); ow[2 * n + 1] = pack2(y2 * sg[2], y3 * sg[3]);
                    }
                    uint4 w; w.x = ow[0]; w.y = ow[1]; w.z = ow[2]; w.w = ow[3];
                    *(uint4*)(MIX + (size_t)row * D + 1024 + c) = w;
                }
                sq += __shfl_xor(sq, 16); sq += __shfl_xor(sq, 32);
                if (fq == 0) atomicAdd(&SSQ[row], sq);
            }
    }
};
struct EpiOut {
    static constexpr bool PERM = true;
    const float* x; u16* H1; const float* SSQ;
    DEVI void operator()(f32x4 (&acc)[2][2][4][2], const pg8::Unit& u, int wr, int wc, int fr, int fq) const {
        const int row0 = u.pm * 256 + wr * 64 + fr, col0 = u.pn * 256 + wc * 32 + 8 * fq;
        if (u.cont == 0) {
#pragma unroll
            for (int ai = 0; ai < 2; ++ai)
#pragma unroll
                for (int m = 0; m < 4; ++m) {
                    const float rs = rsqrtf(SSQ[row0 + ai * 128 + m * 16] * (1.0f / SW) + EPS);
#pragma unroll
                    for (int bj = 0; bj < 2; ++bj)
#pragma unroll
                        for (int n = 0; n < 2; ++n) acc[ai][bj][m][n] *= rs;
                }
        } else {
#pragma unroll
            for (int ai = 0; ai < 2; ++ai)
#pragma unroll
                for (int m = 0; m < 4; ++m) {
                    const size_t base = (size_t)(row0 + ai * 128 + m * 16) * D + col0;
#pragma unroll
                    for (int bj = 0; bj < 2; ++bj) {
                        const f32x4 v0 = __builtin_nontemporal_load((const f32x4*)(x + base + bj * 128)) + acc[ai][bj][m][0], v1 = __builtin_nontemporal_load((const f32x4*)(x + base + bj * 128 + 4)) + acc[ai][bj][m][1];
                        uint4 pk; pk.x = pack2(v0[0], v0[1]); pk.y = pack2(v0[2], v0[3]); pk.z = pack2(v1[0], v1[1]); pk.w = pack2(v1[2], v1[3]);
                        *(uint4*)(H1 + base + bj * 128) = pk;
                    }
                }
        }
    }
};

DEVI void phase1(const Args& a, char* lds, int tid, int wid, int lane) {
    extern __shared__ __attribute__((aligned(16))) char smem_pg8[];
    const int cpos = blockIdx.x % 3, c_lo = blockIdx.x * 30, c_hi = c_lo + 30;
#pragma unroll 1
    for (int part = 0; part < 2; ++part) {
        if (part == cpos) convert_range(a, lds, c_lo, c_hi, tid, wid, lane);
        pg8::Gemm g; g.A = a.ws + WS_HN; g.Bt = a.ws + WS_WINT; g.ld = D; g.K = D;
        pg8::StaticOrder S; S.init(T, PJ, (int)gridDim.x, (int)blockIdx.x);
        if (cpos == 1) { S.i0 = part; S.i1 = part + 1; } else if (part == 1) S.i1 = 0;
        EpiProj E; E.out = (u16*)(a.ws + WS_PROJ); E.ug = (u16*)(a.ws + WS_UG);
        pg8::gemm_phase(( PG8_LAS unsigned char*)(smem_pg8 + 1024), g, S, E);
    }
    if (cpos == 2) convert_range(a, lds, c_lo, c_hi, tid, wid, lane);
    convert_pool(a, lds, 0, 7680, 8192, tid, wid, lane);
}

DEVI void gla_gate(const Args& a, int n, int h, int tid, float* glr, float* tot, float (&b)[16], float& blast) {
    const float* GLR = (const float*)(a.ws + WS_GLR);
    const float* W2 = a.in[3]; const float* gb = a.in[4];
    for (int i = tid; i < 1024; i += 512) glr[i] = GLR[(size_t)n * 64 * 16 + i];
    const int ch = tid & 127, tq = tid >> 7;
    float w[16];
#pragma unroll
    for (int r = 0; r < 16; ++r) w[r] = W2[r * 512 + h * 128 + ch];
    const float bias = gb[h * 128 + ch];
    __syncthreads();
    float run = 0.f;
#pragma unroll
    for (int tt = 0; tt < 16; ++tt) {
        const int t = tq * 16 + tt;
        float s = bias;
#pragma unroll
        for (int r4 = 0; r4 < 4; ++r4) {
            const f32x4 gv = *(const f32x4*)(glr + t * 16 + r4 * 4);
            s += gv[0] * w[r4 * 4] + gv[1] * w[r4 * 4 + 1] + gv[2] * w[r4 * 4 + 2] + gv[3] * w[r4 * 4 + 3];
        }
        run += logsigmoid_(s) * (1.0f / 16.0f);
        b[tt] = run;
    }
    tot[tq * 128 + ch] = run;
    __syncthreads();
    float pre = 0.f;
#pragma unroll
    for (int k = 0; k < 4; ++k) { const float v = tot[k * 128 + ch]; if (k < tq) pre += v; }
    blast = tot[ch] + tot[128 + ch] + tot[256 + ch] + tot[384 + ch];
#pragma unroll
    for (int tt = 0; tt < 16; ++tt) b[tt] += pre;
}
DEVI void gla_stage_vT(const u16* PROJ, int t0, int vcol0, char* img, int tid) {
    if (tid < 256) {
        const int tb = tid >> 5, jb = tid & 31;
        unsigned R[8][4];
#pragma unroll
        for (int tt = 0; tt < 8; ++tt) {
            const uint4 v = *(const uint4*)(PROJ + (size_t)(t0 + tb * 8 + tt) * PJ + vcol0 + jb * 8);
            R[tt][0] = v.x; R[tt][1] = v.y; R[tt][2] = v.z; R[tt][3] = v.w;
        }
#pragma unroll
        for (int jj = 0; jj < 8; ++jj) {
            unsigned o[4];
#pragma unroll
            for (int d = 0; d < 4; ++d) {
                const unsigned lo = R[2 * d][jj >> 1], hi = R[2 * d + 1][jj >> 1];
                o[d] = (jj & 1) ? ((lo >> 16) | (hi & 0xffff0000u)) : ((lo & 0xffffu) | (hi << 16));
            }
            *(uint4*)(img + lds_byte<2>(jb * 8 + jj, tb * 8)) = make_uint4(o[0], o[1], o[2], o[3]);
        }
    }
}

constexpr int USTR = 2048 + 16;
template <int AUX = 0>
DEVI void s5_fill_U(const u16* UG, int g, int cb, char* U, int tid) {
    const int w = tid >> 6, lane = tid & 63;
#pragma unroll
    for (int r = 0; r < 4; ++r)
#pragma unroll
        for (int hf = 0; hf < 2; ++hf) {
            const int c = w * 4 + r, s = hf * 32 + (lane >> 1);
            __builtin_amdgcn_global_load_lds((const unsigned*)(UG + ((size_t)g * T + (cb * 32 + c) * 64 + s) * 16 + (lane & 1) * 8), (LAS unsigned*)(U + c * USTR + hf * 1024), 16, 0, AUX);
        }
}
DEVI void phase2(const Args& a, char* lds, int tid, int wid, int lane) {
    const u16* PROJ = (const u16*)(a.ws + WS_PROJ);
#pragma unroll 1
    for (int u = blockIdx.x; u < 768; u += gridDim.x) {
        { int lq = lane; asm volatile("" : "+v"(lq)); lane = lq; tid = wid * 64 + lq; }
        const int fr = lane & 15, fq = lane >> 4;
        __syncthreads();
        if (u < 256) {
            const int g = u >> 2, cb = u & 3;
            s5_fill_U((const u16*)(a.ws + WS_UG), g, cb, lds, tid);
            WAIT_V0(); __syncthreads();
            const u16* WE = (const u16*)(a.ws + WS_S5WE) + (size_t)(g * 128 + wid * 16 + fr) * 1024 + fq * 8;
            f32x4 acc0 = {0.f, 0.f, 0.f, 0.f}, acc1 = {0.f, 0.f, 0.f, 0.f};
#pragma unroll 8
            for (int ks = 0; ks < 32; ++ks) {
                const bf16x8 bf = *(const bf16x8*)(WE + ks * 32);
                const bf16x8 a0 = *(const bf16x8*)(lds + fr * USTR + (ks * 32 + fq * 8) * 2);
                const bf16x8 a1 = *(const bf16x8*)(lds + (16 + fr) * USTR + (ks * 32 + fq * 8) * 2);
                acc0 = __builtin_amdgcn_mfma_f32_16x16x32_bf16(a0, bf, acc0, 0, 0, 0);
                acc1 = __builtin_amdgcn_mfma_f32_16x16x32_bf16(a1, bf, acc1, 0, 0, 0);
            }
            float* E = (float*)(a.ws + WS_S5E);
#pragma unroll
            for (int j = 0; j < 4; ++j) {
                E[(size_t)(g * 128 + cb * 32 + fq * 4 + j) * 128 + wid * 16 + fr] = acc0[j];
                E[(size_t)(g * 128 + cb * 32 + 16 + fq * 4 + j) * 128 + wid * 16 + fr] = acc1[j];
            }
        } else {
            const int uu = u - 256, n = uu >> 2, h = uu & 3, t0 = n * 64;
            char* vT = lds;
            char* kT = lds + 32768;
            float* glr = (float*)(lds + 49152);
            float* tot = glr + 1024;
            float b[16], blast;
            gla_gate(a, n, h, tid, glr, tot, b, blast);
            const int ch = tid & 127, tq = tid >> 7;
            {
                unsigned pk[8];
#pragma unroll
                for (int tt = 0; tt < 16; tt += 2) {
                    const float k0 = bf2f(PROJ[(size_t)(t0 + tq * 16 + tt) * PJ + 512 + h * 128 + ch]);
                    const float k1 = bf2f(PROJ[(size_t)(t0 + tq * 16 + tt + 1) * PJ + 512 + h * 128 + ch]);
                    pk[tt >> 1] = pack2(k0 * __expf(blast - b[tt]), k1 * __expf(blast - b[tt + 1]));
                }
                *(uint4*)(kT + lds_byte<2>(ch, tq * 16)) = make_uint4(pk[0], pk[1], pk[2], pk[3]);
                *(uint4*)(kT + lds_byte<2>(ch, tq * 16 + 8)) = make_uint4(pk[4], pk[5], pk[6], pk[7]);
                if (tq == 3) ((float*)(a.ws + WS_DEC))[(size_t)(n * 4 + h) * 128 + ch] = __expf(blast);
            }
            gla_stage_vT(PROJ, t0, 1024 + h * 256, vT, tid);
            __syncthreads();
            const int wr = wid >> 1, wc = wid & 1;
            f32x4 acc[4][4];
#pragma unroll
            for (int m = 0; m < 4; ++m)
#pragma unroll
                for (int nn = 0; nn < 4; ++nn) acc[m][nn] = f32x4{0.f, 0.f, 0.f, 0.f};
#pragma unroll
            for (int ks = 0; ks < 2; ++ks) {
                bf16x8 Af[4], Bf[4];
#pragma unroll
                for (int m = 0; m < 4; ++m) Af[m] = *(const bf16x8*)(vT + lds_byte<2>(wr * 64 + m * 16 + fr, ks * 32 + fq * 8));
#pragma unroll
                for (int nn = 0; nn < 4; ++nn) Bf[nn] = *(const bf16x8*)(kT + lds_byte<2>(wc * 64 + nn * 16 + fr, ks * 32 + fq * 8));
#pragma unroll
                for (int m = 0; m < 4; ++m)
#pragma unroll
                    for (int nn = 0; nn < 4; ++nn) acc[m][nn] = __builtin_amdgcn_mfma_f32_16x16x32_bf16(Af[m], Bf[nn], acc[m][nn], 0, 0, 0);
            }
            u16* KV = (u16*)(a.ws + WS_KV) + (size_t)(n * 4 + h) * (HV * HK);
#pragma unroll
            for (int m = 0; m < 4; ++m)
#pragma unroll
                for (int nn = 0; nn < 4; ++nn)
#pragma unroll
                    for (int j = 0; j < 4; ++j)
                        KV[(size_t)(wr * 64 + m * 16 + fq * 4 + j) * 128 + wc * 64 + nn * 16 + fr] = f2bf(acc[m][nn][j]);
        }
    }
}

DEVI void phase3(const Args& a, int tid) {
    const u16* KV = (const u16*)(a.ws + WS_KV); u16* ST = (u16*)(a.ws + WS_ST); const float* DEC = (const float*)(a.ws + WS_DEC);
    for (int e = blockIdx.x * 512 + tid; e < NH * HV * HK; e += gridDim.x * 512) {
        const int h = e >> 15, rem = e & 32767, i = e & 127;
        float S = 0.f;
#pragma unroll 1
        for (int n0 = 0; n0 < NCH; n0 += 16) {
            float kv[16], dc[16];
#pragma unroll
            for (int k = 0; k < 16; ++k) { kv[k] = bf2f(__builtin_nontemporal_load(KV + (size_t)((n0 + k) * 4 + h) * 32768 + rem)); dc[k] = DEC[(size_t)((n0 + k) * 4 + h) * 128 + i]; }
#pragma unroll
            for (int k = 0; k < 16; ++k) { ST[(size_t)((n0 + k) * 4 + h) * 32768 + rem] = f2bf(S); S = dc[k] * S + kv[k]; }
        }
    }
    const float* E = (const float*)(a.ws + WS_S5E); const float* AL = (const float*)(a.ws + WS_S5AL); unsigned* HP = (unsigned*)(a.ws + WS_S5H);
    for (int e = blockIdx.x * 512 + tid; e < NG * SP; e += gridDim.x * 512) {
        const int g = e >> 6, p = e & 63;
        const float ar = AL[e * 2], ai = AL[e * 2 + 1];
        float hr = 0.f, hi = 0.f;
#pragma unroll 1
        for (int c0 = 0; c0 < 128; c0 += 16) {
            float2 ev[16];
#pragma unroll
            for (int k = 0; k < 16; ++k) ev[k] = *(const float2*)(E + (size_t)(g * 128 + c0 + k) * 128 + 2 * p);
#pragma unroll
            for (int k = 0; k < 16; ++k) {
                HP[(size_t)(g * 128 + c0 + k) * 64 + p] = pack2(hr, hi);
                const float nr = ar * hr - ai * hi + ev[k].x, ni = ar * hi + ai * hr + ev[k].y;
                hr = nr; hi = ni;
            }
        }
    }
}

DEVI void phase4(const Args& a, char* lds, int tid, int wid, int lane) {
    const u16* PROJ = (const u16*)(a.ws + WS_PROJ);
    u16* MIX = (u16*)(a.ws + WS_MIX);
#pragma unroll 1
    for (int u = blockIdx.x; u < 768; u += gridDim.x) {
        { int lq = lane; asm volatile("" : "+v"(lq)); lane = lq; tid = wid * 64 + lq; }
        const int fr = lane & 15, fq = lane >> 4;
        __syncthreads();
        if (u < 256) {
            const int g = u >> 2, cb = u & 3;
            char* U = lds; char* KTl = lds + 32 * USTR;
            s5_fill_U<2>((const u16*)(a.ws + WS_UG), g, cb, U, tid);
            {
                const char* srck = (const char*)((const u16*)(a.ws + WS_S5K) + (size_t)g * 16384);
#pragma unroll
                for (int k = 0; k < 4; ++k)
                    __builtin_amdgcn_global_load_lds((const unsigned*)(srck + (wid * 4 + k) * 1024 + lane * 16), (LAS unsigned*)(KTl + (wid * 4 + k) * 1024), 16, 0, 0);
            }
            WAIT_V0(); __syncthreads();
            f32x4 acc[8][2];
#pragma unroll
            for (int tt = 0; tt < 8; ++tt) { acc[tt][0] = f32x4{0.f, 0.f, 0.f, 0.f}; acc[tt][1] = f32x4{0.f, 0.f, 0.f, 0.f}; }
            const int sl = fq >> 1, m0 = (fq & 1) * 8, tb = wid >> 1, tp = wid & 1, t0 = 16 * tb + tp;
            const char* kb0 = KTl + ((t0 - sl) * 256 + fr * 16 + m0) * 2;
            const u16* HP = (const u16*)(a.ws + WS_S5H); const u16* VV = (const u16*)(a.ws + WS_S5V);
            bf16x8 pa0[2], pa1[2], pbv[2][8];
#pragma unroll
            for (int k2 = 0; k2 < 2; ++k2) {
                pa0[k2] = *(const bf16x8*)(HP + (size_t)(g * 128 + cb * 32 + fr) * 128 + k2 * 32 + fq * 8);
                pa1[k2] = *(const bf16x8*)(HP + (size_t)(g * 128 + cb * 32 + 16 + fr) * 128 + k2 * 32 + fq * 8);
#pragma unroll
                for (int tt = 0; tt < 8; ++tt)
                    pbv[k2][tt] = *(const bf16x8*)(VV + (size_t)(g * 1024 + (t0 + 2 * tt) * 16 + fr) * 128 + k2 * 32 + fq * 8);
            }
            bf16x8 win[8];
#pragma unroll
            for (int tt = 0; tt < 8; ++tt) win[tt] = *(const bf16x8*)(kb0 + tt * 1024);
#pragma unroll 1
            for (int jq = 0; jq < tb; ++jq) {
#pragma unroll
                for (int r = 0; r < 8; ++r) {
                    const int j = jq * 8 + r;
                    if (r > 0 || jq > 0) win[(8 - r) & 7] = *(const bf16x8*)(kb0 - j * 1024);
                    const bf16x8 a0 = *(const bf16x8*)(U + fr * USTR + (j * 32 + fq * 8) * 2);
                    const bf16x8 a1 = *(const bf16x8*)(U + (16 + fr) * USTR + (j * 32 + fq * 8) * 2);
#pragma unroll
                    for (int tt = 0; tt < 8; ++tt) {
                        acc[tt][0] = __builtin_amdgcn_mfma_f32_16x16x32_bf16(a0, win[(tt - r) & 7], acc[tt][0], 0, 0, 0);
                        acc[tt][1] = __builtin_amdgcn_mfma_f32_16x16x32_bf16(a1, win[(tt - r) & 7], acc[tt][1], 0, 0, 0);
                    }
                }
            }
#pragma unroll
            for (int r = 0; r < 8; ++r) {
                const int j = tb * 8 + r;
                if (r == 0 && tb > 0) win[0] = *(const bf16x8*)(kb0 - j * 1024);
                const bf16x8 a0 = *(const bf16x8*)(U + fr * USTR + (j * 32 + fq * 8) * 2);
                const bf16x8 a1 = *(const bf16x8*)(U + (16 + fr) * USTR + (j * 32 + fq * 8) * 2);
#pragma unroll
                for (int tt = r; tt < 8; ++tt) {
                    bf16x8 bf = win[(tt - r) & 7];
                    if (tt == r && tp == 0 && sl == 1) bf = bf16x8{0, 0, 0, 0, 0, 0, 0, 0};
                    acc[tt][0] = __builtin_amdgcn_mfma_f32_16x16x32_bf16(a0, bf, acc[tt][0], 0, 0, 0);
                    acc[tt][1] = __builtin_amdgcn_mfma_f32_16x16x32_bf16(a1, bf, acc[tt][1], 0, 0, 0);
                }
            }
#pragma unroll 1
            for (int kp = 0; kp < 2; ++kp) {
                if (kp == 1) {
#pragma unroll
                    for (int k2 = 0; k2 < 2; ++k2) {
                        const int ks = 2 + k2;
                        pa0[k2] = *(const bf16x8*)(HP + (size_t)(g * 128 + cb * 32 + fr) * 128 + ks * 32 + fq * 8);
                        pa1[k2] = *(const bf16x8*)(HP + (size_t)(g * 128 + cb * 32 + 16 + fr) * 128 + ks * 32 + fq * 8);
#pragma unroll
                        for (int tt = 0; tt < 8; ++tt)
                            pbv[k2][tt] = *(const bf16x8*)(VV + (size_t)(g * 1024 + (t0 + 2 * tt) * 16 + fr) * 128 + ks * 32 + fq * 8);
                    }
                }
#pragma unroll
                for (int k2 = 0; k2 < 2; ++k2)
#pragma unroll
                    for (int tt = 0; tt < 8; ++tt) {
                        acc[tt][0] = __builtin_amdgcn_mfma_f32_16x16x32_bf16(pa0[k2], pbv[k2][tt], acc[tt][0], 0, 0, 0);
                        acc[tt][1] = __builtin_amdgcn_mfma_f32_16x16x32_bf16(pa1[k2], pbv[k2][tt], acc[tt][1], 0, 0, 0);
                    }
            }
            const float dsk = a.in[12][g * 16 + fr];
            u16* Z = (u16*)(a.ws + WS_Z);
#pragma unroll
            for (int tt = 0; tt < 8; ++tt) {
                const int t = t0 + 2 * tt;
#pragma unroll
                for (int mf = 0; mf < 2; ++mf)
#pragma unroll
                    for (int j = 0; j < 4; ++j) {
                        const int cl = mf * 16 + fq * 4 + j;
                        const float uv = bf2f(*(const u16*)(U + cl * USTR + (t * 16 + fr) * 2));
                        const float y = acc[tt][mf][j] + dsk * uv;
                        Z[(size_t)((cb * 32 + cl) * 64 + t) * SW + g * 16 + fr] = f2bf(gelu_tanh(y));
                    }
            }
        } else {
            const int uu = u - 256, n = uu >> 2, h = uu & 3, t0 = n * 64;
            char* vT = lds;
            char* qI = lds + 32768;
            char* kI = lds + 49152;
            char* pI = lds + 65536;
            float* glr = (float*)(lds + 73728);
            float* tot = glr + 1024;
            float* rss = tot + 512;
            char* sT = lds + 81920;
            {
                const u16* STg = (const u16*)(a.ws + WS_ST) + (size_t)(n * 4 + h) * (HV * HK);
#pragma unroll
                for (int p = 0; p < 8; ++p) {
                    const int row = p * 32 + wid * 4 + (lane >> 4), chunk = ((lane & 15) ^ row) & 15;
                    __builtin_amdgcn_global_load_lds((const unsigned*)(STg + (size_t)row * 128 + chunk * 8), (LAS unsigned*)(sT + p * 8192 + wid * 1024), 16, 0, 2);
                }
            }
            float b[16], blast;
            gla_gate(a, n, h, tid, glr, tot, b, blast);
            const int ch = tid & 127, tq = tid >> 7;
            {
                const int qb0 = (tq * 4 + (ch >> 5)) * 1024 + (ch & 31) * 2, qb1 = qb0 ^ 32;
                const u16* src = PROJ + (size_t)(t0 + tq * 16) * PJ + h * 128 + ch;
#pragma unroll
                for (int tt = 0; tt < 16; ++tt) {
                    const float qv = bf2f(src[(size_t)tt * PJ]);
                    const float kv = bf2f(src[(size_t)tt * PJ + 512]);
                    const int off = (tt < 8 ? qb0 : qb1) + tt * 64;
                    *(u16*)(qI + off) = f2bf(qv * __expf(b[tt]));
                    *(u16*)(kI + off) = f2bf(kv * __expf(-b[tt]));
                }
            }
            gla_stage_vT(PROJ, t0, 1024 + h * 256, vT, tid);
            __syncthreads();
            {
                const int mf = wid & 3, nb = (wid >> 2) * 2;
                f32x4 s0 = {0.f, 0.f, 0.f, 0.f}, s1 = {0.f, 0.f, 0.f, 0.f};
#pragma unroll
                for (int ks = 0; ks < 4; ++ks) {
                    const bf16x8 af = *(const bf16x8*)(qI + lds_byte<4>(mf * 16 + fr, ks * 32 + fq * 8));
                    const bf16x8 b0 = *(const bf16x8*)(kI + lds_byte<4>(nb * 16 + fr, ks * 32 + fq * 8));
                    const bf16x8 b1 = *(const bf16x8*)(kI + lds_byte<4>((nb + 1) * 16 + fr, ks * 32 + fq * 8));
                    s0 = __builtin_amdgcn_mfma_f32_16x16x32_bf16(af, b0, s0, 0, 0, 0);
                    s1 = __builtin_amdgcn_mfma_f32_16x16x32_bf16(af, b1, s1, 0, 0, 0);
                }
#pragma unroll
                for (int j = 0; j < 4; ++j) {
                    const int t = mf * 16 + fq * 4 + j, sA = nb * 16 + fr, sB = sA + 16;
                    *(u16*)(pI + lds_byte<2>(t, sA)) = f2bf(sA <= t ? s0[j] : 0.f);
                    *(u16*)(pI + lds_byte<2>(t, sB)) = f2bf(sB <= t ? s1[j] : 0.f);
                }
            }
            __syncthreads();
            const int mf = wid & 3, nh = wid >> 2;
            f32x4 acc[8];
#pragma unroll
            for (int nn = 0; nn < 8; ++nn) acc[nn] = f32x4{0.f, 0.f, 0.f, 0.f};
#pragma unroll
            for (int ks = 0; ks < 2; ++ks) {
                const bf16x8 af = *(const bf16x8*)(pI + lds_byte<2>(mf * 16 + fr, ks * 32 + fq * 8));
#pragma unroll
                for (int nn = 0; nn < 8; ++nn) {
                    const bf16x8 bf = *(const bf16x8*)(vT + lds_byte<2>(nh * 128 + nn * 16 + fr, ks * 32 + fq * 8));
                    acc[nn] = __builtin_amdgcn_mfma_f32_16x16x32_bf16(af, bf, acc[nn], 0, 0, 0);
                }
            }
#pragma unroll
            for (int ks = 0; ks < 4; ++ks) {
                const bf16x8 af = *(const bf16x8*)(qI + lds_byte<4>(mf * 16 + fr, ks * 32 + fq * 8));
#pragma unroll
                for (int nn = 0; nn < 8; ++nn) {
                    const bf16x8 bf = *(const bf16x8*)(sT + (nh * 128 + nn * 16 + fr) * 256 + ((((ks * 4 + fq) ^ fr) & 15) << 4));
                    acc[nn] = __builtin_amdgcn_mfma_f32_16x16x32_bf16(af, bf, acc[nn], 0, 0, 0);
                }
            }
            u16 rraw[4][8];
#pragma unroll
            for (int j = 0; j < 4; ++j)
#pragma unroll
                for (int nn = 0; nn < 8; ++nn) rraw[j][nn] = PROJ[(size_t)(t0 + mf * 16 + fq * 4 + j) * PJ + 2048 + h * 256 + nh * 128 + nn * 16 + fr];
            float ss[4];
#pragma unroll
            for (int j = 0; j < 4; ++j) {
                float s = 0.f;
#pragma unroll
                for (int nn = 0; nn < 8; ++nn) s += acc[nn][j] * acc[nn][j];
                ss[j] = sum16(s);
            }
            if (fr == 0) {
#pragma unroll
                for (int j = 0; j < 4; ++j) rss[nh * 64 + mf * 16 + fq * 4 + j] = ss[j];
            }
            __syncthreads();
            const float* gn = a.in[5];
#pragma unroll
            for (int j = 0; j < 4; ++j) {
                const int t = mf * 16 + fq * 4 + j;
                const float rstd = rsqrtf((rss[t] + rss[64 + t]) * (1.0f / 256.0f) + EPS);
#pragma unroll
                for (int nn = 0; nn < 8; ++nn) {
                    const int jc = nh * 128 + nn * 16 + fr;
                    const float rv = bf2f(rraw[j][nn]);
                    const float o = acc[nn][j] * rstd * gn[jc] * (rv * sigmoidf_(rv));
                    MIX[(size_t)(t0 + t) * D + h * 256 + jc] = f2bf(o);
                }
            }
        }
    }
}

DEVI void phase5(const Args& a, char* lds, int tid, int wid, int lane) {
    extern __shared__ __attribute__((aligned(16))) char smem_pg8[];
    if (blockIdx.x >= 128) {
        const int c_lo = 8192 + (blockIdx.x - 128) * 22;
        convert_range(a, lds, c_lo, c_lo + 22, tid, wid, lane);
    } else {
        pg8::Gemm g; g.A = a.ws + WS_Z; g.Bt = a.ws + WS_GLUT; g.ld = SW; g.K = SW;
        pg8::StaticOrder S; S.init(T, SW, 128, (int)blockIdx.x);
        EpiGlu E; E.Z = (const u16*)(a.ws + WS_Z); E.MIX = (u16*)(a.ws + WS_MIX); E.SSQ = (float*)(a.ws + WS_SSQ); E.gbias = a.in[15]; E.sng = a.in[16];
        pg8::gemm_phase((PG8_LAS unsigned char*)(smem_pg8 + 1024), g, S, E);
        const int c_lo = 11008 + blockIdx.x * 6; convert_range(a, lds, c_lo, c_lo + 6, tid, wid, lane);
    }
    convert_pool(a, lds, 1, 11776, 13312, tid, wid, lane);
}

DEVI void phase6(const Args& a, char* lds, int tid, int wid, int lane) {
    extern __shared__ __attribute__((aligned(16))) char smem_pg8[];
    const int c6_lo = 13312 + blockIdx.x * 11, c6_hi = c6_lo + 11;
    if ((blockIdx.x >> 3) & 1) convert_range(a, lds, c6_lo, c6_hi, tid, wid, lane);
    if (blockIdx.x < 256) {
        pg8::Gemm g; g.A = a.ws + WS_MIX; g.Bt = a.ws + WS_WOUTT; g.ld = D; g.K = 1024;
        pg8::SplitKOrder S; S.init(T, D, 256, (int)blockIdx.x); S.khalf = 2048;
        EpiOut E; E.x = a.in[0]; E.H1 = (u16*)(a.ws + WS_H1); E.SSQ = (const float*)(a.ws + WS_SSQ);
        pg8::gemm_phase((PG8_LAS unsigned char*)(smem_pg8 + 1024), g, S, E);
    }
    if (!((blockIdx.x >> 3) & 1)) convert_range(a, lds, c6_lo, c6_hi, tid, wid, lane);
    convert_pool(a, lds, 2, 16128, 16384, tid, wid, lane);
}

DEVI void phase7(const Args& a, char* lds, int tid, int wid, int lane) {
    const u16* H1 = (const u16*)(a.ws + WS_H1);
    const float* g2 = a.in[18]; const float* rw = a.in[19]; const float* rb = a.in[20];
    int* CNT = (int*)(a.ws + WS_CNT); int* LTOK = (int*)(a.ws + WS_LTOK); float* LGATE = (float*)(a.ws + WS_LGATE); int* TSLOT = (int*)(a.ws + WS_TSLOT);
    float* hn = (float*)lds;
    float* red = hn + 8 * 2048;
    float* lg = red + 8 * 8 * 32;
    for (int u = blockIdx.x; u < 256; u += gridDim.x) {
#pragma unroll 1
        for (int ps = 0; ps < 4; ++ps) {
            const int tok0 = u * 32 + ps * 8;
            { int lq = lane; asm volatile("" : "+v"(lq)); lane = lq; tid = wid * 64 + lq; }
            __syncthreads();
            {
                const int tl = wid, tok = tok0 + tl;
                f32x4 xv[8]; float ss = 0.f;
#pragma unroll
                for (int i = 0; i < 8; ++i) { const uint2 hv2 = *(const uint2*)(H1 + (size_t)tok * D + 256 * i + 4 * lane); xv[i] = f32x4{bflo(hv2.x), bfhi(hv2.x), bflo(hv2.y), bfhi(hv2.y)};
#pragma unroll
                    for (int c = 0; c < 4; ++c) ss += xv[i][c] * xv[i][c]; }
                ss = wave_sum(ss);
                const float r = rsqrtf(ss * (1.0f / D) + EPS);
#pragma unroll
                for (int i = 0; i < 8; ++i) {
                    const f32x4 g = *(const f32x4*)(g2 + 256 * i + 4 * lane);
                    f32x4 o;
#pragma unroll
                    for (int c = 0; c < 4; ++c) o[c] = xv[i][c] * r * g[c];
                    *(f32x4*)(hn + tl * 2048 + 256 * i + 4 * lane) = o;
                }
            }
            __syncthreads();
            {
                const int e = tid & 31, dsl = tid >> 5;
                float acc[8];
#pragma unroll
                for (int k = 0; k < 8; ++k) acc[k] = 0.f;
#pragma unroll 1
                for (int d16 = 0; d16 < 8; ++d16) {
                    float w[16];
#pragma unroll
                    for (int q = 0; q < 16; ++q) w[q] = rw[(dsl * 128 + d16 * 16 + q) * 32 + e];
#pragma unroll
                    for (int q4 = 0; q4 < 4; ++q4) {
                        const int d = dsl * 128 + d16 * 16 + q4 * 4;
#pragma unroll
                        for (int k = 0; k < 8; ++k) {
                            const f32x4 hv = *(const f32x4*)(hn + k * 2048 + d);
                            acc[k] += hv[0] * w[q4 * 4] + hv[1] * w[q4 * 4 + 1] + hv[2] * w[q4 * 4 + 2] + hv[3] * w[q4 * 4 + 3];
                        }
                    }
                }
#pragma unroll
                for (int k = 0; k < 8; ++k) { acc[k] += __shfl_xor(acc[k], 32); }
                if (lane < 32) {
#pragma unroll
                    for (int k = 0; k < 8; ++k) red[(wid * 8 + k) * 32 + e] = acc[k];
                }
            }
            __syncthreads();
            if (tid < 256) {
                const int k = tid >> 5, e = tid & 31;
                float s = rb[e];
#pragma unroll
                for (int w = 0; w < 8; ++w) s += red[(w * 8 + k) * 32 + e];
                lg[k * 32 + e] = s;
            }
            __syncthreads();
            {
                const int tok = tok0 + wid, e = lane & 31;
                float x = lg[wid * 32 + e];
                float v[4]; int id[4];
#pragma unroll
                for (int j = 0; j < 4; ++j) {
                    float bv = x; int bi = e;
#pragma unroll
                    for (int o = 16; o >= 1; o >>= 1) {
                        const float ov = __shfl_xor(bv, o); const int oi = __shfl_xor(bi, o);
                        if (ov > bv || (ov == bv && oi < bi)) { bv = ov; bi = oi; }
                    }
                    v[j] = bv; id[j] = bi;
                    if (e == bi) x = -3.0e38f;
                }
                float ex[4], sum = 0.f;
#pragma unroll
                for (int j = 0; j < 4; ++j) { ex[j] = __expf(v[j] - v[0]); sum += ex[j]; }
                const float inv = 1.0f / sum;
                int ri = 0;
                if (lane < 4) {
                    const int myid = lane == 0 ? id[0] : lane == 1 ? id[1] : lane == 2 ? id[2] : id[3];
                    const float myg = (lane == 0 ? ex[0] : lane == 1 ? ex[1] : lane == 2 ? ex[2] : ex[3]) * inv;
                    const int slot = atomicAdd(&CNT[myid], 1);
                    ri = myid * CAP + slot;
                    LTOK[ri] = tok;
                    LGATE[ri] = myg;
                    TSLOT[tok * 4 + lane] = ri;
                }
                {
                    unsigned char* XG = a.ws + WS_XG;
                    const int r0 = __builtin_amdgcn_readlane(ri, 0), r1 = __builtin_amdgcn_readlane(ri, 1), r2 = __builtin_amdgcn_readlane(ri, 2), r3 = __builtin_amdgcn_readlane(ri, 3);
#pragma unroll
                    for (int i = 0; i < 8; ++i) {
                        const f32x4 o = *(const f32x4*)(hn + wid * 2048 + 256 * i + 4 * lane);
                        const unsigned pk = cvt4_fp8(o[0] * 16.f, o[1] * 16.f, o[2] * 16.f, o[3] * 16.f);
                        const size_t co = 256 * i + 4 * lane;
                        *(unsigned*)(XG + (size_t)r0 * D + co) = pk; *(unsigned*)(XG + (size_t)r1 * D + co) = pk;
                        *(unsigned*)(XG + (size_t)r2 * D + co) = pk; *(unsigned*)(XG + (size_t)r3 * D + co) = pk;
                    }
                }
            }
        }
    }
}

struct MoeTab { int cnt[32]; int off[33]; int ord[32]; int xe[4]; int xub[5]; };
DEVI void moe_tables(const Args& a, MoeTab* tb, int tid, int ntn) {
    __syncthreads();
    if (tid < 32) tb->cnt[tid] = ((const int*)(a.ws + WS_CNT))[tid];
    __syncthreads();
    if (tid < 32) {
        const int me = (tb->cnt[tid] + 255) >> 8;
        int rank = 0, o = 0;
        for (int k = 0; k < 32; ++k) {
            const int c = tb->cnt[k], mk = (c + 255) >> 8;
            rank += (mk > me || (mk == me && k < tid)) ? 1 : 0;
            o += (k < tid) ? c : 0;
        }
        tb->ord[rank] = tid; tb->off[tid] = o;
        if (tid == 31) tb->off[32] = o + tb->cnt[31];
    }
    __syncthreads();
    if (tid == 0) {
        const int xcd = blockIdx.x & 7;
        int ub = 0;
        for (int r = 0; r < 4; ++r) {
            const int e = tb->ord[r * 8 + ((r & 1) ? 7 - xcd : xcd)];
            tb->xe[r] = e; tb->xub[r] = ub;
            ub += ((tb->cnt[e] + 255) >> 8) * ntn;
        }
        tb->xub[4] = ub;
    }
    __syncthreads();
}

DEVI void moe_retarget(const Args& a, MoeTab* tb, int tid, int ntn, int phase) {
    if (a.ph_lo >= phase) { moe_tables(a, tb, tid, ntn); return; }
    __syncthreads();
    if (tid == 0) {
        int ub = 0;
        for (int r = 0; r < 4; ++r) { const int e = tb->xe[r]; tb->xub[r] = ub; ub += ((tb->cnt[e] + 255) >> 8) * ntn; }
        tb->xub[4] = ub;
    }
    __syncthreads();
}

struct MoeUnit { int e, nt, r0, rows, grow0, cnt; };
DEVI MoeUnit moe_decode(const MoeTab* tb, int u) {
    int k = 0;
    for (int q = 1; q < 4; ++q) if (u >= tb->xub[q]) k = q;
    MoeUnit d; d.e = tb->xe[k];
    d.cnt = tb->cnt[d.e];
    const int mte = (d.cnt + 255) >> 8, ul = u - tb->xub[k];
    d.nt = ul / mte; const int mi = ul - d.nt * mte;
    d.r0 = mi * 256; d.rows = min(256, d.cnt - d.r0); d.grow0 = tb->off[d.e] + d.r0;
    return d;
}

struct MoeUnit;
namespace pg8 {
struct MU { const char* A; const char* B0; const char* B1; int e, nt, r0, rows, grow0, cnt; };
template <int SCALE_A, int SCALE_B, class Epi, class Sched>
DEVI void f8_gemm_phase(PG8_LAS unsigned char* lds, const Sched& S, const Epi& E) {
    const int tid = threadIdx.x, wid = __builtin_amdgcn_readfirstlane(tid >> 6), lane = tid & 63, wr = wid >> 2, wc = wid & 3, fr = lane & 15, fq = lane >> 4;
    constexpr int nt = 16;
    unsigned voffA[2], voffB[2];
#pragma unroll
    for (int i = 0; i < 2; ++i) { int R, C; stage_rc(tid * 16 + i * 8192, R, C); voffA[i] = (unsigned)(R * 1024 + C) * 2u;
        const int L = wid * 1024 + i * 8192 + lane * 16, q = L >> 9, p0 = (lane & 31) * 4, pu = (p0 - 16 * ((q >> 2) & 3)) & 127;
        voffB[i] = (unsigned)(q * 512 + ((pu & ~31) + perm32(pu & 31)) * 4); }
    const size_t kstep = 128, bstep = 16384, hstep = (size_t)HALF * 2048;
    const unsigned ldsw = (unsigned)wid * 1024u;
    const int aoff = lds_byte(wr * 64 + fr, fq * 8);
    int boffn[2];
#pragma unroll
    for (int n = 0; n < 2; ++n) boffn[n] = (4 * fq) * 512 + ((wc * 32 + 16 * n + fr + 16 * fq) & 127) * 4;
#define PG8_SA(b, h) (((b) * 2 + (h)) * HTB)
#define PG8_SB(b, h) ((4 + (b) * 2 + (h)) * HTB)
#define PG8_STAGE(bufoff, gbase, voff) do { _Pragma("unroll") for (int _i = 0; _i < 2; ++_i) \
        __builtin_amdgcn_global_load_lds((const unsigned*)((const char*)(gbase) + (voff)[_i]), (PG8_LAS unsigned*)(lds + (bufoff) + ldsw + _i * 8192), 16, 0, 0); } while (0)
#define PG8_LDA(dst, b, h) do { _Pragma("unroll") for (int m = 0; m < 4; ++m) { const i32x4 _x = *(const PG8_LAS i32x4*)(lds + PG8_SA(b, h) + aoff + m * 2048), _y = *(const PG8_LAS i32x4*)(lds + PG8_SA(b, h) + aoff + m * 2048 + 1024); \
        dst[m][0] = _x[0]; dst[m][1] = _x[1]; dst[m][2] = _x[2]; dst[m][3] = _x[3]; dst[m][4] = _y[0]; dst[m][5] = _y[1]; dst[m][6] = _y[2]; dst[m][7] = _y[3]; } } while (0)
#define PG8_LDB(dst, b, h) do { _Pragma("unroll") for (int n = 0; n < 2; ++n) _Pragma("unroll") for (int d = 0; d < 8; ++d) dst[n][d] = *(const PG8_LAS int*)(lds + PG8_SB(b, h) + boffn[n] + (d & 3) * 512 + (d >> 2) * 8192); } while (0)
#define PG8_MMA(ai, bj, At, Bt) do { __builtin_amdgcn_s_setprio(1); _Pragma("unroll") for (int m = 0; m < 4; ++m) _Pragma("unroll") for (int n = 0; n < 2; ++n) \
        acc[ai][bj][m][n] = __builtin_amdgcn_mfma_scale_f32_16x16x128_f8f6f4(Bt[n], At[m], acc[ai][bj][m][n], 0, 0, 0, SCALE_B, 0, SCALE_A); __builtin_amdgcn_s_setprio(0); } while (0)
#define PG8_WAIT_V(n) asm volatile("s_waitcnt vmcnt(" #n ")" ::: "memory")
#define PG8_WAIT_L(n) asm volatile("s_waitcnt lgkmcnt(" #n ")" ::: "memory")
#define PG8_BAR __builtin_amdgcn_s_barrier()
#define PG8_SCHED __builtin_amdgcn_sched_barrier(0)
#define PG8_ZERO() do { _Pragma("unroll") for (int a_ = 0; a_ < 2; ++a_) _Pragma("unroll") for (int b_ = 0; b_ < 2; ++b_) _Pragma("unroll") for (int m_ = 0; m_ < 4; ++m_) _Pragma("unroll") for (int n_ = 0; n_ < 2; ++n_) \
        acc[a_][b_][m_][n_] = (f32x4){0.f, 0.f, 0.f, 0.f}; } while (0)
    MU cur, nxt; int ui = 0;
    if (!S.next(0, cur)) return;
    f32x4 acc[2][2][4][2];
    i32x8 At[4], B0[2], B1[2];
    PG8_LAS unsigned char* side = lds + 8 * HTB;
    int sc = 0; E.prefetch(cur, side, wid, lane);
    const char* cA = cur.A; const char* cB0 = cur.B0; const char* cB1 = cur.B1;
    PG8_STAGE(PG8_SB(0, 0), cB0, voffB); PG8_STAGE(PG8_SA(0, 0), cA, voffA); PG8_STAGE(PG8_SB(0, 1), cB1, voffB); PG8_STAGE(PG8_SA(0, 1), cA + hstep, voffA);
    if (wr == 1) PG8_BAR;
    PG8_WAIT_V(4); PG8_BAR;
    E.init(acc, side, wc, fq); PG8_WAIT_L(0);
    PG8_STAGE(PG8_SB(1, 0), cB0 + bstep, voffB); PG8_STAGE(PG8_SA(1, 0), cA + kstep, voffA); PG8_STAGE(PG8_SB(1, 1), cB1 + bstep, voffB);
    PG8_WAIT_V(6); PG8_BAR;
    for (;;) {
        const bool has_next = S.next(ui + 1, nxt);
        const int sn = sc == 2 ? 0 : sc + 1;
        if (has_next) { int lz = lane; asm volatile("" : "+v"(lz)); E.prefetch(nxt, side + sn * 2048, wid, lz); }
        const char* nA = has_next ? nxt.A : cA; const char* nB0 = has_next ? nxt.B0 : cB0; const char* nB1 = has_next ? nxt.B1 : cB1;
#pragma unroll 1
        for (int t = 0; t < nt; t += 2) {
            const bool last = (t == nt - 2);
            const char* a1 = cA + (size_t)(t + 1) * kstep;
            const char* a2 = last ? nA : cA + (size_t)(t + 2) * kstep;
            const char* b20 = last ? nB0 : cB0 + (size_t)(t + 2) * bstep; const char* b21 = last ? nB1 : cB1 + (size_t)(t + 2) * bstep;
            const char* a3 = a2 + kstep; const char* b30 = b20 + bstep; const char* b31 = b21 + bstep;
            PG8_LDB(B0, 0, 0); PG8_SCHED; PG8_LDA(At, 0, 0); PG8_STAGE(PG8_SA(1, 1), a1 + hstep, voffA);
            PG8_WAIT_L(8); PG8_BAR; PG8_WAIT_L(0); PG8_MMA(0, 0, At, B0); PG8_BAR; PG8_SCHED;
            PG8_LDB(B1, 0, 1); PG8_STAGE(PG8_SB(0, 0), b20, voffB);
            PG8_BAR; PG8_WAIT_L(0); PG8_MMA(0, 1, At, B1); PG8_BAR;
            PG8_LDA(At, 0, 1); PG8_STAGE(PG8_SA(0, 0), a2, voffA);
            PG8_BAR; PG8_WAIT_L(0); PG8_MMA(1, 0, At, B0); PG8_BAR; PG8_SCHED;
            PG8_STAGE(PG8_SB(0, 1), b21, voffB);
            PG8_WAIT_V(6); PG8_BAR; PG8_MMA(1, 1, At, B1); PG8_BAR;
            PG8_LDB(B0, 1, 0); PG8_SCHED; PG8_LDA(At, 1, 0); PG8_STAGE(PG8_SA(0, 1), a2 + hstep, voffA);
            PG8_WAIT_L(8); PG8_BAR; PG8_WAIT_L(0); PG8_MMA(0, 0, At, B0); PG8_BAR; PG8_SCHED;
            PG8_LDB(B1, 1, 1); PG8_STAGE(PG8_SB(1, 0), b30, voffB);
            PG8_BAR; PG8_WAIT_L(0); PG8_MMA(0, 1, At, B1); PG8_BAR;
            PG8_LDA(At, 1, 1); PG8_STAGE(PG8_SA(1, 0), a3, voffA);
            PG8_BAR; PG8_WAIT_L(0); PG8_MMA(1, 0, At, B0); PG8_BAR; PG8_SCHED;
            PG8_STAGE(PG8_SB(1, 1), b31, voffB);
            PG8_WAIT_V(6); PG8_BAR; PG8_MMA(1, 1, At, B1); PG8_BAR;
        }
        int lz = lane; asm volatile("" : "+v"(lz));
        E(acc, cur, side + sc * 2048, wr, wc, lz & 15, lz >> 4);
        if (!has_next) break;
        E.init(acc, side + sn * 2048, wc, lz >> 4); PG8_WAIT_L(0);
        sc = sn; cur = nxt; cA = nA; cB0 = nB0; cB1 = nB1; ++ui;
    }
    PG8_WAIT_V(0);
    if (wr == 0) PG8_BAR;
    PG8_BAR;
#undef PG8_SA
#undef PG8_SB
#undef PG8_STAGE
#undef PG8_LDA
#undef PG8_LDB
#undef PG8_MMA
#undef PG8_WAIT_V
#undef PG8_WAIT_L
#undef PG8_BAR
#undef PG8_SCHED
#undef PG8_ZERO
}
}

struct MoeSched {
    const MoeTab* tb; int nun, nper, u0; const char* Ab; const char* Wb; bool first;
    DEVI bool next(int i, pg8::MU& m) const {
        const int u = u0 + i * nper; if (u >= nun) return false;
        const MoeUnit d = moe_decode(tb, u);
        m.e = __builtin_amdgcn_readfirstlane(d.e); m.nt = __builtin_amdgcn_readfirstlane(d.nt); m.r0 = __builtin_amdgcn_readfirstlane(d.r0);
        m.rows = __builtin_amdgcn_readfirstlane(d.rows); m.grow0 = __builtin_amdgcn_readfirstlane(d.grow0); m.cnt = __builtin_amdgcn_readfirstlane(d.cnt);
        if (first) { m.A = Ab + ((size_t)m.e * CAP + m.r0) * D;
            m.B0 = Wb + (size_t)((m.e * 32 + m.nt) * 512) * 512; m.B1 = m.B0 + (size_t)(16 * 512) * 512; }
        else { m.A = Ab + (size_t)m.grow0 * FF;
            m.B0 = Wb + (size_t)((m.e * 16 + m.nt * 2) * 512) * 512; m.B1 = m.B0 + (size_t)512 * 512; }
        return true;
    }
};
typedef float f32x2 __attribute__((ext_vector_type(2)));
struct EpiMoe1 {
    unsigned char* ACT; const float* b1;
    DEVI void prefetch(const pg8::MU& u, PG8_LAS unsigned char* side, int wid, int lane) const {
        if (wid == 0) __builtin_amdgcn_global_load_lds((const unsigned*)(b1 + (size_t)u.e * 4096 + u.nt * 128 + (lane >> 5) * 2048 + 4 * (lane & 31)), (PG8_LAS unsigned*)side, 16, 0, 0);
    }
    DEVI void init(f32x4 (&acc)[2][2][4][2], PG8_LAS unsigned char* side, int wc, int fq) const {
#pragma unroll
        for (int bj = 0; bj < 2; ++bj)
#pragma unroll
            for (int n = 0; n < 2; ++n) { const f32x4 b = *(const PG8_LAS f32x4*)(side + bj * 512 + (wc * 32 + 8 * fq + 4 * n) * 4);
#pragma unroll
                for (int ai = 0; ai < 2; ++ai)
#pragma unroll
                    for (int m = 0; m < 4; ++m) acc[ai][bj][m][n] = b; }
    }
    DEVI void operator()(f32x4 (&acc)[2][2][4][2], const pg8::MU& u, PG8_LAS unsigned char* side, int wr, int wc, int fr, int fq) const {
#pragma unroll
        for (int ai = 0; ai < 2; ++ai)
#pragma unroll
            for (int m = 0; m < 4; ++m) {
                const int row = ai * 128 + wr * 64 + m * 16 + fr;
                const int orow = (row < u.rows) ? u.grow0 + row : T * 4 + row;
                unsigned w[2];
#pragma unroll
                for (int n = 0; n < 2; ++n) {
                    const f32x4 g4 = acc[ai][0][m][n], l4 = acc[ai][1][m][n];
                    f32x2 av[2];
#pragma unroll
                    for (int h = 0; h < 2; ++h) {
                        f32x2 gl, ln;
                        gl.x = __builtin_amdgcn_fmed3f(g4[2 * h], -3.0e38f, 7.0f); gl.y = __builtin_amdgcn_fmed3f(g4[2 * h + 1], -3.0e38f, 7.0f);
                        ln.x = __builtin_amdgcn_fmed3f(l4[2 * h], -7.0f, 7.0f); ln.y = __builtin_amdgcn_fmed3f(l4[2 * h + 1], -7.0f, 7.0f);
                        const f32x2 ea = gl * (-1.702f * 1.4426950408889634f);
                        f32x2 e; e.x = __builtin_amdgcn_exp2f(ea.x); e.y = __builtin_amdgcn_exp2f(ea.y);
                        const f32x2 d = e + 1.0f;
                        f32x2 r; r.x = __builtin_amdgcn_rcpf(d.x); r.y = __builtin_amdgcn_rcpf(d.y);
                        av[h] = (gl * r) * (ln * 4.0f + 4.0f);
                    }
                    w[n] = cvt4_fp8(av[0].x, av[0].y, av[1].x, av[1].y);
                }
                uint2 pk; pk.x = w[0]; pk.y = w[1];
                *(uint2*)(ACT + (size_t)orow * FF + u.nt * 128 + wc * 32 + 8 * fq) = pk;
            }
    }
};
struct EpiMoe2 {
    unsigned char* Y8; float* YSC; const float* b2; const float* LGATE; PG8_LAS float* wmax;
    DEVI void prefetch(const pg8::MU& u, PG8_LAS unsigned char* side, int wid, int lane) const {
        if (wid == 0) __builtin_amdgcn_global_load_lds((const unsigned*)(b2 + (size_t)u.e * D + u.nt * 256 + 4 * lane), (PG8_LAS unsigned*)side, 16, 0, 0);
        if (wid == 1) __builtin_amdgcn_global_load_lds((const unsigned*)(LGATE + (size_t)u.e * CAP + u.r0 + 4 * lane), (PG8_LAS unsigned*)(side + 1024), 16, 0, 0);
    }
    DEVI void init(f32x4 (&acc)[2][2][4][2], PG8_LAS unsigned char* side, int wc, int fq) const {
#pragma unroll
        for (int bj = 0; bj < 2; ++bj)
#pragma unroll
            for (int n = 0; n < 2; ++n) { const f32x4 b = *(const PG8_LAS f32x4*)(side + (bj * 128 + wc * 32 + 8 * fq + 4 * n) * 4);
#pragma unroll
                for (int ai = 0; ai < 2; ++ai)
#pragma unroll
                    for (int m = 0; m < 4; ++m) acc[ai][bj][m][n] = b; }
    }
    DEVI void operator()(f32x4 (&acc)[2][2][4][2], const pg8::MU& u, PG8_LAS unsigned char* side, int wr, int wc, int fr, int fq) const {
#pragma unroll
        for (int ai = 0; ai < 2; ++ai)
#pragma unroll
            for (int m = 0; m < 4; ++m) {
                const int row = ai * 128 + wr * 64 + m * 16 + fr;
                const float gt = *(const PG8_LAS float*)(side + 1024 + row * 4);
                float mx = 0.f;
#pragma unroll
                for (int bj = 0; bj < 2; ++bj)
#pragma unroll
                    for (int n = 0; n < 2; ++n) { acc[ai][bj][m][n] *= gt;
#pragma unroll
                        for (int c = 0; c < 4; ++c) mx = fmaxf(mx, fabsf(acc[ai][bj][m][n][c])); }
                mx = fmaxf(mx, __shfl_xor(mx, 16)); mx = fmaxf(mx, __shfl_xor(mx, 32));
                if (fq == 0) wmax[row * 4 + wc] = mx;
            }
        asm volatile("s_waitcnt lgkmcnt(0)" ::: "memory");
        __builtin_amdgcn_s_barrier();
        asm volatile("" ::: "memory");
#pragma unroll
        for (int ai = 0; ai < 2; ++ai)
#pragma unroll
            for (int m = 0; m < 4; ++m) {
                const int row = ai * 128 + wr * 64 + m * 16 + fr;
                const f32x4 w4 = *(const PG8_LAS f32x4*)(wmax + row * 4);
                const float rmax = fmaxf(fmaxf(w4[0], w4[1]), fmaxf(w4[2], w4[3]));
                const float inv = rmax > 0.f ? 440.0f * __builtin_amdgcn_rcpf(rmax) : 0.f;
                const int orow = (row < u.rows) ? u.grow0 + row : T * 4 + row;
                unsigned char* dst = Y8 + (size_t)orow * D + u.nt * 256 + wc * 32 + 8 * fq;
#pragma unroll
                for (int bj = 0; bj < 2; ++bj) {
                    const f32x4 v0 = acc[ai][bj][m][0] * inv, v1 = acc[ai][bj][m][1] * inv;
                    uint2 pk; pk.x = cvt4_fp8(v0[0], v0[1], v0[2], v0[3]); pk.y = cvt4_fp8(v1[0], v1[1], v1[2], v1[3]);
                    *(uint2*)(dst + bj * 128) = pk;
                }
                if (wc == 0 && fq == 0) YSC[(size_t)orow * 8 + u.nt] = rmax * (1.0f / 440.0f);
            }
    }
};
DEVI void phase8(const Args& a, char* lds, MoeTab* tb, int tid, int wid, int lane) {
    extern __shared__ __attribute__((aligned(16))) char smem_pg8[];
    moe_tables(a, tb, tid, 16);
    const int nun = tb->xub[4], nper = gridDim.x >> 3;
    const int u = blockIdx.x >> 3;
    const int c_lo = 16384 + blockIdx.x * 30, c_hi = c_lo + 30;
    const int nb = u < nun ? (nun - u + nper - 1) / nper : 0;
    const int kc = (u * (nb + 1)) / nper;
#pragma unroll 1
    for (int part = 0; part < 2; ++part) {
        const int ulo = part == 0 ? u : u + kc * nper, uhi = part == 0 ? min(nun, u + kc * nper) : nun;
        if (ulo < uhi) {
            MoeSched S; S.tb = tb; S.nun = uhi; S.nper = nper; S.u0 = ulo; S.Ab = (const char*)(a.ws + WS_XG); S.Wb = (const char*)(a.ws + WS_W1T); S.first = true;
            EpiMoe1 E; E.ACT = a.ws + WS_ACT; E.b1 = a.in[22];
            pg8::f8_gemm_phase<0x7b7b7b7b, 0x77777777>((PG8_LAS unsigned char*)(smem_pg8 + 1024), S, E);
        }
        if (part == 0) convert_range(a, lds, c_lo, c_hi, tid, wid, lane);
    }
    convert_pool(a, lds, 3, 24064, 24576, tid, wid, lane);
}

DEVI void phase9(const Args& a, char* lds, MoeTab* tb, int tid, int wid, int lane) {
    extern __shared__ __attribute__((aligned(16))) char smem_pg8[];
    moe_retarget(a, tb, tid, 8, 9);
    const int nun = tb->xub[4], nper = gridDim.x >> 3;
    const int u = blockIdx.x >> 3;
    if (u >= nun) return;
    MoeSched S; S.tb = tb; S.nun = nun; S.nper = nper; S.u0 = u; S.Ab = (const char*)(a.ws + WS_ACT); S.Wb = (const char*)(a.ws + WS_W2T); S.first = false;
    EpiMoe2 E; E.Y8 = a.ws + WS_Y; E.YSC = (float*)(a.ws + WS_YSC); E.b2 = a.in[24]; E.LGATE = (const float*)(a.ws + WS_LGATE);
    E.wmax = (PG8_LAS float*)(smem_pg8 + 1024 + 131072 + 8192);
    pg8::f8_gemm_phase<0x7d7d7d7d, 0x77777777>((PG8_LAS unsigned char*)(smem_pg8 + 1024), S, E);
}

DEVI void phase10(const Args& a, MoeTab* tb, int tid, int wid, int lane) {
    const u16* H1 = (const u16*)(a.ws + WS_H1); const unsigned char* Y8 = a.ws + WS_Y; const float* YSC = (const float*)(a.ws + WS_YSC); const int* TSLOT = (const int*)(a.ws + WS_TSLOT);
    const float* fg = a.in[25];
    if (a.ph_lo >= 10) moe_tables(a, tb, tid, 8);
    for (int tok = blockIdx.x * 8 + wid; tok < T; tok += gridDim.x * 8) {
        int rowi[4];
#pragma unroll
        for (int j = 0; j < 4; ++j) { const int ts = TSLOT[tok * 4 + j]; rowi[j] = tb->off[ts >> 13] + (ts & (CAP - 1)); }
        f32x4 ysc[4][2];
#pragma unroll
        for (int j = 0; j < 4; ++j) { ysc[j][0] = *(const f32x4*)(YSC + (size_t)rowi[j] * 8); ysc[j][1] = *(const f32x4*)(YSC + (size_t)rowi[j] * 8 + 4); }
        f32x4 hv[8]; float ss = 0.f;
#pragma unroll
        for (int i = 0; i < 8; ++i) {
            { typedef unsigned u32x2w __attribute__((ext_vector_type(2))); const u32x2w h2 = __builtin_nontemporal_load((const u32x2w*)(H1 + (size_t)tok * D + 256 * i + 4 * lane)); hv[i] = f32x4{bflo(h2.x), bfhi(h2.x), bflo(h2.y), bfhi(h2.y)}; }
#pragma unroll
            for (int j = 0; j < 4; ++j) {
                const unsigned yq = __builtin_nontemporal_load((const unsigned*)(Y8 + (size_t)rowi[j] * D + 256 * i + 4 * lane));
                const float s = ysc[j][i >> 2][i & 3];
                const auto lo = __builtin_amdgcn_cvt_pk_f32_fp8((int)yq, false), hi = __builtin_amdgcn_cvt_pk_f32_fp8((int)yq, true);
                hv[i][0] += lo[0] * s; hv[i][1] += lo[1] * s; hv[i][2] += hi[0] * s; hv[i][3] += hi[1] * s;
            }
#pragma unroll
            for (int c = 0; c < 4; ++c) ss += hv[i][c] * hv[i][c];
        }
        ss = wave_sum(ss);
        const float r = rsqrtf(ss * (1.0f / D) + EPS);
#pragma unroll
        for (int i = 0; i < 8; ++i) {
            const f32x4 g = *(const f32x4*)(fg + 256 * i + 4 * lane);
            f32x4 o;
#pragma unroll
            for (int c = 0; c < 4; ++c) o[c] = hv[i][c] * r * g[c];
            __builtin_nontemporal_store(o, (f32x4*)(a.out + (size_t)tok * D + 256 * i + 4 * lane));
        }
    }
}

DEVI void warm_code(unsigned long long pc, unsigned dlo, unsigned dhi, unsigned len, int wid_s) {
    if (wid_s != 7 || len > 131072u) return;
    const unsigned long long base = (pc + (((unsigned long long)dhi << 32) | dlo)) & ~127ull;
    const unsigned nl = (len + 255u) >> 7;
    for (unsigned i = blockIdx.x >> 3; i < nl; i += gridDim.x >> 3) {
        unsigned t; asm volatile("s_load_dword %0, %1, 0x0" : "=s"(t) : "s"(base + (unsigned long long)i * 128ull));
    }
    asm volatile("s_waitcnt lgkmcnt(0)" ::: "memory");
}
constexpr int NPHASE = 11;
__global__ void __launch_bounds__(512, 2) mega_fwd(Args a) {
    extern __shared__ __attribute__((aligned(1024))) char smem[];
    const int wid_s = __builtin_amdgcn_readfirstlane((int)threadIdx.x >> 6);
    if (threadIdx.x == 0) *(uint4*)smem = make_uint4(0u, 0u, 0u, 0u);
    __syncthreads();
    XcdBarrier bar = xcd_barrier_post((unsigned*)(a.ws + WS_BAR), (volatile LAS unsigned*)smem);
    char* lds = smem + LDS_BASE;
    MoeTab* tb = (MoeTab*)(smem + 64);
#ifndef REP_MASK
#define REP_MASK 0
#endif
#define PHASE(k, k1, call) if (a.ph_lo <= (k) && (k) < a.ph_hi) { if (a.ph_lo < (k)) { \
        unsigned long long pc_; unsigned dlo_, dhi_, len_; \
        asm volatile("s_getpc_b64 %0\n.Lmkw" #k ":\n\ts_mov_b32 %1, (.Lmkph" #k "-.Lmkw" #k ")&4294967295\n\ts_mov_b32 %2, (.Lmkph" #k "-.Lmkw" #k ")>>32\n\ts_mov_b32 %3, (.Lmkph" #k1 "-.Lmkph" #k ")&4294967295" \
                     : "=s"(pc_), "=s"(dlo_), "=s"(dhi_), "=s"(len_)); \
        warm_code(pc_, dlo_, dhi_, len_, wid_s); xcd_barrier(bar); } \
        asm volatile(".Lmkph" #k ":"); \
        int lane = (int)__builtin_amdgcn_mbcnt_hi(~0u, __builtin_amdgcn_mbcnt_lo(~0u, 0u)); asm volatile("" : "+v"(lane)); \
        const int wid = wid_s, tid = wid_s * 64 + lane; \
        call; if ((REP_MASK >> (k)) & 1) { __syncthreads(); call; } }
    PHASE(0, 1, phase0(a, lds, tid, wid, lane))
    PHASE(1, 2, phase1(a, lds, tid, wid, lane))
    PHASE(2, 3, phase2(a, lds, tid, wid, lane))
    PHASE(3, 4, phase3(a, tid))
    PHASE(4, 5, phase4(a, lds, tid, wid, lane))
    PHASE(5, 6, phase5(a, lds, tid, wid, lane))
    PHASE(6, 7, phase6(a, lds, tid, wid, lane))
    PHASE(7, 8, phase7(a, lds, tid, wid, lane))
    PHASE(8, 9, phase8(a, lds, tb, tid, wid, lane))
    PHASE(9, 10, phase9(a, lds, tb, tid, wid, lane))
    PHASE(10, 11, phase10(a, tb, tid, wid, lane))
    asm volatile(".Lmkph11:");
#undef PHASE
}

extern "C" void kernel_launch(void* const* d_in, const int* in_sizes, int n_in, void* d_out, int out_size, void* d_ws, size_t ws_size, hipStream_t stream) {
    static int grid = 0;
    if (grid == 0) {
        if (n_in != 26 || out_size != T * D || ws_size < WS_END) { fprintf(stderr, "kernel_launch: unexpected shapes (n_in %d out %d ws %zu need %zu)\n", n_in, out_size, ws_size, (size_t)WS_END); grid = -1; return; }
        int dev = 0, cus = 0, per_cu = 0;
        if (hipGetDevice(&dev) != hipSuccess || hipDeviceGetAttribute(&cus, hipDeviceAttributeMultiprocessorCount, dev) != hipSuccess) { grid = -1; return; }
        if (hipFuncSetAttribute((const void*)mega_fwd, hipFuncAttributeMaxDynamicSharedMemorySize, LDS_BYTES) != hipSuccess) { fprintf(stderr, "kernel_launch: hipFuncSetAttribute failed\n"); grid = -1; return; }
        if (hipOccupancyMaxActiveBlocksPerMultiprocessor(&per_cu, (const void*)mega_fwd, 512, LDS_BYTES) != hipSuccess || per_cu < 1)
            fprintf(stderr, "kernel_launch: occupancy query reports %d blocks per CU\n", per_cu);
        (void)hipGetLastError();
        if (cus < 256) { fprintf(stderr, "kernel_launch: %d CUs, the work dealing needs 256 co-resident workgroups\n", cus); grid = -1; return; }
        grid = 256;
    }
    if (grid < 0) return;
    Args a{};
    for (int i = 0; i < 26; ++i) a.in[i] = (const float*)d_in[i];
    a.out = (float*)d_out; a.ws = (unsigned char*)d_ws;
#if N_LAUNCH_SPLIT
    for (int k = 0; k < NPHASE; ++k) {
        (void)hipMemsetAsync((char*)d_ws + WS_BAR, 0, XCD_BAR_WORDS * sizeof(unsigned), stream);
        a.ph_lo = k; a.ph_hi = k + 1;
        hipLaunchKernelGGL(mega_fwd, dim3(grid), dim3(512), LDS_BYTES, stream, a);
    }
#else
    (void)hipMemsetAsync((char*)d_ws + WS_BAR, 0, XCD_BAR_WORDS * sizeof(unsigned), stream);
    a.ph_lo = 0; a.ph_hi = NPHASE;
    hipLaunchKernelGGL(mega_fwd, dim3(grid), dim3(512), LDS_BYTES, stream, a);
#endif
}
```
